# Optimizing an MI355X kernel written in HIP

```python
import math
import jax
import jax.numpy as jnp
from jax import lax
import numpy as np

D_MODEL = 1024
BATCH = 8
SEQ = 2048
DEPTH = 4

CTX_LEN = 256
GRID_W = 64

RET_HEADS = 4
RET_DK = 128
RET_DV = 128
RET_CHUNK = 128
WIN_HEADS = 8
WIN_KV_HEADS = 2
WIN_HD = 64
WINDOW = 128
WIN_BLOCK = 128
NA_HEADS = 8
NA_HD = 64
NA_ROWS_MAX = 8
NA_COLS = 16

BRANCH_W = 512
N_BRANCH = 3
D_FF_DENSE = 2816
N_EXPERTS = 8
TOP_K = 2
D_FF_EXPERT = 3584
ROPE_BASE = 10000.0
NORM_EPS = 1e-6
NEG_INF = -1e30

IN_SPLIT = (
    RET_HEADS * RET_DK,
    RET_HEADS * RET_DK,
    RET_HEADS * RET_DV,
    RET_HEADS * RET_DV,
    WIN_HEADS * WIN_HD,
    WIN_KV_HEADS * WIN_HD,
    WIN_KV_HEADS * WIN_HD,
    NA_HEADS * NA_HD,
    NA_HEADS * NA_HD,
    NA_HEADS * NA_HD,
    N_BRANCH * D_MODEL,
)
D_IN = sum(IN_SPLIT)

kernel_name = "hybrid_flow_backbone_ret_win_na_moe"


def rms_norm(x, g):
    xf = x.astype(jnp.float32)
    y = xf * lax.rsqrt(jnp.mean(xf * xf, axis=-1, keepdims=True) + NORM_EPS)
    return (y * g.astype(jnp.float32)).astype(x.dtype)


def split_cols(a):
    idx = [int(v) for v in np.cumsum(IN_SPLIT)[:-1]]
    return jnp.split(a, idx, axis=-1)


def heads(t, n):
    return t.reshape(t.shape[:2] + (n, -1))


def axial_angles(n_tok, head_dim):
    t = jnp.arange(n_tok)
    n_freq = head_dim // 4
    inv = ROPE_BASE ** (-jnp.arange(n_freq, dtype=jnp.float32) / n_freq)
    row = (t // GRID_W).astype(jnp.float32)[:, None] * inv
    col = (t % GRID_W).astype(jnp.float32)[:, None] * inv
    return jnp.concatenate([row, col], axis=-1)


def linear_angles(pos, head_dim):
    n_freq = head_dim // 2
    inv = ROPE_BASE ** (-jnp.arange(n_freq, dtype=jnp.float32) / n_freq)
    return pos.astype(jnp.float32)[:, None] * inv


def apply_rope(x, angles):
    cos = jnp.cos(angles)[:, None, :]
    sin = jnp.sin(angles)[:, None, :]
    x1, x2 = jnp.split(x.astype(jnp.float32), 2, axis=-1)
    return jnp.concatenate([x1 * cos - x2 * sin, x1 * sin + x2 * cos], axis=-1).astype(x.dtype)


def sink_softmax(logits, sink):
    full = jnp.concatenate([jnp.broadcast_to(sink, logits.shape[:-1] + (1,)), logits], axis=-1)
    return jax.nn.softmax(full, axis=-1)[..., 1:]


def retention_scan(q, k, v, log_gamma, state0, inclusive):
    B, H, L, dk = q.shape
    dv = v.shape[-1]
    C = RET_CHUNK
    nc = L // C
    qc = q.reshape(B, H, nc, C, dk)
    kc = k.reshape(B, H, nc, C, dk)
    vc = v.reshape(B, H, nc, C, dv)
    i = jnp.arange(C, dtype=jnp.float32)
    diff = i[:, None] - i[None, :]
    mask = (diff >= 0) if inclusive else (diff > 0)
    lg = log_gamma[:, None, None]
    d_intra = jnp.where(mask, jnp.exp(lg * jnp.where(mask, diff, 0.0)), 0.0)
    scores = jnp.einsum('bhncd,bhnsd->bhncs', qc, kc) * d_intra[None, :, None]
    y = jnp.einsum('bhncs,bhnse->bhnce', scores, vc)
    lg2 = log_gamma[:, None]
    q_dec = jnp.exp(lg2 * (i + 1.0))
    k_dec = jnp.exp(lg2 * (C - 1.0 - i))
    chunk_dec = jnp.exp(log_gamma * C)[None, :, None, None]
    kv = jnp.einsum('bhncd,bhnce->nbhde', kc * k_dec[None, :, None, :, None], vc)

    def step(s, kv_n):
        return s * chunk_dec + kv_n, s

    _, s_prev = lax.scan(step, state0, kv)
    y = y + jnp.einsum('bhncd,nbhde->bhnce', qc * q_dec[None, :, None, :, None], s_prev)
    return y.reshape(B, H, L, dv)


def retention_final_state(k, v, log_gamma):
    L = k.shape[2]
    w = jnp.exp(log_gamma[:, None] * (L - 1.0 - jnp.arange(L, dtype=jnp.float32)))
    return jnp.einsum('bhld,bhle->bhde', k * w[None, :, :, None], v)


def bidir_retention(q, k, v, log_gamma, state_f, state_b):
    flip = lambda a: jnp.flip(a, axis=2)
    y_f = retention_scan(q, k, v, log_gamma[0], state_f, True)
    y_b = flip(retention_scan(flip(q), flip(k), flip(v), log_gamma[1], state_b, False))
    return y_f + y_b


def retention_out(y, g):
    B, H, L, dv = y.shape
    mu = jnp.mean(y, axis=-1, keepdims=True)
    var = jnp.mean(jnp.square(y - mu), axis=-1, keepdims=True)
    yn = (y - mu) * lax.rsqrt(var + NORM_EPS)
    yn = jnp.swapaxes(yn, 1, 2).reshape(B, L, H * dv)
    return (jax.nn.silu(g.astype(jnp.float32)) * yn).astype(g.dtype)


def window_attention(q, k, v, k_c, v_c, sink):
    B, S, _, hd = q.shape
    G = WIN_HEADS // WIN_KV_HEADS
    nb = S // WIN_BLOCK
    qb = q.reshape(B, nb, WIN_BLOCK, WIN_KV_HEADS, G, hd)

    def band(a):
        ap = jnp.pad(a, ((0, 0), (WIN_BLOCK, WIN_BLOCK), (0, 0), (0, 0)))
        ap = ap.reshape(B, nb + 2, WIN_BLOCK, WIN_KV_HEADS, hd)
        return jnp.concatenate([ap[:, :-2], ap[:, 1:-1], ap[:, 2:]], axis=2)

    kw, vw = band(k), band(v)
    scale = hd ** -0.5
    s_win = jnp.einsum('bnqkgd,bnskd->bnkgqs', qb, kw, preferred_element_type=jnp.float32) * scale
    qpos = (jnp.arange(nb)[:, None] * WIN_BLOCK + jnp.arange(WIN_BLOCK))[:, :, None]
    kpos = (jnp.arange(nb)[:, None] * WIN_BLOCK - WIN_BLOCK + jnp.arange(3 * WIN_BLOCK))[:, None, :]
    valid = (kpos >= 0) & (kpos < S) & (jnp.abs(qpos - kpos) <= WINDOW)
    s_win = jnp.where(valid[None, :, None, None], s_win, NEG_INF)
    s_ctx = jnp.einsum('bnqkgd,bckd->bnkgqc', qb, k_c, preferred_element_type=jnp.float32) * scale
    sink_b = sink.astype(jnp.float32).reshape(WIN_KV_HEADS, G, 1, 1)
    p = sink_softmax(jnp.concatenate([s_win, s_ctx], axis=-1), sink_b)
    nw = 3 * WIN_BLOCK
    y = (jnp.einsum('bnkgqs,bnskd->bnqkgd', p[..., :nw].astype(v.dtype), vw)
         + jnp.einsum('bnkgqc,bckd->bnqkgd', p[..., nw:].astype(v.dtype), v_c))
    return y.reshape(B, S, WIN_HEADS * hd)


def neighbourhood_attention(q, k, v, k_c, v_c, rpb):
    B, S, H, hd = q.shape
    rows = S // GRID_W
    kr = min(NA_ROWS_MAX, rows)
    r = jnp.arange(rows)
    row_idx = jnp.clip(r - kr // 2, 0, rows - kr)[:, None] + jnp.arange(kr)
    cq = jnp.arange(GRID_W)
    c_start = jnp.clip(cq - NA_COLS // 2, 0, GRID_W - NA_COLS)
    ck = jnp.arange(GRID_W)
    col_ok = (ck[None, :] >= c_start[:, None]) & (ck[None, :] < c_start[:, None] + NA_COLS)
    qg = q.reshape(B, rows, GRID_W, H, hd)
    kg = k.reshape(B, rows, GRID_W, H, hd)[:, row_idx]
    vg = v.reshape(B, rows, GRID_W, H, hd)[:, row_idx]
    scale = hd ** -0.5
    s_nb = jnp.einsum('brqhd,brjkhd->bhrqjk', qg, kg, preferred_element_type=jnp.float32) * scale
    dr = row_idx - r[:, None] + (NA_ROWS_MAX - 1)
    dc = jnp.clip(ck[None, :] - cq[:, None] + (NA_COLS - 1), 0, 2 * NA_COLS - 2)
    bias = rpb.astype(jnp.float32)[:, dr[:, None, :, None], dc[None, :, None, :]]
    s_nb = jnp.where(col_ok[:, None, :], s_nb + bias, NEG_INF)
    s_ctx = jnp.einsum('brqhd,bchd->bhrqc', qg, k_c, preferred_element_type=jnp.float32) * scale
    n_nb = kr * GRID_W
    p = jax.nn.softmax(jnp.concatenate([s_nb.reshape(B, H, rows, GRID_W, n_nb), s_ctx], axis=-1), axis=-1)
    p_nb = p[..., :n_nb].reshape(B, H, rows, GRID_W, kr, GRID_W).astype(v.dtype)
    y = (jnp.einsum('bhrqjk,brjkhd->brqhd', p_nb, vg)
         + jnp.einsum('bhrqc,bchd->brqhd', p[..., n_nb:].astype(v.dtype), v_c))
    return y.reshape(B, S, H * hd)


def context_attention(q, k, v, sink):
    B, L = q.shape[:2]
    s = jnp.einsum('bqkgd,bskd->bkgqs', q, k, preferred_element_type=jnp.float32) * q.shape[-1] ** -0.5
    p = jax.nn.softmax(s, axis=-1) if sink is None else sink_softmax(s, sink)
    y = jnp.einsum('bkgqs,bskd->bqkgd', p.astype(v.dtype), v)
    return y.reshape(B, L, -1)


def merge_branches(ys, gate_cols, w_branch, w_out):
    y = jnp.stack(ys, axis=2)
    z = jnp.einsum('blre,red->blrd', y, w_branch)
    g = jax.nn.sigmoid(gate_cols.reshape(gate_cols.shape[:2] + (N_BRANCH, D_MODEL)))
    return jnp.sum(g * z, axis=2) @ w_out


def token_mixing(a_l, a_c, w_in, ret_decay, win_sink, na_rpb, w_branch, w_out,
                 ang_ret_l, ang_ret_c, ang_ax, need_ctx):
    B, S, _ = a_l.shape
    Lc = a_c.shape[1]
    rq, rk, rv, rg, wq, wk, wv, nq, nk, nv, gate = split_cols(a_l @ w_in)
    rq_c, rk_c, rv_c, rg_c, wq_c, wk_c, wv_c, nq_c, nk_c, nv_c, gate_c = split_cols(a_c @ w_in)

    log_gamma = jnp.log1p(-jnp.exp(ret_decay.astype(jnp.float32)))

    def ret_in(q, k, v, ang):
        q = apply_rope(heads(q, RET_HEADS), ang) * RET_DK ** -0.5
        k = apply_rope(heads(k, RET_HEADS), ang)
        v = heads(v, RET_HEADS)
        return (jnp.swapaxes(q, 1, 2).astype(jnp.float32), jnp.swapaxes(k, 1, 2).astype(jnp.float32),
                jnp.swapaxes(v, 1, 2).astype(jnp.float32))

    q_l, k_l, v_l = ret_in(rq, rk, rv, ang_ret_l)
    q_c, k_c, v_c = ret_in(rq_c, rk_c, rv_c, ang_ret_c)
    s_f = retention_final_state(k_c, v_c, log_gamma[0])
    s_b = retention_final_state(jnp.flip(k_c, 2), jnp.flip(v_c, 2), log_gamma[1])
    y_ret = retention_out(bidir_retention(q_l, k_l, v_l, log_gamma, s_f, s_b), rg)

    wk_ch = heads(wk_c, WIN_KV_HEADS)
    wv_ch = heads(wv_c, WIN_KV_HEADS)
    y_win = window_attention(apply_rope(heads(wq, WIN_HEADS), ang_ax),
                             apply_rope(heads(wk, WIN_KV_HEADS), ang_ax),
                             heads(wv, WIN_KV_HEADS), wk_ch, wv_ch, win_sink)

    nk_ch = heads(nk_c, NA_HEADS)
    nv_ch = heads(nv_c, NA_HEADS)
    y_na = neighbourhood_attention(heads(nq, NA_HEADS), heads(nk, NA_HEADS), heads(nv, NA_HEADS),
                                   nk_ch, nv_ch, na_rpb)

    y_l = merge_branches([y_ret, y_win.astype(a_l.dtype), y_na.astype(a_l.dtype)], gate, w_branch, w_out)
    if not need_ctx:
        return y_l, None

    zero = jnp.zeros_like(s_f)
    yc_ret = retention_out(bidir_retention(q_c, k_c, v_c, log_gamma, zero, zero), rg_c)
    G = WIN_HEADS // WIN_KV_HEADS
    yc_win = context_attention(heads(wq_c, WIN_HEADS).reshape(B, Lc, WIN_KV_HEADS, G, WIN_HD), wk_ch, wv_ch,
                               win_sink.astype(jnp.float32).reshape(WIN_KV_HEADS, G, 1, 1))
    yc_na = context_attention(heads(nq_c, NA_HEADS)[:, :, :, None, :], nk_ch, nv_ch, None)
    y_c = merge_branches([yc_ret, yc_win.astype(a_c.dtype), yc_na.astype(a_c.dtype)], gate_c, w_branch, w_out)
    return y_l, y_c


def swiglu(x, w1, w3, w2):
    return (jax.nn.silu(x @ w1) * (x @ w3)) @ w2


def moe_ffn(x, w_router, w1, w3, w2):
    logits = jnp.einsum('bld,de->ble', x, w_router, preferred_element_type=jnp.float32)
    top_val, top_idx = lax.top_k(logits, TOP_K)
    top_w = jax.nn.softmax(top_val, axis=-1)
    gates = jnp.sum(jax.nn.one_hot(top_idx, N_EXPERTS, dtype=jnp.float32) * top_w[..., None], axis=-2)
    y = jnp.zeros_like(x)
    for e in range(N_EXPERTS):
        y = y + gates[..., e:e + 1].astype(x.dtype) * swiglu(x, w1[e], w3[e], w2[e])
    return y


def channel_mixer(a, layer, ffn_w1, ffn_w3, ffn_w2, moe_router, moe_w1, moe_w3, moe_w2):
    i = layer // 2
    if layer % 2 == 0:
        return swiglu(a, ffn_w1[i], ffn_w3[i], ffn_w2[i])
    return moe_ffn(a, moe_router[i], moe_w1[i], moe_w3[i], moe_w2[i])


def setup_inputs(seed: int = 0) -> dict:
    key = jax.random.key(seed)
    ks = jax.random.split(key, 24)
    f32 = jnp.float32
    D = D_MODEL
    nd = (DEPTH + 1) // 2
    nm = DEPTH // 2

    def normal(k, shape, scale):
        return jax.random.normal(k, shape, f32) * scale

    base_decay = jnp.linspace(math.log(1.0 / 32.0), math.log(1.0 / 512.0), RET_HEADS).astype(f32)
    return {
        "x": normal(ks[0], (BATCH, SEQ, D), 1.0),
        "c": normal(ks[1], (BATCH, D), 1.0),
        "ctx": normal(ks[2], (BATCH, CTX_LEN, D), 1.0),
        "c_ctx": normal(ks[3], (D,), 1.0),
        "w_mod": normal(ks[4], (DEPTH, D, 6 * D), 0.5 * D ** -0.5),
        "b_mod": normal(ks[5], (DEPTH, 6 * D), 0.02),
        "norm_gains": 1.0 + normal(ks[6], (DEPTH, 4, D), 0.05),
        "w_in": normal(ks[7], (DEPTH, D, D_IN), D ** -0.5),
        "ret_decay": base_decay + normal(ks[8], (DEPTH, 2, RET_HEADS), 0.1),
        "win_sink": normal(ks[9], (DEPTH, WIN_HEADS), 0.5),
        "na_rpb": normal(ks[10], (DEPTH, NA_HEADS, 2 * NA_ROWS_MAX - 1, 2 * NA_COLS - 1), 0.2),
        "w_branch": normal(ks[11], (DEPTH, N_BRANCH, BRANCH_W, D), BRANCH_W ** -0.5),
        "w_out": normal(ks[12], (DEPTH, D, D), D ** -0.5),
        "ffn_w1": normal(ks[13], (nd, D, D_FF_DENSE), D ** -0.5),
        "ffn_w3": normal(ks[14], (nd, D, D_FF_DENSE), D ** -0.5),
        "ffn_w2": normal(ks[15], (nd, D_FF_DENSE, D), D_FF_DENSE ** -0.5),
        "moe_router": normal(ks[16], (nm, D, N_EXPERTS), D ** -0.5),
        "moe_w1": normal(ks[17], (nm, N_EXPERTS, D, D_FF_EXPERT), D ** -0.5),
        "moe_w3": normal(ks[18], (nm, N_EXPERTS, D, D_FF_EXPERT), D ** -0.5),
        "moe_w2": normal(ks[19], (nm, N_EXPERTS, D_FF_EXPERT, D), D_FF_EXPERT ** -0.5),
    }


def reference(x, c, ctx, c_ctx, w_mod, b_mod, norm_gains, w_in, ret_decay, win_sink, na_rpb,
              w_branch, w_out, ffn_w1, ffn_w3, ffn_w2, moe_router, moe_w1, moe_w3, moe_w2):
    B, S, D = x.shape
    Lc = ctx.shape[1]
    ang_ax = axial_angles(S, WIN_HD)
    ang_ret_c = linear_angles(jnp.arange(Lc), RET_DK)
    ang_ret_l = linear_angles(Lc + jnp.arange(S), RET_DK)
    h, hc = x, ctx
    for layer in range(DEPTH):
        need_ctx = layer < DEPTH - 1
        g = norm_gains[layer]
        mod_l = (jax.nn.silu(c) @ w_mod[layer] + b_mod[layer]).reshape(B, 6, D)
        mod_c = (jax.nn.silu(c_ctx) @ w_mod[layer] + b_mod[layer]).reshape(6, D)
        ml = [mod_l[:, j, None, :] for j in range(6)]
        mc = [mod_c[j] for j in range(6)]

        a_l = rms_norm(h, g[0]) * (1.0 + ml[1]) + ml[0]
        a_c = rms_norm(hc, g[0]) * (1.0 + mc[1]) + mc[0]
        y_l, y_c = token_mixing(a_l, a_c, w_in[layer], ret_decay[layer], win_sink[layer], na_rpb[layer],
                                w_branch[layer], w_out[layer], ang_ret_l, ang_ret_c, ang_ax, need_ctx)
        h = h + ml[2] * rms_norm(y_l, g[1])
        if need_ctx:
            hc = hc + mc[2] * rms_norm(y_c, g[1])

        f_l = rms_norm(h, g[2]) * (1.0 + ml[4]) + ml[3]
        h = h + ml[5] * rms_norm(channel_mixer(f_l, layer, ffn_w1, ffn_w3, ffn_w2,
                                               moe_router, moe_w1, moe_w3, moe_w2), g[3])
        if need_ctx:
            f_c = rms_norm(hc, g[2]) * (1.0 + mc[4]) + mc[3]
            hc = hc + mc[5] * rms_norm(channel_mixer(f_c, layer, ffn_w1, ffn_w3, ffn_w2,
                                                     moe_router, moe_w1, moe_w3, moe_w2), g[3])
    return h
```

```cpp
#include <hip/hip_runtime.h>
#include <cstdio>
#include <cstdint>
#include <cmath>
#define LAS __attribute__((address_space(3)))
namespace pg8 {
#define PG8_LAS __attribute__((address_space(3)))
typedef unsigned short bf16_t;
typedef short bf16x8 __attribute__((ext_vector_type(8)));
typedef float f32x4 __attribute__((ext_vector_type(4)));
typedef unsigned u32x4 __attribute__((ext_vector_type(4)));
constexpr int BM = 256, BK = 64, HALF = 128, HTB = HALF * BK * 2  , STAGE_BYTES = 8 * HTB, NXCD = 8, WGM = 8;

__host__ __device__ __forceinline__ int lds_byte(int r, int c) { const int st = (r >> 4) * 2 + (c >> 5), rr = r & 15, cc = c & 31, ob = rr * 64 + cc * 2; return st * 1024 + (ob ^ (((ob >> 9) & 1) << 5)); }
__host__ __device__ __forceinline__ void stage_rc(int b, int& R, int& C) { const int st = b / 1024, sb = b % 1024, swz = sb ^ (((sb >> 9) & 1) << 5); R = (st >> 1) * 16 + swz / 64; C = (st & 1) * 32 + (swz % 64) / 2; }
__host__ __device__ __forceinline__ int perm32(int rho) { const int n = rho >> 4, i = rho & 15; return 8 * (i >> 2) + 4 * n + (i & 3); }

typedef int v8i32 __attribute__((ext_vector_type(8))); typedef int v4i32 __attribute__((ext_vector_type(4)));
__device__ __forceinline__ v8i32 pg8_cat(bf16x8 lo, bf16x8 hi) { return __builtin_shufflevector(__builtin_bit_cast(v4i32, lo), __builtin_bit_cast(v4i32, hi), 0, 1, 2, 3, 4, 5, 6, 7); }
struct Unit { int pm, pn; };
struct Gemm { const bf16_t* A; const bf16_t* Bt; int M, N, K; };

struct StaticOrder {
    int nM, nN, nwg, G, c;
    __host__ __device__ void init(int M, int N, int G_, int c_) { nM = M / BM; nN = N / BM; nwg = nM * nN; G = G_; c = c_; }
    __host__ __device__ bool next(int i, Unit& u) const { return next_at((long)i * G + c, u); }
    __host__ __device__ bool next_at(long L, Unit& u) const {
        if (L >= nwg) return false;
        int wgid = (int)L; { const int q = nwg / NXCD, r = nwg % NXCD, xcd = wgid % NXCD, off = wgid / NXCD; wgid = (xcd < r ? xcd * (q + 1) : r * (q + 1) + (xcd - r) * q) + off; }
        const int nig = WGM * nN, gid = wgid / nig, fm = gid * WGM, gsz = (nM - fm) < WGM ? (nM - fm) : WGM;
        u.pm = fm + ((wgid % nig) % gsz); u.pn = (wgid % nig) / gsz; return true;
    }
    __device__ __forceinline__ void a_ready(const Unit&) const {}
    __device__ __forceinline__ void done(const Unit&) const {}
};

typedef float f32x2_t __attribute__((ext_vector_type(2))); typedef __bf16 bf16x2_t __attribute__((ext_vector_type(2)));
__device__ __forceinline__ unsigned cvt_pk_bf16(float lo, float hi) { const f32x2_t v = {lo, hi}; const bf16x2_t b = __builtin_convertvector(v, bf16x2_t); return __builtin_bit_cast(unsigned, b); }
typedef float f32x2 __attribute__((ext_vector_type(2)));

struct BranchOrder {
    int nT, G, c;
    __device__ __forceinline__ bool next(int i, Unit& u) const {
        const int rd = i / 3, r = i - rd * 3; const int t = rd * G + c; if (t >= nT) return false;
        u.pm = r * 72 + (t >> 2); u.pn = r * 4 + (t & 3); return true;
    }
    __device__ __forceinline__ void a_ready(const Unit&) const {}
    __device__ __forceinline__ void done(const Unit&) const {}
};
struct PartOrder {
    int G, c;
    __device__ __forceinline__ bool next(int i, Unit& u) const {
        const int j = i * G + c; if (j >= 96) return false;
        const int r = j >> 5, t = j & 31; u.pm = r * 72 + 64 + (t >> 2); u.pn = r * 4 + (t & 3); return true;
    }
    __device__ __forceinline__ void a_ready(const Unit&) const {}
    __device__ __forceinline__ void done(const Unit&) const {}
};
struct MoeOrder {
    int nM, nN, nwg, G, c; int ts[9];
    __device__ __forceinline__ void init(const unsigned* cnt, int nN_, int G_, int c_) {
        int acc = 0;
#pragma unroll
        for (int e = 0; e < 8; ++e) { ts[e] = acc; const unsigned ce = __hip_atomic_load(cnt + 64 * e, __ATOMIC_RELAXED, __HIP_MEMORY_SCOPE_AGENT); acc += (int)((ce + 255u) >> 8); }
        ts[8] = acc; nM = acc; nN = nN_; nwg = nM * nN; G = G_; c = c_;
    }
    __device__ __forceinline__ bool next(int i, Unit& u) const {
        const long L = (long)i * G + c; if (L >= nwg) return false;
        int wgid = (int)L; { const int q = nwg / NXCD, r = nwg % NXCD, xcd = wgid % NXCD, off = wgid / NXCD; wgid = (xcd < r ? xcd * (q + 1) : r * (q + 1) + (xcd - r) * q) + off; }
        const int nig = WGM * nN, gid = wgid / nig, fm = gid * WGM, gsz = (nM - fm) < WGM ? (nM - fm) : WGM;
        const int pm = fm + ((wgid % nig) % gsz), pnt = (wgid % nig) / gsz;
        int e = 0;
#pragma unroll
        for (int k = 1; k < 8; ++k) e += (pm >= ts[k]) ? 1 : 0;
        u.pm = pm; u.pn = e * nN + pnt; return true;
    }
    __device__ __forceinline__ void a_ready(const Unit&) const {}
    __device__ __forceinline__ void done(const Unit&) const {}
};


struct TailOrder : StaticOrder {
    int cut, base;
    __device__ __forceinline__ bool next(int i, Unit& u) const {
        long L;
        if (i < base) L = (long)i * G + c; else { if (c < cut) return false; L = (long)base * G + (long)(i - base) * (G - cut) + (c - cut); }
        if (L >= nwg) return false;
        return next_at(L, u);
    }
};
__device__ __forceinline__ void store8(bf16_t* p, const f32x4 a, const f32x4 b) {
    u32x4 w; w.x = cvt_pk_bf16(a[0], a[1]); w.y = cvt_pk_bf16(a[2], a[3]); w.z = cvt_pk_bf16(b[0], b[1]); w.w = cvt_pk_bf16(b[2], b[3]); *(u32x4*)p = w;
}
__device__ __forceinline__ float sigm(float x) { return __builtin_amdgcn_rcpf(1.0f + __expf(-x)); }
__device__ __forceinline__ f32x4 sigm4(f32x4 v) { f32x4 o; o[0] = sigm(v[0]); o[1] = sigm(v[1]); o[2] = sigm(v[2]); o[3] = sigm(v[3]); return o; }

struct EpiPlain {
    static constexpr bool PERM = true, AFTER_DRAIN = false, KEEP_ACC = false;
    bf16_t* O; int ldc; int pn_mod; float scale;
    __device__ __forceinline__ void operator()(const f32x4 (&acc)[2][2][4][2], const Unit& u, int wr, int wc, int fr, int fq) const {
        const int row0 = u.pm * BM + wr * 64 + fr, col0 = (u.pn % pn_mod) * BM + wc * 32 + 8 * fq;
#pragma unroll
        for (int ai = 0; ai < 2; ++ai)
#pragma unroll
            for (int m = 0; m < 4; ++m) { bf16_t* rowp = O + (size_t)(row0 + ai * HALF + m * 16) * ldc + col0;
#pragma unroll
                for (int bj = 0; bj < 2; ++bj) store8(rowp + bj * HALF, acc[ai][bj][m][0] * scale, acc[ai][bj][m][1] * scale); }
    }
};
__device__ __forceinline__ float clamp_f8(float v) { return __builtin_amdgcn_fmed3f(v, -448.0f, 448.0f); }
__device__ __forceinline__ unsigned pk4_fp8(float a, float b, float c, float d) { a = clamp_f8(a); b = clamp_f8(b); c = clamp_f8(c); d = clamp_f8(d); unsigned w = 0; w = __builtin_amdgcn_cvt_pk_fp8_f32(a, b, w, false); w = __builtin_amdgcn_cvt_pk_fp8_f32(c, d, w, true); return w; }
typedef unsigned u32x2_t __attribute__((ext_vector_type(2)));
template <bool IN8, bool OUT8> struct EpiSwiGLUx {
    static constexpr bool PERM = true, AFTER_DRAIN = false, KEEP_ACC = false;
    unsigned char* O; int ldc; int pn_mod;
    __device__ __forceinline__ void operator()(const f32x4 (&acc)[2][2][4][2], const Unit& u, int wr, int wc, int fr, int fq) const {
        const int row0 = u.pm * BM + wr * 64 + fr, col0 = (u.pn % pn_mod) * HALF + wc * 32 + 8 * fq;
        constexpr float s1 = IN8 ? 0.015625f : 1.0f, s3 = (IN8 ? 0.015625f : 1.0f) * (OUT8 ? 16.0f : 1.0f);
#pragma unroll
        for (int ai = 0; ai < 2; ++ai) {
#pragma unroll
            for (int m = 0; m < 4; ++m) {
                const size_t eoff = (size_t)(row0 + ai * HALF + m * 16) * ldc + col0;
                constexpr float k1 = -1.4426950408889634f * s1, ic = 1.0f / (s1 * s3);
                const f32x4 g0 = acc[ai][0][m][0], g1 = acc[ai][0][m][1];
                const f32x4 t0 = g0 * k1, t1 = g1 * k1; f32x4 e0, e1;
                e0[0] = __builtin_amdgcn_exp2f(t0[0]); e0[1] = __builtin_amdgcn_exp2f(t0[1]); e0[2] = __builtin_amdgcn_exp2f(t0[2]); e0[3] = __builtin_amdgcn_exp2f(t0[3]);
                e1[0] = __builtin_amdgcn_exp2f(t1[0]); e1[1] = __builtin_amdgcn_exp2f(t1[1]); e1[2] = __builtin_amdgcn_exp2f(t1[2]); e1[3] = __builtin_amdgcn_exp2f(t1[3]);
                const f32x4 d0 = e0 * ic + ic, d1 = e1 * ic + ic; f32x4 r0, r1;
                r0[0] = __builtin_amdgcn_rcpf(d0[0]); r0[1] = __builtin_amdgcn_rcpf(d0[1]); r0[2] = __builtin_amdgcn_rcpf(d0[2]); r0[3] = __builtin_amdgcn_rcpf(d0[3]);
                r1[0] = __builtin_amdgcn_rcpf(d1[0]); r1[1] = __builtin_amdgcn_rcpf(d1[1]); r1[2] = __builtin_amdgcn_rcpf(d1[2]); r1[3] = __builtin_amdgcn_rcpf(d1[3]);
                const f32x4 v0 = (g0 * acc[ai][1][m][0]) * r0, v1 = (g1 * acc[ai][1][m][1]) * r1;
                if constexpr (OUT8) { u32x2_t w; w.x = pk4_fp8(v0[0], v0[1], v0[2], v0[3]); w.y = pk4_fp8(v1[0], v1[1], v1[2], v1[3]); *(u32x2_t*)(O + eoff) = w; }
                else store8((bf16_t*)O + eoff, v0, v1);
            }
        }
    }
};
struct EpiBranch {
    static constexpr bool PERM = true, AFTER_DRAIN = false, KEEP_ACC = true;
    const unsigned char* P;
    bf16_t* Mg;
    static __device__ __forceinline__ void unpack8(const u32x2_t g, f32x4& g0, f32x4& g1) {
        constexpr float s = 1.0f / 255.0f;
        g0[0] = (float)(g.x & 0xffu) * s; g0[1] = (float)((g.x >> 8) & 0xffu) * s; g0[2] = (float)((g.x >> 16) & 0xffu) * s; g0[3] = (float)(g.x >> 24) * s;
        g1[0] = (float)(g.y & 0xffu) * s; g1[1] = (float)((g.y >> 8) & 0xffu) * s; g1[2] = (float)((g.y >> 16) & 0xffu) * s; g1[3] = (float)(g.y >> 24) * s; }
    static __device__ __forceinline__ void unpack8raw(const u32x2_t g, f32x4& g0, f32x4& g1) {
        g0[0] = (float)(g.x & 0xffu); g0[1] = (float)((g.x >> 8) & 0xffu); g0[2] = (float)((g.x >> 16) & 0xffu); g0[3] = (float)(g.x >> 24);
        g1[0] = (float)(g.y & 0xffu); g1[1] = (float)((g.y >> 8) & 0xffu); g1[2] = (float)((g.y >> 16) & 0xffu); g1[3] = (float)(g.y >> 24); }
    static __device__ __forceinline__ f32x4 clampr(f32x4 v) { f32x4 o; o[0] = fmaxf(v[0], 255e-6f); o[1] = fmaxf(v[1], 255e-6f); o[2] = fmaxf(v[2], 255e-6f); o[3] = fmaxf(v[3], 255e-6f); return o; }
    static __device__ __forceinline__ f32x4 clampg(f32x4 v) { f32x4 o; o[0] = fmaxf(v[0], 1e-6f); o[1] = fmaxf(v[1], 1e-6f); o[2] = fmaxf(v[2], 1e-6f); o[3] = fmaxf(v[3], 1e-6f); return o; }
    static __device__ __forceinline__ f32x4 rcp4(f32x4 v) { f32x4 o; o[0] = __builtin_amdgcn_rcpf(v[0]); o[1] = __builtin_amdgcn_rcpf(v[1]); o[2] = __builtin_amdgcn_rcpf(v[2]); o[3] = __builtin_amdgcn_rcpf(v[3]); return o; }
    __device__ __forceinline__ void operator()(f32x4 (&acc)[2][2][4][2], const Unit& u, int wr, int wc, int fr, int fq) const {
        const int r = u.pn >> 2, pnn = u.pn & 3, pmm = u.pm - r * 72;
        const int row0 = pmm * BM + wr * 64 + fr, col0 = pnn * BM + wc * 32 + 8 * fq;
#pragma unroll
        for (int ai = 0; ai < 2; ++ai)
#pragma unroll
            for (int m = 0; m < 4; ++m) { const size_t row = (size_t)(row0 + ai * HALF + m * 16);
#pragma unroll
                for (int bj = 0; bj < 2; ++bj) { const int col = col0 + bj * HALF;
                    const unsigned char* gp = P + row * 3072 + r * 1024 + col;
                    f32x4 a0, a1; unpack8raw(*(const u32x2_t*)gp, a0, a1);
                    if (r < 2) { f32x4 b0, b1; unpack8raw(*(const u32x2_t*)(gp + 1024), b0, b1);
                        if (r == 1) { a0 = clampr(a0); a1 = clampr(a1); }
                        acc[ai][bj][m][0] = acc[ai][bj][m][0] * (a0 * rcp4(clampr(b0))); acc[ai][bj][m][1] = acc[ai][bj][m][1] * (a1 * rcp4(clampr(b1)));
                    } else { store8(Mg + row * 1024 + col, acc[ai][bj][m][0] * (clampr(a0) * (1.0f / 255.0f)), acc[ai][bj][m][1] * (clampr(a1) * (1.0f / 255.0f)));
                        acc[ai][bj][m][0] = (f32x4){0.f, 0.f, 0.f, 0.f}; acc[ai][bj][m][1] = (f32x4){0.f, 0.f, 0.f, 0.f}; } } }
    }
};
struct EpiBranchPart {
    static constexpr bool PERM = true, AFTER_DRAIN = false, KEEP_ACC = false;
    const unsigned char* P;
    bf16_t* O;
    __device__ __forceinline__ void operator()(const f32x4 (&acc)[2][2][4][2], const Unit& u, int wr, int wc, int fr, int fq) const {
        const int r = u.pn >> 2, pnn = u.pn & 3, pmm = u.pm - r * 72;
        const int row0 = pmm * BM + wr * 64 + fr, col0 = pnn * BM + wc * 32 + 8 * fq;
#pragma unroll
        for (int ai = 0; ai < 2; ++ai)
#pragma unroll
            for (int m = 0; m < 4; ++m) { const size_t row = (size_t)(row0 + ai * HALF + m * 16);
#pragma unroll
                for (int bj = 0; bj < 2; ++bj) { const int col = col0 + bj * HALF;
                    f32x4 a0, a1; EpiBranch::unpack8(*(const u32x2_t*)(P + row * 3072 + r * 1024 + col), a0, a1);
                    store8(O + ((size_t)r * 2048 + (row - 16384)) * 1024 + col, acc[ai][bj][m][0] * a0, acc[ai][bj][m][1] * a1); } }
    }
};
struct EpiGate {
    static constexpr bool PERM = true, AFTER_DRAIN = false, KEEP_ACC = false;
    unsigned char* O;
    static __device__ __forceinline__ unsigned q4(f32x4 g) { return (unsigned)(g[0] * 255.0f + 0.5f) | ((unsigned)(g[1] * 255.0f + 0.5f) << 8) | ((unsigned)(g[2] * 255.0f + 0.5f) << 16) | ((unsigned)(g[3] * 255.0f + 0.5f) << 24); }
    static __device__ __forceinline__ unsigned g4(f32x4 a) {
        const f32x4 t = a * (-1.4426950408889634f * 0.015625f); f32x4 e;
        e[0] = __builtin_amdgcn_exp2f(t[0]); e[1] = __builtin_amdgcn_exp2f(t[1]); e[2] = __builtin_amdgcn_exp2f(t[2]); e[3] = __builtin_amdgcn_exp2f(t[3]);
        const f32x4 d = e * (1.0f / 255.0f) + (1.0f / 255.0f);
        unsigned w = 0;
        w = __builtin_amdgcn_cvt_pk_u8_f32(__builtin_amdgcn_rcpf(d[0]), 0, w); w = __builtin_amdgcn_cvt_pk_u8_f32(__builtin_amdgcn_rcpf(d[1]), 1, w);
        w = __builtin_amdgcn_cvt_pk_u8_f32(__builtin_amdgcn_rcpf(d[2]), 2, w); w = __builtin_amdgcn_cvt_pk_u8_f32(__builtin_amdgcn_rcpf(d[3]), 3, w);
        return w; }
    __device__ __forceinline__ void operator()(const f32x4 (&acc)[2][2][4][2], const Unit& u, int wr, int wc, int fr, int fq) const {
        const int row0 = u.pm * BM + wr * 64 + fr, col0 = u.pn * BM + wc * 32 + 8 * fq;
#pragma unroll
        for (int ai = 0; ai < 2; ++ai)
#pragma unroll
            for (int m = 0; m < 4; ++m) { unsigned char* rowp = O + (size_t)(row0 + ai * HALF + m * 16) * 3072 + col0;
#pragma unroll
                for (int bj = 0; bj < 2; ++bj) { u32x2_t w; w.x = g4(acc[ai][bj][m][0]); w.y = g4(acc[ai][bj][m][1]); *(u32x2_t*)(rowp + bj * HALF) = w; } }
    }
};
template <bool GATES> struct EpiInProj {
    static constexpr bool PERM = true, AFTER_DRAIN = false, KEEP_ACC = false;
    bf16_t* O; const float *rtc, *rts, *axc, *axs; float asc; int pn_off;
    __device__ __forceinline__ void operator()(const f32x4 (&acc)[2][2][4][2], const Unit& u, int wr, int wc, int fr, int fq) const {
        const int pn = u.pn + pn_off, i8 = 8 * fq;
#pragma unroll
        for (int ai = 0; ai < 2; ++ai)
#pragma unroll
            for (int m = 0; m < 4; ++m) {
                const int row = u.pm * BM + ai * HALF + wr * 64 + m * 16 + fr;
                bf16_t* rowp = O + (size_t)row * 4352;
                const f32x4 a0 = acc[ai][0][m][0] * asc, a1 = acc[ai][0][m][1] * asc, b0 = acc[ai][1][m][0] * asc, b1 = acc[ai][1][m][1] * asc;
                if (pn < 4) {
                    const int hl = wc >> 1, i = 32 * (wc & 1) + i8;
                    const int pos = row < 16384 ? 256 + (row & 2047) : ((row - 16384) & 255);
                    const f32x4 c0 = *(const f32x4*)(rtc + pos * 64 + i), c1 = *(const f32x4*)(rtc + pos * 64 + i + 4);
                    const f32x4 s0 = *(const f32x4*)(rts + pos * 64 + i), s1 = *(const f32x4*)(rts + pos * 64 + i + 4);
                    const float sc = pn < 2 ? 0.08838834764831845f : 1.0f;
                    bf16_t* dst = rowp + pn * 256 + hl * 128 + i;
                    store8(dst, (a0 * c0 - b0 * s0) * sc, (a1 * c1 - b1 * s1) * sc);
                    store8(dst + 64, (a0 * s0 + b0 * c0) * sc, (a1 * s1 + b1 * c1) * sc);
                } else if (pn == 8 || pn == 9 || (pn == 10 && wc < 2)) {
                    const bool lat = row < 16384; const int t = row & 2047;
                    f32x4 c0 = *(const f32x4*)(axc + t * 32 + i8), c1 = *(const f32x4*)(axc + t * 32 + i8 + 4);
                    f32x4 s0 = *(const f32x4*)(axs + t * 32 + i8), s1 = *(const f32x4*)(axs + t * 32 + i8 + 4);
                    if (!lat) { c0 = (f32x4){1.f, 1.f, 1.f, 1.f}; c1 = c0; s0 = (f32x4){0.f, 0.f, 0.f, 0.f}; s1 = s0; }
                    const float sc = pn < 10 ? 0.18033688011112042f : 1.0f;
                    bf16_t* dst = rowp + (pn < 10 ? pn * 256 : 2560) + wc * 64 + i8;
                    store8(dst, (a0 * c0 - b0 * s0) * sc, (a1 * c1 - b1 * s1) * sc);
                    store8(dst + 32, (a0 * s0 + b0 * c0) * sc, (a1 * s1 + b1 * c1) * sc);
                } else if (pn == 10) {
                    bf16_t* dst = rowp + 2688 + (wc - 2) * 64 + i8;
                    store8(dst, a0, a1); store8(dst + 32, b0, b1);
                } else {
                    bf16_t* dst = rowp + pn * 256 + wc * 32 + i8;
                    if (pn == 6 || pn == 7) { store8(dst, a0 * sigm4(a0), a1 * sigm4(a1)); store8(dst + 128, b0 * sigm4(b0), b1 * sigm4(b1)); }
                    else if (pn == 11 || pn == 12) { store8(dst, a0 * 0.18033688011112042f, a1 * 0.18033688011112042f); store8(dst + 128, b0 * 0.18033688011112042f, b1 * 0.18033688011112042f); }
                    else if (GATES && pn >= 17) { store8(dst, sigm4(a0), sigm4(a1)); store8(dst + 128, sigm4(b0), sigm4(b1)); }
                    else { store8(dst, a0, a1); store8(dst + 128, b0, b1); }
                }
            }
    }
};
template <class Epi, class Sched, bool ALIGN_EPI = false, bool SP2 = false, bool FP8 = false>
__device__ __forceinline__ void gemm_phase(PG8_LAS unsigned char* lds, const Gemm g, const Sched& S, const Epi& E) {
    int tid_ = threadIdx.x; asm volatile("" : "+v"(tid_));
    const int tid = tid_, wid = __builtin_amdgcn_readfirstlane(tid >> 6), lane = tid & 63, wr = wid >> 2, wc = wid & 3, fr = lane & 15, fq = lane >> 4;
    const int K = g.K, nt = K / BK;
    unsigned voffA[2], voffB[2];
#pragma unroll
    for (int i = 0; i < 2; ++i) { int R, C; stage_rc(tid * 16 + i * 8192, R, C); const int Rb = Epi::PERM ? ((R & ~31) + perm32(R & 31)) : R;
        voffA[i] = (unsigned)(R * K + C) * 2u; voffB[i] = (unsigned)(Rb * K + C) * 2u; }
    const size_t kstep = (size_t)(BK * 2);
    const size_t hstep = (size_t)HALF * K * 2;
    const size_t tstep = 2 * hstep;
    const unsigned ldsw = (unsigned)wid * 1024u;
    const int aoff = lds_byte(wr * 64 + fr, fq * 8), boff = lds_byte(wc * 32 + fr, fq * 8);
    const int cb8 = 32 * fq, rr8 = fr & 15;
    const int aoff8 = (((wr * 64 + fr) >> 4) * 2 + (cb8 >> 6)) * 1024 + ((rr8 * 64 + (cb8 & 63)) ^ ((rr8 >> 3) << 5));
    const int boff8 = (((wc * 32 + fr) >> 4) * 2 + (cb8 >> 6)) * 1024 + ((rr8 * 64 + (cb8 & 63)) ^ ((rr8 >> 3) << 5));
#define PG8_SA(b, h) (((b) * 2 + (h)) * HTB)
#define PG8_SB(b, h) ((4 + (b) * 2 + (h)) * HTB)
#define PG8_STAGE(bufoff, gbase, voff) do { _Pragma("unroll") for (int _i = 0; _i < 2; ++_i) \
        __builtin_amdgcn_global_load_lds((const unsigned*)((const char*)(gbase) + (voff)[_i]), (PG8_LAS unsigned*)(lds + (bufoff) + ldsw + _i * 8192), 16, 0, 0); } while (0)
#define PG8_LDA(dst, b, h) do { if constexpr (FP8) { _Pragma("unroll") for (int m = 0; m < 4; ++m) dst##8[m] = *(const PG8_LAS v8i32*)(lds + PG8_SA(b, h) + aoff8 + m * 2048); } else { _Pragma("unroll") for (int m = 0; m < 4; ++m) _Pragma("unroll") for (int k = 0; k < 2; ++k) dst[m][k] = *(const PG8_LAS bf16x8*)(lds + PG8_SA(b, h) + aoff + m * 2048 + k * 1024); } } while (0)
#define PG8_LDB(dst, b, h) do { if constexpr (FP8) { _Pragma("unroll") for (int n = 0; n < 2; ++n) dst##8[n] = *(const PG8_LAS v8i32*)(lds + PG8_SB(b, h) + boff8 + n * 2048); } else { _Pragma("unroll") for (int n = 0; n < 2; ++n) _Pragma("unroll") for (int k = 0; k < 2; ++k) dst[n][k] = *(const PG8_LAS bf16x8*)(lds + PG8_SB(b, h) + boff + n * 2048 + k * 1024); } } while (0)
#define PG8_MMA(ai, bj, At, Bt) do { __builtin_amdgcn_s_setprio(1); if constexpr (FP8) { _Pragma("unroll") for (int m = 0; m < 4; ++m) _Pragma("unroll") for (int n = 0; n < 2; ++n) \
        asm volatile("v_mfma_scale_f32_16x16x128_f8f6f4 %0, %1, %2, %0, %3, %3 op_sel_hi:[0,0,0]" : "+v"(acc[ai][bj][m][n]) : "v"(Bt##8[n]), "v"(At##8[m]), "v"(sc127)); } else { \
        _Pragma("unroll") for (int m = 0; m < 4; ++m) _Pragma("unroll") for (int n = 0; n < 2; ++n) _Pragma("unroll") for (int k = 0; k < 2; ++k) \
        acc[ai][bj][m][n] = __builtin_amdgcn_mfma_f32_16x16x32_bf16(Bt[n][k], At[m][k], acc[ai][bj][m][n], 0, 0, 0); } __builtin_amdgcn_s_setprio(0); } while (0)
#define PG8_WAIT_V(n) asm volatile("s_waitcnt vmcnt(" #n ")" ::: "memory")
#define PG8_WAIT_L(n) asm volatile("s_waitcnt lgkmcnt(" #n ")" ::: "memory")
#define PG8_BAR __builtin_amdgcn_s_barrier()
#define PG8_SCHED __builtin_amdgcn_sched_barrier(0)
    Unit cur, nxt; int ui = 0;
    if (!S.next(0, cur)) return;
    f32x4 acc[2][2][4][2];
#pragma unroll
    for (int a = 0; a < 2; ++a)
#pragma unroll
        for (int b = 0; b < 2; ++b)
#pragma unroll
            for (int m = 0; m < 4; ++m)
#pragma unroll
                for (int n = 0; n < 2; ++n) acc[a][b][m][n] = (f32x4){0.f, 0.f, 0.f, 0.f};
    bf16x8 At[4][2], B0[2][2], B1[2][2];
    v8i32 At8[4], B08[2], B18[2]; const int sc127 = 127;
    const char* cA = (const char*)g.A + (size_t)cur.pm * tstep; const char* cB = (const char*)g.Bt + (size_t)cur.pn * tstep;
    S.a_ready(cur);
    if constexpr (SP2) {
        PG8_STAGE(PG8_SB(0, 0), cB, voffB); PG8_STAGE(PG8_SB(0, 1), cB + hstep, voffB); PG8_STAGE(PG8_SA(0, 0), cA, voffA); PG8_STAGE(PG8_SA(0, 1), cA + hstep, voffA);
        if (wr == 1) PG8_BAR;
        PG8_WAIT_V(2); PG8_BAR;
        PG8_STAGE(PG8_SB(1, 0), cB + kstep, voffB); PG8_STAGE(PG8_SA(1, 0), cA + kstep, voffA); PG8_STAGE(PG8_SB(1, 1), cB + hstep + kstep, voffB);
        PG8_WAIT_V(6); PG8_BAR;
    } else {
        PG8_STAGE(PG8_SB(0, 0), cB, voffB); PG8_STAGE(PG8_SA(0, 0), cA, voffA); PG8_STAGE(PG8_SB(0, 1), cB + hstep, voffB); PG8_STAGE(PG8_SA(0, 1), cA + hstep, voffA);
        if (wr == 1) PG8_BAR;
        PG8_WAIT_V(4); PG8_BAR;
        PG8_STAGE(PG8_SB(1, 0), cB + kstep, voffB); PG8_STAGE(PG8_SA(1, 0), cA + kstep, voffA); PG8_STAGE(PG8_SB(1, 1), cB + hstep + kstep, voffB);
        PG8_WAIT_V(6); PG8_BAR;
    }
    for (;;) {
        const bool has_next = S.next(ui + 1, nxt);
        const char* nA = has_next ? (const char*)g.A + (size_t)nxt.pm * tstep : cA; const char* nB = has_next ? (const char*)g.Bt + (size_t)nxt.pn * tstep : cB;
        for (int t = 0; t < nt; t += 2) {
            const bool last = (t == nt - 2);
            const char* a1 = cA + (size_t)(t + 1) * kstep;
            const char* a2 = last ? nA : cA + (size_t)(t + 2) * kstep; const char* b2 = last ? nB : cB + (size_t)(t + 2) * kstep;
            const char* a3 = a2 + kstep; const char* b3 = b2 + kstep;
            if (last && has_next) S.a_ready(nxt);
            if constexpr (SP2) {
            PG8_LDB(B0, 0, 0); PG8_LDB(B1, 0, 1); PG8_SCHED; PG8_LDA(At, 0, 0); PG8_STAGE(PG8_SA(1, 1), a1 + hstep, voffA);
            PG8_WAIT_V(8); PG8_WAIT_L(0); PG8_BAR; PG8_MMA(0, 0, At, B0); PG8_MMA(0, 1, At, B1); PG8_BAR; PG8_SCHED;
            PG8_LDA(At, 0, 1); PG8_STAGE(PG8_SB(0, 0), b2, voffB); PG8_STAGE(PG8_SB(0, 1), b2 + hstep, voffB); PG8_STAGE(PG8_SA(0, 0), a2, voffA);
            PG8_WAIT_V(8); PG8_WAIT_L(0); PG8_BAR; PG8_MMA(1, 0, At, B0); PG8_MMA(1, 1, At, B1); PG8_BAR; PG8_SCHED;
            PG8_LDB(B0, 1, 0); PG8_LDB(B1, 1, 1); PG8_SCHED; PG8_LDA(At, 1, 0); PG8_STAGE(PG8_SA(0, 1), a2 + hstep, voffA);
            PG8_WAIT_V(8); PG8_WAIT_L(0); PG8_BAR; PG8_MMA(0, 0, At, B0); PG8_MMA(0, 1, At, B1); PG8_BAR; PG8_SCHED;
            PG8_LDA(At, 1, 1); PG8_STAGE(PG8_SB(1, 0), b3, voffB); PG8_STAGE(PG8_SB(1, 1), b3 + hstep, voffB); PG8_STAGE(PG8_SA(1, 0), a3, voffA);
            PG8_WAIT_V(8); PG8_WAIT_L(0); PG8_BAR; PG8_MMA(1, 0, At, B0); PG8_MMA(1, 1, At, B1); PG8_BAR; PG8_SCHED;
            } else {
            PG8_LDB(B0, 0, 0); PG8_SCHED; PG8_LDA(At, 0, 0); PG8_STAGE(PG8_SA(1, 1), a1 + hstep, voffA);
            PG8_WAIT_L(8); PG8_BAR; PG8_WAIT_L(0); PG8_MMA(0, 0, At, B0); PG8_BAR; PG8_SCHED;
            PG8_LDB(B1, 0, 1); PG8_STAGE(PG8_SB(0, 0), b2, voffB);
            PG8_BAR; PG8_WAIT_L(0); PG8_MMA(0, 1, At, B1); PG8_BAR;
            PG8_LDA(At, 0, 1); PG8_STAGE(PG8_SA(0, 0), a2, voffA);
            PG8_BAR; PG8_WAIT_L(0); PG8_MMA(1, 0, At, B0); PG8_BAR; PG8_SCHED;
            PG8_STAGE(PG8_SB(0, 1), b2 + hstep, voffB);
            PG8_WAIT_V(6); PG8_BAR; PG8_MMA(1, 1, At, B1); PG8_BAR;
            PG8_LDB(B0, 1, 0); PG8_SCHED; PG8_LDA(At, 1, 0); PG8_STAGE(PG8_SA(0, 1), a2 + hstep, voffA);
            PG8_WAIT_L(8); PG8_BAR; PG8_WAIT_L(0); PG8_MMA(0, 0, At, B0); PG8_BAR; PG8_SCHED;
            PG8_LDB(B1, 1, 1); PG8_STAGE(PG8_SB(1, 0), b3, voffB);
            PG8_BAR; PG8_WAIT_L(0); PG8_MMA(0, 1, At, B1); PG8_BAR;
            PG8_LDA(At, 1, 1); PG8_STAGE(PG8_SA(1, 0), a3, voffA);
            PG8_BAR; PG8_WAIT_L(0); PG8_MMA(1, 0, At, B0); PG8_BAR; PG8_SCHED;
            PG8_STAGE(PG8_SB(1, 1), b3 + hstep, voffB);
            PG8_WAIT_V(6); PG8_BAR; PG8_MMA(1, 1, At, B1); PG8_BAR;
            }
        }
        if constexpr (ALIGN_EPI) { if (wr == 0) PG8_BAR; }
        if constexpr (FP8) asm volatile("s_nop 15\n\ts_nop 7" ::: "memory");
        if constexpr (!Epi::AFTER_DRAIN) { E(acc, cur, wr, wc, fr, fq); S.done(cur); }
        if (!has_next) break;
        if constexpr (!Epi::KEEP_ACC) {
#pragma unroll
        for (int a = 0; a < 2; ++a)
#pragma unroll
            for (int b = 0; b < 2; ++b)
#pragma unroll
                for (int m = 0; m < 4; ++m)
#pragma unroll
                    for (int n = 0; n < 2; ++n) acc[a][b][m][n] = (f32x4){0.f, 0.f, 0.f, 0.f};
        }
        cur = nxt; cA = nA; cB = nB; ++ui;
        if constexpr (ALIGN_EPI) { if (wr == 1) PG8_BAR; }
    }
    PG8_WAIT_V(0);
    if constexpr (!ALIGN_EPI) { if (wr == 0) PG8_BAR; }
    PG8_BAR;
    if constexpr (Epi::AFTER_DRAIN) { E.fused(acc, cur, wr, wc, fr, fq, lds, wid, lane); S.done(cur); }
#undef PG8_SA
#undef PG8_SB
#undef PG8_STAGE
#undef PG8_LDA
#undef PG8_LDB
#undef PG8_MMA
#undef PG8_WAIT_V
#undef PG8_WAIT_L
#undef PG8_BAR
#undef PG8_SCHED
}
}

#define XB_TMO      128
#define XB_XCNT(j)  (256  + 64 * (j))
#define XB_XSUB(j)  (1280 + 64 * (j))
#define XB_XGEN(j)  (2304 + 64 * (j))
#define XB_TOP      3328
#define XB_TOPGEN   3392
#define XCD_BAR_WORDS 3456
#define XB_SPIN_CAP (1u << 18)

__device__ __forceinline__ unsigned xb_ld(unsigned* p)              { return __hip_atomic_load(p, __ATOMIC_RELAXED, __HIP_MEMORY_SCOPE_AGENT); }
__device__ __forceinline__ unsigned xb_add(unsigned* p, unsigned v) { return __hip_atomic_fetch_add(p, v, __ATOMIC_RELAXED, __HIP_MEMORY_SCOPE_AGENT); }
__device__ __forceinline__ unsigned xb_xcc_id() { return (unsigned)__builtin_amdgcn_s_getreg((3 << 11) | 20) & 0xFu; }
#define XB_SPIN(cond, bar) do { unsigned _sp = 0; while (cond) { __builtin_amdgcn_s_sleep(1); \
    if ((++_sp & 255u) == 0u) { if (xb_ld(&(bar)[XB_TMO])) break; if (_sp > XB_SPIN_CAP) { atomicAdd(&(bar)[XB_TMO], 1u); break; } } } } while (0)

struct XcdBarrier {
    unsigned* bar; unsigned x;
    volatile LAS unsigned* st;
};

__device__ __forceinline__ XcdBarrier xcd_barrier_post(unsigned* bar, volatile LAS unsigned* st) {
    XcdBarrier b; b.bar = bar; b.x = xb_xcc_id(); b.st = st;
    if (threadIdx.x == 0) (void)xb_add(&bar[XB_XCNT(b.x)], 1u);
    return b;
}
__device__ __forceinline__ void xcd_barrier_complete(unsigned* bar, unsigned x, unsigned& nloc, unsigned& nx) {
    const unsigned G = gridDim.x * gridDim.y * gridDim.z;
    unsigned sum, cnt, mine, sp = 0u;
    for (;;) {
        sum = 0u; cnt = 0u; mine = 0u;
#pragma unroll
        for (unsigned j = 0; j < 16; ++j) { const unsigned c = xb_ld(&bar[XB_XCNT(j)]); sum += c; cnt += (c > 0u) ? 1u : 0u; mine = (j == x) ? c : mine; }
        if (sum == G) break;
        __builtin_amdgcn_s_sleep(1);
        if ((++sp & 255u) == 0u) { if (xb_ld(&bar[XB_TMO])) break; if (sp > XB_SPIN_CAP) { atomicAdd(&bar[XB_TMO], 1u); break; } }
    }
    nloc = mine > 0u ? mine : 1u; nx = cnt > 0u ? cnt : 1u;
}

__device__ __forceinline__ void xcd_barrier(const XcdBarrier& b) {
    asm volatile("s_waitcnt vmcnt(0)" ::: "memory");
    __syncthreads();
    if (threadIdx.x == 0) {
        unsigned* bar = b.bar;
        __builtin_amdgcn_s_waitcnt(0);
        unsigned nloc = b.st[0], nx = b.st[1];
        if (nloc == 0u) { xcd_barrier_complete(bar, b.x, nloc, nx); b.st[0] = nloc; b.st[1] = nx; }
        const unsigned old = xb_add(&bar[XB_XSUB(b.x)], 1u);
        const unsigned gen = old / nloc;
        if (old + 1u == (gen + 1u) * nloc) {
            __builtin_amdgcn_fence(__ATOMIC_RELEASE, "agent");
            asm volatile("s_waitcnt vmcnt(0)" ::: "memory");
            const unsigned og = xb_add(&bar[XB_TOP], 1u);
            const unsigned tg = og / nx;
            if (og + 1u == (tg + 1u) * nx) xb_add(&bar[XB_TOPGEN], 1u);
            else XB_SPIN(xb_ld(&bar[XB_TOPGEN]) == tg, bar);
            __builtin_amdgcn_fence(__ATOMIC_ACQUIRE, "agent");
            xb_add(&bar[XB_XGEN(b.x)], 1u);
            asm volatile("s_waitcnt vmcnt(0)" ::: "memory");
        } else {
            XB_SPIN(xb_ld(&bar[XB_XGEN(b.x)]) == gen, bar);
            __builtin_amdgcn_fence(__ATOMIC_ACQUIRE, "agent");
            asm volatile("s_waitcnt vmcnt(0)" ::: "memory");
        }
    }
    __syncthreads();
}

constexpr int D = 1024, NB = 8, SEQ = 2048, LC = 256, DEPTH = 4;
constexpr int ML = NB * SEQ, MC = NB * LC, MT = ML + MC;
constexpr int DIN = 7424, FFD = 2816, FFE = 3584, NE = 8;
constexpr int PS = 4352;
constexpr int MSORT = 38912;
constexpr float EPS = 1e-6f;
constexpr int NWAVES = 8, NTHREADS = 512;
#ifndef MK_PER_PHASE
#define MK_PER_PHASE 0
#endif
constexpr int NPH = 2 + 11 * DEPTH;
#ifndef MK_EN
#define MK_EN 0xFFFFFFFFu
#endif
#ifndef MK_DUMP
#define MK_DUMP 0
#endif
#ifndef MK_F8
#define MK_F8 0x2F
#endif
constexpr bool F8IN = (MK_F8 & 16) != 0, F8GATE = (MK_F8 & 32) != 0;
constexpr bool F8UP_D = (MK_F8 & 1) != 0, F8DN_D = (MK_F8 & 2) != 0, F8UP_M = (MK_F8 & 4) != 0, F8DN_M = (MK_F8 & 8) != 0;
#ifndef MK_REP
#define MK_REP 0u
#endif
#ifndef MK_NPH_RUN
#define MK_NPH_RUN NPH
#endif

constexpr size_t MiB = (size_t)1 << 20;
constexpr size_t WS_CTL = 0, CTL_ZERO_BYTES = MiB;
constexpr size_t WS_MOD = 1 * MiB;
constexpr size_t WS_TAB = 2 * MiB;
constexpr size_t WS_ROUTE = 4 * MiB;
constexpr size_t WS_HC = 5 * MiB;
constexpr size_t WS_XN = 13 * MiB;
constexpr size_t WS_YOUT = 49 * MiB;
constexpr size_t WS_WIN = 85 * MiB, WS_WBR = 143 * MiB, WS_WOUT = 155 * MiB, WS_WF13 = 163 * MiB, WS_WF2 = 185 * MiB, WS_WM13 = 196 * MiB, WS_WM2 = 420 * MiB;
constexpr size_t WS_OVL = 532 * MiB;
constexpr size_t WS_PROJ = WS_OVL, WS_YBR = WS_OVL + 261 * MiB, WS_KV = WS_OVL + 315 * MiB, WS_ST = WS_OVL + 387 * MiB;
constexpr size_t WS_TMP = WS_KV, WS_MERGED = WS_ST;
constexpr size_t WS_PART = WS_OVL;
constexpr size_t WS_G8 = WS_OVL + 153 * MiB;
constexpr size_t WS_ASORT = WS_OVL, WS_HID = WS_OVL + 76 * MiB, WS_OSORT = WS_OVL + 342 * MiB;
constexpr size_t WS_HB = WS_OVL + 423 * MiB;
constexpr size_t WS_WIN8 = WS_HB + 36 * MiB;
constexpr size_t WS_XN8 = WS_WIN8 + 12 * MiB;
constexpr size_t WS_END = WS_XN8 + 18 * MiB;
static_assert(WS_OSORT + (size_t)MSORT * D * 2 <= WS_END && WS_ST + 36 * MiB <= WS_END, "map");
constexpr int TAB_RTC = 0, TAB_RTS = 2304 * 64, TAB_AXC = 2 * 2304 * 64, TAB_AXS = 2 * 2304 * 64 + 2048 * 32;
constexpr int CW_BAR = 4096, CW_MOE = 8192, CW_WQ = 12288, CW_RFLAG = 24576, CW_PFLAG = 32768;

constexpr int LDS_BYTES = 147456, MISC_OFF = 131072 + 320;

#define GAS __attribute__((address_space(1)))
#define DEV __device__ __forceinline__
typedef unsigned short bf16;
typedef float f32x4 __attribute__((ext_vector_type(4)));
typedef short bf16x8 __attribute__((ext_vector_type(8)));
typedef short s16x4 __attribute__((ext_vector_type(4)));
typedef unsigned u32x4 __attribute__((ext_vector_type(4)));
typedef unsigned u32x2 __attribute__((ext_vector_type(2)));
#define MFMA16(a, b, c) __builtin_amdgcn_mfma_f32_16x16x32_bf16((a), (b), (c), 0, 0, 0)
DEV float bf2f(unsigned short b) { return __uint_as_float(((unsigned)b) << 16); }
DEV float bflo(unsigned u) { return __uint_as_float(u << 16); }
DEV float bfhi(unsigned u) { return __uint_as_float(u & 0xffff0000u); }
DEV unsigned pk2(float lo, float hi) { return pg8::cvt_pk_bf16(lo, hi); }
DEV unsigned short f2bf(float f) { return (unsigned short)(pg8::cvt_pk_bf16(f, 0.f) & 0xffffu); }
template <int CTRL> DEV float dpp_add(float v) { return v + __int_as_float(__builtin_amdgcn_update_dpp(0, __float_as_int(v), CTRL, 0xf, 0xf, true)); }
DEV float wave_sum(float v) {
    v = dpp_add<0xB1>(v); v = dpp_add<0x4E>(v); v = dpp_add<0x141>(v); v = dpp_add<0x140>(v);
    const int iv = __float_as_int(v);
    return (__int_as_float(__builtin_amdgcn_readlane(iv, 0)) + __int_as_float(__builtin_amdgcn_readlane(iv, 16))) + (__int_as_float(__builtin_amdgcn_readlane(iv, 32)) + __int_as_float(__builtin_amdgcn_readlane(iv, 48)));
}
DEV bf16x8 pack8(const f32x4 a, const f32x4 b) { u32x4 w; w.x = pk2(a[0], a[1]); w.y = pk2(a[2], a[3]); w.z = pk2(b[0], b[1]); w.w = pk2(b[2], b[3]); return __builtin_bit_cast(bf16x8, w); }

struct Args { const float* in[20]; float* out; unsigned char* ws; int ph_lo, ph_hi, li, pad; };
enum { I_X = 0, I_C, I_CTX, I_CCTX, I_WMOD, I_BMOD, I_GAINS, I_WIN, I_DECAY, I_SINK, I_RPB, I_WBR, I_WOUT, I_F1, I_F3, I_F2, I_ROUTER, I_M1, I_M3, I_M2 };

DEV void p0_transpose_item(const float* W, int K, int N, bf16* WT, LAS float* scr, int kb, int n0, int drow0, int lane) {
    const int k0 = 64 * kb;
#pragma unroll 8
    for (int i = 0; i < 32; ++i) { const int kk = 2 * i + (lane >> 5); scr[kk * 33 + (lane & 31)] = W[(size_t)(k0 + kk) * N + n0 + (lane & 31)]; }
    asm volatile("s_waitcnt lgkmcnt(0)" ::: "memory");
    const int c = lane & 7;
#pragma unroll
    for (int j = 0; j < 4; ++j) { const int n = (lane >> 3) + 8 * j; const LAS float* s = scr + (8 * c) * 33 + n;
        u32x4 o; o.x = pk2(s[0 * 33], s[1 * 33]); o.y = pk2(s[2 * 33], s[3 * 33]); o.z = pk2(s[4 * 33], s[5 * 33]); o.w = pk2(s[6 * 33], s[7 * 33]);
        *(u32x4*)(WT + (size_t)(drow0 + n) * K + k0 + 8 * c) = o; }
    asm volatile("s_waitcnt lgkmcnt(0)" ::: "memory");
}

DEV float clampf8(float v) { return __builtin_amdgcn_fmed3f(v, -448.0f, 448.0f); }
DEV unsigned pk4f8(float a, float b, float c, float d) { a = clampf8(a); b = clampf8(b); c = clampf8(c); d = clampf8(d); unsigned w = 0; w = __builtin_amdgcn_cvt_pk_fp8_f32(a, b, w, false); w = __builtin_amdgcn_cvt_pk_fp8_f32(c, d, w, true); return w; }
DEV void p0_transpose_item_f8(const float* W, int K, int N, unsigned char* WT, LAS float* scr, int kb, int n0, int drow0, float scale, int lane) {
    const int k0 = 64 * kb;
#pragma unroll 8
    for (int i = 0; i < 32; ++i) { const int kk = 2 * i + (lane >> 5); scr[kk * 33 + (lane & 31)] = W[(size_t)(k0 + kk) * N + n0 + (lane & 31)] * scale; }
    asm volatile("s_waitcnt lgkmcnt(0)" ::: "memory");
    const int c = lane & 3;
#pragma unroll
    for (int j = 0; j < 2; ++j) { const int n = (lane >> 2) + 16 * j; const LAS float* s = scr + (16 * c) * 33 + n;
        u32x4 o; o.x = pk4f8(s[0 * 33], s[1 * 33], s[2 * 33], s[3 * 33]); o.y = pk4f8(s[4 * 33], s[5 * 33], s[6 * 33], s[7 * 33]);
        o.z = pk4f8(s[8 * 33], s[9 * 33], s[10 * 33], s[11 * 33]); o.w = pk4f8(s[12 * 33], s[13 * 33], s[14 * 33], s[15 * 33]);
        *(u32x4*)(WT + (size_t)(drow0 + n) * K + k0 + 16 * c) = o; }
    asm volatile("s_waitcnt lgkmcnt(0)" ::: "memory");
}
DEV int inproj_dest_row(int n0) {
    const int pn = n0 >> 8, wi = n0 & 255;
    if (pn < 4) { const int hl = wi >> 7, rem = wi & 127, half = rem >> 6, i = rem & 63; return pn * 256 + half * 128 + hl * 64 + i; }
    if (pn == 8 || pn == 9) { const int hl = wi >> 6, rem = wi & 63, half = rem >> 5, i = rem & 31; return pn * 256 + half * 128 + hl * 32 + i; }
    if (pn == 10) { const int isv = wi >> 7, w2 = wi & 127, hl = w2 >> 6, half = (w2 & 63) >> 5, i = w2 & 31; return 2560 + half * 128 + (2 * isv + hl) * 32 + i; }
    return n0;
}
DEV void p0_prologue(const Args& A, LAS unsigned char* lds, int vcu, int G, int tid) {
    const int wave = __builtin_amdgcn_readfirstlane(tid >> 6), lane = tid & 63;
    unsigned char* ws = A.ws;
    {
        LAS float* sc = (LAS float*)lds;
        LAS float* red = (LAS float*)(lds + 9 * 1024 * 4);
        for (int i = tid; i < 9 * 1024; i += NTHREADS) { const int r = i >> 10, k = i & 1023; const float v = r < 8 ? A.in[I_C][r * 1024 + k] : A.in[I_CCTX][k]; sc[i] = v / (1.0f + __expf(-v)); }
        __syncthreads();
        float* MOD = (float*)(ws + WS_MOD);
        for (int it = vcu; it < 4 * 96; it += G) {
            const int l = it / 96, cg = it % 96, col = cg * 64 + lane;
            const float* W = A.in[I_WMOD] + (size_t)l * 1024 * 6144 + col;
            float acc[9];
#pragma unroll
            for (int r = 0; r < 9; ++r) acc[r] = 0.f;
#pragma unroll 4
            for (int kk = 0; kk < 128; ++kk) { const int k = wave * 128 + kk; const float w = W[(size_t)k * 6144];
#pragma unroll
                for (int r = 0; r < 9; ++r) acc[r] += sc[r * 1024 + k] * w; }
#pragma unroll
            for (int r = 0; r < 9; ++r) red[(wave * 9 + r) * 64 + lane] = acc[r];
            __syncthreads();
            for (int o = tid; o < 9 * 64; o += NTHREADS) { const int r = o >> 6, ln = o & 63; float s = 0.f;
#pragma unroll
                for (int w = 0; w < 8; ++w) s += red[(w * 9 + r) * 64 + ln];
                MOD[((size_t)l * 9 + r) * 6144 + cg * 64 + ln] = s + A.in[I_BMOD][l * 6144 + cg * 64 + ln]; }
            __syncthreads();
        }
    }
    {
        float* TAB = (float*)(ws + WS_TAB);
        const int gt = vcu * NTHREADS + tid, NGT = G * NTHREADS;
        for (int i = gt; i < 2304 * 64; i += NGT) { const int pos = i >> 6, f = i & 63; const float inv = exp2f(-(float)f * (13.287712379549449f / 64.0f)); const float ang = (float)pos * inv; float s, c; sincosf(ang, &s, &c); TAB[TAB_RTC + i] = c; TAB[TAB_RTS + i] = s; }
        for (int i = gt; i < 2048 * 32; i += NGT) { const int t = i >> 5, f = i & 31; const float inv = exp2f(-(float)(f & 15) * (13.287712379549449f / 16.0f)); const float p = (f < 16) ? (float)(t >> 6) : (float)(t & 63); const float ang = p * inv; float s, c; sincosf(ang, &s, &c); TAB[TAB_AXC + i] = c; TAB[TAB_AXS + i] = s; }
    }
    __syncthreads();
    {
        LAS float* scr = (LAS float*)(lds + wave * 16384);
        const int gw = vcu * NWAVES + wave, NGW = G * NWAVES;
        constexpr int C_IN = 16 * 232, C_BR = 8 * 32, C_OUT = 16 * 32, C_F13 = 16 * 88, C_F2 = 44 * 32, C_M13 = 16 * 112, C_M2 = 56 * 32;
        constexpr int N_IN = 4 * C_IN, N_BR = 12 * C_BR, N_OUT = 4 * C_OUT, N_F13 = 4 * C_F13, N_F2 = 2 * C_F2, N_M13 = 32 * C_M13, N_M2 = 16 * C_M2;
        constexpr int NITEMS = N_IN + N_BR + N_OUT + N_F13 + N_F2 + N_M13 + N_M2;
        for (int it = gw; it < NITEMS; it += NGW) {
            int r = it;
            if (r < N_IN) { const int l = r / C_IN, q = r % C_IN, kb = q / 232, nb = q % 232;
                if constexpr (F8IN) p0_transpose_item_f8(A.in[I_WIN] + (size_t)l * 1024 * DIN, 1024, DIN, ws + WS_WIN + (size_t)l * DIN * 1024, scr, kb, 32 * nb, inproj_dest_row(32 * nb), 64.0f, lane);
                else if (F8GATE && 32 * nb >= 4352) p0_transpose_item_f8(A.in[I_WIN] + (size_t)l * 1024 * DIN, 1024, DIN, ws + WS_WIN8 + (size_t)l * 3072 * 1024, scr, kb, 32 * nb, 32 * nb - 4352, 64.0f, lane);
                else p0_transpose_item(A.in[I_WIN] + (size_t)l * 1024 * DIN, 1024, DIN, (bf16*)(ws + WS_WIN) + (size_t)l * DIN * 1024, scr, kb, 32 * nb, inproj_dest_row(32 * nb), lane);
                continue; } r -= N_IN;
            if (r < N_BR) { const int mtx = r / C_BR, q = r % C_BR, kb = q / 32, nb = q % 32;
                p0_transpose_item(A.in[I_WBR] + (size_t)mtx * 512 * 1024, 512, 1024, (bf16*)(ws + WS_WBR) + (size_t)mtx * 1024 * 512, scr, kb, 32 * nb, 32 * nb, lane); continue; } r -= N_BR;
            if (r < N_OUT) { const int l = r / C_OUT, q = r % C_OUT, kb = q / 32, nb = q % 32;
                p0_transpose_item(A.in[I_WOUT] + (size_t)l * 1024 * 1024, 1024, 1024, (bf16*)(ws + WS_WOUT) + (size_t)l * 1024 * 1024, scr, kb, 32 * nb, 32 * nb, lane); continue; } r -= N_OUT;
            if (r < N_F13) { const int mtx = r / C_F13, q = r % C_F13, kb = q / 88, nb = q % 88, i = mtx >> 1, which = mtx & 1, n0 = 32 * nb;
                if constexpr (F8UP_D) p0_transpose_item_f8(A.in[which ? I_F3 : I_F1] + (size_t)i * 1024 * FFD, 1024, FFD, ws + WS_WF13 + (size_t)i * 2 * FFD * 1024, scr, kb, n0, (n0 >> 7) * 256 + which * 128 + (n0 & 127), 64.0f, lane);
                else p0_transpose_item(A.in[which ? I_F3 : I_F1] + (size_t)i * 1024 * FFD, 1024, FFD, (bf16*)(ws + WS_WF13) + (size_t)i * 2 * FFD * 1024, scr, kb, n0, (n0 >> 7) * 256 + which * 128 + (n0 & 127), lane);
                continue; } r -= N_F13;
            if (r < N_F2) { const int i = r / C_F2, q = r % C_F2, kb = q / 32, nb = q % 32;
                if constexpr (F8DN_D) p0_transpose_item_f8(A.in[I_F2] + (size_t)i * FFD * 1024, FFD, 1024, ws + WS_WF2 + (size_t)i * 1024 * FFD, scr, kb, 32 * nb, 32 * nb, 128.0f, lane);
                else p0_transpose_item(A.in[I_F2] + (size_t)i * FFD * 1024, FFD, 1024, (bf16*)(ws + WS_WF2) + (size_t)i * 1024 * FFD, scr, kb, 32 * nb, 32 * nb, lane);
                continue; } r -= N_F2;
            if (r < N_M13) { const int mtx = r / C_M13, q = r % C_M13, kb = q / 112, nb = q % 112, ie = mtx >> 1, which = mtx & 1, n0 = 32 * nb;
                if constexpr (F8UP_M) p0_transpose_item_f8(A.in[which ? I_M3 : I_M1] + (size_t)ie * 1024 * FFE, 1024, FFE, ws + WS_WM13 + (size_t)ie * 2 * FFE * 1024, scr, kb, n0, (n0 >> 7) * 256 + which * 128 + (n0 & 127), 64.0f, lane);
                else p0_transpose_item(A.in[which ? I_M3 : I_M1] + (size_t)ie * 1024 * FFE, 1024, FFE, (bf16*)(ws + WS_WM13) + (size_t)ie * 2 * FFE * 1024, scr, kb, n0, (n0 >> 7) * 256 + which * 128 + (n0 & 127), lane);
                continue; } r -= N_M13;
            { const int ie = r / C_M2, q = r % C_M2, kb = q / 32, nb = q % 32;
                if constexpr (F8DN_M) p0_transpose_item_f8(A.in[I_M2] + (size_t)ie * FFE * 1024, FFE, 1024, ws + WS_WM2 + (size_t)ie * 1024 * FFE, scr, kb, 32 * nb, 32 * nb, 128.0f, lane);
                else p0_transpose_item(A.in[I_M2] + (size_t)ie * FFE * 1024, FFE, 1024, (bf16*)(ws + WS_WM2) + (size_t)ie * 1024 * FFE, scr, kb, 32 * nb, 32 * nb, lane); }
        }
    }
}

DEV void ld_row_f32(const float* p, int lane, f32x4 (&v)[4]) {
#pragma unroll
    for (int j = 0; j < 4; ++j) v[j] = *(const f32x4*)(p + 4 * lane + 256 * j);
}
DEV void ld_row_bf16(const bf16* p, int lane, f32x4 (&v)[4]) {
#pragma unroll
    for (int j = 0; j < 4; ++j) { const u32x2 u = *(const u32x2*)(p + 4 * lane + 256 * j); v[j][0] = bflo(u.x); v[j][1] = bfhi(u.x); v[j][2] = bflo(u.y); v[j][3] = bfhi(u.y); }
}
DEV void st_row_bf16(bf16* p, int lane, const f32x4 (&v)[4]) {
#pragma unroll
    for (int j = 0; j < 4; ++j) { u32x2 u; u.x = pk2(v[j][0], v[j][1]); u.y = pk2(v[j][2], v[j][3]); *(u32x2*)(p + 4 * lane + 256 * j) = u; }
}
DEV float row_rstd(const f32x4 (&v)[4]) {
    float s = 0.f;
#pragma unroll
    for (int j = 0; j < 4; ++j) s += (v[j][0] * v[j][0] + v[j][1] * v[j][1]) + (v[j][2] * v[j][2] + v[j][3] * v[j][3]);
    return rsqrtf(wave_sum(s) * (1.0f / 1024.0f) + EPS);
}
DEV void moe_bases(const unsigned* cnt, int (&base)[8]) {
    int acc = 0;
#pragma unroll
    for (int e = 0; e < 8; ++e) { base[e] = acc; const unsigned ce = __hip_atomic_load(cnt + 64 * e, __ATOMIC_RELAXED, __HIP_MEMORY_SCOPE_AGENT); acc += (int)(((ce + 255u) >> 8) << 8); }
}
DEV int sel8(const int (&b)[8], int e) { int r = 0;
#pragma unroll
    for (int k = 0; k < 8; ++k) r = (e == k) ? b[k] : r;
    return r; }

DEV void raw_row_bf16(const bf16* p, int lane, u32x2 (&v)[4]) {
#pragma unroll
    for (int j = 0; j < 4; ++j) v[j] = *(const u32x2*)(p + 4 * lane + 256 * j);
}
DEV void cvt_row_bf16(const u32x2 (&u)[4], f32x4 (&v)[4]) {
#pragma unroll
    for (int j = 0; j < 4; ++j) { v[j][0] = bflo(u[j].x); v[j][1] = bfhi(u[j].x); v[j][2] = bflo(u[j].y); v[j][3] = bfhi(u[j].y); }
}
constexpr int TR = 2;
template <int MODE> DEV void thin_phase(const Args& A, int L, int wid, int nw, int row_lo, int row_hi, int tid, LAS unsigned char* lds) {
    const int wave = __builtin_amdgcn_readfirstlane(tid >> 6), lane = tid & 63;
    const int gw = wid * NWAVES + wave, NGW = nw * NWAVES;
    unsigned char* ws = A.ws;
    const float* MOD = (const float*)(ws + WS_MOD);
    const float* GN = A.in[I_GAINS];
    unsigned char* HC = ws + WS_HB;
    bf16* XN = (bf16*)(ws + WS_XN);
    const bf16* YOUT = (const bf16*)(ws + WS_YOUT);
    int* ROUTE = (int*)(ws + WS_ROUTE);
    const int mi = L >> 1;
    unsigned* cnt = (unsigned*)(ws + WS_CTL) + CW_MOE + mi * 8 * 64;
    int base[8];
    const bool moe2 = (MODE == 2) && (L & 1);
    if (moe2) moe_bases(cnt, base);
    const bool first = (L == 0 && MODE <= 1);
    const bool rout = (MODE == 1) && (L & 1);
    const LAS f32x4* WL = (const LAS f32x4*)lds;
    if (rout) {
        const f32x4* WR4 = (const f32x4*)(A.in[I_ROUTER] + (size_t)mi * 1024 * 8);
        for (int s4 = tid; s4 < 2048; s4 += NTHREADS) { const int k = s4 >> 1, hf_ = s4 & 1; ((LAS f32x4*)lds)[(((k >> 8) * 4 + (k & 3)) * 2 + hf_) * 64 + ((k & 255) >> 2)] = WR4[s4]; }
        __syncthreads();
    }
    const float* gn = GN + L * 4096;
    const bf16* OS = (const bf16*)(ws + WS_OSORT);
    const int nrows_ = row_hi - row_lo, r_beg = row_lo + (int)(((long)gw * nrows_) / NGW), r_end = row_lo + (int)(((long)(gw + 1) * nrows_) / NGW);
    const int Ln = (MODE == 2) ? L + 1 : L;
    f32x4 vgy[4], vgx[4], vgate[4], vsh[4], vsc[4]; int mr_cur = -1;
    if (r_beg < r_end) {
        const float* gy = gn + (MODE == 1 ? 1 : 3) * 1024; const float* gx = GN + Ln * 4096 + (MODE == 1 ? 2 : 0) * 1024;
#pragma unroll
        for (int j = 0; j < 4; ++j) { if (MODE != 0) vgy[j] = *(const f32x4*)(gy + 4 * lane + 256 * j); vgx[j] = *(const f32x4*)(gx + 4 * lane + 256 * j); }
    }
    const bool pre = moe2 && (r_end - r_beg <= 64);
    int4 prq = {0, 0, 0, 0}; int2 prw = {0, 0};
    if (pre && r_beg < r_end) { const int* rt = ROUTE + (size_t)((r_beg + lane < r_end) ? r_beg + lane : r_beg) * 8; prq = *(const int4*)rt; prw = *(const int2*)(rt + 4); }
    for (int m0 = r_beg; m0 < r_end; m0 += TR) {
        int mm[TR]; bool on[TR];
#pragma unroll
        for (int r = 0; r < TR; ++r) { const int m = m0 + r; on[r] = m < r_end; mm[r] = on[r] ? m : m0; }
        int4 rq[TR]; int2 rw[TR];
        if (moe2) {
#pragma unroll
            for (int r = 0; r < TR; ++r) {
                if (pre) { const int k = mm[r] - r_beg;
                    rq[r].x = __builtin_amdgcn_readlane(prq.x, k); rq[r].y = __builtin_amdgcn_readlane(prq.y, k); rq[r].z = __builtin_amdgcn_readlane(prq.z, k); rq[r].w = __builtin_amdgcn_readlane(prq.w, k);
                    rw[r].x = __builtin_amdgcn_readlane(prw.x, k); rw[r].y = __builtin_amdgcn_readlane(prw.y, k); }
                else { const int* rt = ROUTE + (size_t)mm[r] * 8; rq[r] = *(const int4*)rt; rw[r] = *(const int2*)(rt + 4); } }
        }
        f32x4 hf[TR][4]; u32x2 hr[TR][4], ya[TR][4], yb[TR][4];
#pragma unroll
        for (int r = 0; r < TR; ++r) { const int m = mm[r];
            if (first) ld_row_f32(m >= ML ? A.in[I_CTX] + (size_t)(m - ML) * D : A.in[I_X] + (size_t)m * D, lane, hf[r]);
            else raw_row_bf16((const bf16*)HC + (size_t)m * D, lane, hr[r]);
            if (MODE != 0) {
                if (moe2) { raw_row_bf16(OS + (size_t)(sel8(base, rq[r].x) + rq[r].z) * D, lane, ya[r]); raw_row_bf16(OS + (size_t)(sel8(base, rq[r].y) + rq[r].w) * D, lane, yb[r]); }
                else raw_row_bf16(YOUT + (size_t)m * D, lane, ya[r]);
            } }
#pragma unroll
        for (int r = 0; r < TR; ++r) if (on[r]) { const int m = mm[r];
        const bool isc = m >= ML;
        const int mr = isc ? 8 : (m >> 11);
        if (mr != mr_cur) { mr_cur = mr;
            const float* md = MOD + ((size_t)L * 9 + mr) * 6144; const float* mdn = MOD + ((size_t)Ln * 9 + mr) * 6144;
            const float* gate = md + (MODE == 1 ? 2 : 5) * 1024; const float* sh = mdn + (MODE == 1 ? 3 : 0) * 1024; const float* sc = mdn + (MODE == 1 ? 4 : 1) * 1024;
#pragma unroll
            for (int j = 0; j < 4; ++j) { if (MODE != 0) vgate[j] = *(const f32x4*)(gate + 4 * lane + 256 * j); vsh[j] = *(const f32x4*)(sh + 4 * lane + 256 * j); vsc[j] = *(const f32x4*)(sc + 4 * lane + 256 * j); }
        }
        bf16* hb = (bf16*)HC + (size_t)m * D;
        f32x4 h[4];
        if (first) {
#pragma unroll
            for (int j = 0; j < 4; ++j) h[j] = hf[r][j];
        } else cvt_row_bf16(hr[r], h);
        if (MODE != 0) {
            f32x4 y[4];
            if (moe2) {
                const float w0 = __int_as_float(rw[r].x), w1 = __int_as_float(rw[r].y);
                f32x4 y0[4], y1[4]; cvt_row_bf16(ya[r], y0); cvt_row_bf16(yb[r], y1);
#pragma unroll
                for (int j = 0; j < 4; ++j) y[j] = y0[j] * w0 + y1[j] * w1;
            } else cvt_row_bf16(ya[r], y);
            const float rs = row_rstd(y);
#pragma unroll
            for (int j = 0; j < 4; ++j) h[j] = h[j] + vgate[j] * (y[j] * rs * vgy[j]);
            if (MODE == 2 && L == 3) {
#pragma unroll
                for (int j = 0; j < 4; ++j) *(f32x4*)(A.out + (size_t)m * D + 4 * lane + 256 * j) = h[j];
            } else st_row_bf16(hb, lane, h);
        }
        if (MODE == 2 && L == 3) continue;
        const float rs = row_rstd(h);
        f32x4 a[4];
#pragma unroll
        for (int j = 0; j < 4; ++j) a[j] = (h[j] * rs * vgx[j]) * (vsc[j] + 1.0f) + vsh[j];
        if ((MODE == 1 && ((L & 1) ? F8UP_M : F8UP_D)) || (MODE != 1 && F8IN)) {
#pragma unroll
            for (int j = 0; j < 4; ++j) *(unsigned*)((unsigned char*)XN + (size_t)m * D + 4 * lane + 256 * j) = pk4f8(a[j][0], a[j][1], a[j][2], a[j][3]);
        } else { st_row_bf16(XN + (size_t)m * D, lane, a);
            if (MODE != 1 && F8GATE) {
#pragma unroll
                for (int j = 0; j < 4; ++j) *(unsigned*)(ws + WS_XN8 + (size_t)m * D + 4 * lane + 256 * j) = pk4f8(a[j][0], a[j][1], a[j][2], a[j][3]); } }
        if (MODE == 1 && (L & 1)) {
            float lg[8];
            f32x4 l0 = {0.f, 0.f, 0.f, 0.f}, l1 = {0.f, 0.f, 0.f, 0.f};
#pragma unroll
            for (int j = 0; j < 4; ++j)
#pragma unroll
                for (int i = 0; i < 4; ++i) { if ((i & 1) == 0) __builtin_amdgcn_sched_barrier(0); const f32x4 w0 = WL[((j * 4 + i) * 2 + 0) * 64 + lane], w1 = WL[((j * 4 + i) * 2 + 1) * 64 + lane]; const float x = a[j][i];
                    l0 = l0 + w0 * x; l1 = l1 + w1 * x; }
            lg[0] = l0[0]; lg[1] = l0[1]; lg[2] = l0[2]; lg[3] = l0[3]; lg[4] = l1[0]; lg[5] = l1[1]; lg[6] = l1[2]; lg[7] = l1[3];
#pragma unroll
            for (int e = 0; e < 8; ++e) lg[e] = wave_sum(lg[e]);
            int e0 = 0; float v0 = lg[0];
#pragma unroll
            for (int e = 1; e < 8; ++e) if (lg[e] > v0) { v0 = lg[e]; e0 = e; }
            int e1 = -1; float v1 = -INFINITY;
#pragma unroll
            for (int e = 0; e < 8; ++e) if (e != e0 && lg[e] > v1) { v1 = lg[e]; e1 = e; }
            const float ex = __expf(v1 - v0), w0 = 1.0f / (1.0f + ex), w1 = ex * w0;
            if (lane == 0) {
                const int r0 = (int)__hip_atomic_fetch_add(cnt + 64 * e0, 1u, __ATOMIC_RELAXED, __HIP_MEMORY_SCOPE_AGENT);
                const int r1 = (int)__hip_atomic_fetch_add(cnt + 64 * e1, 1u, __ATOMIC_RELAXED, __HIP_MEMORY_SCOPE_AGENT);
                int* rt = ROUTE + (size_t)m * 8; rt[0] = e0; rt[1] = e1; rt[2] = r0; rt[3] = r1; rt[4] = __float_as_int(w0); rt[5] = __float_as_int(w1);
            }
        }
        }
    }
    if (rout) __syncthreads();
}
DEV void gather_phase(const Args& A, int L, int vcu, int G, int tid) {
    const int wave = __builtin_amdgcn_readfirstlane(tid >> 6), lane = tid & 63;
    const int gw = vcu * NWAVES + wave, NGW = G * NWAVES;
    unsigned char* ws = A.ws;
    const int nrows = (L == 3) ? ML : MT, mi = L >> 1;
    const unsigned* cnt = (const unsigned*)(ws + WS_CTL) + CW_MOE + mi * 8 * 64;
    int base[8]; moe_bases(cnt, base);
    const bf16* XN = (const bf16*)(ws + WS_XN); bf16* AS = (bf16*)(ws + WS_ASORT); const int* ROUTE = (const int*)(ws + WS_ROUTE);
    constexpr int RB = F8UP_M ? D : 2 * D;
    const int t_beg = (int)(((long)gw * nrows) / NGW), t_end = (int)(((long)(gw + 1) * nrows) / NGW);
    for (int c0 = t_beg; c0 < t_end; c0 += 64) {
        const int c1 = (c0 + 64 < t_end) ? c0 + 64 : t_end;
        int d0, d1; { const int4 rq = *(const int4*)(ROUTE + (size_t)((c0 + lane < c1) ? c0 + lane : c0) * 8); d0 = sel8(base, rq.x) + rq.z; d1 = sel8(base, rq.y) + rq.w; }
        for (int k0 = c0; k0 < c1; k0 += 4) {
            u32x4 v[4], w[4];
#pragma unroll
            for (int q = 0; q < 4; ++q) { const int m = k0 + q; if (m < c1) { const u32x4* src = (const u32x4*)((const unsigned char*)XN + (size_t)m * RB); v[q] = src[lane]; if constexpr (!F8UP_M) w[q] = src[lane + 64]; } }
#pragma unroll
            for (int q = 0; q < 4; ++q) { const int m = k0 + q; if (m < c1) {
                const int e0 = __builtin_amdgcn_readlane(d0, m - c0), e1 = __builtin_amdgcn_readlane(d1, m - c0);
                u32x4* p0 = (u32x4*)((unsigned char*)AS + (size_t)e0 * RB); u32x4* p1 = (u32x4*)((unsigned char*)AS + (size_t)e1 * RB);
                p0[lane] = v[q]; p1[lane] = v[q]; if constexpr (!F8UP_M) { p0[lane + 64] = w[q]; p1[lane + 64] = w[q]; } } }
        }
    }
}

#ifndef MK_VTR
#define MK_VTR 1
#endif
constexpr float LOG2E = 1.4426950408889634f;
constexpr int KS_STRIDE = 144;
constexpr int VS_STRIDE = MK_VTR ? 160 : 144;
constexpr int AT_VT = 9216, AT_BUF = AT_VT + 64 * VS_STRIDE, AT_RPB = 2 * AT_BUF, AT_Q = AT_RPB + 8192;
static_assert(AT_Q + 65536 <= 131072, "attention LDS");
typedef short v4i16_t __attribute__((ext_vector_type(4)));
#define AT_SCHED() __builtin_amdgcn_sched_barrier(0)
DEV float xrow16_max(float x) {
    auto s = __builtin_amdgcn_permlane16_swap(__float_as_uint(x), __float_as_uint(x), false, false);
    x = fmaxf(__uint_as_float(s[0]), __uint_as_float(s[1]));
    auto t = __builtin_amdgcn_permlane32_swap(__float_as_uint(x), __float_as_uint(x), false, false);
    return fmaxf(__uint_as_float(t[0]), __uint_as_float(t[1]));
}
DEV float xrow16_sum(float x) {
    auto s = __builtin_amdgcn_permlane16_swap(__float_as_uint(x), __float_as_uint(x), false, false);
    x = __uint_as_float(s[0]) + __uint_as_float(s[1]);
    auto t = __builtin_amdgcn_permlane32_swap(__float_as_uint(x), __float_as_uint(x), false, false);
    return __uint_as_float(t[0]) + __uint_as_float(t[1]);
}
struct KVRegs { u32x4 k, v; };
DEV void kv_load(KVRegs& r, const bf16* kp, const bf16* vp, int tid) {
    const int row = tid >> 3, c = tid & 7;
    r.k = *(const u32x4*)(kp + (size_t)row * PS + 8 * c); r.v = *(const u32x4*)(vp + (size_t)row * PS + 8 * c);
}
DEV void kv_write(LAS unsigned char* buf, const KVRegs& r, int tid) {
    const int row = tid >> 3, c = tid & 7;
    *(LAS u32x4*)(buf + row * KS_STRIDE + c * 16) = r.k;
#if MK_VTR
    *(LAS u32x4*)(buf + AT_VT + row * VS_STRIDE + c * 16) = r.v;
#else
    LAS unsigned short* p = (LAS unsigned short*)(buf + AT_VT) + (8 * c) * (VS_STRIDE / 2) + row;
    p[0 * (VS_STRIDE / 2)] = (unsigned short)(r.v.x & 0xffffu); p[1 * (VS_STRIDE / 2)] = (unsigned short)(r.v.x >> 16);
    p[2 * (VS_STRIDE / 2)] = (unsigned short)(r.v.y & 0xffffu); p[3 * (VS_STRIDE / 2)] = (unsigned short)(r.v.y >> 16);
    p[4 * (VS_STRIDE / 2)] = (unsigned short)(r.v.z & 0xffffu); p[5 * (VS_STRIDE / 2)] = (unsigned short)(r.v.z >> 16);
    p[6 * (VS_STRIDE / 2)] = (unsigned short)(r.v.w & 0xffffu); p[7 * (VS_STRIDE / 2)] = (unsigned short)(r.v.w >> 16);
#endif
}
DEV bf16x8 v_frag(const LAS unsigned char* buf, int u, int dt, int c16, int q4) {
#if MK_VTR
    const LAS unsigned char* vr = buf + AT_VT + (32 * u + 4 * q4 + (c16 >> 2)) * VS_STRIDE + (16 * dt + 4 * (c16 & 3)) * 2;
    const s16x4 lo = __builtin_bit_cast(s16x4, __builtin_amdgcn_ds_read_tr16_b64_v4i16((LAS v4i16_t*)vr));
    const s16x4 hi = __builtin_bit_cast(s16x4, __builtin_amdgcn_ds_read_tr16_b64_v4i16((LAS v4i16_t*)(vr + 16 * VS_STRIDE)));
#else
    const LAS unsigned char* vr = buf + AT_VT + (16 * dt + c16) * VS_STRIDE + (32 * u + 4 * q4) * 2;
    const s16x4 lo = *(const LAS s16x4*)vr, hi = *(const LAS s16x4*)(vr + 32);
#endif
    return __builtin_shufflevector(lo, hi, 0, 1, 2, 3, 4, 5, 6, 7);
}
struct NoInit { DEV float operator()(int) const { return 0.f; } };
template <int NT, int TM0, int TM1, int TM2, int TM3, class F0, class F1, class F2, class F3, class I1 = NoInit, class I2 = NoInit>
DEV void chunk_tiles(const LAS unsigned char* buf, const LAS unsigned char* ql, float (&m_run)[NT], float (&l_run)[NT], f32x4 (&o)[NT][4], int c16, int q4, F0 mf0, F1 mf1, F2 mf2, F3 mf3, I1 in1 = NoInit(), I2 in2 = NoInit()) {
    constexpr int TM[4] = {TM0, TM1, TM2, TM3};
    constexpr int TMALL = TM0 | TM1 | (NT > 2 ? (TM2 | TM3) : 0);
    f32x4 s[NT][4];
    {
        bf16x8 kf[4][2];
#pragma unroll
        for (int t = 0; t < 4; ++t)
            if ((TMALL >> t) & 1) {
#pragma unroll
                for (int k = 0; k < 2; ++k) kf[t][k] = *(const LAS bf16x8*)(buf + (16 * t + c16) * KS_STRIDE + (32 * k + 8 * q4) * 2);
            }
#pragma unroll
        for (int j = 0; j < NT; ++j) {
            const bf16x8 q0 = *(const LAS bf16x8*)(ql + (2 * j) * 1024), q1 = *(const LAS bf16x8*)(ql + (2 * j + 1) * 1024);
#pragma unroll
            for (int t = 0; t < 4; ++t) {
                f32x4 acc = {0.f, 0.f, 0.f, 0.f};
                if ((TM[j] >> t) & 1) {
                    if (j == 1) { acc[0] = in1(16 * t + 4 * q4 + 0); acc[1] = in1(16 * t + 4 * q4 + 1); acc[2] = in1(16 * t + 4 * q4 + 2); acc[3] = in1(16 * t + 4 * q4 + 3); }
                    if (j == 2) { acc[0] = in2(16 * t + 4 * q4 + 0); acc[1] = in2(16 * t + 4 * q4 + 1); acc[2] = in2(16 * t + 4 * q4 + 2); acc[3] = in2(16 * t + 4 * q4 + 3); }
                    acc = MFMA16(kf[t][0], q0, acc); acc = MFMA16(kf[t][1], q1, acc); }
                s[j][t] = acc;
            }
        }
    }
    bf16x8 bp[NT][2];
#pragma unroll
    for (int j = 0; j < NT; ++j) {
        float mx = m_run[j];
#pragma unroll
        for (int t = 0; t < 4; ++t)
            if ((TM[j] >> t) & 1) {
#pragma unroll
                for (int r = 0; r < 4; ++r) { const int kk = 16 * t + 4 * q4 + r; float v = s[j][t][r]; v = (j == 0) ? mf0(kk, v) : (j == 1) ? mf1(kk, v) : (j == 2) ? mf2(kk, v) : mf3(kk, v); s[j][t][r] = v; mx = fmaxf(mx, v); }
            }
        mx = xrow16_max(mx);
        const float alpha = __builtin_amdgcn_exp2f(m_run[j] - mx); m_run[j] = mx;
        float ls = 0.f;
#pragma unroll
        for (int t = 0; t < 4; ++t)
            if ((TM[j] >> t) & 1) {
#pragma unroll
                for (int r = 0; r < 4; ++r) { const float p = __builtin_amdgcn_exp2f(s[j][t][r] - mx); s[j][t][r] = p; ls += p; }
            }
        l_run[j] = l_run[j] * alpha + ls;
#pragma unroll
        for (int dt = 0; dt < 4; ++dt) o[j][dt] = o[j][dt] * alpha;
#pragma unroll
        for (int u = 0; u < 2; ++u) bp[j][u] = pack8(s[j][2 * u], s[j][2 * u + 1]);
    }
#pragma unroll
    for (int u = 0; u < 2; ++u)
        if ((TMALL >> (2 * u)) & 3) {
#pragma unroll
            for (int dt = 0; dt < 4; ++dt) { const bf16x8 vf = v_frag(buf, u, dt, c16, q4);
#pragma unroll
                for (int j = 0; j < NT; ++j) if ((TM[j] >> (2 * u)) & 3) o[j][dt] = MFMA16(vf, bp[j][u], o[j][dt]); }
        }
    AT_SCHED();
}
DEV void attn_store(bf16* dst, float l_run, const f32x4 (&o)[4], int q4) {
    const float inv = 1.0f / xrow16_sum(l_run);
#pragma unroll
    for (int dt = 0; dt < 4; ++dt) { u32x2 u; u.x = pk2(o[dt][0] * inv, o[dt][1] * inv); u.y = pk2(o[dt][2] * inv, o[dt][3] * inv); *(u32x2*)(dst + 16 * dt + 4 * q4) = u; }
}
DEV int na_start(int r) { return r - 4 < 0 ? 0 : (r - 4 > 24 ? 24 : r - 4); }
template <int MODE> DEV void attn4_unit(const Args& A, int L, int unit, LAS unsigned char* lds, int tid) {
    constexpr int NT = (MODE == 3) ? 2 : 4;
    const int w = __builtin_amdgcn_readfirstlane(tid >> 6), lane = tid & 63, c16 = lane & 15, q4 = lane >> 4;
    unsigned char* ws = A.ws;
    const bf16* proj = (const bf16*)(ws + WS_PROJ);
    bf16* ybr = (bf16*)(ws + WS_YBR);
    LAS float* RPB = (LAS float*)(lds + AT_RPB);
    int b, h = 0, kcol, vcol, nlat = 0, lat0 = 0, kr0 = 0, tq = 0, rq = 0;
    size_t qrow0; int qcol0; float m_run[NT], l_run[NT]; int kvh = 0;
    if (MODE == 0 || MODE == 2) {
        if (MODE == 0) { const int qb = unit & 15; kvh = (unit >> 4) & 1; b = unit >> 5; tq = qb * 128 + 16 * w + c16;
            const int lo = qb * 128 - 128 < 0 ? 0 : qb * 128 - 128, hi = qb * 128 + 256 > SEQ ? SEQ : qb * 128 + 256; lat0 = lo; nlat = (hi - lo) >> 6; }
        else { const int qb = unit & 1; kvh = (unit >> 1) & 1; b = unit >> 2; tq = qb * 128 + 16 * w + c16; }
        kcol = 2560 + kvh * 64; vcol = 2688 + kvh * 64;
#pragma unroll
        for (int j = 0; j < NT; ++j) { const int hq = kvh * 4 + j; m_run[j] = A.in[I_SINK][L * 8 + hq] * LOG2E; l_run[j] = q4 == 0 ? 1.f : 0.f; }
        qrow0 = (MODE == 0) ? (size_t)b * SEQ + tq : (size_t)ML + b * LC + tq; qcol0 = 2048 + kvh * 4 * 64;
    } else {
        if (MODE == 1) { const int rg = unit & 3; h = (unit >> 2) & 7; b = unit >> 5; rq = 8 * rg + w; kr0 = na_start(8 * rg); nlat = na_start(8 * rg + 7) + 8 - kr0; }
        else { h = unit & 7; b = unit >> 3; }
        kcol = 3328 + h * 64; vcol = 3840 + h * 64;
#pragma unroll
        for (int j = 0; j < NT; ++j) { m_run[j] = -1e30f; l_run[j] = 0.f; }
        qrow0 = (MODE == 1) ? (size_t)b * SEQ + rq * 64 + c16 : (size_t)ML + b * LC + 32 * w + c16; qcol0 = 2816 + h * 64;
    }
    f32x4 o[NT][4];
#pragma unroll
    for (int j = 0; j < NT; ++j)
#pragma unroll
        for (int dt = 0; dt < 4; ++dt) o[j][dt] = (f32x4){0.f, 0.f, 0.f, 0.f};
    constexpr size_t QSTRIDE = (MODE == 0 || MODE == 2) ? (size_t)64 : (size_t)16 * PS;
    const bf16* qb = proj + qrow0 * PS + qcol0 + 8 * q4;
    LAS unsigned char* ql = lds + AT_Q + w * 8192 + lane * 16;
    const int nch = 4 + nlat;
#define CH_ROW0(ci) ((ci) < 4 ? (size_t)ML + b * LC + (ci) * 64 : (MODE == 0 ? (size_t)b * SEQ + lat0 + ((ci) - 4) * 64 : (size_t)b * SEQ + (kr0 + (ci) - 4) * 64))
#define CH_LOAD(R, ci) do { const size_t r_ = CH_ROW0(ci); kv_load(R, proj + r_ * PS + kcol, proj + r_ * PS + vcol, tid); } while (0)
    KVRegs kvA, kvB;
    __syncthreads();
    if (MODE == 1) {
        for (int i = tid; i < 960; i += NTHREADS) { const int rw = i >> 6, dc = (i & 63) - 16; const bool in = dc >= 0 && dc <= 30;
            const float v = in ? A.in[I_RPB][(size_t)(L * 8 + h) * 465 + rw * 31 + dc] * LOG2E : 0.f;
            RPB[i] = v; RPB[960 + i] = (dc >= 7 && dc <= 22) ? v : -INFINITY; } }
    CH_LOAD(kvA, 0);
    CH_LOAD(kvB, 1);
#pragma unroll
    for (int j = 0; j < NT; ++j)
#pragma unroll
        for (int k = 0; k < 2; ++k) *(LAS u32x4*)(ql + (2 * j + k) * 1024) = *(const u32x4*)(qb + j * QSTRIDE + 32 * k);
    kv_write(lds, kvA, tid);
    CH_LOAD(kvA, 2);
    const int sw = na_start(rq);
    auto compute = [&](int ci) {
        const LAS unsigned char* buf = lds + (ci & 1) * AT_BUF;
        if (ci < 4) {
            auto nomask = [](int, float s) { return s; };
            chunk_tiles<NT, 15, 15, 15, 15>(buf, ql, m_run, l_run, o, c16, q4, nomask, nomask, nomask, nomask);
        } else if constexpr (MODE == 0) {
            const int k0 = lat0 + (ci - 4) * 64, tq0 = tq - c16;
            if (k0 >= tq0 + 15 - 128 && k0 + 63 <= tq0 + 128) {
                auto nomask = [](int, float s) { return s; };
                chunk_tiles<NT, 15, 15, 15, 15>(buf, ql, m_run, l_run, o, c16, q4, nomask, nomask, nomask, nomask);
            } else if (k0 + 63 >= tq0 - 128 && k0 <= tq0 + 15 + 128) {
                auto wmask = [=](int kk, float s) { const int d = tq - (k0 + kk); return (d <= 128 && d >= -128) ? s : -INFINITY; };
                chunk_tiles<NT, 15, 15, 15, 15>(buf, ql, m_run, l_run, o, c16, q4, wmask, wmask, wmask, wmask);
            }
        } else if constexpr (MODE == 1) {
            const int kr = kr0 + ci - 4;
            if (kr >= sw && kr < sw + 8) {
                const LAS float* brow = RPB + (kr - rq + 7) * 64 + 16 + 15 - c16;
#define NA_ME(j) [=](int ck, float s) { const int cq = 16 * (j) + c16; const int cs = cq - 8 < 0 ? 0 : (cq - 8 > 48 ? 48 : cq - 8); return ((unsigned)(ck - cs) < 16u) ? s + brow[ck - 16 * (j)] : -INFINITY; }
#define NA_MI(j) [=](int ck) { return brow[960 + ck - 16 * (j)]; }
                auto ident = [](int, float s) { return s; };
                chunk_tiles<NT, 3, 7, 14, 12>(buf, ql, m_run, l_run, o, c16, q4, NA_ME(0), ident, ident, NA_ME(3), NA_MI(1), NA_MI(2));
#undef NA_ME
#undef NA_MI
            }
        }
    };
    for (int ci = 0; ci < nch; ci += 2) {
        __syncthreads();
        if (ci + 1 < nch) { kv_write(lds + AT_BUF, kvB, tid); if (ci + 3 < nch) CH_LOAD(kvB, ci + 3); }
        AT_SCHED();
        compute(ci);
        if (ci + 1 >= nch) break;
        __syncthreads();
        if (ci + 2 < nch) { kv_write(lds, kvA, tid); if (ci + 4 < nch) CH_LOAD(kvA, ci + 4); }
        AT_SCHED();
        compute(ci + 1);
    }
#undef CH_LOAD
#undef CH_ROW0
#pragma unroll
    for (int j = 0; j < NT; ++j) {
        size_t qr; int oc, br;
        if (MODE == 0 || MODE == 2) { qr = (MODE == 0) ? (size_t)b * SEQ + tq : (size_t)ML + b * LC + tq; oc = (kvh * 4 + j) * 64; br = 1; }
        else { qr = (MODE == 1) ? (size_t)b * SEQ + rq * 64 + 16 * j + c16 : (size_t)ML + b * LC + 32 * w + 16 * j + c16; oc = h * 64; br = 2; }
        attn_store(ybr + ((size_t)br * MT + qr) * 512 + oc, l_run[j], o[j], q4);
    }
}

constexpr int RS = 136;
DEV void ret_unit_ids(int unit, int& b, int& h, int& ck, size_t& row0) {
    ck = unit % 18; const int bh = unit / 18; h = bh & 3; b = bh >> 2;
    row0 = ck < 16 ? (size_t)b * SEQ + ck * 128 : (size_t)ML + b * LC + (ck - 16) * 128;
}
DEV float log_gamma(const Args& A, int L, int dir, int h) { return log1pf(-__expf(A.in[I_DECAY][L * 8 + dir * 4 + h])); }
constexpr int SC_STRIDE = 288;
constexpr int SC_V = 128 * SC_STRIDE;
DEV void scan_unit(const Args& A, int L, int unit, LAS unsigned char* lds, int tid) {
    const int w = __builtin_amdgcn_readfirstlane(tid >> 6), lane = tid & 63, c16 = lane & 15, q4 = lane >> 4;
    const int dir = unit & 1, bh = unit >> 1, h = bh & 3, b = bh >> 2;
    unsigned char* ws = A.ws; const bf16* proj = (const bf16*)(ws + WS_PROJ);
    const float lg = log_gamma(A, L, dir, h), gC = __expf(lg * 128.0f);
    bf16* ST = (bf16*)(ws + WS_ST) + ((size_t)bh * 18 * 2 + dir) * 16384 + (size_t)(16 * w + c16) * 128 + 4 * q4;
#define SC_CK(s) (dir == 0 ? ((s) < 2 ? 16 + (s) : (s) - 2) : 17 - (s))
#define SC_ROW0(ck) ((ck) < 16 ? (size_t)b * SEQ + (ck) * 128 : (size_t)ML + b * LC + ((ck) - 16) * 128)
    u32x4 rk[4], rv[4];
#define SC_LOAD(s) do { const size_t r0_ = SC_ROW0(SC_CK(s)); _Pragma("unroll") for (int i = 0; i < 4; ++i) { const int q = tid + 512 * i, tk = q >> 4, dc = q & 15; \
        rk[i] = *(const u32x4*)(proj + (r0_ + tk) * PS + 512 + h * 128 + 8 * dc); rv[i] = *(const u32x4*)(proj + (r0_ + tk) * PS + 1024 + h * 128 + 8 * dc); } } while (0)
    f32x4 acc[8];
#pragma unroll
    for (int t = 0; t < 8; ++t) acc[t] = (f32x4){0.f, 0.f, 0.f, 0.f};
    SC_LOAD(0);
    for (int s = 0; s < 18; ++s) {
        { bf16* st = ST + (size_t)SC_CK(s) * 32768;
#pragma unroll
          for (int t = 0; t < 8; ++t) { u32x2 o; o.x = pk2(acc[t][0], acc[t][1]); o.y = pk2(acc[t][2], acc[t][3]); *(u32x2*)(st + 16 * t) = o; } }
        if (s == 17) break;
        __syncthreads();
#pragma unroll
        for (int i = 0; i < 4; ++i) { const int q = tid + 512 * i, tk = q >> 4, dc = q & 15;
            const float wt = dir == 0 ? __expf(lg * (float)(127 - tk)) : __expf(lg * (float)tk);
            u32x4 kw; kw.x = pk2(bflo(rk[i].x) * wt, bfhi(rk[i].x) * wt); kw.y = pk2(bflo(rk[i].y) * wt, bfhi(rk[i].y) * wt); kw.z = pk2(bflo(rk[i].z) * wt, bfhi(rk[i].z) * wt); kw.w = pk2(bflo(rk[i].w) * wt, bfhi(rk[i].w) * wt);
            *(LAS u32x4*)(lds + tk * SC_STRIDE + dc * 16) = kw; *(LAS u32x4*)(lds + SC_V + tk * SC_STRIDE + dc * 16) = rv[i]; }
        if (s + 1 < 17) SC_LOAD(s + 1);
        __syncthreads();
#pragma unroll
        for (int t = 0; t < 8; ++t) acc[t] = acc[t] * gC;
#pragma unroll
        for (int k = 0; k < 4; ++k) {
            const LAS unsigned char* vb = lds + SC_V + (32 * k + 4 * q4 + (c16 >> 2)) * SC_STRIDE + (16 * w + 4 * (c16 & 3)) * 2;
            const s16x4 vlo = __builtin_bit_cast(s16x4, __builtin_amdgcn_ds_read_tr16_b64_v4i16((LAS v4i16_t*)vb)), vhi = __builtin_bit_cast(s16x4, __builtin_amdgcn_ds_read_tr16_b64_v4i16((LAS v4i16_t*)(vb + 16 * SC_STRIDE)));
            const bf16x8 bfrag = __builtin_shufflevector(vlo, vhi, 0, 1, 2, 3, 4, 5, 6, 7);
#pragma unroll
            for (int t = 0; t < 8; ++t) {
                const LAS unsigned char* kb = lds + (32 * k + 4 * q4 + (c16 >> 2)) * SC_STRIDE + (16 * t + 4 * (c16 & 3)) * 2;
                const s16x4 klo = __builtin_bit_cast(s16x4, __builtin_amdgcn_ds_read_tr16_b64_v4i16((LAS v4i16_t*)kb)), khi = __builtin_bit_cast(s16x4, __builtin_amdgcn_ds_read_tr16_b64_v4i16((LAS v4i16_t*)(kb + 16 * SC_STRIDE)));
                acc[t] = MFMA16(__builtin_shufflevector(klo, khi, 0, 1, 2, 3, 4, 5, 6, 7), bfrag, acc[t]);
            }
        }
    }
#undef SC_LOAD
#undef SC_ROW0
#undef SC_CK
    asm volatile("s_waitcnt vmcnt(0)" ::: "memory");
    __syncthreads();
    if (tid == 0) { __builtin_amdgcn_fence(__ATOMIC_RELEASE, "agent"); asm volatile("s_waitcnt vmcnt(0)" ::: "memory");
        __hip_atomic_fetch_add((unsigned*)(ws + WS_CTL) + CW_RFLAG + (L * 32 + bh) * 64, 1u, __ATOMIC_RELAXED, __HIP_MEMORY_SCOPE_AGENT); }
}
DEV void r3_unit(const Args& A, int L, int unit, LAS unsigned char* lds, int tid) {
    const int w = __builtin_amdgcn_readfirstlane(tid >> 6), lane = tid & 63, c16 = lane & 15, q4 = lane >> 4;
    int b, h, ck; size_t row0; ret_unit_ids(unit, b, h, ck, row0);
    unsigned char* ws = A.ws; const bf16* proj = (const bf16*)(ws + WS_PROJ);
    const float lgf = log_gamma(A, L, 0, h), lgb = log_gamma(A, L, 1, h);
    LAS unsigned short* KS = (LAS unsigned short*)lds; LAS unsigned short* VT = KS + 128 * RS;
    if (tid == 0) {
        const unsigned* fl = (const unsigned*)(ws + WS_CTL) + CW_RFLAG + (L * 32 + b * 4 + h) * 64; unsigned sp = 0;
        while (__hip_atomic_load(fl, __ATOMIC_RELAXED, __HIP_MEMORY_SCOPE_AGENT) < 2u) { __builtin_amdgcn_s_sleep(2); if (++sp > (1u << 22)) break; }
        __builtin_amdgcn_fence(__ATOMIC_ACQUIRE, "agent"); asm volatile("s_waitcnt vmcnt(0)" ::: "memory");
    }
    __syncthreads();
    for (int q = tid; q < 2048; q += NTHREADS) { const int i = q >> 4, dc = q & 15;
        const u32x4 kv = *(const u32x4*)(proj + (row0 + i) * PS + 512 + h * 128 + 8 * dc), vv = *(const u32x4*)(proj + (row0 + i) * PS + 1024 + h * 128 + 8 * dc);
        *(LAS u32x4*)(KS + i * RS + 8 * dc) = kv;
        *(LAS u32x4*)((LAS unsigned char*)VT + i * 288 + 16 * dc) = vv; }
    __syncthreads();
    const int n = 16 * w + c16; const size_t row = row0 + n;
    bf16x8 qf[4];
#pragma unroll
    for (int k = 0; k < 4; ++k) qf[k] = *(const bf16x8*)(proj + row * PS + h * 128 + 32 * k + 8 * q4);
    f32x4 sT[8];
#pragma unroll
    for (int t = 0; t < 8; ++t) { f32x4 acc = {0.f, 0.f, 0.f, 0.f};
#pragma unroll
        for (int k = 0; k < 4; ++k) { const bf16x8 a = *(const LAS bf16x8*)(KS + (16 * t + c16) * RS + 32 * k + 8 * q4); acc = MFMA16(a, qf[k], acc); }
#pragma unroll
        for (int r = 0; r < 4; ++r) { const int d = n - (16 * t + 4 * q4 + r); acc[r] *= (d >= 0) ? __expf(lgf * (float)d) : __expf(-lgb * (float)d); }
        sT[t] = acc; }
    f32x4 y[8];
#pragma unroll
    for (int dt = 0; dt < 8; ++dt) y[dt] = (f32x4){0.f, 0.f, 0.f, 0.f};
#pragma unroll
    for (int u = 0; u < 4; ++u) { const bf16x8 bp = pack8(sT[2 * u], sT[2 * u + 1]);
#pragma unroll
        for (int dt = 0; dt < 8; ++dt) { const LAS unsigned char* vr = (const LAS unsigned char*)VT + (32 * u + 4 * q4 + (c16 >> 2)) * 288 + (16 * dt + 4 * (c16 & 3)) * 2;
            const s16x4 lo = __builtin_bit_cast(s16x4, __builtin_amdgcn_ds_read_tr16_b64_v4i16((LAS v4i16_t*)vr)), hi = __builtin_bit_cast(s16x4, __builtin_amdgcn_ds_read_tr16_b64_v4i16((LAS v4i16_t*)(vr + 16 * 288)));
            y[dt] = MFMA16(__builtin_shufflevector(lo, hi, 0, 1, 2, 3, 4, 5, 6, 7), bp, y[dt]); } }
    const float df = __expf(lgf * (float)(n + 1)), db = __expf(lgb * (float)(128 - n));
    bf16x8 qdf[4], qdb[4];
#pragma unroll
    for (int k = 0; k < 4; ++k) { const u32x4 qq = __builtin_bit_cast(u32x4, qf[k]); u32x4 f, g;
        f.x = pk2(bflo(qq.x) * df, bfhi(qq.x) * df); f.y = pk2(bflo(qq.y) * df, bfhi(qq.y) * df); f.z = pk2(bflo(qq.z) * df, bfhi(qq.z) * df); f.w = pk2(bflo(qq.w) * df, bfhi(qq.w) * df);
        g.x = pk2(bflo(qq.x) * db, bfhi(qq.x) * db); g.y = pk2(bflo(qq.y) * db, bfhi(qq.y) * db); g.z = pk2(bflo(qq.z) * db, bfhi(qq.z) * db); g.w = pk2(bflo(qq.w) * db, bfhi(qq.w) * db);
        qdf[k] = __builtin_bit_cast(bf16x8, f); qdb[k] = __builtin_bit_cast(bf16x8, g); }
    const bf16* STf = (const bf16*)(ws + WS_ST) + (size_t)unit * 2 * 16384; const bf16* STb = STf + 16384;
#pragma unroll
    for (int dt = 0; dt < 8; ++dt)
#pragma unroll
        for (int k = 0; k < 4; ++k) { const bf16x8 a = *(const bf16x8*)(STf + (16 * dt + c16) * 128 + 32 * k + 8 * q4), a2 = *(const bf16x8*)(STb + (16 * dt + c16) * 128 + 32 * k + 8 * q4);
            y[dt] = MFMA16(a, qdf[k], y[dt]); y[dt] = MFMA16(a2, qdb[k], y[dt]); }
    float s = 0.f;
#pragma unroll
    for (int dt = 0; dt < 8; ++dt) s += (y[dt][0] + y[dt][1]) + (y[dt][2] + y[dt][3]);
    s = xrow16_sum(s);
    const float mu = s * (1.0f / 128.0f); float v = 0.f;
#pragma unroll
    for (int dt = 0; dt < 8; ++dt) { const f32x4 d = y[dt] - mu; v += (d[0] * d[0] + d[1] * d[1]) + (d[2] * d[2] + d[3] * d[3]); }
    v = xrow16_sum(v);
    const float rstd = rsqrtf(v * (1.0f / 128.0f) + EPS);
    bf16* yo = (bf16*)(ws + WS_YBR) + row * 512 + h * 128;
#pragma unroll
    for (int dt = 0; dt < 8; ++dt) { const u32x2 g = *(const u32x2*)(proj + row * PS + 1536 + h * 128 + 16 * dt + 4 * q4);
        u32x2 o; o.x = pk2(bflo(g.x) * (y[dt][0] - mu) * rstd, bfhi(g.x) * (y[dt][1] - mu) * rstd); o.y = pk2(bflo(g.y) * (y[dt][2] - mu) * rstd, bfhi(g.y) * (y[dt][3] - mu) * rstd);
        *(u32x2*)(yo + 16 * dt + 4 * q4) = o; }
}


DEV void panel_signal(unsigned* flag) {
    asm volatile("s_waitcnt vmcnt(0)" ::: "memory");
    __syncthreads();
    if (threadIdx.x == 0) {
        __builtin_amdgcn_fence(__ATOMIC_RELEASE, "agent"); asm volatile("s_waitcnt vmcnt(0)" ::: "memory");
        __hip_atomic_fetch_add(flag, 1u, __ATOMIC_RELAXED, __HIP_MEMORY_SCOPE_AGENT);
    }
}
DEV void panel_wait(const unsigned* flag) {
    if (threadIdx.x == 0) {
        unsigned sp = 0;
        for (int p = 0; p < 8; ++p)
            while (__hip_atomic_load(flag + p * 64, __ATOMIC_RELAXED, __HIP_MEMORY_SCOPE_AGENT) < 4u) { __builtin_amdgcn_s_sleep(2); if (++sp > (1u << 22)) break; }
        __builtin_amdgcn_fence(__ATOMIC_ACQUIRE, "agent"); asm volatile("s_waitcnt vmcnt(0)" ::: "memory");
    }
    __syncthreads();
}
__global__ void __launch_bounds__(NTHREADS, 2) mk_fwd(Args args) {
    extern __shared__ __attribute__((aligned(16))) unsigned char lds_raw[];
    LAS unsigned char* lds = (LAS unsigned char*)lds_raw;
    const int tid = threadIdx.x, G = gridDim.x;
    const int bx = blockIdx.x, vcu = (G % 8 == 0) ? (bx % 8) * (G / 8) + bx / 8 : bx;
    unsigned char* ws = args.ws;
    volatile LAS unsigned* MISC = (volatile LAS unsigned*)(lds + MISC_OFF);
    for (int u = tid; u < (LDS_BYTES - 131072) / 4; u += NTHREADS) ((LAS unsigned*)(lds + 131072))[u] = 0u;
    __syncthreads();
    const int lo = args.ph_lo, hi = args.ph_hi;
    XcdBarrier bar; bar.bar = (unsigned*)(ws + WS_CTL) + CW_BAR; bar.x = 0; bar.st = nullptr;
    if (hi - lo > 1) bar = xcd_barrier_post((unsigned*)(ws + WS_CTL) + CW_BAR, MISC + 8);
#define IN(k) (lo <= (k) && (k) < hi)
#define EN(b) (((MK_EN) >> (b)) & 1u)
#define REP(b) for (int _rp = 0; _rp < 1 + (int)(((MK_REP) >> (b)) & 1u); ++_rp)
#define OT() ({ int _t = threadIdx.x; asm volatile("" : "+v"(_t)); _t; })
#define SEAM(k) do { if (IN(k) && IN((k) + 1)) xcd_barrier(bar); } while (0)
    const pg8::bf16_t* XN = (const pg8::bf16_t*)(ws + WS_XN);
    pg8::bf16_t* PROJ = (pg8::bf16_t*)(ws + WS_PROJ);
    const float* TAB = (const float*)(ws + WS_TAB);

    if (EN(0) && IN(0)) REP(0) { p0_prologue(args, lds, vcu, G, OT()); } SEAM(0);
    if (EN(1) && IN(1)) REP(1) { thin_phase<0>(args, 0, vcu, G, 0, MT, OT(), lds); } SEAM(1);
    for (int L = 0; L < DEPTH; ++L) {
        const int pb = 2 + 11 * L;
        const bool need_ctx = L < DEPTH - 1;
        const int Mact = need_ctx ? MT : ML;
        if (EN(2) && IN(pb + 0)) REP(2) {
            if constexpr (F8GATE) {
                { pg8::Gemm g{XN, (const pg8::bf16_t*)(ws + WS_WIN + (size_t)L * DIN * 1024 * 2), MT, 4352, 1024}; pg8::StaticOrder S; S.init(MT, 4352, G, bx);
                  pg8::EpiInProj<false> E{PROJ, TAB + TAB_RTC, TAB + TAB_RTS, TAB + TAB_AXC, TAB + TAB_AXS, 1.0f, 0};
                  pg8::gemm_phase<pg8::EpiInProj<false>, pg8::StaticOrder, true, true, false>(lds, g, S, E); }
                { pg8::Gemm g{(const pg8::bf16_t*)(ws + WS_XN8), (const pg8::bf16_t*)(ws + WS_WIN8 + (size_t)L * 3072 * 1024), MT, 3072, 512}; pg8::TailOrder S; S.init(MT, 3072, G, bx); S.cut = (72 * 17) % G; S.base = (72 * 12) / G; if (S.cut == 0) S.base = 1 << 20;
                  pg8::EpiGate E{ws + WS_G8};
                  pg8::gemm_phase<pg8::EpiGate, pg8::TailOrder, true, true, true>(lds, g, S, E); }
            } else {
            pg8::Gemm g{XN, (const pg8::bf16_t*)(ws + WS_WIN + (size_t)L * DIN * 1024 * (F8IN ? 1 : 2)), MT, DIN, F8IN ? 512 : 1024}; pg8::StaticOrder S; S.init(MT, DIN, G, bx);
            pg8::EpiInProj<true> E{PROJ, TAB + TAB_RTC, TAB + TAB_RTS, TAB + TAB_AXC, TAB + TAB_AXS, F8IN ? 0.015625f : 1.0f, 0};
            pg8::gemm_phase<pg8::EpiInProj<true>, pg8::StaticOrder, true, true, F8IN>(lds, g, S, E);
            }
        } SEAM(pb + 0);
        if (IN(pb + 1)) {
            unsigned* wq = (unsigned*)(ws + WS_CTL) + CW_WQ + L * 64;
            const int n_ctx = need_ctx ? 96 : 0, n_att = 64 + 256 + 256 + n_ctx, n_units = n_att + (need_ctx ? 576 : 512);
            for (;;) {
                if (threadIdx.x == 0) MISC[16] = __hip_atomic_fetch_add(wq, 1u, __ATOMIC_RELAXED, __HIP_MEMORY_SCOPE_AGENT);
                __syncthreads();
                const int u = (int)MISC[16];
                __syncthreads();
                if (u >= n_units) break;
                const int n_r3 = need_ctx ? 576 : 512;
                if (u < 64) { if (EN(6)) scan_unit(args, L, u, lds, OT()); }
                else if (u < 320) { if (EN(4)) attn4_unit<1>(args, L, u - 64, lds, OT()); }
                else if (u < 320 + n_r3) { const int v = u - 320; if (EN(8)) r3_unit(args, L, need_ctx ? v : (v >> 4) * 18 + (v & 15), lds, OT()); }
                else if (u < 576 + n_r3) { if (EN(3)) attn4_unit<0>(args, L, u - 320 - n_r3, lds, OT()); }
                else if (u < 608 + n_r3) { if (EN(5)) attn4_unit<2>(args, L, u - 576 - n_r3, lds, OT()); }
                else { if (EN(5)) attn4_unit<3>(args, L, u - 608 - n_r3, lds, OT()); }
            }
        } SEAM(pb + 1);
        if (EN(9) && IN(pb + 4)) REP(9) {
            pg8::Gemm g{(const pg8::bf16_t*)(ws + WS_YBR), (const pg8::bf16_t*)(ws + WS_WBR) + (size_t)L * 3 * 1024 * 512, 3 * MT, 3 * 1024, 512};
            { pg8::BranchOrder S{(ML / 256) * 4, G, vcu};
              pg8::EpiBranch E{ws + WS_G8, (pg8::bf16_t*)(ws + WS_MERGED)};
              pg8::gemm_phase<pg8::EpiBranch, pg8::BranchOrder, true, true>(lds, g, S, E); }
            if (need_ctx) { pg8::PartOrder S{G, vcu};
              pg8::EpiBranchPart E{ws + WS_G8, (pg8::bf16_t*)(ws + WS_PART)};
              pg8::gemm_phase<pg8::EpiBranchPart, pg8::PartOrder, true, true>(lds, g, S, E); }
        } SEAM(pb + 4);
#define BAR_ALWAYS() do { if (hi - lo > 1) xcd_barrier(bar); } while (0)
        if (EN(10) && IN(pb + 5)) {
            const pg8::bf16_t* Wo = (const pg8::bf16_t*)(ws + WS_WOUT) + (size_t)L * 1024 * 1024;
            if (need_ctx) {
                { pg8::Gemm g{(const pg8::bf16_t*)(ws + WS_MERGED), Wo, ML, 1024, 1024}; pg8::StaticOrder S; S.init(ML, 1024, G, bx);
                  pg8::EpiPlain E{(pg8::bf16_t*)(ws + WS_YOUT), 1024, 4, 1.0f};
                  pg8::gemm_phase<pg8::EpiPlain, pg8::StaticOrder, true, true>(lds, g, S, E); }
                { const int t_ = OT(), lane_ = t_ & 63;
                  for (int row = vcu * 8 + (t_ >> 6); row < MC; row += G * 8) {
                      const unsigned char* pp = ws + WS_PART + ((size_t)row * 1024 + lane_ * 16) * 2;
                      float f[16];
#pragma unroll
                      for (int r = 0; r < 3; ++r) {
                          const uint4 w0 = *(const uint4*)(pp + (size_t)r * MC * 2048), w1 = *(const uint4*)(pp + (size_t)r * MC * 2048 + 16);
                          const unsigned ww[8] = {w0.x, w0.y, w0.z, w0.w, w1.x, w1.y, w1.z, w1.w};
#pragma unroll
                          for (int k = 0; k < 8; ++k) { const float lo_ = __uint_as_float(ww[k] << 16), hi_ = __uint_as_float(ww[k] & 0xffff0000u);
                              if (r == 0) { f[2 * k] = lo_; f[2 * k + 1] = hi_; } else { f[2 * k] += lo_; f[2 * k + 1] += hi_; } }
                      }
                      uint4 o0, o1;
                      o0.x = pg8::cvt_pk_bf16(f[0], f[1]); o0.y = pg8::cvt_pk_bf16(f[2], f[3]); o0.z = pg8::cvt_pk_bf16(f[4], f[5]); o0.w = pg8::cvt_pk_bf16(f[6], f[7]);
                      o1.x = pg8::cvt_pk_bf16(f[8], f[9]); o1.y = pg8::cvt_pk_bf16(f[10], f[11]); o1.z = pg8::cvt_pk_bf16(f[12], f[13]); o1.w = pg8::cvt_pk_bf16(f[14], f[15]);
                      unsigned char* op = ws + WS_MERGED + ((size_t)(ML + row) * 1024 + lane_ * 16) * 2;
                      *(uint4*)op = o0; *(uint4*)(op + 16) = o1;
                  } }
                BAR_ALWAYS();
                if (vcu < 32) { pg8::Gemm g{(const pg8::bf16_t*)(ws + WS_MERGED) + (size_t)ML * 1024, Wo, MC, 1024, 1024}; pg8::StaticOrder S; S.init(MC, 1024, 32, vcu);
                  pg8::EpiPlain E{(pg8::bf16_t*)(ws + WS_YOUT) + (size_t)ML * 1024, 1024, 4, 1.0f};
                  pg8::gemm_phase<pg8::EpiPlain, pg8::StaticOrder, true, true>(lds, g, S, E);
                  panel_signal((unsigned*)(ws + WS_CTL) + CW_PFLAG + ((L * 2 + 0) * 8 + (((vcu % 8) * 4 + vcu / 8) & 7)) * 64); }
                else thin_phase<1>(args, L, vcu - 32, G - 32, 0, ML, OT(), lds);
                panel_wait((const unsigned*)(ws + WS_CTL) + CW_PFLAG + (L * 2 + 0) * 8 * 64);
                thin_phase<1>(args, L, vcu, G, ML, MT, OT(), lds);
            } else {
                pg8::Gemm g{(const pg8::bf16_t*)(ws + WS_MERGED), Wo, ML, 1024, 1024}; pg8::StaticOrder S; S.init(ML, 1024, G, bx);
                pg8::EpiPlain E{(pg8::bf16_t*)(ws + WS_YOUT), 1024, 4, 1.0f};
                pg8::gemm_phase<pg8::EpiPlain, pg8::StaticOrder, true, true>(lds, g, S, E);
            }
        } SEAM(pb + 5);
        if (EN(11) && IN(pb + 6)) { if (!need_ctx) thin_phase<1>(args, L, vcu, G, 0, ML, OT(), lds); } if (!need_ctx) SEAM(pb + 6);
        if (L & 1) {
            const int mi = L >> 1;
            const unsigned* cnt = (const unsigned*)(ws + WS_CTL) + CW_MOE + mi * 8 * 64;
            if (EN(12) && IN(pb + 7)) REP(12) { gather_phase(args, L, vcu, G, OT()); } SEAM(pb + 7);
            if (EN(13) && IN(pb + 8)) REP(13) {
                constexpr int EB = F8UP_M ? 1 : 2;
                pg8::Gemm g{(const pg8::bf16_t*)(ws + WS_ASORT), (const pg8::bf16_t*)(ws + WS_WM13 + (size_t)mi * 8 * 2 * FFE * 1024 * EB), MSORT, 8 * 2 * FFE, 512 * EB};
                pg8::MoeOrder S; S.init(cnt, 28, G, bx);
                pg8::EpiSwiGLUx<F8UP_M, F8DN_M> E{ws + WS_HID, FFE, 28};
                pg8::gemm_phase<pg8::EpiSwiGLUx<F8UP_M, F8DN_M>, pg8::MoeOrder, true, true, F8UP_M>(lds, g, S, E);
            } SEAM(pb + 8);
            if (EN(14) && IN(pb + 9)) REP(14) {
                constexpr int EB = F8DN_M ? 1 : 2;
                pg8::Gemm g{(const pg8::bf16_t*)(ws + WS_HID), (const pg8::bf16_t*)(ws + WS_WM2 + (size_t)mi * 8 * 1024 * FFE * EB), MSORT, 8 * 1024, FFE / 2 * EB};
                pg8::MoeOrder S; S.init(cnt, 4, G, bx);
                pg8::EpiPlain E{(pg8::bf16_t*)(ws + WS_OSORT), 1024, 4, F8DN_M ? 1.0f / 2048.0f : 1.0f};
                pg8::gemm_phase<pg8::EpiPlain, pg8::MoeOrder, true, true, F8DN_M>(lds, g, S, E);
            } SEAM(pb + 9);
        } else {
            const int fi = L >> 1;
            if (EN(15) && IN(pb + 8)) REP(15) {
                constexpr int EB = F8UP_D ? 1 : 2;
                pg8::Gemm g{XN, (const pg8::bf16_t*)(ws + WS_WF13 + (size_t)fi * 2 * FFD * 1024 * EB), Mact, 2 * FFD, 512 * EB}; pg8::StaticOrder S; S.init(Mact, 2 * FFD, G, bx);
                pg8::EpiSwiGLUx<F8UP_D, F8DN_D> E{ws + WS_HID, FFD, 22};
                pg8::gemm_phase<pg8::EpiSwiGLUx<F8UP_D, F8DN_D>, pg8::StaticOrder, true, true, F8UP_D>(lds, g, S, E);
            } SEAM(pb + 8);
            if (EN(16) && IN(pb + 9)) {
                constexpr int EB = F8DN_D ? 1 : 2; constexpr float sc = F8DN_D ? 1.0f / 2048.0f : 1.0f;
                const pg8::bf16_t* W2 = (const pg8::bf16_t*)(ws + WS_WF2 + (size_t)fi * 1024 * FFD * EB);
                { pg8::Gemm g{(const pg8::bf16_t*)(ws + WS_HID), W2, ML, 1024, FFD / 2 * EB}; pg8::StaticOrder S; S.init(ML, 1024, G, bx);
                  pg8::EpiPlain E{(pg8::bf16_t*)(ws + WS_YOUT), 1024, 4, sc};
                  pg8::gemm_phase<pg8::EpiPlain, pg8::StaticOrder, true, true, F8DN_D>(lds, g, S, E); }
                BAR_ALWAYS();
                if (vcu < 32) { pg8::Gemm g{(const pg8::bf16_t*)(ws + WS_HID + (size_t)ML * FFD * EB), W2, MC, 1024, FFD / 2 * EB}; pg8::StaticOrder S; S.init(MC, 1024, 32, vcu);
                  pg8::EpiPlain E{(pg8::bf16_t*)(ws + WS_YOUT) + (size_t)ML * 1024, 1024, 4, sc};
                  pg8::gemm_phase<pg8::EpiPlain, pg8::StaticOrder, true, true, F8DN_D>(lds, g, S, E);
                  panel_signal((unsigned*)(ws + WS_CTL) + CW_PFLAG + ((L * 2 + 1) * 8 + (((vcu % 8) * 4 + vcu / 8) & 7)) * 64); }
                else thin_phase<2>(args, L, vcu - 32, G - 32, 0, ML, OT(), lds);
                panel_wait((const unsigned*)(ws + WS_CTL) + CW_PFLAG + (L * 2 + 1) * 8 * 64);
                thin_phase<2>(args, L, vcu, G, ML, MT, OT(), lds);
            } SEAM(pb + 9);
        }
        if (EN(17) && IN(pb + 10)) { if (L & 1) thin_phase<2>(args, L, vcu, G, 0, Mact, OT(), lds); } if (L & 1) SEAM(pb + 10);
    }
#undef IN
#undef SEAM
}


extern "C" void kernel_launch(void* const* d_in, const int* in_sizes, int n_in, void* d_out, int out_size, void* d_ws, size_t ws_size, hipStream_t stream) {
    static int grid = 0;
    if (grid == 0) {
        if (n_in != 20 || out_size != ML * D || ws_size < WS_END) { fprintf(stderr, "kernel_launch: unexpected shapes (n_in %d out %d ws %zu need %zu)\n", n_in, out_size, ws_size, (size_t)WS_END); grid = -1; return; }
        int dev = 0, cus = 0;
        if (hipGetDevice(&dev) != hipSuccess || hipDeviceGetAttribute(&cus, hipDeviceAttributeMultiprocessorCount, dev) != hipSuccess) { grid = -1; return; }
        if (hipFuncSetAttribute((const void*)mk_fwd, hipFuncAttributeMaxDynamicSharedMemorySize, LDS_BYTES) != hipSuccess) { fprintf(stderr, "kernel_launch: hipFuncSetAttribute failed\n"); grid = -1; return; }
        int per_cu = 0;
        (void)hipOccupancyMaxActiveBlocksPerMultiprocessor(&per_cu, (const void*)mk_fwd, NTHREADS, LDS_BYTES);
        (void)hipGetLastError();
        grid = cus;
    }
    if (grid < 0) return;
    (void)hipMemsetAsync((char*)d_ws + WS_CTL, 0, CTL_ZERO_BYTES, stream);
    Args a{};
    for (int i = 0; i < 20; ++i) a.in[i] = (const float*)d_in[i];
    a.out = (float*)d_out; a.ws = (unsigned char*)d_ws; a.li = 0; a.pad = 0;
#if MK_PER_PHASE
    for (int ph = 0; ph < MK_NPH_RUN; ++ph) { a.ph_lo = ph; a.ph_hi = ph + 1; hipLaunchKernelGGL(mk_fwd, dim3(grid), dim3(NTHREADS), LDS_BYTES, stream, a); }
#else
    a.ph_lo = 0; a.ph_hi = MK_NPH_RUN;
    hipLaunchKernelGGL(mk_fwd, dim3(grid), dim3(NTHREADS), LDS_BYTES, stream, a);
#endif
}
```

```cpp
#include <hip/hip_runtime.h>
#include <cstdio>
#include <cstdint>
#include <cmath>
#define LAS __attribute__((address_space(3)))
namespace pg8 {
#define PG8_LAS __attribute__((address_space(3)))
typedef unsigned short bf16_t;
typedef short bf16x8 __attribute__((ext_vector_type(8)));
typedef float f32x4 __attribute__((ext_vector_type(4)));
typedef unsigned u32x4 __attribute__((ext_vector_type(4)));
constexpr int BM = 256, BK = 64, HALF = 128, HTB = HALF * BK * 2  , STAGE_BYTES = 8 * HTB, NXCD = 8, WGM = 8;

__host__ __device__ __forceinline__ int lds_byte(int r, int c) { const int st = (r >> 4) * 2 + (c >> 5), rr = r & 15, cc = c & 31, ob = rr * 64 + cc * 2; return st * 1024 + (ob ^ (((ob >> 9) & 1) << 5)); }
__host__ __device__ __forceinline__ void stage_rc(int b, int& R, int& C) { const int st = b / 1024, sb = b % 1024, swz = sb ^ (((sb >> 9) & 1) << 5); R = (st >> 1) * 16 + swz / 64; C = (st & 1) * 32 + (swz % 64) / 2; }
__host__ __device__ __forceinline__ int perm32(int rho) { const int n = rho >> 4, i = rho & 15; return 8 * (i >> 2) + 4 * n + (i & 3); }

typedef int v8i32 __attribute__((ext_vector_type(8))); typedef int v4i32 __attribute__((ext_vector_type(4)));
__device__ __forceinline__ v8i32 pg8_cat(bf16x8 lo, bf16x8 hi) { return __builtin_shufflevector(__builtin_bit_cast(v4i32, lo), __builtin_bit_cast(v4i32, hi), 0, 1, 2, 3, 4, 5, 6, 7); }
struct Unit { int pm, pn; };
struct Gemm { const bf16_t* A; const bf16_t* Bt; int M, N, K; };

struct StaticOrder {
    int nM, nN, nwg, G, c;
    __host__ __device__ void init(int M, int N, int G_, int c_) { nM = M / BM; nN = N / BM; nwg = nM * nN; G = G_; c = c_; }
    __host__ __device__ bool next(int i, Unit& u) const { return next_at((long)i * G + c, u); }
    __host__ __device__ bool next_at(long L, Unit& u) const {
        if (L >= nwg) return false;
        int wgid = (int)L; { const int q = nwg / NXCD, r = nwg % NXCD, xcd = wgid % NXCD, off = wgid / NXCD; wgid = (xcd < r ? xcd * (q + 1) : r * (q + 1) + (xcd - r) * q) + off; }
        const int nig = WGM * nN, gid = wgid / nig, fm = gid * WGM, gsz = (nM - fm) < WGM ? (nM - fm) : WGM;
        u.pm = fm + ((wgid % nig) % gsz); u.pn = (wgid % nig) / gsz; return true;
    }
    __device__ __forceinline__ void a_ready(const Unit&) const {}
    __device__ __forceinline__ void done(const Unit&) const {}
};

typedef float f32x2_t __attribute__((ext_vector_type(2))); typedef __bf16 bf16x2_t __attribute__((ext_vector_type(2)));
__device__ __forceinline__ unsigned cvt_pk_bf16(float lo, float hi) { const f32x2_t v = {lo, hi}; const bf16x2_t b = __builtin_convertvector(v, bf16x2_t); return __builtin_bit_cast(unsigned, b); }
typedef float f32x2 __attribute__((ext_vector_type(2)));

struct BranchOrder {
    int nT, G, c;
    __device__ __forceinline__ bool next(int i, Unit& u) const {
        const int rd = i / 3, r = i - rd * 3; const int t = rd * G + c; if (t >= nT) return false;
        u.pm = r * 72 + (t >> 2); u.pn = r * 4 + (t & 3); return true;
    }
    __device__ __forceinline__ void a_ready(const Unit&) const {}
    __device__ __forceinline__ void done(const Unit&) const {}
};
struct PartOrder {
    int G, c;
    __device__ __forceinline__ bool next(int i, Unit& u) const {
        const int j = i * G + c; if (j >= 96) return false;
        const int r = j >> 5, t = j & 31; u.pm = r * 72 + 64 + (t >> 2); u.pn = r * 4 + (t & 3); return true;
    }
    __device__ __forceinline__ void a_ready(const Unit&) const {}
    __device__ __forceinline__ void done(const Unit&) const {}
};
struct MoeOrder {
    int nM, nN, nwg, G, c; int ts[9];
    __device__ __forceinline__ void init(const unsigned* cnt, int nN_, int G_, int c_) {
        int acc = 0;
#pragma unroll
        for (int e = 0; e < 8; ++e) { ts[e] = acc; const unsigned ce = __hip_atomic_load(cnt + 64 * e, __ATOMIC_RELAXED, __HIP_MEMORY_SCOPE_AGENT); acc += (int)((ce + 255u) >> 8); }
        ts[8] = acc; nM = acc; nN = nN_; nwg = nM * nN; G = G_; c = c_;
    }
    __device__ __forceinline__ bool next(int i, Unit& u) const {
        const long L = (long)i * G + c; if (L >= nwg) return false;
        int wgid = (int)L; { const int q = nwg / NXCD, r = nwg % NXCD, xcd = wgid % NXCD, off = wgid / NXCD; wgid = (xcd < r ? xcd * (q + 1) : r * (q + 1) + (xcd - r) * q) + off; }
        const int nig = WGM * nN, gid = wgid / nig, fm = gid * WGM, gsz = (nM - fm) < WGM ? (nM - fm) : WGM;
        const int pm = fm + ((wgid % nig) % gsz), pnt = (wgid % nig) / gsz;
        int e = 0;
#pragma unroll
        for (int k = 1; k < 8; ++k) e += (pm >= ts[k]) ? 1 : 0;
        u.pm = pm; u.pn = e * nN + pnt; return true;
    }
    __device__ __forceinline__ void a_ready(const Unit&) const {}
    __device__ __forceinline__ void done(const Unit&) const {}
};


struct TailOrder : StaticOrder {
    int cut, base;
    __device__ __forceinline__ bool next(int i, Unit& u) const {
        long L;
        if (i < base) L = (long)i * G + c; else { if (c < cut) return false; L = (long)base * G + (long)(i - base) * (G - cut) + (c - cut); }
        if (L >= nwg) return false;
        return next_at(L, u);
    }
};
__device__ __forceinline__ void store8(bf16_t* p, const f32x4 a, const f32x4 b) {
    u32x4 w; w.x = cvt_pk_bf16(a[0], a[1]); w.y = cvt_pk_bf16(a[2], a[3]); w.z = cvt_pk_bf16(b[0], b[1]); w.w = cvt_pk_bf16(b[2], b[3]); *(u32x4*)p = w;
}
__device__ __forceinline__ float sigm(float x) { return __builtin_amdgcn_rcpf(1.0f + __expf(-x)); }
__device__ __forceinline__ f32x4 sigm4(f32x4 v) { f32x4 o; o[0] = sigm(v[0]); o[1] = sigm(v[1]); o[2] = sigm(v[2]); o[3] = sigm(v[3]); return o; }

struct EpiPlain {
    static constexpr bool PERM = true, AFTER_DRAIN = false, KEEP_ACC = false;
    bf16_t* O; int ldc; int pn_mod; float scale;
    __device__ __forceinline__ void operator()(const f32x4 (&acc)[2][2][4][2], const Unit& u, int wr, int wc, int fr, int fq) const {
        const int row0 = u.pm * BM + wr * 64 + fr, col0 = (u.pn % pn_mod) * BM + wc * 32 + 8 * fq;
#pragma unroll
        for (int ai = 0; ai < 2; ++ai)
#pragma unroll
            for (int m = 0; m < 4; ++m) { bf16_t* rowp = O + (size_t)(row0 + ai * HALF + m * 16) * ldc + col0;
#pragma unroll
                for (int bj = 0; bj < 2; ++bj) store8(rowp + bj * HALF, acc[ai][bj][m][0] * scale, acc[ai][bj][m][1] * scale); }
    }
};
__device__ __forceinline__ float clamp_f8(float v) { return __builtin_amdgcn_fmed3f(v, -448.0f, 448.0f); }
__device__ __forceinline__ unsigned pk4_fp8(float a, float b, float c, float d) { a = clamp_f8(a); b = clamp_f8(b); c = clamp_f8(c); d = clamp_f8(d); unsigned w = 0; w = __builtin_amdgcn_cvt_pk_fp8_f32(a, b, w, false); w = __builtin_amdgcn_cvt_pk_fp8_f32(c, d, w, true); return w; }
typedef unsigned u32x2_t __attribute__((ext_vector_type(2)));
template <bool IN8, bool OUT8> struct EpiSwiGLUx {
    static constexpr bool PERM = true, AFTER_DRAIN = false, KEEP_ACC = false;
    unsigned char* O; int ldc; int pn_mod;
    __device__ __forceinline__ void operator()(const f32x4 (&acc)[2][2][4][2], const Unit& u, int wr, int wc, int fr, int fq) const {
        const int row0 = u.pm * BM + wr * 64 + fr, col0 = (u.pn % pn_mod) * HALF + wc * 32 + 8 * fq;
        constexpr float s1 = IN8 ? 0.015625f : 1.0f, s3 = (IN8 ? 0.015625f : 1.0f) * (OUT8 ? 16.0f : 1.0f);
#pragma unroll
        for (int ai = 0; ai < 2; ++ai) {
#pragma unroll
            for (int m = 0; m < 4; ++m) {
                const size_t eoff = (size_t)(row0 + ai * HALF + m * 16) * ldc + col0;
                constexpr float k1 = -1.4426950408889634f * s1, ic = 1.0f / (s1 * s3);
                const f32x4 g0 = acc[ai][0][m][0], g1 = acc[ai][0][m][1];
                const f32x4 t0 = g0 * k1, t1 = g1 * k1; f32x4 e0, e1;
                e0[0] = __builtin_amdgcn_exp2f(t0[0]); e0[1] = __builtin_amdgcn_exp2f(t0[1]); e0[2] = __builtin_amdgcn_exp2f(t0[2]); e0[3] = __builtin_amdgcn_exp2f(t0[3]);
                e1[0] = __builtin_amdgcn_exp2f(t1[0]); e1[1] = __builtin_amdgcn_exp2f(t1[1]); e1[2] = __builtin_amdgcn_exp2f(t1[2]); e1[3] = __builtin_amdgcn_exp2f(t1[3]);
                const f32x4 d0 = e0 * ic + ic, d1 = e1 * ic + ic; f32x4 r0, r1;
                r0[0] = __builtin_amdgcn_rcpf(d0[0]); r0[1] = __builtin_amdgcn_rcpf(d0[1]); r0[2] = __builtin_amdgcn_rcpf(d0[2]); r0[3] = __builtin_amdgcn_rcpf(d0[3]);
                r1[0] = __builtin_amdgcn_rcpf(d1[0]); r1[1] = __builtin_amdgcn_rcpf(d1[1]); r1[2] = __builtin_amdgcn_rcpf(d1[2]); r1[3] = __builtin_amdgcn_rcpf(d1[3]);
                const f32x4 v0 = (g0 * acc[ai][1][m][0]) * r0, v1 = (g1 * acc[ai][1][m][1]) * r1;
                if constexpr (OUT8) { u32x2_t w; w.x = pk4_fp8(v0[0], v0[1], v0[2], v0[3]); w.y = pk4_fp8(v1[0], v1[1], v1[2], v1[3]); *(u32x2_t*)(O + eoff) = w; }
                else store8((bf16_t*)O + eoff, v0, v1);
            }
        }
    }
};
struct EpiBranch {
    static constexpr bool PERM = true, AFTER_DRAIN = false, KEEP_ACC = true;
    const unsigned char* P;
    bf16_t* Mg;
    static __device__ __forceinline__ void unpack8(const u32x2_t g, f32x4& g0, f32x4& g1) {
        constexpr float s = 1.0f / 255.0f;
        g0[0] = (float)(g.x & 0xffu) * s; g0[1] = (float)((g.x >> 8) & 0xffu) * s; g0[2] = (float)((g.x >> 16) & 0xffu) * s; g0[3] = (float)(g.x >> 24) * s;
        g1[0] = (float)(g.y & 0xffu) * s; g1[1] = (float)((g.y >> 8) & 0xffu) * s; g1[2] = (float)((g.y >> 16) & 0xffu) * s; g1[3] = (float)(g.y >> 24) * s; }
    static __device__ __forceinline__ void unpack8raw(const u32x2_t g, f32x4& g0, f32x4& g1) {
        g0[0] = (float)(g.x & 0xffu); g0[1] = (float)((g.x >> 8) & 0xffu); g0[2] = (float)((g.x >> 16) & 0xffu); g0[3] = (float)(g.x >> 24);
        g1[0] = (float)(g.y & 0xffu); g1[1] = (float)((g.y >> 8) & 0xffu); g1[2] = (float)((g.y >> 16) & 0xffu); g1[3] = (float)(g.y >> 24); }
    static __device__ __forceinline__ f32x4 clampr(f32x4 v) { f32x4 o; o[0] = fmaxf(v[0], 255e-6f); o[1] = fmaxf(v[1], 255e-6f); o[2] = fmaxf(v[2], 255e-6f); o[3] = fmaxf(v[3], 255e-6f); return o; }
    static __device__ __forceinline__ f32x4 clampg(f32x4 v) { f32x4 o; o[0] = fmaxf(v[0], 1e-6f); o[1] = fmaxf(v[1], 1e-6f); o[2] = fmaxf(v[2], 1e-6f); o[3] = fmaxf(v[3], 1e-6f); return o; }
    static __device__ __forceinline__ f32x4 rcp4(f32x4 v) { f32x4 o; o[0] = __builtin_amdgcn_rcpf(v[0]); o[1] = __builtin_amdgcn_rcpf(v[1]); o[2] = __builtin_amdgcn_rcpf(v[2]); o[3] = __builtin_amdgcn_rcpf(v[3]); return o; }
    __device__ __forceinline__ void operator()(f32x4 (&acc)[2][2][4][2], const Unit& u, int wr, int wc, int fr, int fq) const {
        const int r = u.pn >> 2, pnn = u.pn & 3, pmm = u.pm - r * 72;
        const int row0 = pmm * BM + wr * 64 + fr, col0 = pnn * BM + wc * 32 + 8 * fq;
#pragma unroll
        for (int ai = 0; ai < 2; ++ai)
#pragma unroll
            for (int m = 0; m < 4; ++m) { const size_t row = (size_t)(row0 + ai * HALF + m * 16);
#pragma unroll
                for (int bj = 0; bj < 2; ++bj) { const int col = col0 + bj * HALF;
                    const unsigned char* gp = P + row * 3072 + r * 1024 + col;
                    f32x4 a0, a1; unpack8raw(*(const u32x2_t*)gp, a0, a1);
                    if (r < 2) { f32x4 b0, b1; unpack8raw(*(const u32x2_t*)(gp + 1024), b0, b1);
                        if (r == 1) { a0 = clampr(a0); a1 = clampr(a1); }
                        acc[ai][bj][m][0] = acc[ai][bj][m][0] * (a0 * rcp4(clampr(b0))); acc[ai][bj][m][1] = acc[ai][bj][m][1] * (a1 * rcp4(clampr(b1)));
                    } else { store8(Mg + row * 1024 + col, acc[ai][bj][m][0] * (clampr(a0) * (1.0f / 255.0f)), acc[ai][bj][m][1] * (clampr(a1) * (1.0f / 255.0f)));
                        acc[ai][bj][m][0] = (f32x4){0.f, 0.f, 0.f, 0.f}; acc[ai][bj][m][1] = (f32x4){0.f, 0.f, 0.f, 0.f}; } } }
    }
};
struct EpiBranchPart {
    static constexpr bool PERM = true, AFTER_DRAIN = false, KEEP_ACC = false;
    const unsigned char* P;
    bf16_t* O;
    __device__ __forceinline__ void operator()(const f32x4 (&acc)[2][2][4][2], const Unit& u, int wr, int wc, int fr, int fq) const {
        const int r = u.pn >> 2, pnn = u.pn & 3, pmm = u.pm - r * 72;
        const int row0 = pmm * BM + wr * 64 + fr, col0 = pnn * BM + wc * 32 + 8 * fq;
#pragma unroll
        for (int ai = 0; ai < 2; ++ai)
#pragma unroll
            for (int m = 0; m < 4; ++m) { const size_t row = (size_t)(row0 + ai * HALF + m * 16);
#pragma unroll
                for (int bj = 0; bj < 2; ++bj) { const int col = col0 + bj * HALF;
                    f32x4 a0, a1; EpiBranch::unpack8(*(const u32x2_t*)(P + row * 3072 + r * 1024 + col), a0, a1);
                    store8(O + ((size_t)r * 2048 + (row - 16384)) * 1024 + col, acc[ai][bj][m][0] * a0, acc[ai][bj][m][1] * a1); } }
    }
};
struct EpiGate {
    static constexpr bool PERM = true, AFTER_DRAIN = false, KEEP_ACC = false;
    unsigned char* O;
    static __device__ __forceinline__ unsigned q4(f32x4 g) { return (unsigned)(g[0] * 255.0f + 0.5f) | ((unsigned)(g[1] * 255.0f + 0.5f) << 8) | ((unsigned)(g[2] * 255.0f + 0.5f) << 16) | ((unsigned)(g[3] * 255.0f + 0.5f) << 24); }
    static __device__ __forceinline__ unsigned g4(f32x4 a) {
        const f32x4 t = a * (-1.4426950408889634f * 0.015625f); f32x4 e;
        e[0] = __builtin_amdgcn_exp2f(t[0]); e[1] = __builtin_amdgcn_exp2f(t[1]); e[2] = __builtin_amdgcn_exp2f(t[2]); e[3] = __builtin_amdgcn_exp2f(t[3]);
        const f32x4 d = e * (1.0f / 255.0f) + (1.0f / 255.0f);
        unsigned w = 0;
        w = __builtin_amdgcn_cvt_pk_u8_f32(__builtin_amdgcn_rcpf(d[0]), 0, w); w = __builtin_amdgcn_cvt_pk_u8_f32(__builtin_amdgcn_rcpf(d[1]), 1, w);
        w = __builtin_amdgcn_cvt_pk_u8_f32(__builtin_amdgcn_rcpf(d[2]), 2, w); w = __builtin_amdgcn_cvt_pk_u8_f32(__builtin_amdgcn_rcpf(d[3]), 3, w);
        return w; }
    __device__ __forceinline__ void operator()(const f32x4 (&acc)[2][2][4][2], const Unit& u, int wr, int wc, int fr, int fq) const {
        const int row0 = u.pm * BM + wr * 64 + fr, col0 = u.pn * BM + wc * 32 + 8 * fq;
#pragma unroll
        for (int ai = 0; ai < 2; ++ai)
#pragma unroll
            for (int m = 0; m < 4; ++m) { unsigned char* rowp = O + (size_t)(row0 + ai * HALF + m * 16) * 3072 + col0;
#pragma unroll
                for (int bj = 0; bj < 2; ++bj) { u32x2_t w; w.x = g4(acc[ai][bj][m][0]); w.y = g4(acc[ai][bj][m][1]); *(u32x2_t*)(rowp + bj * HALF) = w; } }
    }
};
template <bool GATES> struct EpiInProj {
    static constexpr bool PERM = true, AFTER_DRAIN = false, KEEP_ACC = false;
    bf16_t* O; const float *rtc, *rts, *axc, *axs; float asc; int pn_off;
    __device__ __forceinline__ void operator()(const f32x4 (&acc)[2][2][4][2], const Unit& u, int wr, int wc, int fr, int fq) const {
        const int pn = u.pn + pn_off, i8 = 8 * fq;
#pragma unroll
        for (int ai = 0; ai < 2; ++ai)
#pragma unroll
            for (int m = 0; m < 4; ++m) {
                const int row = u.pm * BM + ai * HALF + wr * 64 + m * 16 + fr;
                bf16_t* rowp = O + (size_t)row * 4352;
                const f32x4 a0 = acc[ai][0][m][0] * asc, a1 = acc[ai][0][m][1] * asc, b0 = acc[ai][1][m][0] * asc, b1 = acc[ai][1][m][1] * asc;
                if (pn < 4) {
                    const int hl = wc >> 1, i = 32 * (wc & 1) + i8;
                    const int pos = row < 16384 ? 256 + (row & 2047) : ((row - 16384) & 255);
                    const f32x4 c0 = *(const f32x4*)(rtc + pos * 64 + i), c1 = *(const f32x4*)(rtc + pos * 64 + i + 4);
                    const f32x4 s0 = *(const f32x4*)(rts + pos * 64 + i), s1 = *(const f32x4*)(rts + pos * 64 + i + 4);
                    const float sc = pn < 2 ? 0.08838834764831845f : 1.0f;
                    bf16_t* dst = rowp + pn * 256 + hl * 128 + i;
                    store8(dst, (a0 * c0 - b0 * s0) * sc, (a1 * c1 - b1 * s1) * sc);
                    store8(dst + 64, (a0 * s0 + b0 * c0) * sc, (a1 * s1 + b1 * c1) * sc);
                } else if (pn == 8 || pn == 9 || (pn == 10 && wc < 2)) {
                    const bool lat = row < 16384; const int t = row & 2047;
                    f32x4 c0 = *(const f32x4*)(axc + t * 32 + i8), c1 = *(const f32x4*)(axc + t * 32 + i8 + 4);
                    f32x4 s0 = *(const f32x4*)(axs + t * 32 + i8), s1 = *(const f32x4*)(axs + t * 32 + i8 + 4);
                    if (!lat) { c0 = (f32x4){1.f, 1.f, 1.f, 1.f}; c1 = c0; s0 = (f32x4){0.f, 0.f, 0.f, 0.f}; s1 = s0; }
                    const float sc = pn < 10 ? 0.18033688011112042f : 1.0f;
                    bf16_t* dst = rowp + (pn < 10 ? pn * 256 : 2560) + wc * 64 + i8;
                    store8(dst, (a0 * c0 - b0 * s0) * sc, (a1 * c1 - b1 * s1) * sc);
                    store8(dst + 32, (a0 * s0 + b0 * c0) * sc, (a1 * s1 + b1 * c1) * sc);
                } else if (pn == 10) {
                    bf16_t* dst = rowp + 2688 + (wc - 2) * 64 + i8;
                    store8(dst, a0, a1); store8(dst + 32, b0, b1);
                } else {
                    bf16_t* dst = rowp + pn * 256 + wc * 32 + i8;
                    if (pn == 6 || pn == 7) { store8(dst, a0 * sigm4(a0), a1 * sigm4(a1)); store8(dst + 128, b0 * sigm4(b0), b1 * sigm4(b1)); }
                    else if (pn == 11 || pn == 12) { store8(dst, a0 * 0.18033688011112042f, a1 * 0.18033688011112042f); store8(dst + 128, b0 * 0.18033688011112042f, b1 * 0.18033688011112042f); }
                    else if (GATES && pn >= 17) { store8(dst, sigm4(a0), sigm4(a1)); store8(dst + 128, sigm4(b0), sigm4(b1)); }
                    else { store8(dst, a0, a1); store8(dst + 128, b0, b1); }
                }
            }
    }
};
template <class Epi, class Sched, bool ALIGN_EPI = false, bool SP2 = false, bool FP8 = false>
__device__ __forceinline__ void gemm_phase(PG8_LAS unsigned char* lds, const Gemm g, const Sched& S, const Epi& E) {
    int tid_ = threadIdx.x; asm volatile("" : "+v"(tid_));
    const int tid = tid_, wid = __builtin_amdgcn_readfirstlane(tid >> 6), lane = tid & 63, wr = wid >> 2, wc = wid & 3, fr = lane & 15, fq = lane >> 4;
    const int K = g.K, nt = K / BK;
    unsigned voffA[2], voffB[2];
#pragma unroll
    for (int i = 0; i < 2; ++i) { int R, C; stage_rc(tid * 16 + i * 8192, R, C); const int Rb = Epi::PERM ? ((R & ~31) + perm32(R & 31)) : R;
        voffA[i] = (unsigned)(R * K + C) * 2u; voffB[i] = (unsigned)(Rb * K + C) * 2u; }
    const size_t kstep = (size_t)(BK * 2);
    const size_t hstep = (size_t)HALF * K * 2;
    const size_t tstep = 2 * hstep;
    const unsigned ldsw = (unsigned)wid * 1024u;
    const int aoff = lds_byte(wr * 64 + fr, fq * 8), boff = lds_byte(wc * 32 + fr, fq * 8);
    const int cb8 = 32 * fq, rr8 = fr & 15;
    const int aoff8 = (((wr * 64 + fr) >> 4) * 2 + (cb8 >> 6)) * 1024 + ((rr8 * 64 + (cb8 & 63)) ^ ((rr8 >> 3) << 5));
    const int boff8 = (((wc * 32 + fr) >> 4) * 2 + (cb8 >> 6)) * 1024 + ((rr8 * 64 + (cb8 & 63)) ^ ((rr8 >> 3) << 5));
#define PG8_SA(b, h) (((b) * 2 + (h)) * HTB)
#define PG8_SB(b, h) ((4 + (b) * 2 + (h)) * HTB)
#define PG8_STAGE(bufoff, gbase, voff) do { _Pragma("unroll") for (int _i = 0; _i < 2; ++_i) \
        __builtin_amdgcn_global_load_lds((const unsigned*)((const char*)(gbase) + (voff)[_i]), (PG8_LAS unsigned*)(lds + (bufoff) + ldsw + _i * 8192), 16, 0, 0); } while (0)
#define PG8_LDA(dst, b, h) do { if constexpr (FP8) { _Pragma("unroll") for (int m = 0; m < 4; ++m) dst##8[m] = *(const PG8_LAS v8i32*)(lds + PG8_SA(b, h) + aoff8 + m * 2048); } else { _Pragma("unroll") for (int m = 0; m < 4; ++m) _Pragma("unroll") for (int k = 0; k < 2; ++k) dst[m][k] = *(const PG8_LAS bf16x8*)(lds + PG8_SA(b, h) + aoff + m * 2048 + k * 1024); } } while (0)
#define PG8_LDB(dst, b, h) do { if constexpr (FP8) { _Pragma("unroll") for (int n = 0; n < 2; ++n) dst##8[n] = *(const PG8_LAS v8i32*)(lds + PG8_SB(b, h) + boff8 + n * 2048); } else { _Pragma("unroll") for (int n = 0; n < 2; ++n) _Pragma("unroll") for (int k = 0; k < 2; ++k) dst[n][k] = *(const PG8_LAS bf16x8*)(lds + PG8_SB(b, h) + boff + n * 2048 + k * 1024); } } while (0)
#define PG8_MMA(ai, bj, At, Bt) do { __builtin_amdgcn_s_setprio(1); if constexpr (FP8) { _Pragma("unroll") for (int m = 0; m < 4; ++m) _Pragma("unroll") for (int n = 0; n < 2; ++n) \
        asm volatile("v_mfma_scale_f32_16x16x128_f8f6f4 %0, %1, %2, %0, %3, %3 op_sel_hi:[0,0,0]" : "+v"(acc[ai][bj][m][n]) : "v"(Bt##8[n]), "v"(At##8[m]), "v"(sc127)); } else { \
        _Pragma("unroll") for (int m = 0; m < 4; ++m) _Pragma("unroll") for (int n = 0; n < 2; ++n) _Pragma("unroll") for (int k = 0; k < 2; ++k) \
        acc[ai][bj][m][n] = __builtin_amdgcn_mfma_f32_16x16x32_bf16(Bt[n][k], At[m][k], acc[ai][bj][m][n], 0, 0, 0); } __builtin_amdgcn_s_setprio(0); } while (0)
#define PG8_WAIT_V(n) asm volatile("s_waitcnt vmcnt(" #n ")" ::: "memory")
#define PG8_WAIT_L(n) asm volatile("s_waitcnt lgkmcnt(" #n ")" ::: "memory")
#define PG8_BAR __builtin_amdgcn_s_barrier()
#define PG8_SCHED __builtin_amdgcn_sched_barrier(0)
    Unit cur, nxt; int ui = 0;
    if (!S.next(0, cur)) return;
    f32x4 acc[2][2][4][2];
#pragma unroll
    for (int a = 0; a < 2; ++a)
#pragma unroll
        for (int b = 0; b < 2; ++b)
#pragma unroll
            for (int m = 0; m < 4; ++m)
#pragma unroll
                for (int n = 0; n < 2; ++n) acc[a][b][m][n] = (f32x4){0.f, 0.f, 0.f, 0.f};
    bf16x8 At[4][2], B0[2][2], B1[2][2];
    v8i32 At8[4], B08[2], B18[2]; const int sc127 = 127;
    const char* cA = (const char*)g.A + (size_t)cur.pm * tstep; const char* cB = (const char*)g.Bt + (size_t)cur.pn * tstep;
    S.a_ready(cur);
    if constexpr (SP2) {
        PG8_STAGE(PG8_SB(0, 0), cB, voffB); PG8_STAGE(PG8_SB(0, 1), cB + hstep, voffB); PG8_STAGE(PG8_SA(0, 0), cA, voffA); PG8_STAGE(PG8_SA(0, 1), cA + hstep, voffA);
        if (wr == 1) PG8_BAR;
        PG8_WAIT_V(2); PG8_BAR;
        PG8_STAGE(PG8_SB(1, 0), cB + kstep, voffB); PG8_STAGE(PG8_SA(1, 0), cA + kstep, voffA); PG8_STAGE(PG8_SB(1, 1), cB + hstep + kstep, voffB);
        PG8_WAIT_V(6); PG8_BAR;
    } else {
        PG8_STAGE(PG8_SB(0, 0), cB, voffB); PG8_STAGE(PG8_SA(0, 0), cA, voffA); PG8_STAGE(PG8_SB(0, 1), cB + hstep, voffB); PG8_STAGE(PG8_SA(0, 1), cA + hstep, voffA);
        if (wr == 1) PG8_BAR;
        PG8_WAIT_V(4); PG8_BAR;
        PG8_STAGE(PG8_SB(1, 0), cB + kstep, voffB); PG8_STAGE(PG8_SA(1, 0), cA + kstep, voffA); PG8_STAGE(PG8_SB(1, 1), cB + hstep + kstep, voffB);
        PG8_WAIT_V(6); PG8_BAR;
    }
    for (;;) {
        const bool has_next = S.next(ui + 1, nxt);
        const char* nA = has_next ? (const char*)g.A + (size_t)nxt.pm * tstep : cA; const char* nB = has_next ? (const char*)g.Bt + (size_t)nxt.pn * tstep : cB;
        for (int t = 0; t < nt; t += 2) {
            const bool last = (t == nt - 2);
            const char* a1 = cA + (size_t)(t + 1) * kstep;
            const char* a2 = last ? nA : cA + (size_t)(t + 2) * kstep; const char* b2 = last ? nB : cB + (size_t)(t + 2) * kstep;
            const char* a3 = a2 + kstep; const char* b3 = b2 + kstep;
            if (last && has_next) S.a_ready(nxt);
            if constexpr (SP2) {
            PG8_LDB(B0, 0, 0); PG8_LDB(B1, 0, 1); PG8_SCHED; PG8_LDA(At, 0, 0); PG8_STAGE(PG8_SA(1, 1), a1 + hstep, voffA);
            PG8_WAIT_V(8); PG8_WAIT_L(0); PG8_BAR; PG8_MMA(0, 0, At, B0); PG8_MMA(0, 1, At, B1); PG8_BAR; PG8_SCHED;
            PG8_LDA(At, 0, 1); PG8_STAGE(PG8_SB(0, 0), b2, voffB); PG8_STAGE(PG8_SB(0, 1), b2 + hstep, voffB); PG8_STAGE(PG8_SA(0, 0), a2, voffA);
            PG8_WAIT_V(8); PG8_WAIT_L(0); PG8_BAR; PG8_MMA(1, 0, At, B0); PG8_MMA(1, 1, At, B1); PG8_BAR; PG8_SCHED;
            PG8_LDB(B0, 1, 0); PG8_LDB(B1, 1, 1); PG8_SCHED; PG8_LDA(At, 1, 0); PG8_STAGE(PG8_SA(0, 1), a2 + hstep, voffA);
            PG8_WAIT_V(8); PG8_WAIT_L(0); PG8_BAR; PG8_MMA(0, 0, At, B0); PG8_MMA(0, 1, At, B1); PG8_BAR; PG8_SCHED;
            PG8_LDA(At, 1, 1); PG8_STAGE(PG8_SB(1, 0), b3, voffB); PG8_STAGE(PG8_SB(1, 1), b3 + hstep, voffB); PG8_STAGE(PG8_SA(1, 0), a3, voffA);
            PG8_WAIT_V(8); PG8_WAIT_L(0); PG8_BAR; PG8_MMA(1, 0, At, B0); PG8_MMA(1, 1, At, B1); PG8_BAR; PG8_SCHED;
            } else {
            PG8_LDB(B0, 0, 0); PG8_SCHED; PG8_LDA(At, 0, 0); PG8_STAGE(PG8_SA(1, 1), a1 + hstep, voffA);
            PG8_WAIT_L(8); PG8_BAR; PG8_WAIT_L(0); PG8_MMA(0, 0, At, B0); PG8_BAR; PG8_SCHED;
            PG8_LDB(B1, 0, 1); PG8_STAGE(PG8_SB(0, 0), b2, voffB);
            PG8_BAR; PG8_WAIT_L(0); PG8_MMA(0, 1, At, B1); PG8_BAR;
            PG8_LDA(At, 0, 1); PG8_STAGE(PG8_SA(0, 0), a2, voffA);
            PG8_BAR; PG8_WAIT_L(0); PG8_MMA(1, 0, At, B0); PG8_BAR; PG8_SCHED;
            PG8_STAGE(PG8_SB(0, 1), b2 + hstep, voffB);
            PG8_WAIT_V(6); PG8_BAR; PG8_MMA(1, 1, At, B1); PG8_BAR;
            PG8_LDB(B0, 1, 0); PG8_SCHED; PG8_LDA(At, 1, 0); PG8_STAGE(PG8_SA(0, 1), a2 + hstep, voffA);
            PG8_WAIT_L(8); PG8_BAR; PG8_WAIT_L(0); PG8_MMA(0, 0, At, B0); PG8_BAR; PG8_SCHED;
            PG8_LDB(B1, 1, 1); PG8_STAGE(PG8_SB(1, 0), b3, voffB);
            PG8_BAR; PG8_WAIT_L(0); PG8_MMA(0, 1, At, B1); PG8_BAR;
            PG8_LDA(At, 1, 1); PG8_STAGE(PG8_SA(1, 0), a3, voffA);
            PG8_BAR; PG8_WAIT_L(0); PG8_MMA(1, 0, At, B0); PG8_BAR; PG8_SCHED;
            PG8_STAGE(PG8_SB(1, 1), b3 + hstep, voffB);
            PG8_WAIT_V(6); PG8_BAR; PG8_MMA(1, 1, At, B1); PG8_BAR;
            }
        }
        if constexpr (ALIGN_EPI) { if (wr == 0) PG8_BAR; }
        if constexpr (FP8) asm volatile("s_nop 15\n\ts_nop 7" ::: "memory");
        if constexpr (!Epi::AFTER_DRAIN) { E(acc, cur, wr, wc, fr, fq); S.done(cur); }
        if (!has_next) break;
        if constexpr (!Epi::KEEP_ACC) {
#pragma unroll
        for (int a = 0; a < 2; ++a)
#pragma unroll
            for (int b = 0; b < 2; ++b)
#pragma unroll
                for (int m = 0; m < 4; ++m)
#pragma unroll
                    for (int n = 0; n < 2; ++n) acc[a][b][m][n] = (f32x4){0.f, 0.f, 0.f, 0.f};
        }
        cur = nxt; cA = nA; cB = nB; ++ui;
        if constexpr (ALIGN_EPI) { if (wr == 1) PG8_BAR; }
    }
    PG8_WAIT_V(0);
    if constexpr (!ALIGN_EPI) { if (wr == 0) PG8_BAR; }
    PG8_BAR;
    if constexpr (Epi::AFTER_DRAIN) { E.fused(acc, cur, wr, wc, fr, fq, lds, wid, lane); S.done(cur); }
#undef PG8_SA
#undef PG8_SB
#undef PG8_STAGE
#undef PG8_LDA
#undef PG8_LDB
#undef PG8_MMA
#undef PG8_WAIT_V
#undef PG8_WAIT_L
#undef PG8_BAR
#undef PG8_SCHED
}
}

#define XB_TMO      128
#define XB_XCNT(j)  (256  + 64 * (j))
#define XB_XSUB(j)  (1280 + 64 * (j))
#define XB_XGEN(j)  (2304 + 64 * (j))
#define XB_TOP      3328
#define XB_TOPGEN   3392
#define XCD_BAR_WORDS 3456
#define XB_SPIN_CAP (1u << 18)

__device__ __forceinline__ unsigned xb_ld(unsigned* p)              { return __hip_atomic_load(p, __ATOMIC_RELAXED, __HIP_MEMORY_SCOPE_AGENT); }
__device__ __forceinline__ unsigned xb_add(unsigned* p, unsigned v) { return __hip_atomic_fetch_add(p, v, __ATOMIC_RELAXED, __HIP_MEMORY_SCOPE_AGENT); }
__device__ __forceinline__ unsigned xb_xcc_id() { return (unsigned)__builtin_amdgcn_s_getreg((3 << 11) | 20) & 0xFu; }
#define XB_SPIN(cond, bar) do { unsigned _sp = 0; while (cond) { __builtin_amdgcn_s_sleep(1); \
    if ((++_sp & 255u) == 0u) { if (xb_ld(&(bar)[XB_TMO])) break; if (_sp > XB_SPIN_CAP) { atomicAdd(&(bar)[XB_TMO], 1u); break; } } } } while (0)

struct XcdBarrier {
    unsigned* bar; unsigned x;
    volatile LAS unsigned* st;
};

__device__ __forceinline__ XcdBarrier xcd_barrier_post(unsigned* bar, volatile LAS unsigned* st) {
    XcdBarrier b; b.bar = bar; b.x = xb_xcc_id(); b.st = st;
    if (threadIdx.x == 0) (void)xb_add(&bar[XB_XCNT(b.x)], 1u);
    return b;
}
__device__ __forceinline__ void xcd_barrier_complete(unsigned* bar, unsigned x, unsigned& nloc, unsigned& nx) {
    const unsigned G = gridDim.x * gridDim.y * gridDim.z;
    unsigned sum, cnt, mine, sp = 0u;
    for (;;) {
        sum = 0u; cnt = 0u; mine = 0u;
#pragma unroll
        for (unsigned j = 0; j < 16; ++j) { const unsigned c = xb_ld(&bar[XB_XCNT(j)]); sum += c; cnt += (c > 0u) ? 1u : 0u; mine = (j == x) ? c : mine; }
        if (sum == G) break;
        __builtin_amdgcn_s_sleep(1);
        if ((++sp & 255u) == 0u) { if (xb_ld(&bar[XB_TMO])) break; if (sp > XB_SPIN_CAP) { atomicAdd(&bar[XB_TMO], 1u); break; } }
    }
    nloc = mine > 0u ? mine : 1u; nx = cnt > 0u ? cnt : 1u;
}

__device__ __forceinline__ void xcd_barrier(const XcdBarrier& b) {
    asm volatile("s_waitcnt vmcnt(0)" ::: "memory");
    __syncthreads();
    if (threadIdx.x == 0) {
        unsigned* bar = b.bar;
        __builtin_amdgcn_s_waitcnt(0);
        unsigned nloc = b.st[0], nx = b.st[1];
        if (nloc == 0u) { xcd_barrier_complete(bar, b.x, nloc, nx); b.st[0] = nloc; b.st[1] = nx; }
        const unsigned old = xb_add(&bar[XB_XSUB(b.x)], 1u);
        const unsigned gen = old / nloc;
        if (old + 1u == (gen + 1u) * nloc) {
            __builtin_amdgcn_fence(__ATOMIC_RELEASE, "agent");
            asm volatile("s_waitcnt vmcnt(0)" ::: "memory");
            const unsigned og = xb_add(&bar[XB_TOP], 1u);
            const unsigned tg = og / nx;
            if (og + 1u == (tg + 1u) * nx) xb_add(&bar[XB_TOPGEN], 1u);
            else XB_SPIN(xb_ld(&bar[XB_TOPGEN]) == tg, bar);
            __builtin_amdgcn_fence(__ATOMIC_ACQUIRE, "agent");
            xb_add(&bar[XB_XGEN(b.x)], 1u);
            asm volatile("s_waitcnt vmcnt(0)" ::: "memory");
        } else {
            XB_SPIN(xb_ld(&bar[XB_XGEN(b.x)]) == gen, bar);
            __builtin_amdgcn_fence(__ATOMIC_ACQUIRE, "agent");
            asm volatile("s_waitcnt vmcnt(0)" ::: "memory");
        }
    }
    __syncthreads();
}

constexpr int D = 1024, NB = 8, SEQ = 2048, LC = 256, DEPTH = 4;
constexpr int ML = NB * SEQ, MC = NB * LC, MT = ML + MC;
constexpr int DIN = 7424, FFD = 2816, FFE = 3584, NE = 8;
constexpr int PS = 4352;
constexpr int MSORT = 38912;
constexpr float EPS = 1e-6f;
constexpr int NWAVES = 8, NTHREADS = 512;
#ifndef MK_PER_PHASE
#define MK_PER_PHASE 0
#endif
constexpr int NPH = 2 + 11 * DEPTH;
#ifndef MK_EN
#define MK_EN 0xFFFFFFFFu
#endif
#ifndef MK_DUMP
#define MK_DUMP 0
#endif
#ifndef MK_F8
#define MK_F8 0x2F
#endif
constexpr bool F8IN = (MK_F8 & 16) != 0, F8GATE = (MK_F8 & 32) != 0;
constexpr bool F8UP_D = (MK_F8 & 1) != 0, F8DN_D = (MK_F8 & 2) != 0, F8UP_M = (MK_F8 & 4) != 0, F8DN_M = (MK_F8 & 8) != 0;
#ifndef MK_REP
#define MK_REP 0u
#endif
#ifndef MK_NPH_RUN
#define MK_NPH_RUN NPH
#endif

constexpr size_t MiB = (size_t)1 << 20;
constexpr size_t WS_CTL = 0, CTL_ZERO_BYTES = MiB;
constexpr size_t WS_MOD = 1 * MiB;
constexpr size_t WS_TAB = 2 * MiB;
constexpr size_t WS_ROUTE = 4 * MiB;
constexpr size_t WS_HC = 5 * MiB;
constexpr size_t WS_XN = 13 * MiB;
constexpr size_t WS_YOUT = 49 * MiB;
constexpr size_t WS_WIN = 85 * MiB, WS_WBR = 143 * MiB, WS_WOUT = 155 * MiB, WS_WF13 = 163 * MiB, WS_WF2 = 185 * MiB, WS_WM13 = 196 * MiB, WS_WM2 = 420 * MiB;
constexpr size_t WS_OVL = 532 * MiB;
constexpr size_t WS_PROJ = WS_OVL, WS_YBR = WS_OVL + 261 * MiB, WS_KV = WS_OVL + 315 * MiB, WS_ST = WS_OVL + 387 * MiB;
constexpr size_t WS_TMP = WS_KV, WS_MERGED = WS_ST;
constexpr size_t WS_PART = WS_OVL;
constexpr size_t WS_G8 = WS_OVL + 153 * MiB;
constexpr size_t WS_ASORT = WS_OVL, WS_HID = WS_OVL + 76 * MiB, WS_OSORT = WS_OVL + 342 * MiB;
constexpr size_t WS_HB = WS_OVL + 423 * MiB;
constexpr size_t WS_WIN8 = WS_HB + 36 * MiB;
constexpr size_t WS_XN8 = WS_WIN8 + 12 * MiB;
constexpr size_t WS_END = WS_XN8 + 18 * MiB;
static_assert(WS_OSORT + (size_t)MSORT * D * 2 <= WS_END && WS_ST + 36 * MiB <= WS_END, "map");
constexpr int TAB_RTC = 0, TAB_RTS = 2304 * 64, TAB_AXC = 2 * 2304 * 64, TAB_AXS = 2 * 2304 * 64 + 2048 * 32;
constexpr int CW_BAR = 4096, CW_MOE = 8192, CW_WQ = 12288, CW_RFLAG = 24576, CW_PFLAG = 32768;

constexpr int LDS_BYTES = 147456, MISC_OFF = 131072 + 320;

#define GAS __attribute__((address_space(1)))
#define DEV __device__ __forceinline__
typedef unsigned short bf16;
typedef float f32x4 __attribute__((ext_vector_type(4)));
typedef short bf16x8 __attribute__((ext_vector_type(8)));
typedef short s16x4 __attribute__((ext_vector_type(4)));
typedef unsigned u32x4 __attribute__((ext_vector_type(4)));
typedef unsigned u32x2 __attribute__((ext_vector_type(2)));
#define MFMA16(a, b, c) __builtin_amdgcn_mfma_f32_16x16x32_bf16((a), (b), (c), 0, 0, 0)
DEV float bf2f(unsigned short b) { return __uint_as_float(((unsigned)b) << 16); }
DEV float bflo(unsigned u) { return __uint_as_float(u << 16); }
DEV float bfhi(unsigned u) { return __uint_as_float(u & 0xffff0000u); }
DEV unsigned pk2(float lo, float hi) { return pg8::cvt_pk_bf16(lo, hi); }
DEV unsigned short f2bf(float f) { return (unsigned short)(pg8::cvt_pk_bf16(f, 0.f) & 0xffffu); }
template <int CTRL> DEV float dpp_add(float v) { return v + __int_as_float(__builtin_amdgcn_update_dpp(0, __float_as_int(v), CTRL, 0xf, 0xf, true)); }
DEV float wave_sum(float v) {
    v = dpp_add<0xB1>(v); v = dpp_add<0x4E>(v); v = dpp_add<0x141>(v); v = dpp_add<0x140>(v);
    const int iv = __float_as_int(v);
    return (__int_as_float(__builtin_amdgcn_readlane(iv, 0)) + __int_as_float(__builtin_amdgcn_readlane(iv, 16))) + (__int_as_float(__builtin_amdgcn_readlane(iv, 32)) + __int_as_float(__builtin_amdgcn_readlane(iv, 48)));
}
DEV bf16x8 pack8(const f32x4 a, const f32x4 b) { u32x4 w; w.x = pk2(a[0], a[1]); w.y = pk2(a[2], a[3]); w.z = pk2(b[0], b[1]); w.w = pk2(b[2], b[3]); return __builtin_bit_cast(bf16x8, w); }

struct Args { const float* in[20]; float* out; unsigned char* ws; int ph_lo, ph_hi, li, pad; };
enum { I_X = 0, I_C, I_CTX, I_CCTX, I_WMOD, I_BMOD, I_GAINS, I_WIN, I_DECAY, I_SINK, I_RPB, I_WBR, I_WOUT, I_F1, I_F3, I_F2, I_ROUTER, I_M1, I_M3, I_M2 };

DEV void p0_transpose_item(const float* W, int K, int N, bf16* WT, LAS float* scr, int kb, int n0, int drow0, int lane) {
    const int k0 = 64 * kb;
#pragma unroll 8
    for (int i = 0; i < 32; ++i) { const int kk = 2 * i + (lane >> 5); scr[kk * 33 + (lane & 31)] = W[(size_t)(k0 + kk) * N + n0 + (lane & 31)]; }
    asm volatile("s_waitcnt lgkmcnt(0)" ::: "memory");
    const int c = lane & 7;
#pragma unroll
    for (int j = 0; j < 4; ++j) { const int n = (lane >> 3) + 8 * j; const LAS float* s = scr + (8 * c) * 33 + n;
        u32x4 o; o.x = pk2(s[0 * 33], s[1 * 33]); o.y = pk2(s[2 * 33], s[3 * 33]); o.z = pk2(s[4 * 33], s[5 * 33]); o.w = pk2(s[6 * 33], s[7 * 33]);
        *(u32x4*)(WT + (size_t)(drow0 + n) * K + k0 + 8 * c) = o; }
    asm volatile("s_waitcnt lgkmcnt(0)" ::: "memory");
}

DEV float clampf8(float v) { return __builtin_amdgcn_fmed3f(v, -448.0f, 448.0f); }
DEV unsigned pk4f8(float a, float b, float c, float d) { a = clampf8(a); b = clampf8(b); c = clampf8(c); d = clampf8(d); unsigned w = 0; w = __builtin_amdgcn_cvt_pk_fp8_f32(a, b, w, false); w = __builtin_amdgcn_cvt_pk_fp8_f32(c, d, w, true); return w; }
DEV void p0_transpose_item_f8(const float* W, int K, int N, unsigned char* WT, LAS float* scr, int kb, int n0, int drow0, float scale, int lane) {
    const int k0 = 64 * kb;
#pragma unroll 8
    for (int i = 0; i < 32; ++i) { const int kk = 2 * i + (lane >> 5); scr[kk * 33 + (lane & 31)] = W[(size_t)(k0 + kk) * N + n0 + (lane & 31)] * scale; }
    asm volatile("s_waitcnt lgkmcnt(0)" ::: "memory");
    const int c = lane & 3;
#pragma unroll
    for (int j = 0; j < 2; ++j) { const int n = (lane >> 2) + 16 * j; const LAS float* s = scr + (16 * c) * 33 + n;
        u32x4 o; o.x = pk4f8(s[0 * 33], s[1 * 33], s[2 * 33], s[3 * 33]); o.y = pk4f8(s[4 * 33], s[5 * 33], s[6 * 33], s[7 * 33]);
        o.z = pk4f8(s[8 * 33], s[9 * 33], s[10 * 33], s[11 * 33]); o.w = pk4f8(s[12 * 33], s[13 * 33], s[14 * 33], s[15 * 33]);
        *(u32x4*)(WT + (size_t)(drow0 + n) * K + k0 + 16 * c) = o; }
    asm volatile("s_waitcnt lgkmcnt(0)" ::: "memory");
}
DEV int inproj_dest_row(int n0) {
    const int pn = n0 >> 8, wi = n0 & 255;
    if (pn < 4) { const int hl = wi >> 7, rem = wi & 127, half = rem >> 6, i = rem & 63; return pn * 256 + half * 128 + hl * 64 + i; }
    if (pn == 8 || pn == 9) { const int hl = wi >> 6, rem = wi & 63, half = rem >> 5, i = rem & 31; return pn * 256 + half * 128 + hl * 32 + i; }
    if (pn == 10) { const int isv = wi >> 7, w2 = wi & 127, hl = w2 >> 6, half = (w2 & 63) >> 5, i = w2 & 31; return 2560 + half * 128 + (2 * isv + hl) * 32 + i; }
    return n0;
}
DEV void p0_prologue(const Args& A, LAS unsigned char* lds, int vcu, int G, int tid) {
    const int wave = __builtin_amdgcn_readfirstlane(tid >> 6), lane = tid & 63;
    unsigned char* ws = A.ws;
    {
        LAS float* sc = (LAS float*)lds;
        LAS float* red = (LAS float*)(lds + 9 * 1024 * 4);
        for (int i = tid; i < 9 * 1024; i += NTHREADS) { const int r = i >> 10, k = i & 1023; const float v = r < 8 ? A.in[I_C][r * 1024 + k] : A.in[I_CCTX][k]; sc[i] = v / (1.0f + __expf(-v)); }
        __syncthreads();
        float* MOD = (float*)(ws + WS_MOD);
        for (int it = vcu; it < 4 * 96; it += G) {
            const int l = it / 96, cg = it % 96, col = cg * 64 + lane;
            const float* W = A.in[I_WMOD] + (size_t)l * 1024 * 6144 + col;
            float acc[9];
#pragma unroll
            for (int r = 0; r < 9; ++r) acc[r] = 0.f;
#pragma unroll 4
            for (int kk = 0; kk < 128; ++kk) { const int k = wave * 128 + kk; const float w = W[(size_t)k * 6144];
#pragma unroll
                for (int r = 0; r < 9; ++r) acc[r] += sc[r * 1024 + k] * w; }
#pragma unroll
            for (int r = 0; r < 9; ++r) red[(wave * 9 + r) * 64 + lane] = acc[r];
            __syncthreads();
            for (int o = tid; o < 9 * 64; o += NTHREADS) { const int r = o >> 6, ln = o & 63; float s = 0.f;
#pragma unroll
                for (int w = 0; w < 8; ++w) s += red[(w * 9 + r) * 64 + ln];
                MOD[((size_t)l * 9 + r) * 6144 + cg * 64 + ln] = s + A.in[I_BMOD][l * 6144 + cg * 64 + ln]; }
            __syncthreads();
        }
    }
    {
        float* TAB = (float*)(ws + WS_TAB);
        const int gt = vcu * NTHREADS + tid, NGT = G * NTHREADS;
        for (int i = gt; i < 2304 * 64; i += NGT) { const int pos = i >> 6, f = i & 63; const float inv = exp2f(-(float)f * (13.287712379549449f / 64.0f)); const float ang = (float)pos * inv; float s, c; sincosf(ang, &s, &c); TAB[TAB_RTC + i] = c; TAB[TAB_RTS + i] = s; }
        for (int i = gt; i < 2048 * 32; i += NGT) { const int t = i >> 5, f = i & 31; const float inv = exp2f(-(float)(f & 15) * (13.287712379549449f / 16.0f)); const float p = (f < 16) ? (float)(t >> 6) : (float)(t & 63); const float ang = p * inv; float s, c; sincosf(ang, &s, &c); TAB[TAB_AXC + i] = c; TAB[TAB_AXS + i] = s; }
    }
    __syncthreads();
    {
        LAS float* scr = (LAS float*)(lds + wave * 16384);
        const int gw = vcu * NWAVES + wave, NGW = G * NWAVES;
        constexpr int C_IN = 16 * 232, C_BR = 8 * 32, C_OUT = 16 * 32, C_F13 = 16 * 88, C_F2 = 44 * 32, C_M13 = 16 * 112, C_M2 = 56 * 32;
        constexpr int N_IN = 4 * C_IN, N_BR = 12 * C_BR, N_OUT = 4 * C_OUT, N_F13 = 4 * C_F13, N_F2 = 2 * C_F2, N_M13 = 32 * C_M13, N_M2 = 16 * C_M2;
        constexpr int NITEMS = N_IN + N_BR + N_OUT + N_F13 + N_F2 + N_M13 + N_M2;
        for (int it = gw; it < NITEMS; it += NGW) {
            int r = it;
            if (r < N_IN) { const int l = r / C_IN, q = r % C_IN, kb = q / 232, nb = q % 232;
                if constexpr (F8IN) p0_transpose_item_f8(A.in[I_WIN] + (size_t)l * 1024 * DIN, 1024, DIN, ws + WS_WIN + (size_t)l * DIN * 1024, scr, kb, 32 * nb, inproj_dest_row(32 * nb), 64.0f, lane);
                else if (F8GATE && 32 * nb >= 4352) p0_transpose_item_f8(A.in[I_WIN] + (size_t)l * 1024 * DIN, 1024, DIN, ws + WS_WIN8 + (size_t)l * 3072 * 1024, scr, kb, 32 * nb, 32 * nb - 4352, 64.0f, lane);
                else p0_transpose_item(A.in[I_WIN] + (size_t)l * 1024 * DIN, 1024, DIN, (bf16*)(ws + WS_WIN) + (size_t)l * DIN * 1024, scr, kb, 32 * nb, inproj_dest_row(32 * nb), lane);
                continue; } r -= N_IN;
            if (r < N_BR) { const int mtx = r / C_BR, q = r % C_BR, kb = q / 32, nb = q % 32;
                p0_transpose_item(A.in[I_WBR] + (size_t)mtx * 512 * 1024, 512, 1024, (bf16*)(ws + WS_WBR) + (size_t)mtx * 1024 * 512, scr, kb, 32 * nb, 32 * nb, lane); continue; } r -= N_BR;
            if (r < N_OUT) { const int l = r / C_OUT, q = r % C_OUT, kb = q / 32, nb = q % 32;
                p0_transpose_item(A.in[I_WOUT] + (size_t)l * 1024 * 1024, 1024, 1024, (bf16*)(ws + WS_WOUT) + (size_t)l * 1024 * 1024, scr, kb, 32 * nb, 32 * nb, lane); continue; } r -= N_OUT;
            if (r < N_F13) { const int mtx = r / C_F13, q = r % C_F13, kb = q / 88, nb = q % 88, i = mtx >> 1, which = mtx & 1, n0 = 32 * nb;
                if constexpr (F8UP_D) p0_transpose_item_f8(A.in[which ? I_F3 : I_F1] + (size_t)i * 1024 * FFD, 1024, FFD, ws + WS_WF13 + (size_t)i * 2 * FFD * 1024, scr, kb, n0, (n0 >> 7) * 256 + which * 128 + (n0 & 127), 64.0f, lane);
                else p0_transpose_item(A.in[which ? I_F3 : I_F1] + (size_t)i * 1024 * FFD, 1024, FFD, (bf16*)(ws + WS_WF13) + (size_t)i * 2 * FFD * 1024, scr, kb, n0, (n0 >> 7) * 256 + which * 128 + (n0 & 127), lane);
                continue; } r -= N_F13;
            if (r < N_F2) { const int i = r / C_F2, q = r % C_F2, kb = q / 32, nb = q % 32;
                if constexpr (F8DN_D) p0_transpose_item_f8(A.in[I_F2] + (size_t)i * FFD * 1024, FFD, 1024, ws + WS_WF2 + (size_t)i * 1024 * FFD, scr, kb, 32 * nb, 32 * nb, 128.0f, lane);
                else p0_transpose_item(A.in[I_F2] + (size_t)i * FFD * 1024, FFD, 1024, (bf16*)(ws + WS_WF2) + (size_t)i * 1024 * FFD, scr, kb, 32 * nb, 32 * nb, lane);
                continue; } r -= N_F2;
            if (r < N_M13) { const int mtx = r / C_M13, q = r % C_M13, kb = q / 112, nb = q % 112, ie = mtx >> 1, which = mtx & 1, n0 = 32 * nb;
                if constexpr (F8UP_M) p0_transpose_item_f8(A.in[which ? I_M3 : I_M1] + (size_t)ie * 1024 * FFE, 1024, FFE, ws + WS_WM13 + (size_t)ie * 2 * FFE * 1024, scr, kb, n0, (n0 >> 7) * 256 + which * 128 + (n0 & 127), 64.0f, lane);
                else p0_transpose_item(A.in[which ? I_M3 : I_M1] + (size_t)ie * 1024 * FFE, 1024, FFE, (bf16*)(ws + WS_WM13) + (size_t)ie * 2 * FFE * 1024, scr, kb, n0, (n0 >> 7) * 256 + which * 128 + (n0 & 127), lane);
                continue; } r -= N_M13;
            { const int ie = r / C_M2, q = r % C_M2, kb = q / 32, nb = q % 32;
                if constexpr (F8DN_M) p0_transpose_item_f8(A.in[I_M2] + (size_t)ie * FFE * 1024, FFE, 1024, ws + WS_WM2 + (size_t)ie * 1024 * FFE, scr, kb, 32 * nb, 32 * nb, 128.0f, lane);
                else p0_transpose_item(A.in[I_M2] + (size_t)ie * FFE * 1024, FFE, 1024, (bf16*)(ws + WS_WM2) + (size_t)ie * 1024 * FFE, scr, kb, 32 * nb, 32 * nb, lane); }
        }
    }
}

DEV void ld_row_f32(const float* p, int lane, f32x4 (&v)[4]) {
#pragma unroll
    for (int j = 0; j < 4; ++j) v[j] = *(const f32x4*)(p + 4 * lane + 256 * j);
}
DEV void ld_row_bf16(const bf16* p, int lane, f32x4 (&v)[4]) {
#pragma unroll
    for (int j = 0; j < 4; ++j) { const u32x2 u = *(const u32x2*)(p + 4 * lane + 256 * j); v[j][0] = bflo(u.x); v[j][1] = bfhi(u.x); v[j][2] = bflo(u.y); v[j][3] = bfhi(u.y); }
}
DEV void st_row_bf16(bf16* p, int lane, const f32x4 (&v)[4]) {
#pragma unroll
    for (int j = 0; j < 4; ++j) { u32x2 u; u.x = pk2(v[j][0], v[j][1]); u.y = pk2(v[j][2], v[j][3]); *(u32x2*)(p + 4 * lane + 256 * j) = u; }
}
DEV float row_rstd(const f32x4 (&v)[4]) {
    float s = 0.f;
#pragma unroll
    for (int j = 0; j < 4; ++j) s += (v[j][0] * v[j][0] + v[j][1] * v[j][1]) + (v[j][2] * v[j][2] + v[j][3] * v[j][3]);
    return rsqrtf(wave_sum(s) * (1.0f / 1024.0f) + EPS);
}
DEV void moe_bases(const unsigned* cnt, int (&base)[8]) {
    int acc = 0;
#pragma unroll
    for (int e = 0; e < 8; ++e) { base[e] = acc; const unsigned ce = __hip_atomic_load(cnt + 64 * e, __ATOMIC_RELAXED, __HIP_MEMORY_SCOPE_AGENT); acc += (int)(((ce + 255u) >> 8) << 8); }
}
DEV int sel8(const int (&b)[8], int e) { int r = 0;
#pragma unroll
    for (int k = 0; k < 8; ++k) r = (e == k) ? b[k] : r;
    return r; }

DEV void raw_row_bf16(const bf16* p, int lane, u32x2 (&v)[4]) {
#pragma unroll
    for (int j = 0; j < 4; ++j) v[j] = *(const u32x2*)(p + 4 * lane + 256 * j);
}
DEV void cvt_row_bf16(const u32x2 (&u)[4], f32x4 (&v)[4]) {
#pragma unroll
    for (int j = 0; j < 4; ++j) { v[j][0] = bflo(u[j].x); v[j][1] = bfhi(u[j].x); v[j][2] = bflo(u[j].y); v[j][3] = bfhi(u[j].y); }
}
constexpr int TR = 2;
template <int MODE> DEV void thin_phase(const Args& A, int L, int wid, int nw, int row_lo, int row_hi, int tid, LAS unsigned char* lds) {
    const int wave = __builtin_amdgcn_readfirstlane(tid >> 6), lane = tid & 63;
    const int gw = wid * NWAVES + wave, NGW = nw * NWAVES;
    unsigned char* ws = A.ws;
    const float* MOD = (const float*)(ws + WS_MOD);
    const float* GN = A.in[I_GAINS];
    unsigned char* HC = ws + WS_HB;
    bf16* XN = (bf16*)(ws + WS_XN);
    const bf16* YOUT = (const bf16*)(ws + WS_YOUT);
    int* ROUTE = (int*)(ws + WS_ROUTE);
    const int mi = L >> 1;
    unsigned* cnt = (unsigned*)(ws + WS_CTL) + CW_MOE + mi * 8 * 64;
    int base[8];
    const bool moe2 = (MODE == 2) && (L & 1);
    if (moe2) moe_bases(cnt, base);
    const bool first = (L == 0 && MODE <= 1);
    const bool rout = (MODE == 1) && (L & 1);
    const LAS f32x4* WL = (const LAS f32x4*)lds;
    if (rout) {
        const f32x4* WR4 = (const f32x4*)(A.in[I_ROUTER] + (size_t)mi * 1024 * 8);
        for (int s4 = tid; s4 < 2048; s4 += NTHREADS) { const int k = s4 >> 1, hf_ = s4 & 1; ((LAS f32x4*)lds)[(((k >> 8) * 4 + (k & 3)) * 2 + hf_) * 64 + ((k & 255) >> 2)] = WR4[s4]; }
        __syncthreads();
    }
    const float* gn = GN + L * 4096;
    const bf16* OS = (const bf16*)(ws + WS_OSORT);
    const int nrows_ = row_hi - row_lo, r_beg = row_lo + (int)(((long)gw * nrows_) / NGW), r_end = row_lo + (int)(((long)(gw + 1) * nrows_) / NGW);
    const int Ln = (MODE == 2) ? L + 1 : L;
    f32x4 vgy[4], vgx[4], vgate[4], vsh[4], vsc[4]; int mr_cur = -1;
    if (r_beg < r_end) {
        const float* gy = gn + (MODE == 1 ? 1 : 3) * 1024; const float* gx = GN + Ln * 4096 + (MODE == 1 ? 2 : 0) * 1024;
#pragma unroll
        for (int j = 0; j < 4; ++j) { if (MODE != 0) vgy[j] = *(const f32x4*)(gy + 4 * lane + 256 * j); vgx[j] = *(const f32x4*)(gx + 4 * lane + 256 * j); }
    }
    const bool pre = moe2 && (r_end - r_beg <= 64);
    int4 prq = {0, 0, 0, 0}; int2 prw = {0, 0};
    if (pre && r_beg < r_end) { const int* rt = ROUTE + (size_t)((r_beg + lane < r_end) ? r_beg + lane : r_beg) * 8; prq = *(const int4*)rt; prw = *(const int2*)(rt + 4); }
    for (int m0 = r_beg; m0 < r_end; m0 += TR) {
        int mm[TR]; bool on[TR];
#pragma unroll
        for (int r = 0; r < TR; ++r) { const int m = m0 + r; on[r] = m < r_end; mm[r] = on[r] ? m : m0; }
        int4 rq[TR]; int2 rw[TR];
        if (moe2) {
#pragma unroll
            for (int r = 0; r < TR; ++r) {
                if (pre) { const int k = mm[r] - r_beg;
                    rq[r].x = __builtin_amdgcn_readlane(prq.x, k); rq[r].y = __builtin_amdgcn_readlane(prq.y, k); rq[r].z = __builtin_amdgcn_readlane(prq.z, k); rq[r].w = __builtin_amdgcn_readlane(prq.w, k);
                    rw[r].x = __builtin_amdgcn_readlane(prw.x, k); rw[r].y = __builtin_amdgcn_readlane(prw.y, k); }
                else { const int* rt = ROUTE + (size_t)mm[r] * 8; rq[r] = *(const int4*)rt; rw[r] = *(const int2*)(rt + 4); } }
        }
        f32x4 hf[TR][4]; u32x2 hr[TR][4], ya[TR][4], yb[TR][4];
#pragma unroll
        for (int r = 0; r < TR; ++r) { const int m = mm[r];
            if (first) ld_row_f32(m >= ML ? A.in[I_CTX] + (size_t)(m - ML) * D : A.in[I_X] + (size_t)m * D, lane, hf[r]);
            else raw_row_bf16((const bf16*)HC + (size_t)m * D, lane, hr[r]);
            if (MODE != 0) {
                if (moe2) { raw_row_bf16(OS + (size_t)(sel8(base, rq[r].x) + rq[r].z) * D, lane, ya[r]); raw_row_bf16(OS + (size_t)(sel8(base, rq[r].y) + rq[r].w) * D, lane, yb[r]); }
                else raw_row_bf16(YOUT + (size_t)m * D, lane, ya[r]);
            } }
#pragma unroll
        for (int r = 0; r < TR; ++r) if (on[r]) { const int m = mm[r];
        const bool isc = m >= ML;
        const int mr = isc ? 8 : (m >> 11);
        if (mr != mr_cur) { mr_cur = mr;
            const float* md = MOD + ((size_t)L * 9 + mr) * 6144; const float* mdn = MOD + ((size_t)Ln * 9 + mr) * 6144;
            const float* gate = md + (MODE == 1 ? 2 : 5) * 1024; const float* sh = mdn + (MODE == 1 ? 3 : 0) * 1024; const float* sc = mdn + (MODE == 1 ? 4 : 1) * 1024;
#pragma unroll
            for (int j = 0; j < 4; ++j) { if (MODE != 0) vgate[j] = *(const f32x4*)(gate + 4 * lane + 256 * j); vsh[j] = *(const f32x4*)(sh + 4 * lane + 256 * j); vsc[j] = *(const f32x4*)(sc + 4 * lane + 256 * j); }
        }
        bf16* hb = (bf16*)HC + (size_t)m * D;
        f32x4 h[4];
        if (first) {
#pragma unroll
            for (int j = 0; j < 4; ++j) h[j] = hf[r][j];
        } else cvt_row_bf16(hr[r], h);
        if (MODE != 0) {
            f32x4 y[4];
            if (moe2) {
                const float w0 = __int_as_float(rw[r].x), w1 = __int_as_float(rw[r].y);
                f32x4 y0[4], y1[4]; cvt_row_bf16(ya[r], y0); cvt_row_bf16(yb[r], y1);
#pragma unroll
                for (int j = 0; j < 4; ++j) y[j] = y0[j] * w0 + y1[j] * w1;
            } else cvt_row_bf16(ya[r], y);
            const float rs = row_rstd(y);
#pragma unroll
            for (int j = 0; j < 4; ++j) h[j] = h[j] + vgate[j] * (y[j] * rs * vgy[j]);
            if (MODE == 2 && L == 3) {
#pragma unroll
                for (int j = 0; j < 4; ++j) *(f32x4*)(A.out + (size_t)m * D + 4 * lane + 256 * j) = h[j];
            } else st_row_bf16(hb, lane, h);
        }
        if (MODE == 2 && L == 3) continue;
        const float rs = row_rstd(h);
        f32x4 a[4];
#pragma unroll
        for (int j = 0; j < 4; ++j) a[j] = (h[j] * rs * vgx[j]) * (vsc[j] + 1.0f) + vsh[j];
        if ((MODE == 1 && ((L & 1) ? F8UP_M : F8UP_D)) || (MODE != 1 && F8IN)) {
#pragma unroll
            for (int j = 0; j < 4; ++j) *(unsigned*)((unsigned char*)XN + (size_t)m * D + 4 * lane + 256 * j) = pk4f8(a[j][0], a[j][1], a[j][2], a[j][3]);
        } else { st_row_bf16(XN + (size_t)m * D, lane, a);
            if (MODE != 1 && F8GATE) {
#pragma unroll
                for (int j = 0; j < 4; ++j) *(unsigned*)(ws + WS_XN8 + (size_t)m * D + 4 * lane + 256 * j) = pk4f8(a[j][0], a[j][1], a[j][2], a[j][3]); } }
        if (MODE == 1 && (L & 1)) {
            float lg[8];
#pragma unroll
            for (int e = 0; e < 8; ++e) lg[e] = 0.f;
#pragma unroll
            for (int j = 0; j < 4; ++j)
#pragma unroll
                for (int i = 0; i < 4; ++i) { if ((i & 1) == 0) __builtin_amdgcn_sched_barrier(0); const f32x4 w0 = WL[((j * 4 + i) * 2 + 0) * 64 + lane], w1 = WL[((j * 4 + i) * 2 + 1) * 64 + lane]; const float x = a[j][i];
                    lg[0] += x * w0[0]; lg[1] += x * w0[1]; lg[2] += x * w0[2]; lg[3] += x * w0[3]; lg[4] += x * w1[0]; lg[5] += x * w1[1]; lg[6] += x * w1[2]; lg[7] += x * w1[3]; }
#pragma unroll
            for (int e = 0; e < 8; ++e) lg[e] = wave_sum(lg[e]);
            int e0 = 0; float v0 = lg[0];
#pragma unroll
            for (int e = 1; e < 8; ++e) if (lg[e] > v0) { v0 = lg[e]; e0 = e; }
            int e1 = -1; float v1 = -INFINITY;
#pragma unroll
            for (int e = 0; e < 8; ++e) if (e != e0 && lg[e] > v1) { v1 = lg[e]; e1 = e; }
            const float ex = __expf(v1 - v0), w0 = 1.0f / (1.0f + ex), w1 = ex * w0;
            if (lane == 0) {
                const int r0 = (int)__hip_atomic_fetch_add(cnt + 64 * e0, 1u, __ATOMIC_RELAXED, __HIP_MEMORY_SCOPE_AGENT);
                const int r1 = (int)__hip_atomic_fetch_add(cnt + 64 * e1, 1u, __ATOMIC_RELAXED, __HIP_MEMORY_SCOPE_AGENT);
                int* rt = ROUTE + (size_t)m * 8; rt[0] = e0; rt[1] = e1; rt[2] = r0; rt[3] = r1; rt[4] = __float_as_int(w0); rt[5] = __float_as_int(w1);
            }
        }
        }
    }
    if (rout) __syncthreads();
}
DEV void gather_phase(const Args& A, int L, int vcu, int G, int tid) {
    const int wave = __builtin_amdgcn_readfirstlane(tid >> 6), lane = tid & 63;
    const int gw = vcu * NWAVES + wave, NGW = G * NWAVES;
    unsigned char* ws = A.ws;
    const int nrows = (L == 3) ? ML : MT, mi = L >> 1;
    const unsigned* cnt = (const unsigned*)(ws + WS_CTL) + CW_MOE + mi * 8 * 64;
    int base[8]; moe_bases(cnt, base);
    const bf16* XN = (const bf16*)(ws + WS_XN); bf16* AS = (bf16*)(ws + WS_ASORT); const int* ROUTE = (const int*)(ws + WS_ROUTE);
    constexpr int RB = F8UP_M ? D : 2 * D;
    const int t_beg = (int)(((long)gw * nrows) / NGW), t_end = (int)(((long)(gw + 1) * nrows) / NGW);
    for (int c0 = t_beg; c0 < t_end; c0 += 64) {
        const int c1 = (c0 + 64 < t_end) ? c0 + 64 : t_end;
        int d0, d1; { const int4 rq = *(const int4*)(ROUTE + (size_t)((c0 + lane < c1) ? c0 + lane : c0) * 8); d0 = sel8(base, rq.x) + rq.z; d1 = sel8(base, rq.y) + rq.w; }
        for (int k0 = c0; k0 < c1; k0 += 4) {
            u32x4 v[4], w[4];
#pragma unroll
            for (int q = 0; q < 4; ++q) { const int m = k0 + q; if (m < c1) { const u32x4* src = (const u32x4*)((const unsigned char*)XN + (size_t)m * RB); v[q] = src[lane]; if constexpr (!F8UP_M) w[q] = src[lane + 64]; } }
#pragma unroll
            for (int q = 0; q < 4; ++q) { const int m = k0 + q; if (m < c1) {
                const int e0 = __builtin_amdgcn_readlane(d0, m - c0), e1 = __builtin_amdgcn_readlane(d1, m - c0);
                u32x4* p0 = (u32x4*)((unsigned char*)AS + (size_t)e0 * RB); u32x4* p1 = (u32x4*)((unsigned char*)AS + (size_t)e1 * RB);
                p0[lane] = v[q]; p1[lane] = v[q]; if constexpr (!F8UP_M) { p0[lane + 64] = w[q]; p1[lane + 64] = w[q]; } } }
        }
    }
}

#ifndef MK_VTR
#define MK_VTR 1
#endif
constexpr float LOG2E = 1.4426950408889634f;
constexpr int KS_STRIDE = 144;
constexpr int VS_STRIDE = MK_VTR ? 160 : 144;
constexpr int AT_VT = 9216, AT_BUF = AT_VT + 64 * VS_STRIDE, AT_RPB = 2 * AT_BUF, AT_Q = AT_RPB + 8192;
static_assert(AT_Q + 65536 <= 131072, "attention LDS");
typedef short v4i16_t __attribute__((ext_vector_type(4)));
#define AT_SCHED() __builtin_amdgcn_sched_barrier(0)
DEV float xrow16_max(float x) {
    auto s = __builtin_amdgcn_permlane16_swap(__float_as_uint(x), __float_as_uint(x), false, false);
    x = fmaxf(__uint_as_float(s[0]), __uint_as_float(s[1]));
    auto t = __builtin_amdgcn_permlane32_swap(__float_as_uint(x), __float_as_uint(x), false, false);
    return fmaxf(__uint_as_float(t[0]), __uint_as_float(t[1]));
}
DEV float xrow16_sum(float x) {
    auto s = __builtin_amdgcn_permlane16_swap(__float_as_uint(x), __float_as_uint(x), false, false);
    x = __uint_as_float(s[0]) + __uint_as_float(s[1]);
    auto t = __builtin_amdgcn_permlane32_swap(__float_as_uint(x), __float_as_uint(x), false, false);
    return __uint_as_float(t[0]) + __uint_as_float(t[1]);
}
struct KVRegs { u32x4 k, v; };
DEV void kv_load(KVRegs& r, const bf16* kp, const bf16* vp, int tid) {
    const int row = tid >> 3, c = tid & 7;
    r.k = *(const u32x4*)(kp + (size_t)row * PS + 8 * c); r.v = *(const u32x4*)(vp + (size_t)row * PS + 8 * c);
}
DEV void kv_write(LAS unsigned char* buf, const KVRegs& r, int tid) {
    const int row = tid >> 3, c = tid & 7;
    *(LAS u32x4*)(buf + row * KS_STRIDE + c * 16) = r.k;
#if MK_VTR
    *(LAS u32x4*)(buf + AT_VT + row * VS_STRIDE + c * 16) = r.v;
#else
    LAS unsigned short* p = (LAS unsigned short*)(buf + AT_VT) + (8 * c) * (VS_STRIDE / 2) + row;
    p[0 * (VS_STRIDE / 2)] = (unsigned short)(r.v.x & 0xffffu); p[1 * (VS_STRIDE / 2)] = (unsigned short)(r.v.x >> 16);
    p[2 * (VS_STRIDE / 2)] = (unsigned short)(r.v.y & 0xffffu); p[3 * (VS_STRIDE / 2)] = (unsigned short)(r.v.y >> 16);
    p[4 * (VS_STRIDE / 2)] = (unsigned short)(r.v.z & 0xffffu); p[5 * (VS_STRIDE / 2)] = (unsigned short)(r.v.z >> 16);
    p[6 * (VS_STRIDE / 2)] = (unsigned short)(r.v.w & 0xffffu); p[7 * (VS_STRIDE / 2)] = (unsigned short)(r.v.w >> 16);
#endif
}
DEV bf16x8 v_frag(const LAS unsigned char* buf, int u, int dt, int c16, int q4) {
#if MK_VTR
    const LAS unsigned char* vr = buf + AT_VT + (32 * u + 4 * q4 + (c16 >> 2)) * VS_STRIDE + (16 * dt + 4 * (c16 & 3)) * 2;
    const s16x4 lo = __builtin_bit_cast(s16x4, __builtin_amdgcn_ds_read_tr16_b64_v4i16((LAS v4i16_t*)vr));
    const s16x4 hi = __builtin_bit_cast(s16x4, __builtin_amdgcn_ds_read_tr16_b64_v4i16((LAS v4i16_t*)(vr + 16 * VS_STRIDE)));
#else
    const LAS unsigned char* vr = buf + AT_VT + (16 * dt + c16) * VS_STRIDE + (32 * u + 4 * q4) * 2;
    const s16x4 lo = *(const LAS s16x4*)vr, hi = *(const LAS s16x4*)(vr + 32);
#endif
    return __builtin_shufflevector(lo, hi, 0, 1, 2, 3, 4, 5, 6, 7);
}
template <int NT, int TM0, int TM1, int TM2, int TM3, class F0, class F1, class F2, class F3>
DEV void chunk_tiles(const LAS unsigned char* buf, const LAS unsigned char* ql, float (&m_run)[NT], float (&l_run)[NT], f32x4 (&o)[NT][4], int c16, int q4, F0 mf0, F1 mf1, F2 mf2, F3 mf3) {
    constexpr int TM[4] = {TM0, TM1, TM2, TM3};
    constexpr int TMALL = TM0 | TM1 | (NT > 2 ? (TM2 | TM3) : 0);
    f32x4 s[NT][4];
    {
        bf16x8 kf[4][2];
#pragma unroll
        for (int t = 0; t < 4; ++t)
            if ((TMALL >> t) & 1) {
#pragma unroll
                for (int k = 0; k < 2; ++k) kf[t][k] = *(const LAS bf16x8*)(buf + (16 * t + c16) * KS_STRIDE + (32 * k + 8 * q4) * 2);
            }
#pragma unroll
        for (int j = 0; j < NT; ++j) {
            const bf16x8 q0 = *(const LAS bf16x8*)(ql + (2 * j) * 1024), q1 = *(const LAS bf16x8*)(ql + (2 * j + 1) * 1024);
#pragma unroll
            for (int t = 0; t < 4; ++t) {
                f32x4 acc = {0.f, 0.f, 0.f, 0.f};
                if ((TM[j] >> t) & 1) { acc = MFMA16(kf[t][0], q0, acc); acc = MFMA16(kf[t][1], q1, acc); }
                s[j][t] = acc;
            }
        }
    }
    bf16x8 bp[NT][2];
#pragma unroll
    for (int j = 0; j < NT; ++j) {
        float mx = m_run[j];
#pragma unroll
        for (int t = 0; t < 4; ++t)
            if ((TM[j] >> t) & 1) {
#pragma unroll
                for (int r = 0; r < 4; ++r) { const int kk = 16 * t + 4 * q4 + r; float v = s[j][t][r]; v = (j == 0) ? mf0(kk, v) : (j == 1) ? mf1(kk, v) : (j == 2) ? mf2(kk, v) : mf3(kk, v); s[j][t][r] = v; mx = fmaxf(mx, v); }
            }
        mx = xrow16_max(mx);
        const float alpha = __builtin_amdgcn_exp2f(m_run[j] - mx); m_run[j] = mx;
        float ls = 0.f;
#pragma unroll
        for (int t = 0; t < 4; ++t)
            if ((TM[j] >> t) & 1) {
#pragma unroll
                for (int r = 0; r < 4; ++r) { const float p = __builtin_amdgcn_exp2f(s[j][t][r] - mx); s[j][t][r] = p; ls += p; }
            }
        l_run[j] = l_run[j] * alpha + ls;
#pragma unroll
        for (int dt = 0; dt < 4; ++dt) o[j][dt] = o[j][dt] * alpha;
#pragma unroll
        for (int u = 0; u < 2; ++u) bp[j][u] = pack8(s[j][2 * u], s[j][2 * u + 1]);
    }
#pragma unroll
    for (int u = 0; u < 2; ++u)
        if ((TMALL >> (2 * u)) & 3) {
#pragma unroll
            for (int dt = 0; dt < 4; ++dt) { const bf16x8 vf = v_frag(buf, u, dt, c16, q4);
#pragma unroll
                for (int j = 0; j < NT; ++j) if ((TM[j] >> (2 * u)) & 3) o[j][dt] = MFMA16(vf, bp[j][u], o[j][dt]); }
        }
    AT_SCHED();
}
DEV void attn_store(bf16* dst, float l_run, const f32x4 (&o)[4], int q4) {
    const float inv = 1.0f / xrow16_sum(l_run);
#pragma unroll
    for (int dt = 0; dt < 4; ++dt) { u32x2 u; u.x = pk2(o[dt][0] * inv, o[dt][1] * inv); u.y = pk2(o[dt][2] * inv, o[dt][3] * inv); *(u32x2*)(dst + 16 * dt + 4 * q4) = u; }
}
DEV int na_start(int r) { return r - 4 < 0 ? 0 : (r - 4 > 24 ? 24 : r - 4); }
template <int MODE> DEV void attn4_unit(const Args& A, int L, int unit, LAS unsigned char* lds, int tid) {
    constexpr int NT = (MODE == 3) ? 2 : 4;
    const int w = __builtin_amdgcn_readfirstlane(tid >> 6), lane = tid & 63, c16 = lane & 15, q4 = lane >> 4;
    unsigned char* ws = A.ws;
    const bf16* proj = (const bf16*)(ws + WS_PROJ);
    bf16* ybr = (bf16*)(ws + WS_YBR);
    LAS float* RPB = (LAS float*)(lds + AT_RPB);
    int b, h = 0, kcol, vcol, nlat = 0, lat0 = 0, kr0 = 0, tq = 0, rq = 0;
    size_t qrow0; int qcol0; float m_run[NT], l_run[NT]; int kvh = 0;
    if (MODE == 0 || MODE == 2) {
        if (MODE == 0) { const int qb = unit & 15; kvh = (unit >> 4) & 1; b = unit >> 5; tq = qb * 128 + 16 * w + c16;
            const int lo = qb * 128 - 128 < 0 ? 0 : qb * 128 - 128, hi = qb * 128 + 256 > SEQ ? SEQ : qb * 128 + 256; lat0 = lo; nlat = (hi - lo) >> 6; }
        else { const int qb = unit & 1; kvh = (unit >> 1) & 1; b = unit >> 2; tq = qb * 128 + 16 * w + c16; }
        kcol = 2560 + kvh * 64; vcol = 2688 + kvh * 64;
#pragma unroll
        for (int j = 0; j < NT; ++j) { const int hq = kvh * 4 + j; m_run[j] = A.in[I_SINK][L * 8 + hq] * LOG2E; l_run[j] = q4 == 0 ? 1.f : 0.f; }
        qrow0 = (MODE == 0) ? (size_t)b * SEQ + tq : (size_t)ML + b * LC + tq; qcol0 = 2048 + kvh * 4 * 64;
    } else {
        if (MODE == 1) { const int rg = unit & 3; h = (unit >> 2) & 7; b = unit >> 5; rq = 8 * rg + w; kr0 = na_start(8 * rg); nlat = na_start(8 * rg + 7) + 8 - kr0; }
        else { h = unit & 7; b = unit >> 3; }
        kcol = 3328 + h * 64; vcol = 3840 + h * 64;
#pragma unroll
        for (int j = 0; j < NT; ++j) { m_run[j] = -1e30f; l_run[j] = 0.f; }
        qrow0 = (MODE == 1) ? (size_t)b * SEQ + rq * 64 + c16 : (size_t)ML + b * LC + 32 * w + c16; qcol0 = 2816 + h * 64;
    }
    f32x4 o[NT][4];
#pragma unroll
    for (int j = 0; j < NT; ++j)
#pragma unroll
        for (int dt = 0; dt < 4; ++dt) o[j][dt] = (f32x4){0.f, 0.f, 0.f, 0.f};
    constexpr size_t QSTRIDE = (MODE == 0 || MODE == 2) ? (size_t)64 : (size_t)16 * PS;
    const bf16* qb = proj + qrow0 * PS + qcol0 + 8 * q4;
    LAS unsigned char* ql = lds + AT_Q + w * 8192 + lane * 16;
    const int nch = 4 + nlat;
#define CH_ROW0(ci) ((ci) < 4 ? (size_t)ML + b * LC + (ci) * 64 : (MODE == 0 ? (size_t)b * SEQ + lat0 + ((ci) - 4) * 64 : (size_t)b * SEQ + (kr0 + (ci) - 4) * 64))
#define CH_LOAD(R, ci) do { const size_t r_ = CH_ROW0(ci); kv_load(R, proj + r_ * PS + kcol, proj + r_ * PS + vcol, tid); } while (0)
    KVRegs kvA, kvB;
    __syncthreads();
    if (MODE == 1) {
        for (int i = tid; i < 960; i += NTHREADS) { const int rw = i >> 6, dc = (i & 63) - 16; const bool in = dc >= 0 && dc <= 30;
            const float v = in ? A.in[I_RPB][(size_t)(L * 8 + h) * 465 + rw * 31 + dc] * LOG2E : 0.f;
            RPB[i] = v; RPB[960 + i] = (dc >= 7 && dc <= 22) ? v : -INFINITY; } }
    CH_LOAD(kvA, 0);
    CH_LOAD(kvB, 1);
#pragma unroll
    for (int j = 0; j < NT; ++j)
#pragma unroll
        for (int k = 0; k < 2; ++k) *(LAS u32x4*)(ql + (2 * j + k) * 1024) = *(const u32x4*)(qb + j * QSTRIDE + 32 * k);
    kv_write(lds, kvA, tid);
    CH_LOAD(kvA, 2);
    const int sw = na_start(rq);
    auto compute = [&](int ci) {
        const LAS unsigned char* buf = lds + (ci & 1) * AT_BUF;
        if (ci < 4) {
            auto nomask = [](int, float s) { return s; };
            chunk_tiles<NT, 15, 15, 15, 15>(buf, ql, m_run, l_run, o, c16, q4, nomask, nomask, nomask, nomask);
        } else if constexpr (MODE == 0) {
            const int k0 = lat0 + (ci - 4) * 64, tq0 = tq - c16;
            if (k0 >= tq0 + 15 - 128 && k0 + 63 <= tq0 + 128) {
                auto nomask = [](int, float s) { return s; };
                chunk_tiles<NT, 15, 15, 15, 15>(buf, ql, m_run, l_run, o, c16, q4, nomask, nomask, nomask, nomask);
            } else if (k0 + 63 >= tq0 - 128 && k0 <= tq0 + 15 + 128) {
                auto wmask = [=](int kk, float s) { const int d = tq - (k0 + kk); return (d <= 128 && d >= -128) ? s : -INFINITY; };
                chunk_tiles<NT, 15, 15, 15, 15>(buf, ql, m_run, l_run, o, c16, q4, wmask, wmask, wmask, wmask);
            }
        } else if constexpr (MODE == 1) {
            const int kr = kr0 + ci - 4;
            if (kr >= sw && kr < sw + 8) {
                const LAS float* brow = RPB + (kr - rq + 7) * 64 + 16 + 15 - c16;
#define NA_ME(j) [=](int ck, float s) { const int cq = 16 * (j) + c16; const int cs = cq - 8 < 0 ? 0 : (cq - 8 > 48 ? 48 : cq - 8); return ((unsigned)(ck - cs) < 16u) ? s + brow[ck - 16 * (j)] : -INFINITY; }
#define NA_MI(j) [=](int ck, float s) { return s + brow[960 + ck - 16 * (j)]; }
                chunk_tiles<NT, 3, 7, 14, 12>(buf, ql, m_run, l_run, o, c16, q4, NA_ME(0), NA_MI(1), NA_MI(2), NA_ME(3));
#undef NA_ME
#undef NA_MI
            }
        }
    };
    for (int ci = 0; ci < nch; ci += 2) {
        __syncthreads();
        if (ci + 1 < nch) { kv_write(lds + AT_BUF, kvB, tid); if (ci + 3 < nch) CH_LOAD(kvB, ci + 3); }
        AT_SCHED();
        compute(ci);
        if (ci + 1 >= nch) break;
        __syncthreads();
        if (ci + 2 < nch) { kv_write(lds, kvA, tid); if (ci + 4 < nch) CH_LOAD(kvA, ci + 4); }
        AT_SCHED();
        compute(ci + 1);
    }
#undef CH_LOAD
#undef CH_ROW0
#pragma unroll
    for (int j = 0; j < NT; ++j) {
        size_t qr; int oc, br;
        if (MODE == 0 || MODE == 2) { qr = (MODE == 0) ? (size_t)b * SEQ + tq : (size_t)ML + b * LC + tq; oc = (kvh * 4 + j) * 64; br = 1; }
        else { qr = (MODE == 1) ? (size_t)b * SEQ + rq * 64 + 16 * j + c16 : (size_t)ML + b * LC + 32 * w + 16 * j + c16; oc = h * 64; br = 2; }
        attn_store(ybr + ((size_t)br * MT + qr) * 512 + oc, l_run[j], o[j], q4);
    }
}

constexpr int RS = 136;
DEV void ret_unit_ids(int unit, int& b, int& h, int& ck, size_t& row0) {
    ck = unit % 18; const int bh = unit / 18; h = bh & 3; b = bh >> 2;
    row0 = ck < 16 ? (size_t)b * SEQ + ck * 128 : (size_t)ML + b * LC + (ck - 16) * 128;
}
DEV float log_gamma(const Args& A, int L, int dir, int h) { return log1pf(-__expf(A.in[I_DECAY][L * 8 + dir * 4 + h])); }
constexpr int SC_STRIDE = 288;
constexpr int SC_V = 128 * SC_STRIDE;
DEV void scan_unit(const Args& A, int L, int unit, LAS unsigned char* lds, int tid) {
    const int w = __builtin_amdgcn_readfirstlane(tid >> 6), lane = tid & 63, c16 = lane & 15, q4 = lane >> 4;
    const int dir = unit & 1, bh = unit >> 1, h = bh & 3, b = bh >> 2;
    unsigned char* ws = A.ws; const bf16* proj = (const bf16*)(ws + WS_PROJ);
    const float lg = log_gamma(A, L, dir, h), gC = __expf(lg * 128.0f);
    bf16* ST = (bf16*)(ws + WS_ST) + ((size_t)bh * 18 * 2 + dir) * 16384 + (size_t)(16 * w + c16) * 128 + 4 * q4;
#define SC_CK(s) (dir == 0 ? ((s) < 2 ? 16 + (s) : (s) - 2) : 17 - (s))
#define SC_ROW0(ck) ((ck) < 16 ? (size_t)b * SEQ + (ck) * 128 : (size_t)ML + b * LC + ((ck) - 16) * 128)
    u32x4 rk[4], rv[4];
#define SC_LOAD(s) do { const size_t r0_ = SC_ROW0(SC_CK(s)); _Pragma("unroll") for (int i = 0; i < 4; ++i) { const int q = tid + 512 * i, tk = q >> 4, dc = q & 15; \
        rk[i] = *(const u32x4*)(proj + (r0_ + tk) * PS + 512 + h * 128 + 8 * dc); rv[i] = *(const u32x4*)(proj + (r0_ + tk) * PS + 1024 + h * 128 + 8 * dc); } } while (0)
    f32x4 acc[8];
#pragma unroll
    for (int t = 0; t < 8; ++t) acc[t] = (f32x4){0.f, 0.f, 0.f, 0.f};
    SC_LOAD(0);
    for (int s = 0; s < 18; ++s) {
        { bf16* st = ST + (size_t)SC_CK(s) * 32768;
#pragma unroll
          for (int t = 0; t < 8; ++t) { u32x2 o; o.x = pk2(acc[t][0], acc[t][1]); o.y = pk2(acc[t][2], acc[t][3]); *(u32x2*)(st + 16 * t) = o; } }
        if (s == 17) break;
        __syncthreads();
#pragma unroll
        for (int i = 0; i < 4; ++i) { const int q = tid + 512 * i, tk = q >> 4, dc = q & 15;
            const float wt = dir == 0 ? __expf(lg * (float)(127 - tk)) : __expf(lg * (float)tk);
            u32x4 kw; kw.x = pk2(bflo(rk[i].x) * wt, bfhi(rk[i].x) * wt); kw.y = pk2(bflo(rk[i].y) * wt, bfhi(rk[i].y) * wt); kw.z = pk2(bflo(rk[i].z) * wt, bfhi(rk[i].z) * wt); kw.w = pk2(bflo(rk[i].w) * wt, bfhi(rk[i].w) * wt);
            *(LAS u32x4*)(lds + tk * SC_STRIDE + dc * 16) = kw; *(LAS u32x4*)(lds + SC_V + tk * SC_STRIDE + dc * 16) = rv[i]; }
        if (s + 1 < 17) SC_LOAD(s + 1);
        __syncthreads();
#pragma unroll
        for (int t = 0; t < 8; ++t) acc[t] = acc[t] * gC;
#pragma unroll
        for (int k = 0; k < 4; ++k) {
            const LAS unsigned char* vb = lds + SC_V + (32 * k + 4 * q4 + (c16 >> 2)) * SC_STRIDE + (16 * w + 4 * (c16 & 3)) * 2;
            const s16x4 vlo = __builtin_bit_cast(s16x4, __builtin_amdgcn_ds_read_tr16_b64_v4i16((LAS v4i16_t*)vb)), vhi = __builtin_bit_cast(s16x4, __builtin_amdgcn_ds_read_tr16_b64_v4i16((LAS v4i16_t*)(vb + 16 * SC_STRIDE)));
            const bf16x8 bfrag = __builtin_shufflevector(vlo, vhi, 0, 1, 2, 3, 4, 5, 6, 7);
#pragma unroll
            for (int t = 0; t < 8; ++t) {
                const LAS unsigned char* kb = lds + (32 * k + 4 * q4 + (c16 >> 2)) * SC_STRIDE + (16 * t + 4 * (c16 & 3)) * 2;
                const s16x4 klo = __builtin_bit_cast(s16x4, __builtin_amdgcn_ds_read_tr16_b64_v4i16((LAS v4i16_t*)kb)), khi = __builtin_bit_cast(s16x4, __builtin_amdgcn_ds_read_tr16_b64_v4i16((LAS v4i16_t*)(kb + 16 * SC_STRIDE)));
                acc[t] = MFMA16(__builtin_shufflevector(klo, khi, 0, 1, 2, 3, 4, 5, 6, 7), bfrag, acc[t]);
            }
        }
    }
#undef SC_LOAD
#undef SC_ROW0
#undef SC_CK
    asm volatile("s_waitcnt vmcnt(0)" ::: "memory");
    __syncthreads();
    if (tid == 0) { __builtin_amdgcn_fence(__ATOMIC_RELEASE, "agent"); asm volatile("s_waitcnt vmcnt(0)" ::: "memory");
        __hip_atomic_fetch_add((unsigned*)(ws + WS_CTL) + CW_RFLAG + (L * 32 + bh) * 64, 1u, __ATOMIC_RELAXED, __HIP_MEMORY_SCOPE_AGENT); }
}
DEV void r3_unit(const Args& A, int L, int unit, LAS unsigned char* lds, int tid) {
    const int w = __builtin_amdgcn_readfirstlane(tid >> 6), lane = tid & 63, c16 = lane & 15, q4 = lane >> 4;
    int b, h, ck; size_t row0; ret_unit_ids(unit, b, h, ck, row0);
    unsigned char* ws = A.ws; const bf16* proj = (const bf16*)(ws + WS_PROJ);
    const float lgf = log_gamma(A, L, 0, h), lgb = log_gamma(A, L, 1, h);
    LAS unsigned short* KS = (LAS unsigned short*)lds; LAS unsigned short* VT = KS + 128 * RS;
    if (tid == 0) {
        const unsigned* fl = (const unsigned*)(ws + WS_CTL) + CW_RFLAG + (L * 32 + b * 4 + h) * 64; unsigned sp = 0;
        while (__hip_atomic_load(fl, __ATOMIC_RELAXED, __HIP_MEMORY_SCOPE_AGENT) < 2u) { __builtin_amdgcn_s_sleep(2); if (++sp > (1u << 22)) break; }
        __builtin_amdgcn_fence(__ATOMIC_ACQUIRE, "agent"); asm volatile("s_waitcnt vmcnt(0)" ::: "memory");
    }
    __syncthreads();
    for (int q = tid; q < 2048; q += NTHREADS) { const int i = q >> 4, dc = q & 15;
        const u32x4 kv = *(const u32x4*)(proj + (row0 + i) * PS + 512 + h * 128 + 8 * dc), vv = *(const u32x4*)(proj + (row0 + i) * PS + 1024 + h * 128 + 8 * dc);
        *(LAS u32x4*)(KS + i * RS + 8 * dc) = kv;
        *(LAS u32x4*)((LAS unsigned char*)VT + i * 288 + 16 * dc) = vv; }
    __syncthreads();
    const int n = 16 * w + c16; const size_t row = row0 + n;
    bf16x8 qf[4];
#pragma unroll
    for (int k = 0; k < 4; ++k) qf[k] = *(const bf16x8*)(proj + row * PS + h * 128 + 32 * k + 8 * q4);
    f32x4 sT[8];
#pragma unroll
    for (int t = 0; t < 8; ++t) { f32x4 acc = {0.f, 0.f, 0.f, 0.f};
#pragma unroll
        for (int k = 0; k < 4; ++k) { const bf16x8 a = *(const LAS bf16x8*)(KS + (16 * t + c16) * RS + 32 * k + 8 * q4); acc = MFMA16(a, qf[k], acc); }
#pragma unroll
        for (int r = 0; r < 4; ++r) { const int d = n - (16 * t + 4 * q4 + r); acc[r] *= (d >= 0) ? __expf(lgf * (float)d) : __expf(-lgb * (float)d); }
        sT[t] = acc; }
    f32x4 y[8];
#pragma unroll
    for (int dt = 0; dt < 8; ++dt) y[dt] = (f32x4){0.f, 0.f, 0.f, 0.f};
#pragma unroll
    for (int u = 0; u < 4; ++u) { const bf16x8 bp = pack8(sT[2 * u], sT[2 * u + 1]);
#pragma unroll
        for (int dt = 0; dt < 8; ++dt) { const LAS unsigned char* vr = (const LAS unsigned char*)VT + (32 * u + 4 * q4 + (c16 >> 2)) * 288 + (16 * dt + 4 * (c16 & 3)) * 2;
            const s16x4 lo = __builtin_bit_cast(s16x4, __builtin_amdgcn_ds_read_tr16_b64_v4i16((LAS v4i16_t*)vr)), hi = __builtin_bit_cast(s16x4, __builtin_amdgcn_ds_read_tr16_b64_v4i16((LAS v4i16_t*)(vr + 16 * 288)));
            y[dt] = MFMA16(__builtin_shufflevector(lo, hi, 0, 1, 2, 3, 4, 5, 6, 7), bp, y[dt]); } }
    const float df = __expf(lgf * (float)(n + 1)), db = __expf(lgb * (float)(128 - n));
    bf16x8 qdf[4], qdb[4];
#pragma unroll
    for (int k = 0; k < 4; ++k) { const u32x4 qq = __builtin_bit_cast(u32x4, qf[k]); u32x4 f, g;
        f.x = pk2(bflo(qq.x) * df, bfhi(qq.x) * df); f.y = pk2(bflo(qq.y) * df, bfhi(qq.y) * df); f.z = pk2(bflo(qq.z) * df, bfhi(qq.z) * df); f.w = pk2(bflo(qq.w) * df, bfhi(qq.w) * df);
        g.x = pk2(bflo(qq.x) * db, bfhi(qq.x) * db); g.y = pk2(bflo(qq.y) * db, bfhi(qq.y) * db); g.z = pk2(bflo(qq.z) * db, bfhi(qq.z) * db); g.w = pk2(bflo(qq.w) * db, bfhi(qq.w) * db);
        qdf[k] = __builtin_bit_cast(bf16x8, f); qdb[k] = __builtin_bit_cast(bf16x8, g); }
    const bf16* STf = (const bf16*)(ws + WS_ST) + (size_t)unit * 2 * 16384; const bf16* STb = STf + 16384;
#pragma unroll
    for (int dt = 0; dt < 8; ++dt)
#pragma unroll
        for (int k = 0; k < 4; ++k) { const bf16x8 a = *(const bf16x8*)(STf + (16 * dt + c16) * 128 + 32 * k + 8 * q4), a2 = *(const bf16x8*)(STb + (16 * dt + c16) * 128 + 32 * k + 8 * q4);
            y[dt] = MFMA16(a, qdf[k], y[dt]); y[dt] = MFMA16(a2, qdb[k], y[dt]); }
    float s = 0.f;
#pragma unroll
    for (int dt = 0; dt < 8; ++dt) s += (y[dt][0] + y[dt][1]) + (y[dt][2] + y[dt][3]);
    s = xrow16_sum(s);
    const float mu = s * (1.0f / 128.0f); float v = 0.f;
#pragma unroll
    for (int dt = 0; dt < 8; ++dt) { const f32x4 d = y[dt] - mu; v += (d[0] * d[0] + d[1] * d[1]) + (d[2] * d[2] + d[3] * d[3]); }
    v = xrow16_sum(v);
    const float rstd = rsqrtf(v * (1.0f / 128.0f) + EPS);
    bf16* yo = (bf16*)(ws + WS_YBR) + row * 512 + h * 128;
#pragma unroll
    for (int dt = 0; dt < 8; ++dt) { const u32x2 g = *(const u32x2*)(proj + row * PS + 1536 + h * 128 + 16 * dt + 4 * q4);
        u32x2 o; o.x = pk2(bflo(g.x) * (y[dt][0] - mu) * rstd, bfhi(g.x) * (y[dt][1] - mu) * rstd); o.y = pk2(bflo(g.y) * (y[dt][2] - mu) * rstd, bfhi(g.y) * (y[dt][3] - mu) * rstd);
        *(u32x2*)(yo + 16 * dt + 4 * q4) = o; }
}


DEV void panel_signal(unsigned* flag) {
    asm volatile("s_waitcnt vmcnt(0)" ::: "memory");
    __syncthreads();
    if (threadIdx.x == 0) {
        __builtin_amdgcn_fence(__ATOMIC_RELEASE, "agent"); asm volatile("s_waitcnt vmcnt(0)" ::: "memory");
        __hip_atomic_fetch_add(flag, 1u, __ATOMIC_RELAXED, __HIP_MEMORY_SCOPE_AGENT);
    }
}
DEV void panel_wait(const unsigned* flag) {
    if (threadIdx.x == 0) {
        unsigned sp = 0;
        for (int p = 0; p < 8; ++p)
            while (__hip_atomic_load(flag + p * 64, __ATOMIC_RELAXED, __HIP_MEMORY_SCOPE_AGENT) < 4u) { __builtin_amdgcn_s_sleep(2); if (++sp > (1u << 22)) break; }
        __builtin_amdgcn_fence(__ATOMIC_ACQUIRE, "agent"); asm volatile("s_waitcnt vmcnt(0)" ::: "memory");
    }
    __syncthreads();
}
__global__ void __launch_bounds__(NTHREADS, 2) mk_fwd(Args args) {
    extern __shared__ __attribute__((aligned(16))) unsigned char lds_raw[];
    LAS unsigned char* lds = (LAS unsigned char*)lds_raw;
    const int tid = threadIdx.x, G = gridDim.x;
    const int bx = blockIdx.x, vcu = (G % 8 == 0) ? (bx % 8) * (G / 8) + bx / 8 : bx;
    unsigned char* ws = args.ws;
    volatile LAS unsigned* MISC = (volatile LAS unsigned*)(lds + MISC_OFF);
    for (int u = tid; u < (LDS_BYTES - 131072) / 4; u += NTHREADS) ((LAS unsigned*)(lds + 131072))[u] = 0u;
    __syncthreads();
    const int lo = args.ph_lo, hi = args.ph_hi;
    XcdBarrier bar; bar.bar = (unsigned*)(ws + WS_CTL) + CW_BAR; bar.x = 0; bar.st = nullptr;
    if (hi - lo > 1) bar = xcd_barrier_post((unsigned*)(ws + WS_CTL) + CW_BAR, MISC + 8);
#define IN(k) (lo <= (k) && (k) < hi)
#define EN(b) (((MK_EN) >> (b)) & 1u)
#define REP(b) for (int _rp = 0; _rp < 1 + (int)(((MK_REP) >> (b)) & 1u); ++_rp)
#define OT() ({ int _t = threadIdx.x; asm volatile("" : "+v"(_t)); _t; })
#define SEAM(k) do { if (IN(k) && IN((k) + 1)) xcd_barrier(bar); } while (0)
    const pg8::bf16_t* XN = (const pg8::bf16_t*)(ws + WS_XN);
    pg8::bf16_t* PROJ = (pg8::bf16_t*)(ws + WS_PROJ);
    const float* TAB = (const float*)(ws + WS_TAB);

    if (EN(0) && IN(0)) REP(0) { p0_prologue(args, lds, vcu, G, OT()); } SEAM(0);
    if (EN(1) && IN(1)) REP(1) { thin_phase<0>(args, 0, vcu, G, 0, MT, OT(), lds); } SEAM(1);
    for (int L = 0; L < DEPTH; ++L) {
        const int pb = 2 + 11 * L;
        const bool need_ctx = L < DEPTH - 1;
        const int Mact = need_ctx ? MT : ML;
        if (EN(2) && IN(pb + 0)) REP(2) {
            if constexpr (F8GATE) {
                { pg8::Gemm g{XN, (const pg8::bf16_t*)(ws + WS_WIN + (size_t)L * DIN * 1024 * 2), MT, 4352, 1024}; pg8::StaticOrder S; S.init(MT, 4352, G, bx);
                  pg8::EpiInProj<false> E{PROJ, TAB + TAB_RTC, TAB + TAB_RTS, TAB + TAB_AXC, TAB + TAB_AXS, 1.0f, 0};
                  pg8::gemm_phase<pg8::EpiInProj<false>, pg8::StaticOrder, true, true, false>(lds, g, S, E); }
                { pg8::Gemm g{(const pg8::bf16_t*)(ws + WS_XN8), (const pg8::bf16_t*)(ws + WS_WIN8 + (size_t)L * 3072 * 1024), MT, 3072, 512}; pg8::TailOrder S; S.init(MT, 3072, G, bx); S.cut = (72 * 17) % G; S.base = (72 * 12) / G; if (S.cut == 0) S.base = 1 << 20;
                  pg8::EpiGate E{ws + WS_G8};
                  pg8::gemm_phase<pg8::EpiGate, pg8::TailOrder, true, true, true>(lds, g, S, E); }
            } else {
            pg8::Gemm g{XN, (const pg8::bf16_t*)(ws + WS_WIN + (size_t)L * DIN * 1024 * (F8IN ? 1 : 2)), MT, DIN, F8IN ? 512 : 1024}; pg8::StaticOrder S; S.init(MT, DIN, G, bx);
            pg8::EpiInProj<true> E{PROJ, TAB + TAB_RTC, TAB + TAB_RTS, TAB + TAB_AXC, TAB + TAB_AXS, F8IN ? 0.015625f : 1.0f, 0};
            pg8::gemm_phase<pg8::EpiInProj<true>, pg8::StaticOrder, true, true, F8IN>(lds, g, S, E);
            }
        } SEAM(pb + 0);
        if (IN(pb + 1)) {
            unsigned* wq = (unsigned*)(ws + WS_CTL) + CW_WQ + L * 64;
            const int n_ctx = need_ctx ? 96 : 0, n_att = 64 + 256 + 256 + n_ctx, n_units = n_att + (need_ctx ? 576 : 512);
            for (int it_ = 0;; ++it_) {
                int u;
                if (it_ == 0) u = bx;
                else {
                    if (threadIdx.x == 0) MISC[16] = __hip_atomic_fetch_add(wq, 1u, __ATOMIC_RELAXED, __HIP_MEMORY_SCOPE_AGENT);
                    __syncthreads();
                    u = (int)MISC[16] + G;
                    __syncthreads();
                }
                if (u >= n_units) break;
                const int n_r3 = need_ctx ? 576 : 512;
                if (u < 64) { if (EN(6)) scan_unit(args, L, u, lds, OT()); }
                else if (u < 320) { if (EN(4)) attn4_unit<1>(args, L, u - 64, lds, OT()); }
                else if (u < 320 + n_r3) { const int v = u - 320; if (EN(8)) r3_unit(args, L, need_ctx ? v : (v >> 4) * 18 + (v & 15), lds, OT()); }
                else if (u < 576 + n_r3) { if (EN(3)) attn4_unit<0>(args, L, u - 320 - n_r3, lds, OT()); }
                else if (u < 608 + n_r3) { if (EN(5)) attn4_unit<2>(args, L, u - 576 - n_r3, lds, OT()); }
                else { if (EN(5)) attn4_unit<3>(args, L, u - 608 - n_r3, lds, OT()); }
            }
        } SEAM(pb + 1);
        if (EN(9) && IN(pb + 4)) REP(9) {
            pg8::Gemm g{(const pg8::bf16_t*)(ws + WS_YBR), (const pg8::bf16_t*)(ws + WS_WBR) + (size_t)L * 3 * 1024 * 512, 3 * MT, 3 * 1024, 512};
            { pg8::BranchOrder S{(ML / 256) * 4, G, vcu};
              pg8::EpiBranch E{ws + WS_G8, (pg8::bf16_t*)(ws + WS_MERGED)};
              pg8::gemm_phase<pg8::EpiBranch, pg8::BranchOrder, true, true>(lds, g, S, E); }
            if (need_ctx) { pg8::PartOrder S{G, vcu};
              pg8::EpiBranchPart E{ws + WS_G8, (pg8::bf16_t*)(ws + WS_PART)};
              pg8::gemm_phase<pg8::EpiBranchPart, pg8::PartOrder, true, true>(lds, g, S, E); }
        } SEAM(pb + 4);
#define BAR_ALWAYS() do { if (hi - lo > 1) xcd_barrier(bar); } while (0)
        if (EN(10) && IN(pb + 5)) {
            const pg8::bf16_t* Wo = (const pg8::bf16_t*)(ws + WS_WOUT) + (size_t)L * 1024 * 1024;
            if (need_ctx) {
                { pg8::Gemm g{(const pg8::bf16_t*)(ws + WS_MERGED), Wo, ML, 1024, 1024}; pg8::StaticOrder S; S.init(ML, 1024, G, bx);
                  pg8::EpiPlain E{(pg8::bf16_t*)(ws + WS_YOUT), 1024, 4, 1.0f};
                  pg8::gemm_phase<pg8::EpiPlain, pg8::StaticOrder, true, true>(lds, g, S, E); }
                { const int t_ = OT(), lane_ = t_ & 63;
                  for (int row = vcu * 8 + (t_ >> 6); row < MC; row += G * 8) {
                      const unsigned char* pp = ws + WS_PART + ((size_t)row * 1024 + lane_ * 16) * 2;
                      float f[16];
#pragma unroll
                      for (int r = 0; r < 3; ++r) {
                          const uint4 w0 = *(const uint4*)(pp + (size_t)r * MC * 2048), w1 = *(const uint4*)(pp + (size_t)r * MC * 2048 + 16);
                          const unsigned ww[8] = {w0.x, w0.y, w0.z, w0.w, w1.x, w1.y, w1.z, w1.w};
#pragma unroll
                          for (int k = 0; k < 8; ++k) { const float lo_ = __uint_as_float(ww[k] << 16), hi_ = __uint_as_float(ww[k] & 0xffff0000u);
                              if (r == 0) { f[2 * k] = lo_; f[2 * k + 1] = hi_; } else { f[2 * k] += lo_; f[2 * k + 1] += hi_; } }
                      }
                      uint4 o0, o1;
                      o0.x = pg8::cvt_pk_bf16(f[0], f[1]); o0.y = pg8::cvt_pk_bf16(f[2], f[3]); o0.z = pg8::cvt_pk_bf16(f[4], f[5]); o0.w = pg8::cvt_pk_bf16(f[6], f[7]);
                      o1.x = pg8::cvt_pk_bf16(f[8], f[9]); o1.y = pg8::cvt_pk_bf16(f[10], f[11]); o1.z = pg8::cvt_pk_bf16(f[12], f[13]); o1.w = pg8::cvt_pk_bf16(f[14], f[15]);
                      unsigned char* op = ws + WS_MERGED + ((size_t)(ML + row) * 1024 + lane_ * 16) * 2;
                      *(uint4*)op = o0; *(uint4*)(op + 16) = o1;
                  } }
                BAR_ALWAYS();
                if (vcu < 32) { pg8::Gemm g{(const pg8::bf16_t*)(ws + WS_MERGED) + (size_t)ML * 1024, Wo, MC, 1024, 1024}; pg8::StaticOrder S; S.init(MC, 1024, 32, vcu);
                  pg8::EpiPlain E{(pg8::bf16_t*)(ws + WS_YOUT) + (size_t)ML * 1024, 1024, 4, 1.0f};
                  pg8::gemm_phase<pg8::EpiPlain, pg8::StaticOrder, true, true>(lds, g, S, E);
                  panel_signal((unsigned*)(ws + WS_CTL) + CW_PFLAG + ((L * 2 + 0) * 8 + (((vcu % 8) * 4 + vcu / 8) & 7)) * 64); }
                else thin_phase<1>(args, L, vcu - 32, G - 32, 0, ML, OT(), lds);
                panel_wait((const unsigned*)(ws + WS_CTL) + CW_PFLAG + (L * 2 + 0) * 8 * 64);
                thin_phase<1>(args, L, vcu, G, ML, MT, OT(), lds);
            } else {
                pg8::Gemm g{(const pg8::bf16_t*)(ws + WS_MERGED), Wo, ML, 1024, 1024}; pg8::StaticOrder S; S.init(ML, 1024, G, bx);
                pg8::EpiPlain E{(pg8::bf16_t*)(ws + WS_YOUT), 1024, 4, 1.0f};
                pg8::gemm_phase<pg8::EpiPlain, pg8::StaticOrder, true, true>(lds, g, S, E);
            }
        } SEAM(pb + 5);
        if (EN(11) && IN(pb + 6)) { if (!need_ctx) thin_phase<1>(args, L, vcu, G, 0, ML, OT(), lds); } if (!need_ctx) SEAM(pb + 6);
        if (L & 1) {
            const int mi = L >> 1;
            const unsigned* cnt = (const unsigned*)(ws + WS_CTL) + CW_MOE + mi * 8 * 64;
            if (EN(12) && IN(pb + 7)) REP(12) { gather_phase(args, L, vcu, G, OT()); } SEAM(pb + 7);
            if (EN(13) && IN(pb + 8)) REP(13) {
                constexpr int EB = F8UP_M ? 1 : 2;
                pg8::Gemm g{(const pg8::bf16_t*)(ws + WS_ASORT), (const pg8::bf16_t*)(ws + WS_WM13 + (size_t)mi * 8 * 2 * FFE * 1024 * EB), MSORT, 8 * 2 * FFE, 512 * EB};
                pg8::MoeOrder S; S.init(cnt, 28, G, bx);
                pg8::EpiSwiGLUx<F8UP_M, F8DN_M> E{ws + WS_HID, FFE, 28};
                pg8::gemm_phase<pg8::EpiSwiGLUx<F8UP_M, F8DN_M>, pg8::MoeOrder, true, true, F8UP_M>(lds, g, S, E);
            } SEAM(pb + 8);
            if (EN(14) && IN(pb + 9)) REP(14) {
                constexpr int EB = F8DN_M ? 1 : 2;
                pg8::Gemm g{(const pg8::bf16_t*)(ws + WS_HID), (const pg8::bf16_t*)(ws + WS_WM2 + (size_t)mi * 8 * 1024 * FFE * EB), MSORT, 8 * 1024, FFE / 2 * EB};
                pg8::MoeOrder S; S.init(cnt, 4, G, bx);
                pg8::EpiPlain E{(pg8::bf16_t*)(ws + WS_OSORT), 1024, 4, F8DN_M ? 1.0f / 2048.0f : 1.0f};
                pg8::gemm_phase<pg8::EpiPlain, pg8::MoeOrder, true, true, F8DN_M>(lds, g, S, E);
            } SEAM(pb + 9);
        } else {
            const int fi = L >> 1;
            if (EN(15) && IN(pb + 8)) REP(15) {
                constexpr int EB = F8UP_D ? 1 : 2;
                pg8::Gemm g{XN, (const pg8::bf16_t*)(ws + WS_WF13 + (size_t)fi * 2 * FFD * 1024 * EB), Mact, 2 * FFD, 512 * EB}; pg8::StaticOrder S; S.init(Mact, 2 * FFD, G, bx);
                pg8::EpiSwiGLUx<F8UP_D, F8DN_D> E{ws + WS_HID, FFD, 22};
                pg8::gemm_phase<pg8::EpiSwiGLUx<F8UP_D, F8DN_D>, pg8::StaticOrder, true, true, F8UP_D>(lds, g, S, E);
            } SEAM(pb + 8);
            if (EN(16) && IN(pb + 9)) {
                constexpr int EB = F8DN_D ? 1 : 2; constexpr float sc = F8DN_D ? 1.0f / 2048.0f : 1.0f;
                const pg8::bf16_t* W2 = (const pg8::bf16_t*)(ws + WS_WF2 + (size_t)fi * 1024 * FFD * EB);
                { pg8::Gemm g{(const pg8::bf16_t*)(ws + WS_HID), W2, ML, 1024, FFD / 2 * EB}; pg8::StaticOrder S; S.init(ML, 1024, G, bx);
                  pg8::EpiPlain E{(pg8::bf16_t*)(ws + WS_YOUT), 1024, 4, sc};
                  pg8::gemm_phase<pg8::EpiPlain, pg8::StaticOrder, true, true, F8DN_D>(lds, g, S, E); }
                BAR_ALWAYS();
                if (vcu < 32) { pg8::Gemm g{(const pg8::bf16_t*)(ws + WS_HID + (size_t)ML * FFD * EB), W2, MC, 1024, FFD / 2 * EB}; pg8::StaticOrder S; S.init(MC, 1024, 32, vcu);
                  pg8::EpiPlain E{(pg8::bf16_t*)(ws + WS_YOUT) + (size_t)ML * 1024, 1024, 4, sc};
                  pg8::gemm_phase<pg8::EpiPlain, pg8::StaticOrder, true, true, F8DN_D>(lds, g, S, E);
                  panel_signal((unsigned*)(ws + WS_CTL) + CW_PFLAG + ((L * 2 + 1) * 8 + (((vcu % 8) * 4 + vcu / 8) & 7)) * 64); }
                else thin_phase<2>(args, L, vcu - 32, G - 32, 0, ML, OT(), lds);
                panel_wait((const unsigned*)(ws + WS_CTL) + CW_PFLAG + (L * 2 + 1) * 8 * 64);
                thin_phase<2>(args, L, vcu, G, ML, MT, OT(), lds);
            } SEAM(pb + 9);
        }
        if (EN(17) && IN(pb + 10)) { if (L & 1) thin_phase<2>(args, L, vcu, G, 0, Mact, OT(), lds); } if (L & 1) SEAM(pb + 10);
    }
#undef IN
#undef SEAM
}


extern "C" void kernel_launch(void* const* d_in, const int* in_sizes, int n_in, void* d_out, int out_size, void* d_ws, size_t ws_size, hipStream_t stream) {
    static int grid = 0;
    if (grid == 0) {
        if (n_in != 20 || out_size != ML * D || ws_size < WS_END) { fprintf(stderr, "kernel_launch: unexpected shapes (n_in %d out %d ws %zu need %zu)\n", n_in, out_size, ws_size, (size_t)WS_END); grid = -1; return; }
        int dev = 0, cus = 0;
        if (hipGetDevice(&dev) != hipSuccess || hipDeviceGetAttribute(&cus, hipDeviceAttributeMultiprocessorCount, dev) != hipSuccess) { grid = -1; return; }
        if (hipFuncSetAttribute((const void*)mk_fwd, hipFuncAttributeMaxDynamicSharedMemorySize, LDS_BYTES) != hipSuccess) { fprintf(stderr, "kernel_launch: hipFuncSetAttribute failed\n"); grid = -1; return; }
        int per_cu = 0;
        (void)hipOccupancyMaxActiveBlocksPerMultiprocessor(&per_cu, (const void*)mk_fwd, NTHREADS, LDS_BYTES);
        (void)hipGetLastError();
        grid = cus;
    }
    if (grid < 0) return;
    (void)hipMemsetAsync((char*)d_ws + WS_CTL, 0, CTL_ZERO_BYTES, stream);
    Args a{};
    for (int i = 0; i < 20; ++i) a.in[i] = (const float*)d_in[i];
    a.out = (float*)d_out; a.ws = (unsigned char*)d_ws; a.li = 0; a.pad = 0;
#if MK_PER_PHASE
    for (int ph = 0; ph < MK_NPH_RUN; ++ph) { a.ph_lo = ph; a.ph_hi = ph + 1; hipLaunchKernelGGL(mk_fwd, dim3(grid), dim3(NTHREADS), LDS_BYTES, stream, a); }
#else
    a.ph_lo = 0; a.ph_hi = MK_NPH_RUN;
    hipLaunchKernelGGL(mk_fwd, dim3(grid), dim3(NTHREADS), LDS_BYTES, stream, a);
#endif
}
```

```cpp
#include <hip/hip_runtime.h>
#include <cstdio>
#include <cstdint>
#include <cmath>
#define LAS __attribute__((address_space(3)))
namespace pg8 {
#define PG8_LAS __attribute__((address_space(3)))
typedef unsigned short bf16_t;
typedef short bf16x8 __attribute__((ext_vector_type(8)));
typedef float f32x4 __attribute__((ext_vector_type(4)));
typedef unsigned u32x4 __attribute__((ext_vector_type(4)));
constexpr int BM = 256, BK = 64, HALF = 128, HTB = HALF * BK * 2  , STAGE_BYTES = 8 * HTB, NXCD = 8, WGM = 8;

__host__ __device__ __forceinline__ int lds_byte(int r, int c) { const int st = (r >> 4) * 2 + (c >> 5), rr = r & 15, cc = c & 31, ob = rr * 64 + cc * 2; return st * 1024 + (ob ^ (((ob >> 9) & 1) << 5)); }
__host__ __device__ __forceinline__ void stage_rc(int b, int& R, int& C) { const int st = b / 1024, sb = b % 1024, swz = sb ^ (((sb >> 9) & 1) << 5); R = (st >> 1) * 16 + swz / 64; C = (st & 1) * 32 + (swz % 64) / 2; }
__host__ __device__ __forceinline__ int perm32(int rho) { const int n = rho >> 4, i = rho & 15; return 8 * (i >> 2) + 4 * n + (i & 3); }

typedef int v8i32 __attribute__((ext_vector_type(8))); typedef int v4i32 __attribute__((ext_vector_type(4)));
__device__ __forceinline__ v8i32 pg8_cat(bf16x8 lo, bf16x8 hi) { return __builtin_shufflevector(__builtin_bit_cast(v4i32, lo), __builtin_bit_cast(v4i32, hi), 0, 1, 2, 3, 4, 5, 6, 7); }
struct Unit { int pm, pn; };
struct Gemm { const bf16_t* A; const bf16_t* Bt; int M, N, K; };

struct StaticOrder {
    int nM, nN, nwg, G, c;
    __host__ __device__ void init(int M, int N, int G_, int c_) { nM = M / BM; nN = N / BM; nwg = nM * nN; G = G_; c = c_; }
    __host__ __device__ bool next(int i, Unit& u) const { return next_at((long)i * G + c, u); }
    __host__ __device__ bool next_at(long L, Unit& u) const {
        if (L >= nwg) return false;
        int wgid = (int)L; { const int q = nwg / NXCD, r = nwg % NXCD, xcd = wgid % NXCD, off = wgid / NXCD; wgid = (xcd < r ? xcd * (q + 1) : r * (q + 1) + (xcd - r) * q) + off; }
        const int nig = WGM * nN, gid = wgid / nig, fm = gid * WGM, gsz = (nM - fm) < WGM ? (nM - fm) : WGM;
        u.pm = fm + ((wgid % nig) % gsz); u.pn = (wgid % nig) / gsz; return true;
    }
    __device__ __forceinline__ void a_ready(const Unit&) const {}
    __device__ __forceinline__ void done(const Unit&) const {}
};

typedef float f32x2_t __attribute__((ext_vector_type(2))); typedef __bf16 bf16x2_t __attribute__((ext_vector_type(2)));
__device__ __forceinline__ unsigned cvt_pk_bf16(float lo, float hi) { const f32x2_t v = {lo, hi}; const bf16x2_t b = __builtin_convertvector(v, bf16x2_t); return __builtin_bit_cast(unsigned, b); }
typedef float f32x2 __attribute__((ext_vector_type(2)));

struct BranchOrder {
    int nT, G, c;
    __device__ __forceinline__ bool next(int i, Unit& u) const {
        const int rd = i / 3, r = i - rd * 3; const int t = rd * G + c; if (t >= nT) return false;
        u.pm = r * 72 + (t >> 2); u.pn = r * 4 + (t & 3); return true;
    }
    __device__ __forceinline__ void a_ready(const Unit&) const {}
    __device__ __forceinline__ void done(const Unit&) const {}
};
struct PartOrder {
    int G, c;
    __device__ __forceinline__ bool next(int i, Unit& u) const {
        const int j = i * G + c; if (j >= 96) return false;
        const int r = j >> 5, t = j & 31; u.pm = r * 72 + 64 + (t >> 2); u.pn = r * 4 + (t & 3); return true;
    }
    __device__ __forceinline__ void a_ready(const Unit&) const {}
    __device__ __forceinline__ void done(const Unit&) const {}
};
struct MoeOrder {
    int nM, nN, nwg, G, c; int ts[9];
    __device__ __forceinline__ void init(const unsigned* cnt, int nN_, int G_, int c_) {
        int acc = 0;
#pragma unroll
        for (int e = 0; e < 8; ++e) { ts[e] = acc; const unsigned ce = __hip_atomic_load(cnt + 64 * e, __ATOMIC_RELAXED, __HIP_MEMORY_SCOPE_AGENT); acc += (int)((ce + 255u) >> 8); }
        ts[8] = acc; nM = acc; nN = nN_; nwg = nM * nN; G = G_; c = c_;
    }
    __device__ __forceinline__ bool next(int i, Unit& u) const {
        const long L = (long)i * G + c; if (L >= nwg) return false;
        int wgid = (int)L; { const int q = nwg / NXCD, r = nwg % NXCD, xcd = wgid % NXCD, off = wgid / NXCD; wgid = (xcd < r ? xcd * (q + 1) : r * (q + 1) + (xcd - r) * q) + off; }
        const int nig = WGM * nN, gid = wgid / nig, fm = gid * WGM, gsz = (nM - fm) < WGM ? (nM - fm) : WGM;
        const int pm = fm + ((wgid % nig) % gsz), pnt = (wgid % nig) / gsz;
        int e = 0;
#pragma unroll
        for (int k = 1; k < 8; ++k) e += (pm >= ts[k]) ? 1 : 0;
        u.pm = pm; u.pn = e * nN + pnt; return true;
    }
    __device__ __forceinline__ void a_ready(const Unit&) const {}
    __device__ __forceinline__ void done(const Unit&) const {}
};


struct TailOrder : StaticOrder {
    int cut, base;
    __device__ __forceinline__ bool next(int i, Unit& u) const {
        long L;
        if (i < base) L = (long)i * G + c; else { if (c < cut) return false; L = (long)base * G + (long)(i - base) * (G - cut) + (c - cut); }
        if (L >= nwg) return false;
        return next_at(L, u);
    }
};
__device__ __forceinline__ void store8(bf16_t* p, const f32x4 a, const f32x4 b) {
    u32x4 w; w.x = cvt_pk_bf16(a[0], a[1]); w.y = cvt_pk_bf16(a[2], a[3]); w.z = cvt_pk_bf16(b[0], b[1]); w.w = cvt_pk_bf16(b[2], b[3]); *(u32x4*)p = w;
}
__device__ __forceinline__ float sigm(float x) { return __builtin_amdgcn_rcpf(1.0f + __expf(-x)); }
__device__ __forceinline__ f32x4 sigm4(f32x4 v) { f32x4 o; o[0] = sigm(v[0]); o[1] = sigm(v[1]); o[2] = sigm(v[2]); o[3] = sigm(v[3]); return o; }

struct EpiPlain {
    static constexpr bool PERM = true, AFTER_DRAIN = false, KEEP_ACC = false;
    bf16_t* O; int ldc; int pn_mod; float scale;
    __device__ __forceinline__ void operator()(const f32x4 (&acc)[2][2][4][2], const Unit& u, int wr, int wc, int fr, int fq) const {
        const int row0 = u.pm * BM + wr * 64 + fr, col0 = (u.pn % pn_mod) * BM + wc * 32 + 8 * fq;
#pragma unroll
        for (int ai = 0; ai < 2; ++ai)
#pragma unroll
            for (int m = 0; m < 4; ++m) { bf16_t* rowp = O + (size_t)(row0 + ai * HALF + m * 16) * ldc + col0;
#pragma unroll
                for (int bj = 0; bj < 2; ++bj) store8(rowp + bj * HALF, acc[ai][bj][m][0] * scale, acc[ai][bj][m][1] * scale); }
    }
};
__device__ __forceinline__ float clamp_f8(float v) { return __builtin_amdgcn_fmed3f(v, -448.0f, 448.0f); }
__device__ __forceinline__ unsigned pk4_fp8(float a, float b, float c, float d) { a = clamp_f8(a); b = clamp_f8(b); c = clamp_f8(c); d = clamp_f8(d); unsigned w = 0; w = __builtin_amdgcn_cvt_pk_fp8_f32(a, b, w, false); w = __builtin_amdgcn_cvt_pk_fp8_f32(c, d, w, true); return w; }
typedef unsigned u32x2_t __attribute__((ext_vector_type(2)));
template <bool IN8, bool OUT8> struct EpiSwiGLUx {
    static constexpr bool PERM = true, AFTER_DRAIN = false, KEEP_ACC = false;
    unsigned char* O; int ldc; int pn_mod;
    __device__ __forceinline__ void operator()(const f32x4 (&acc)[2][2][4][2], const Unit& u, int wr, int wc, int fr, int fq) const {
        const int row0 = u.pm * BM + wr * 64 + fr, col0 = (u.pn % pn_mod) * HALF + wc * 32 + 8 * fq;
        constexpr float s1 = IN8 ? 0.015625f : 1.0f, s3 = (IN8 ? 0.015625f : 1.0f) * (OUT8 ? 16.0f : 1.0f);
#pragma unroll
        for (int ai = 0; ai < 2; ++ai) {
#pragma unroll
            for (int m = 0; m < 4; ++m) {
                const size_t eoff = (size_t)(row0 + ai * HALF + m * 16) * ldc + col0;
                constexpr float k1 = -1.4426950408889634f * s1, ic = 1.0f / (s1 * s3);
                const f32x4 g0 = acc[ai][0][m][0], g1 = acc[ai][0][m][1];
                const f32x4 t0 = g0 * k1, t1 = g1 * k1; f32x4 e0, e1;
                e0[0] = __builtin_amdgcn_exp2f(t0[0]); e0[1] = __builtin_amdgcn_exp2f(t0[1]); e0[2] = __builtin_amdgcn_exp2f(t0[2]); e0[3] = __builtin_amdgcn_exp2f(t0[3]);
                e1[0] = __builtin_amdgcn_exp2f(t1[0]); e1[1] = __builtin_amdgcn_exp2f(t1[1]); e1[2] = __builtin_amdgcn_exp2f(t1[2]); e1[3] = __builtin_amdgcn_exp2f(t1[3]);
                const f32x4 d0 = e0 * ic + ic, d1 = e1 * ic + ic; f32x4 r0, r1;
                r0[0] = __builtin_amdgcn_rcpf(d0[0]); r0[1] = __builtin_amdgcn_rcpf(d0[1]); r0[2] = __builtin_amdgcn_rcpf(d0[2]); r0[3] = __builtin_amdgcn_rcpf(d0[3]);
                r1[0] = __builtin_amdgcn_rcpf(d1[0]); r1[1] = __builtin_amdgcn_rcpf(d1[1]); r1[2] = __builtin_amdgcn_rcpf(d1[2]); r1[3] = __builtin_amdgcn_rcpf(d1[3]);
                const f32x4 v0 = (g0 * acc[ai][1][m][0]) * r0, v1 = (g1 * acc[ai][1][m][1]) * r1;
                if constexpr (OUT8) { u32x2_t w; w.x = pk4_fp8(v0[0], v0[1], v0[2], v0[3]); w.y = pk4_fp8(v1[0], v1[1], v1[2], v1[3]); *(u32x2_t*)(O + eoff) = w; }
                else store8((bf16_t*)O + eoff, v0, v1);
            }
        }
    }
};
struct EpiBranch {
    static constexpr bool PERM = true, AFTER_DRAIN = false, KEEP_ACC = true;
    const unsigned char* P;
    bf16_t* Mg;
    static __device__ __forceinline__ void unpack8(const u32x2_t g, f32x4& g0, f32x4& g1) {
        constexpr float s = 1.0f / 255.0f;
        g0[0] = (float)(g.x & 0xffu) * s; g0[1] = (float)((g.x >> 8) & 0xffu) * s; g0[2] = (float)((g.x >> 16) & 0xffu) * s; g0[3] = (float)(g.x >> 24) * s;
        g1[0] = (float)(g.y & 0xffu) * s; g1[1] = (float)((g.y >> 8) & 0xffu) * s; g1[2] = (float)((g.y >> 16) & 0xffu) * s; g1[3] = (float)(g.y >> 24) * s; }
    static __device__ __forceinline__ f32x4 clampg(f32x4 v) { f32x4 o; o[0] = fmaxf(v[0], 1e-6f); o[1] = fmaxf(v[1], 1e-6f); o[2] = fmaxf(v[2], 1e-6f); o[3] = fmaxf(v[3], 1e-6f); return o; }
    static __device__ __forceinline__ f32x4 rcp4(f32x4 v) { f32x4 o; o[0] = __builtin_amdgcn_rcpf(v[0]); o[1] = __builtin_amdgcn_rcpf(v[1]); o[2] = __builtin_amdgcn_rcpf(v[2]); o[3] = __builtin_amdgcn_rcpf(v[3]); return o; }
    __device__ __forceinline__ void operator()(f32x4 (&acc)[2][2][4][2], const Unit& u, int wr, int wc, int fr, int fq) const {
        const int r = u.pn >> 2, pnn = u.pn & 3, pmm = u.pm - r * 72;
        const int row0 = pmm * BM + wr * 64 + fr, col0 = pnn * BM + wc * 32 + 8 * fq;
#pragma unroll
        for (int ai = 0; ai < 2; ++ai)
#pragma unroll
            for (int m = 0; m < 4; ++m) { const size_t row = (size_t)(row0 + ai * HALF + m * 16);
#pragma unroll
                for (int bj = 0; bj < 2; ++bj) { const int col = col0 + bj * HALF;
                    const unsigned char* gp = P + row * 3072 + r * 1024 + col;
                    f32x4 a0, a1; unpack8(*(const u32x2_t*)gp, a0, a1);
                    if (r < 2) { f32x4 b0, b1; unpack8(*(const u32x2_t*)(gp + 1024), b0, b1);
                        if (r == 1) { a0 = clampg(a0); a1 = clampg(a1); }
                        acc[ai][bj][m][0] = acc[ai][bj][m][0] * (a0 * rcp4(clampg(b0))); acc[ai][bj][m][1] = acc[ai][bj][m][1] * (a1 * rcp4(clampg(b1)));
                    } else { store8(Mg + row * 1024 + col, acc[ai][bj][m][0] * clampg(a0), acc[ai][bj][m][1] * clampg(a1));
                        acc[ai][bj][m][0] = (f32x4){0.f, 0.f, 0.f, 0.f}; acc[ai][bj][m][1] = (f32x4){0.f, 0.f, 0.f, 0.f}; } } }
    }
};
struct EpiBranchPart {
    static constexpr bool PERM = true, AFTER_DRAIN = false, KEEP_ACC = false;
    const unsigned char* P;
    bf16_t* O;
    __device__ __forceinline__ void operator()(const f32x4 (&acc)[2][2][4][2], const Unit& u, int wr, int wc, int fr, int fq) const {
        const int r = u.pn >> 2, pnn = u.pn & 3, pmm = u.pm - r * 72;
        const int row0 = pmm * BM + wr * 64 + fr, col0 = pnn * BM + wc * 32 + 8 * fq;
#pragma unroll
        for (int ai = 0; ai < 2; ++ai)
#pragma unroll
            for (int m = 0; m < 4; ++m) { const size_t row = (size_t)(row0 + ai * HALF + m * 16);
#pragma unroll
                for (int bj = 0; bj < 2; ++bj) { const int col = col0 + bj * HALF;
                    f32x4 a0, a1; EpiBranch::unpack8(*(const u32x2_t*)(P + row * 3072 + r * 1024 + col), a0, a1);
                    store8(O + ((size_t)r * 2048 + (row - 16384)) * 1024 + col, acc[ai][bj][m][0] * a0, acc[ai][bj][m][1] * a1); } }
    }
};
struct EpiGate {
    static constexpr bool PERM = true, AFTER_DRAIN = false, KEEP_ACC = false;
    unsigned char* O;
    static __device__ __forceinline__ unsigned q4(f32x4 g) { return (unsigned)(g[0] * 255.0f + 0.5f) | ((unsigned)(g[1] * 255.0f + 0.5f) << 8) | ((unsigned)(g[2] * 255.0f + 0.5f) << 16) | ((unsigned)(g[3] * 255.0f + 0.5f) << 24); }
    __device__ __forceinline__ void operator()(const f32x4 (&acc)[2][2][4][2], const Unit& u, int wr, int wc, int fr, int fq) const {
        const int row0 = u.pm * BM + wr * 64 + fr, col0 = u.pn * BM + wc * 32 + 8 * fq;
#pragma unroll
        for (int ai = 0; ai < 2; ++ai)
#pragma unroll
            for (int m = 0; m < 4; ++m) { unsigned char* rowp = O + (size_t)(row0 + ai * HALF + m * 16) * 3072 + col0;
#pragma unroll
                for (int bj = 0; bj < 2; ++bj) { u32x2_t w; w.x = q4(sigm4(acc[ai][bj][m][0] * 0.015625f)); w.y = q4(sigm4(acc[ai][bj][m][1] * 0.015625f)); *(u32x2_t*)(rowp + bj * HALF) = w; } }
    }
};
template <bool GATES> struct EpiInProj {
    static constexpr bool PERM = true, AFTER_DRAIN = false, KEEP_ACC = false;
    bf16_t* O; const float *rtc, *rts, *axc, *axs; float asc; int pn_off;
    __device__ __forceinline__ void operator()(const f32x4 (&acc)[2][2][4][2], const Unit& u, int wr, int wc, int fr, int fq) const {
        const int pn = u.pn + pn_off, i8 = 8 * fq;
#pragma unroll
        for (int ai = 0; ai < 2; ++ai)
#pragma unroll
            for (int m = 0; m < 4; ++m) {
                const int row = u.pm * BM + ai * HALF + wr * 64 + m * 16 + fr;
                bf16_t* rowp = O + (size_t)row * 4352;
                const f32x4 a0 = acc[ai][0][m][0] * asc, a1 = acc[ai][0][m][1] * asc, b0 = acc[ai][1][m][0] * asc, b1 = acc[ai][1][m][1] * asc;
                if (pn < 4) {
                    const int hl = wc >> 1, i = 32 * (wc & 1) + i8;
                    const int pos = row < 16384 ? 256 + (row & 2047) : ((row - 16384) & 255);
                    const f32x4 c0 = *(const f32x4*)(rtc + pos * 64 + i), c1 = *(const f32x4*)(rtc + pos * 64 + i + 4);
                    const f32x4 s0 = *(const f32x4*)(rts + pos * 64 + i), s1 = *(const f32x4*)(rts + pos * 64 + i + 4);
                    const float sc = pn < 2 ? 0.08838834764831845f : 1.0f;
                    bf16_t* dst = rowp + pn * 256 + hl * 128 + i;
                    store8(dst, (a0 * c0 - b0 * s0) * sc, (a1 * c1 - b1 * s1) * sc);
                    store8(dst + 64, (a0 * s0 + b0 * c0) * sc, (a1 * s1 + b1 * c1) * sc);
                } else if (pn == 8 || pn == 9 || (pn == 10 && wc < 2)) {
                    const bool lat = row < 16384; const int t = row & 2047;
                    f32x4 c0 = *(const f32x4*)(axc + t * 32 + i8), c1 = *(const f32x4*)(axc + t * 32 + i8 + 4);
                    f32x4 s0 = *(const f32x4*)(axs + t * 32 + i8), s1 = *(const f32x4*)(axs + t * 32 + i8 + 4);
                    if (!lat) { c0 = (f32x4){1.f, 1.f, 1.f, 1.f}; c1 = c0; s0 = (f32x4){0.f, 0.f, 0.f, 0.f}; s1 = s0; }
                    const float sc = pn < 10 ? 0.18033688011112042f : 1.0f;
                    bf16_t* dst = rowp + (pn < 10 ? pn * 256 : 2560) + wc * 64 + i8;
                    store8(dst, (a0 * c0 - b0 * s0) * sc, (a1 * c1 - b1 * s1) * sc);
                    store8(dst + 32, (a0 * s0 + b0 * c0) * sc, (a1 * s1 + b1 * c1) * sc);
                } else if (pn == 10) {
                    bf16_t* dst = rowp + 2688 + (wc - 2) * 64 + i8;
                    store8(dst, a0, a1); store8(dst + 32, b0, b1);
                } else {
                    bf16_t* dst = rowp + pn * 256 + wc * 32 + i8;
                    if (pn == 6 || pn == 7) { store8(dst, a0 * sigm4(a0), a1 * sigm4(a1)); store8(dst + 128, b0 * sigm4(b0), b1 * sigm4(b1)); }
                    else if (pn == 11 || pn == 12) { store8(dst, a0 * 0.18033688011112042f, a1 * 0.18033688011112042f); store8(dst + 128, b0 * 0.18033688011112042f, b1 * 0.18033688011112042f); }
                    else if (GATES && pn >= 17) { store8(dst, sigm4(a0), sigm4(a1)); store8(dst + 128, sigm4(b0), sigm4(b1)); }
                    else { store8(dst, a0, a1); store8(dst + 128, b0, b1); }
                }
            }
    }
};
template <class Epi, class Sched, bool ALIGN_EPI = false, bool SP2 = false, bool FP8 = false>
__device__ __forceinline__ void gemm_phase(PG8_LAS unsigned char* lds, const Gemm g, const Sched& S, const Epi& E) {
    int tid_ = threadIdx.x; asm volatile("" : "+v"(tid_));
    const int tid = tid_, wid = __builtin_amdgcn_readfirstlane(tid >> 6), lane = tid & 63, wr = wid >> 2, wc = wid & 3, fr = lane & 15, fq = lane >> 4;
    const int K = g.K, nt = K / BK;
    unsigned voffA[2], voffB[2];
#pragma unroll
    for (int i = 0; i < 2; ++i) { int R, C; stage_rc(tid * 16 + i * 8192, R, C); const int Rb = Epi::PERM ? ((R & ~31) + perm32(R & 31)) : R;
        voffA[i] = (unsigned)(R * K + C) * 2u; voffB[i] = (unsigned)(Rb * K + C) * 2u; }
    const size_t kstep = (size_t)(BK * 2);
    const size_t hstep = (size_t)HALF * K * 2;
    const size_t tstep = 2 * hstep;
    const unsigned ldsw = (unsigned)wid * 1024u;
    const int aoff = lds_byte(wr * 64 + fr, fq * 8), boff = lds_byte(wc * 32 + fr, fq * 8);
    const int cb8 = 32 * fq, rr8 = fr & 15;
    const int aoff8 = (((wr * 64 + fr) >> 4) * 2 + (cb8 >> 6)) * 1024 + ((rr8 * 64 + (cb8 & 63)) ^ ((rr8 >> 3) << 5));
    const int boff8 = (((wc * 32 + fr) >> 4) * 2 + (cb8 >> 6)) * 1024 + ((rr8 * 64 + (cb8 & 63)) ^ ((rr8 >> 3) << 5));
#define PG8_SA(b, h) (((b) * 2 + (h)) * HTB)
#define PG8_SB(b, h) ((4 + (b) * 2 + (h)) * HTB)
#define PG8_STAGE(bufoff, gbase, voff) do { _Pragma("unroll") for (int _i = 0; _i < 2; ++_i) \
        __builtin_amdgcn_global_load_lds((const unsigned*)((const char*)(gbase) + (voff)[_i]), (PG8_LAS unsigned*)(lds + (bufoff) + ldsw + _i * 8192), 16, 0, 0); } while (0)
#define PG8_LDA(dst, b, h) do { if constexpr (FP8) { _Pragma("unroll") for (int m = 0; m < 4; ++m) dst##8[m] = *(const PG8_LAS v8i32*)(lds + PG8_SA(b, h) + aoff8 + m * 2048); } else { _Pragma("unroll") for (int m = 0; m < 4; ++m) _Pragma("unroll") for (int k = 0; k < 2; ++k) dst[m][k] = *(const PG8_LAS bf16x8*)(lds + PG8_SA(b, h) + aoff + m * 2048 + k * 1024); } } while (0)
#define PG8_LDB(dst, b, h) do { if constexpr (FP8) { _Pragma("unroll") for (int n = 0; n < 2; ++n) dst##8[n] = *(const PG8_LAS v8i32*)(lds + PG8_SB(b, h) + boff8 + n * 2048); } else { _Pragma("unroll") for (int n = 0; n < 2; ++n) _Pragma("unroll") for (int k = 0; k < 2; ++k) dst[n][k] = *(const PG8_LAS bf16x8*)(lds + PG8_SB(b, h) + boff + n * 2048 + k * 1024); } } while (0)
#define PG8_MMA(ai, bj, At, Bt) do { __builtin_amdgcn_s_setprio(1); if constexpr (FP8) { _Pragma("unroll") for (int m = 0; m < 4; ++m) _Pragma("unroll") for (int n = 0; n < 2; ++n) \
        asm volatile("v_mfma_scale_f32_16x16x128_f8f6f4 %0, %1, %2, %0, %3, %3 op_sel_hi:[0,0,0]" : "+v"(acc[ai][bj][m][n]) : "v"(Bt##8[n]), "v"(At##8[m]), "v"(sc127)); } else { \
        _Pragma("unroll") for (int m = 0; m < 4; ++m) _Pragma("unroll") for (int n = 0; n < 2; ++n) _Pragma("unroll") for (int k = 0; k < 2; ++k) \
        acc[ai][bj][m][n] = __builtin_amdgcn_mfma_f32_16x16x32_bf16(Bt[n][k], At[m][k], acc[ai][bj][m][n], 0, 0, 0); } __builtin_amdgcn_s_setprio(0); } while (0)
#define PG8_WAIT_V(n) asm volatile("s_waitcnt vmcnt(" #n ")" ::: "memory")
#define PG8_WAIT_L(n) asm volatile("s_waitcnt lgkmcnt(" #n ")" ::: "memory")
#define PG8_BAR __builtin_amdgcn_s_barrier()
#define PG8_SCHED __builtin_amdgcn_sched_barrier(0)
    Unit cur, nxt; int ui = 0;
    if (!S.next(0, cur)) return;
    f32x4 acc[2][2][4][2];
#pragma unroll
    for (int a = 0; a < 2; ++a)
#pragma unroll
        for (int b = 0; b < 2; ++b)
#pragma unroll
            for (int m = 0; m < 4; ++m)
#pragma unroll
                for (int n = 0; n < 2; ++n) acc[a][b][m][n] = (f32x4){0.f, 0.f, 0.f, 0.f};
    bf16x8 At[4][2], B0[2][2], B1[2][2];
    v8i32 At8[4], B08[2], B18[2]; const int sc127 = 127;
    const char* cA = (const char*)g.A + (size_t)cur.pm * tstep; const char* cB = (const char*)g.Bt + (size_t)cur.pn * tstep;
    S.a_ready(cur);
    if constexpr (SP2) {
        PG8_STAGE(PG8_SB(0, 0), cB, voffB); PG8_STAGE(PG8_SB(0, 1), cB + hstep, voffB); PG8_STAGE(PG8_SA(0, 0), cA, voffA); PG8_STAGE(PG8_SA(0, 1), cA + hstep, voffA);
        if (wr == 1) PG8_BAR;
        PG8_WAIT_V(2); PG8_BAR;
        PG8_STAGE(PG8_SB(1, 0), cB + kstep, voffB); PG8_STAGE(PG8_SA(1, 0), cA + kstep, voffA); PG8_STAGE(PG8_SB(1, 1), cB + hstep + kstep, voffB);
        PG8_WAIT_V(6); PG8_BAR;
    } else {
        PG8_STAGE(PG8_SB(0, 0), cB, voffB); PG8_STAGE(PG8_SA(0, 0), cA, voffA); PG8_STAGE(PG8_SB(0, 1), cB + hstep, voffB); PG8_STAGE(PG8_SA(0, 1), cA + hstep, voffA);
        if (wr == 1) PG8_BAR;
        PG8_WAIT_V(4); PG8_BAR;
        PG8_STAGE(PG8_SB(1, 0), cB + kstep, voffB); PG8_STAGE(PG8_SA(1, 0), cA + kstep, voffA); PG8_STAGE(PG8_SB(1, 1), cB + hstep + kstep, voffB);
        PG8_WAIT_V(6); PG8_BAR;
    }
    for (;;) {
        const bool has_next = S.next(ui + 1, nxt);
        const char* nA = has_next ? (const char*)g.A + (size_t)nxt.pm * tstep : cA; const char* nB = has_next ? (const char*)g.Bt + (size_t)nxt.pn * tstep : cB;
        for (int t = 0; t < nt; t += 2) {
            const bool last = (t == nt - 2);
            const char* a1 = cA + (size_t)(t + 1) * kstep;
            const char* a2 = last ? nA : cA + (size_t)(t + 2) * kstep; const char* b2 = last ? nB : cB + (size_t)(t + 2) * kstep;
            const char* a3 = a2 + kstep; const char* b3 = b2 + kstep;
            if (last && has_next) S.a_ready(nxt);
            if constexpr (SP2) {
            PG8_LDB(B0, 0, 0); PG8_LDB(B1, 0, 1); PG8_SCHED; PG8_LDA(At, 0, 0); PG8_STAGE(PG8_SA(1, 1), a1 + hstep, voffA);
            PG8_WAIT_V(8); PG8_WAIT_L(0); PG8_BAR; PG8_MMA(0, 0, At, B0); PG8_MMA(0, 1, At, B1); PG8_BAR; PG8_SCHED;
            PG8_LDA(At, 0, 1); PG8_STAGE(PG8_SB(0, 0), b2, voffB); PG8_STAGE(PG8_SB(0, 1), b2 + hstep, voffB); PG8_STAGE(PG8_SA(0, 0), a2, voffA);
            PG8_WAIT_V(8); PG8_WAIT_L(0); PG8_BAR; PG8_MMA(1, 0, At, B0); PG8_MMA(1, 1, At, B1); PG8_BAR; PG8_SCHED;
            PG8_LDB(B0, 1, 0); PG8_LDB(B1, 1, 1); PG8_SCHED; PG8_LDA(At, 1, 0); PG8_STAGE(PG8_SA(0, 1), a2 + hstep, voffA);
            PG8_WAIT_V(8); PG8_WAIT_L(0); PG8_BAR; PG8_MMA(0, 0, At, B0); PG8_MMA(0, 1, At, B1); PG8_BAR; PG8_SCHED;
            PG8_LDA(At, 1, 1); PG8_STAGE(PG8_SB(1, 0), b3, voffB); PG8_STAGE(PG8_SB(1, 1), b3 + hstep, voffB); PG8_STAGE(PG8_SA(1, 0), a3, voffA);
            PG8_WAIT_V(8); PG8_WAIT_L(0); PG8_BAR; PG8_MMA(1, 0, At, B0); PG8_MMA(1, 1, At, B1); PG8_BAR; PG8_SCHED;
            } else {
            PG8_LDB(B0, 0, 0); PG8_SCHED; PG8_LDA(At, 0, 0); PG8_STAGE(PG8_SA(1, 1), a1 + hstep, voffA);
            PG8_WAIT_L(8); PG8_BAR; PG8_WAIT_L(0); PG8_MMA(0, 0, At, B0); PG8_BAR; PG8_SCHED;
            PG8_LDB(B1, 0, 1); PG8_STAGE(PG8_SB(0, 0), b2, voffB);
            PG8_BAR; PG8_WAIT_L(0); PG8_MMA(0, 1, At, B1); PG8_BAR;
            PG8_LDA(At, 0, 1); PG8_STAGE(PG8_SA(0, 0), a2, voffA);
            PG8_BAR; PG8_WAIT_L(0); PG8_MMA(1, 0, At, B0); PG8_BAR; PG8_SCHED;
            PG8_STAGE(PG8_SB(0, 1), b2 + hstep, voffB);
            PG8_WAIT_V(6); PG8_BAR; PG8_MMA(1, 1, At, B1); PG8_BAR;
            PG8_LDB(B0, 1, 0); PG8_SCHED; PG8_LDA(At, 1, 0); PG8_STAGE(PG8_SA(0, 1), a2 + hstep, voffA);
            PG8_WAIT_L(8); PG8_BAR; PG8_WAIT_L(0); PG8_MMA(0, 0, At, B0); PG8_BAR; PG8_SCHED;
            PG8_LDB(B1, 1, 1); PG8_STAGE(PG8_SB(1, 0), b3, voffB);
            PG8_BAR; PG8_WAIT_L(0); PG8_MMA(0, 1, At, B1); PG8_BAR;
            PG8_LDA(At, 1, 1); PG8_STAGE(PG8_SA(1, 0), a3, voffA);
            PG8_BAR; PG8_WAIT_L(0); PG8_MMA(1, 0, At, B0); PG8_BAR; PG8_SCHED;
            PG8_STAGE(PG8_SB(1, 1), b3 + hstep, voffB);
            PG8_WAIT_V(6); PG8_BAR; PG8_MMA(1, 1, At, B1); PG8_BAR;
            }
        }
        if constexpr (ALIGN_EPI) { if (wr == 0) PG8_BAR; }
        if constexpr (FP8) asm volatile("s_nop 15\n\ts_nop 7" ::: "memory");
        if constexpr (!Epi::AFTER_DRAIN) { E(acc, cur, wr, wc, fr, fq); S.done(cur); }
        if (!has_next) break;
        if constexpr (!Epi::KEEP_ACC) {
#pragma unroll
        for (int a = 0; a < 2; ++a)
#pragma unroll
            for (int b = 0; b < 2; ++b)
#pragma unroll
                for (int m = 0; m < 4; ++m)
#pragma unroll
                    for (int n = 0; n < 2; ++n) acc[a][b][m][n] = (f32x4){0.f, 0.f, 0.f, 0.f};
        }
        cur = nxt; cA = nA; cB = nB; ++ui;
        if constexpr (ALIGN_EPI) { if (wr == 1) PG8_BAR; }
    }
    PG8_WAIT_V(0);
    if constexpr (!ALIGN_EPI) { if (wr == 0) PG8_BAR; }
    PG8_BAR;
    if constexpr (Epi::AFTER_DRAIN) { E.fused(acc, cur, wr, wc, fr, fq, lds, wid, lane); S.done(cur); }
#undef PG8_SA
#undef PG8_SB
#undef PG8_STAGE
#undef PG8_LDA
#undef PG8_LDB
#undef PG8_MMA
#undef PG8_WAIT_V
#undef PG8_WAIT_L
#undef PG8_BAR
#undef PG8_SCHED
}
}

#define XB_TMO      128
#define XB_XCNT(j)  (256  + 64 * (j))
#define XB_XSUB(j)  (1280 + 64 * (j))
#define XB_XGEN(j)  (2304 + 64 * (j))
#define XB_TOP      3328
#define XB_TOPGEN   3392
#define XCD_BAR_WORDS 3456
#define XB_SPIN_CAP (1u << 18)

__device__ __forceinline__ unsigned xb_ld(unsigned* p)              { return __hip_atomic_load(p, __ATOMIC_RELAXED, __HIP_MEMORY_SCOPE_AGENT); }
__device__ __forceinline__ unsigned xb_add(unsigned* p, unsigned v) { return __hip_atomic_fetch_add(p, v, __ATOMIC_RELAXED, __HIP_MEMORY_SCOPE_AGENT); }
__device__ __forceinline__ unsigned xb_xcc_id() { return (unsigned)__builtin_amdgcn_s_getreg((3 << 11) | 20) & 0xFu; }
#define XB_SPIN(cond, bar) do { unsigned _sp = 0; while (cond) { __builtin_amdgcn_s_sleep(1); \
    if ((++_sp & 255u) == 0u) { if (xb_ld(&(bar)[XB_TMO])) break; if (_sp > XB_SPIN_CAP) { atomicAdd(&(bar)[XB_TMO], 1u); break; } } } } while (0)

struct XcdBarrier {
    unsigned* bar; unsigned x;
    volatile LAS unsigned* st;
};

__device__ __forceinline__ XcdBarrier xcd_barrier_post(unsigned* bar, volatile LAS unsigned* st) {
    XcdBarrier b; b.bar = bar; b.x = xb_xcc_id(); b.st = st;
    if (threadIdx.x == 0) (void)xb_add(&bar[XB_XCNT(b.x)], 1u);
    return b;
}
__device__ __forceinline__ void xcd_barrier_complete(unsigned* bar, unsigned x, unsigned& nloc, unsigned& nx) {
    const unsigned G = gridDim.x * gridDim.y * gridDim.z;
    unsigned sum, cnt, mine, sp = 0u;
    for (;;) {
        sum = 0u; cnt = 0u; mine = 0u;
#pragma unroll
        for (unsigned j = 0; j < 16; ++j) { const unsigned c = xb_ld(&bar[XB_XCNT(j)]); sum += c; cnt += (c > 0u) ? 1u : 0u; mine = (j == x) ? c : mine; }
        if (sum == G) break;
        __builtin_amdgcn_s_sleep(1);
        if ((++sp & 255u) == 0u) { if (xb_ld(&bar[XB_TMO])) break; if (sp > XB_SPIN_CAP) { atomicAdd(&bar[XB_TMO], 1u); break; } }
    }
    nloc = mine > 0u ? mine : 1u; nx = cnt > 0u ? cnt : 1u;
}

__device__ __forceinline__ void xcd_barrier(const XcdBarrier& b) {
    asm volatile("s_waitcnt vmcnt(0)" ::: "memory");
    __syncthreads();
    if (threadIdx.x == 0) {
        unsigned* bar = b.bar;
        __builtin_amdgcn_s_waitcnt(0);
        unsigned nloc = b.st[0], nx = b.st[1];
        if (nloc == 0u) { xcd_barrier_complete(bar, b.x, nloc, nx); b.st[0] = nloc; b.st[1] = nx; }
        const unsigned old = xb_add(&bar[XB_XSUB(b.x)], 1u);
        const unsigned gen = old / nloc;
        if (old + 1u == (gen + 1u) * nloc) {
            __builtin_amdgcn_fence(__ATOMIC_RELEASE, "agent");
            asm volatile("s_waitcnt vmcnt(0)" ::: "memory");
            const unsigned og = xb_add(&bar[XB_TOP], 1u);
            const unsigned tg = og / nx;
            if (og + 1u == (tg + 1u) * nx) xb_add(&bar[XB_TOPGEN], 1u);
            else XB_SPIN(xb_ld(&bar[XB_TOPGEN]) == tg, bar);
            __builtin_amdgcn_fence(__ATOMIC_ACQUIRE, "agent");
            xb_add(&bar[XB_XGEN(b.x)], 1u);
            asm volatile("s_waitcnt vmcnt(0)" ::: "memory");
        } else {
            XB_SPIN(xb_ld(&bar[XB_XGEN(b.x)]) == gen, bar);
            __builtin_amdgcn_fence(__ATOMIC_ACQUIRE, "agent");
            asm volatile("s_waitcnt vmcnt(0)" ::: "memory");
        }
    }
    __syncthreads();
}

constexpr int D = 1024, NB = 8, SEQ = 2048, LC = 256, DEPTH = 4;
constexpr int ML = NB * SEQ, MC = NB * LC, MT = ML + MC;
constexpr int DIN = 7424, FFD = 2816, FFE = 3584, NE = 8;
constexpr int PS = 4352;
constexpr int MSORT = 38912;
constexpr float EPS = 1e-6f;
constexpr int NWAVES = 8, NTHREADS = 512;
#ifndef MK_PER_PHASE
#define MK_PER_PHASE 0
#endif
constexpr int NPH = 2 + 11 * DEPTH;
#ifndef MK_EN
#define MK_EN 0xFFFFFFFFu
#endif
#ifndef MK_DUMP
#define MK_DUMP 0
#endif
#ifndef MK_F8
#define MK_F8 0x2F
#endif
constexpr bool F8IN = (MK_F8 & 16) != 0, F8GATE = (MK_F8 & 32) != 0;
constexpr bool F8UP_D = (MK_F8 & 1) != 0, F8DN_D = (MK_F8 & 2) != 0, F8UP_M = (MK_F8 & 4) != 0, F8DN_M = (MK_F8 & 8) != 0;
#ifndef MK_REP
#define MK_REP 0u
#endif
#ifndef MK_NPH_RUN
#define MK_NPH_RUN NPH
#endif

constexpr size_t MiB = (size_t)1 << 20;
constexpr size_t WS_CTL = 0, CTL_ZERO_BYTES = MiB;
constexpr size_t WS_MOD = 1 * MiB;
constexpr size_t WS_TAB = 2 * MiB;
constexpr size_t WS_ROUTE = 4 * MiB;
constexpr size_t WS_HC = 5 * MiB;
constexpr size_t WS_XN = 13 * MiB;
constexpr size_t WS_YOUT = 49 * MiB;
constexpr size_t WS_WIN = 85 * MiB, WS_WBR = 143 * MiB, WS_WOUT = 155 * MiB, WS_WF13 = 163 * MiB, WS_WF2 = 185 * MiB, WS_WM13 = 196 * MiB, WS_WM2 = 420 * MiB;
constexpr size_t WS_OVL = 532 * MiB;
constexpr size_t WS_PROJ = WS_OVL, WS_YBR = WS_OVL + 261 * MiB, WS_KV = WS_OVL + 315 * MiB, WS_ST = WS_OVL + 387 * MiB;
constexpr size_t WS_TMP = WS_KV, WS_MERGED = WS_ST;
constexpr size_t WS_PART = WS_OVL;
constexpr size_t WS_G8 = WS_OVL + 153 * MiB;
constexpr size_t WS_ASORT = WS_OVL, WS_HID = WS_OVL + 76 * MiB, WS_OSORT = WS_OVL + 342 * MiB;
constexpr size_t WS_HB = WS_OVL + 423 * MiB;
constexpr size_t WS_WIN8 = WS_HB + 36 * MiB;
constexpr size_t WS_XN8 = WS_WIN8 + 12 * MiB;
constexpr size_t WS_END = WS_XN8 + 18 * MiB;
static_assert(WS_OSORT + (size_t)MSORT * D * 2 <= WS_END && WS_ST + 36 * MiB <= WS_END, "map");
constexpr int TAB_RTC = 0, TAB_RTS = 2304 * 64, TAB_AXC = 2 * 2304 * 64, TAB_AXS = 2 * 2304 * 64 + 2048 * 32;
constexpr int CW_BAR = 4096, CW_MOE = 8192, CW_WQ = 12288, CW_RFLAG = 24576, CW_PFLAG = 32768;

constexpr int LDS_BYTES = 147456, MISC_OFF = 131072 + 320;

#define GAS __attribute__((address_space(1)))
#define DEV __device__ __forceinline__
typedef unsigned short bf16;
typedef float f32x4 __attribute__((ext_vector_type(4)));
typedef short bf16x8 __attribute__((ext_vector_type(8)));
typedef short s16x4 __attribute__((ext_vector_type(4)));
typedef unsigned u32x4 __attribute__((ext_vector_type(4)));
typedef unsigned u32x2 __attribute__((ext_vector_type(2)));
#define MFMA16(a, b, c) __builtin_amdgcn_mfma_f32_16x16x32_bf16((a), (b), (c), 0, 0, 0)
DEV float bf2f(unsigned short b) { return __uint_as_float(((unsigned)b) << 16); }
DEV float bflo(unsigned u) { return __uint_as_float(u << 16); }
DEV float bfhi(unsigned u) { return __uint_as_float(u & 0xffff0000u); }
DEV unsigned pk2(float lo, float hi) { return pg8::cvt_pk_bf16(lo, hi); }
DEV unsigned short f2bf(float f) { return (unsigned short)(pg8::cvt_pk_bf16(f, 0.f) & 0xffffu); }
template <int CTRL> DEV float dpp_add(float v) { return v + __int_as_float(__builtin_amdgcn_update_dpp(0, __float_as_int(v), CTRL, 0xf, 0xf, true)); }
DEV float wave_sum(float v) {
    v = dpp_add<0xB1>(v); v = dpp_add<0x4E>(v); v = dpp_add<0x141>(v); v = dpp_add<0x140>(v);
    const int iv = __float_as_int(v);
    return (__int_as_float(__builtin_amdgcn_readlane(iv, 0)) + __int_as_float(__builtin_amdgcn_readlane(iv, 16))) + (__int_as_float(__builtin_amdgcn_readlane(iv, 32)) + __int_as_float(__builtin_amdgcn_readlane(iv, 48)));
}
DEV bf16x8 pack8(const f32x4 a, const f32x4 b) { u32x4 w; w.x = pk2(a[0], a[1]); w.y = pk2(a[2], a[3]); w.z = pk2(b[0], b[1]); w.w = pk2(b[2], b[3]); return __builtin_bit_cast(bf16x8, w); }

struct Args { const float* in[20]; float* out; unsigned char* ws; int ph_lo, ph_hi, li, pad; };
enum { I_X = 0, I_C, I_CTX, I_CCTX, I_WMOD, I_BMOD, I_GAINS, I_WIN, I_DECAY, I_SINK, I_RPB, I_WBR, I_WOUT, I_F1, I_F3, I_F2, I_ROUTER, I_M1, I_M3, I_M2 };

DEV void p0_transpose_item(const float* W, int K, int N, bf16* WT, LAS float* scr, int kb, int n0, int drow0, int lane) {
    const int k0 = 64 * kb;
#pragma unroll 8
    for (int i = 0; i < 32; ++i) { const int kk = 2 * i + (lane >> 5); scr[kk * 33 + (lane & 31)] = __builtin_nontemporal_load(W + (size_t)(k0 + kk) * N + n0 + (lane & 31)); }
    asm volatile("s_waitcnt lgkmcnt(0)" ::: "memory");
    const int c = lane & 7;
#pragma unroll
    for (int j = 0; j < 4; ++j) { const int n = (lane >> 3) + 8 * j; const LAS float* s = scr + (8 * c) * 33 + n;
        u32x4 o; o.x = pk2(s[0 * 33], s[1 * 33]); o.y = pk2(s[2 * 33], s[3 * 33]); o.z = pk2(s[4 * 33], s[5 * 33]); o.w = pk2(s[6 * 33], s[7 * 33]);
        *(u32x4*)(WT + (size_t)(drow0 + n) * K + k0 + 8 * c) = o; }
    asm volatile("s_waitcnt lgkmcnt(0)" ::: "memory");
}

DEV float clampf8(float v) { return __builtin_amdgcn_fmed3f(v, -448.0f, 448.0f); }
DEV unsigned pk4f8(float a, float b, float c, float d) { a = clampf8(a); b = clampf8(b); c = clampf8(c); d = clampf8(d); unsigned w = 0; w = __builtin_amdgcn_cvt_pk_fp8_f32(a, b, w, false); w = __builtin_amdgcn_cvt_pk_fp8_f32(c, d, w, true); return w; }
DEV void p0_transpose_item_f8(const float* W, int K, int N, unsigned char* WT, LAS float* scr, int kb, int n0, int drow0, float scale, int lane) {
    const int k0 = 64 * kb;
#pragma unroll 8
    for (int i = 0; i < 32; ++i) { const int kk = 2 * i + (lane >> 5); scr[kk * 33 + (lane & 31)] = __builtin_nontemporal_load(W + (size_t)(k0 + kk) * N + n0 + (lane & 31)) * scale; }
    asm volatile("s_waitcnt lgkmcnt(0)" ::: "memory");
    const int c = lane & 3;
#pragma unroll
    for (int j = 0; j < 2; ++j) { const int n = (lane >> 2) + 16 * j; const LAS float* s = scr + (16 * c) * 33 + n;
        u32x4 o; o.x = pk4f8(s[0 * 33], s[1 * 33], s[2 * 33], s[3 * 33]); o.y = pk4f8(s[4 * 33], s[5 * 33], s[6 * 33], s[7 * 33]);
        o.z = pk4f8(s[8 * 33], s[9 * 33], s[10 * 33], s[11 * 33]); o.w = pk4f8(s[12 * 33], s[13 * 33], s[14 * 33], s[15 * 33]);
        *(u32x4*)(WT + (size_t)(drow0 + n) * K + k0 + 16 * c) = o; }
    asm volatile("s_waitcnt lgkmcnt(0)" ::: "memory");
}
DEV int inproj_dest_row(int n0) {
    const int pn = n0 >> 8, wi = n0 & 255;
    if (pn < 4) { const int hl = wi >> 7, rem = wi & 127, half = rem >> 6, i = rem & 63; return pn * 256 + half * 128 + hl * 64 + i; }
    if (pn == 8 || pn == 9) { const int hl = wi >> 6, rem = wi & 63, half = rem >> 5, i = rem & 31; return pn * 256 + half * 128 + hl * 32 + i; }
    if (pn == 10) { const int isv = wi >> 7, w2 = wi & 127, hl = w2 >> 6, half = (w2 & 63) >> 5, i = w2 & 31; return 2560 + half * 128 + (2 * isv + hl) * 32 + i; }
    return n0;
}
DEV void p0_prologue(const Args& A, LAS unsigned char* lds, int vcu, int G, int tid) {
    const int wave = __builtin_amdgcn_readfirstlane(tid >> 6), lane = tid & 63;
    unsigned char* ws = A.ws;
    {
        LAS float* sc = (LAS float*)lds;
        LAS float* red = (LAS float*)(lds + 9 * 1024 * 4);
        for (int i = tid; i < 9 * 1024; i += NTHREADS) { const int r = i >> 10, k = i & 1023; const float v = r < 8 ? A.in[I_C][r * 1024 + k] : A.in[I_CCTX][k]; sc[i] = v / (1.0f + __expf(-v)); }
        __syncthreads();
        float* MOD = (float*)(ws + WS_MOD);
        for (int it = vcu; it < 4 * 96; it += G) {
            const int l = it / 96, cg = it % 96, col = cg * 64 + lane;
            const float* W = A.in[I_WMOD] + (size_t)l * 1024 * 6144 + col;
            float acc[9];
#pragma unroll
            for (int r = 0; r < 9; ++r) acc[r] = 0.f;
#pragma unroll 4
            for (int kk = 0; kk < 128; ++kk) { const int k = wave * 128 + kk; const float w = W[(size_t)k * 6144];
#pragma unroll
                for (int r = 0; r < 9; ++r) acc[r] += sc[r * 1024 + k] * w; }
#pragma unroll
            for (int r = 0; r < 9; ++r) red[(wave * 9 + r) * 64 + lane] = acc[r];
            __syncthreads();
            for (int o = tid; o < 9 * 64; o += NTHREADS) { const int r = o >> 6, ln = o & 63; float s = 0.f;
#pragma unroll
                for (int w = 0; w < 8; ++w) s += red[(w * 9 + r) * 64 + ln];
                MOD[((size_t)l * 9 + r) * 6144 + cg * 64 + ln] = s + A.in[I_BMOD][l * 6144 + cg * 64 + ln]; }
            __syncthreads();
        }
    }
    {
        float* TAB = (float*)(ws + WS_TAB);
        const int gt = vcu * NTHREADS + tid, NGT = G * NTHREADS;
        for (int i = gt; i < 2304 * 64; i += NGT) { const int pos = i >> 6, f = i & 63; const float inv = exp2f(-(float)f * (13.287712379549449f / 64.0f)); const float ang = (float)pos * inv; float s, c; sincosf(ang, &s, &c); TAB[TAB_RTC + i] = c; TAB[TAB_RTS + i] = s; }
        for (int i = gt; i < 2048 * 32; i += NGT) { const int t = i >> 5, f = i & 31; const float inv = exp2f(-(float)(f & 15) * (13.287712379549449f / 16.0f)); const float p = (f < 16) ? (float)(t >> 6) : (float)(t & 63); const float ang = p * inv; float s, c; sincosf(ang, &s, &c); TAB[TAB_AXC + i] = c; TAB[TAB_AXS + i] = s; }
    }
    __syncthreads();
    {
        LAS float* scr = (LAS float*)(lds + wave * 16384);
        const int gw = vcu * NWAVES + wave, NGW = G * NWAVES;
        constexpr int C_IN = 16 * 232, C_BR = 8 * 32, C_OUT = 16 * 32, C_F13 = 16 * 88, C_F2 = 44 * 32, C_M13 = 16 * 112, C_M2 = 56 * 32;
        constexpr int N_IN = 4 * C_IN, N_BR = 12 * C_BR, N_OUT = 4 * C_OUT, N_F13 = 4 * C_F13, N_F2 = 2 * C_F2, N_M13 = 32 * C_M13, N_M2 = 16 * C_M2;
        constexpr int NITEMS = N_IN + N_BR + N_OUT + N_F13 + N_F2 + N_M13 + N_M2;
        for (int it = gw; it < NITEMS; it += NGW) {
            int r = it;
            if (r < N_IN) { const int l = r / C_IN, q = r % C_IN, kb = q / 232, nb = q % 232;
                if constexpr (F8IN) p0_transpose_item_f8(A.in[I_WIN] + (size_t)l * 1024 * DIN, 1024, DIN, ws + WS_WIN + (size_t)l * DIN * 1024, scr, kb, 32 * nb, inproj_dest_row(32 * nb), 64.0f, lane);
                else if (F8GATE && 32 * nb >= 4352) p0_transpose_item_f8(A.in[I_WIN] + (size_t)l * 1024 * DIN, 1024, DIN, ws + WS_WIN8 + (size_t)l * 3072 * 1024, scr, kb, 32 * nb, 32 * nb - 4352, 64.0f, lane);
                else p0_transpose_item(A.in[I_WIN] + (size_t)l * 1024 * DIN, 1024, DIN, (bf16*)(ws + WS_WIN) + (size_t)l * DIN * 1024, scr, kb, 32 * nb, inproj_dest_row(32 * nb), lane);
                continue; } r -= N_IN;
            if (r < N_BR) { const int mtx = r / C_BR, q = r % C_BR, kb = q / 32, nb = q % 32;
                p0_transpose_item(A.in[I_WBR] + (size_t)mtx * 512 * 1024, 512, 1024, (bf16*)(ws + WS_WBR) + (size_t)mtx * 1024 * 512, scr, kb, 32 * nb, 32 * nb, lane); continue; } r -= N_BR;
            if (r < N_OUT) { const int l = r / C_OUT, q = r % C_OUT, kb = q / 32, nb = q % 32;
                p0_transpose_item(A.in[I_WOUT] + (size_t)l * 1024 * 1024, 1024, 1024, (bf16*)(ws + WS_WOUT) + (size_t)l * 1024 * 1024, scr, kb, 32 * nb, 32 * nb, lane); continue; } r -= N_OUT;
            if (r < N_F13) { const int mtx = r / C_F13, q = r % C_F13, kb = q / 88, nb = q % 88, i = mtx >> 1, which = mtx & 1, n0 = 32 * nb;
                if constexpr (F8UP_D) p0_transpose_item_f8(A.in[which ? I_F3 : I_F1] + (size_t)i * 1024 * FFD, 1024, FFD, ws + WS_WF13 + (size_t)i * 2 * FFD * 1024, scr, kb, n0, (n0 >> 7) * 256 + which * 128 + (n0 & 127), 64.0f, lane);
                else p0_transpose_item(A.in[which ? I_F3 : I_F1] + (size_t)i * 1024 * FFD, 1024, FFD, (bf16*)(ws + WS_WF13) + (size_t)i * 2 * FFD * 1024, scr, kb, n0, (n0 >> 7) * 256 + which * 128 + (n0 & 127), lane);
                continue; } r -= N_F13;
            if (r < N_F2) { const int i = r / C_F2, q = r % C_F2, kb = q / 32, nb = q % 32;
                if constexpr (F8DN_D) p0_transpose_item_f8(A.in[I_F2] + (size_t)i * FFD * 1024, FFD, 1024, ws + WS_WF2 + (size_t)i * 1024 * FFD, scr, kb, 32 * nb, 32 * nb, 128.0f, lane);
                else p0_transpose_item(A.in[I_F2] + (size_t)i * FFD * 1024, FFD, 1024, (bf16*)(ws + WS_WF2) + (size_t)i * 1024 * FFD, scr, kb, 32 * nb, 32 * nb, lane);
                continue; } r -= N_F2;
            if (r < N_M13) { const int mtx = r / C_M13, q = r % C_M13, kb = q / 112, nb = q % 112, ie = mtx >> 1, which = mtx & 1, n0 = 32 * nb;
                if constexpr (F8UP_M) p0_transpose_item_f8(A.in[which ? I_M3 : I_M1] + (size_t)ie * 1024 * FFE, 1024, FFE, ws + WS_WM13 + (size_t)ie * 2 * FFE * 1024, scr, kb, n0, (n0 >> 7) * 256 + which * 128 + (n0 & 127), 64.0f, lane);
                else p0_transpose_item(A.in[which ? I_M3 : I_M1] + (size_t)ie * 1024 * FFE, 1024, FFE, (bf16*)(ws + WS_WM13) + (size_t)ie * 2 * FFE * 1024, scr, kb, n0, (n0 >> 7) * 256 + which * 128 + (n0 & 127), lane);
                continue; } r -= N_M13;
            { const int ie = r / C_M2, q = r % C_M2, kb = q / 32, nb = q % 32;
                if constexpr (F8DN_M) p0_transpose_item_f8(A.in[I_M2] + (size_t)ie * FFE * 1024, FFE, 1024, ws + WS_WM2 + (size_t)ie * 1024 * FFE, scr, kb, 32 * nb, 32 * nb, 128.0f, lane);
                else p0_transpose_item(A.in[I_M2] + (size_t)ie * FFE * 1024, FFE, 1024, (bf16*)(ws + WS_WM2) + (size_t)ie * 1024 * FFE, scr, kb, 32 * nb, 32 * nb, lane); }
        }
    }
}

DEV void ld_row_f32(const float* p, int lane, f32x4 (&v)[4]) {
#pragma unroll
    for (int j = 0; j < 4; ++j) v[j] = *(const f32x4*)(p + 4 * lane + 256 * j);
}
DEV void ld_row_bf16(const bf16* p, int lane, f32x4 (&v)[4]) {
#pragma unroll
    for (int j = 0; j < 4; ++j) { const u32x2 u = *(const u32x2*)(p + 4 * lane + 256 * j); v[j][0] = bflo(u.x); v[j][1] = bfhi(u.x); v[j][2] = bflo(u.y); v[j][3] = bfhi(u.y); }
}
DEV void st_row_bf16(bf16* p, int lane, const f32x4 (&v)[4]) {
#pragma unroll
    for (int j = 0; j < 4; ++j) { u32x2 u; u.x = pk2(v[j][0], v[j][1]); u.y = pk2(v[j][2], v[j][3]); *(u32x2*)(p + 4 * lane + 256 * j) = u; }
}
DEV float row_rstd(const f32x4 (&v)[4]) {
    float s = 0.f;
#pragma unroll
    for (int j = 0; j < 4; ++j) s += (v[j][0] * v[j][0] + v[j][1] * v[j][1]) + (v[j][2] * v[j][2] + v[j][3] * v[j][3]);
    return rsqrtf(wave_sum(s) * (1.0f / 1024.0f) + EPS);
}
DEV void moe_bases(const unsigned* cnt, int (&base)[8]) {
    int acc = 0;
#pragma unroll
    for (int e = 0; e < 8; ++e) { base[e] = acc; const unsigned ce = __hip_atomic_load(cnt + 64 * e, __ATOMIC_RELAXED, __HIP_MEMORY_SCOPE_AGENT); acc += (int)(((ce + 255u) >> 8) << 8); }
}
DEV int sel8(const int (&b)[8], int e) { int r = 0;
#pragma unroll
    for (int k = 0; k < 8; ++k) r = (e == k) ? b[k] : r;
    return r; }

DEV void raw_row_bf16(const bf16* p, int lane, u32x2 (&v)[4]) {
#pragma unroll
    for (int j = 0; j < 4; ++j) v[j] = *(const u32x2*)(p + 4 * lane + 256 * j);
}
DEV void cvt_row_bf16(const u32x2 (&u)[4], f32x4 (&v)[4]) {
#pragma unroll
    for (int j = 0; j < 4; ++j) { v[j][0] = bflo(u[j].x); v[j][1] = bfhi(u[j].x); v[j][2] = bflo(u[j].y); v[j][3] = bfhi(u[j].y); }
}
constexpr int TR = 2;
template <int MODE> DEV void thin_phase(const Args& A, int L, int wid, int nw, int row_lo, int row_hi, int tid, LAS unsigned char* lds) {
    const int wave = __builtin_amdgcn_readfirstlane(tid >> 6), lane = tid & 63;
    const int gw = wid * NWAVES + wave, NGW = nw * NWAVES;
    unsigned char* ws = A.ws;
    const float* MOD = (const float*)(ws + WS_MOD);
    const float* GN = A.in[I_GAINS];
    unsigned char* HC = ws + WS_HB;
    bf16* XN = (bf16*)(ws + WS_XN);
    const bf16* YOUT = (const bf16*)(ws + WS_YOUT);
    int* ROUTE = (int*)(ws + WS_ROUTE);
    const int mi = L >> 1;
    unsigned* cnt = (unsigned*)(ws + WS_CTL) + CW_MOE + mi * 8 * 64;
    int base[8];
    const bool moe2 = (MODE == 2) && (L & 1);
    if (moe2) moe_bases(cnt, base);
    const bool first = (L == 0 && MODE <= 1);
    const bool rout = (MODE == 1) && (L & 1);
    const LAS f32x4* WL = (const LAS f32x4*)lds;
    if (rout) {
        const f32x4* WR4 = (const f32x4*)(A.in[I_ROUTER] + (size_t)mi * 1024 * 8);
        for (int s4 = tid; s4 < 2048; s4 += NTHREADS) { const int k = s4 >> 1, hf_ = s4 & 1; ((LAS f32x4*)lds)[(((k >> 8) * 4 + (k & 3)) * 2 + hf_) * 64 + ((k & 255) >> 2)] = WR4[s4]; }
        __syncthreads();
    }
    const float* gn = GN + L * 4096;
    const bf16* OS = (const bf16*)(ws + WS_OSORT);
    const int nrows_ = row_hi - row_lo, r_beg = row_lo + (int)(((long)gw * nrows_) / NGW), r_end = row_lo + (int)(((long)(gw + 1) * nrows_) / NGW);
    const int Ln = (MODE == 2) ? L + 1 : L;
    f32x4 vgy[4], vgx[4], vgate[4], vsh[4], vsc[4]; int mr_cur = -1;
    if (r_beg < r_end) {
        const float* gy = gn + (MODE == 1 ? 1 : 3) * 1024; const float* gx = GN + Ln * 4096 + (MODE == 1 ? 2 : 0) * 1024;
#pragma unroll
        for (int j = 0; j < 4; ++j) { if (MODE != 0) vgy[j] = *(const f32x4*)(gy + 4 * lane + 256 * j); vgx[j] = *(const f32x4*)(gx + 4 * lane + 256 * j); }
    }
    const bool pre = moe2 && (r_end - r_beg <= 64);
    int4 prq = {0, 0, 0, 0}; int2 prw = {0, 0};
    if (pre && r_beg < r_end) { const int* rt = ROUTE + (size_t)((r_beg + lane < r_end) ? r_beg + lane : r_beg) * 8; prq = *(const int4*)rt; prw = *(const int2*)(rt + 4); }
    for (int m0 = r_beg; m0 < r_end; m0 += TR) {
        int mm[TR]; bool on[TR];
#pragma unroll
        for (int r = 0; r < TR; ++r) { const int m = m0 + r; on[r] = m < r_end; mm[r] = on[r] ? m : m0; }
        int4 rq[TR]; int2 rw[TR];
        if (moe2) {
#pragma unroll
            for (int r = 0; r < TR; ++r) {
                if (pre) { const int k = mm[r] - r_beg;
                    rq[r].x = __builtin_amdgcn_readlane(prq.x, k); rq[r].y = __builtin_amdgcn_readlane(prq.y, k); rq[r].z = __builtin_amdgcn_readlane(prq.z, k); rq[r].w = __builtin_amdgcn_readlane(prq.w, k);
                    rw[r].x = __builtin_amdgcn_readlane(prw.x, k); rw[r].y = __builtin_amdgcn_readlane(prw.y, k); }
                else { const int* rt = ROUTE + (size_t)mm[r] * 8; rq[r] = *(const int4*)rt; rw[r] = *(const int2*)(rt + 4); } }
        }
        f32x4 hf[TR][4]; u32x2 hr[TR][4], ya[TR][4], yb[TR][4];
#pragma unroll
        for (int r = 0; r < TR; ++r) { const int m = mm[r];
            if (first) ld_row_f32(m >= ML ? A.in[I_CTX] + (size_t)(m - ML) * D : A.in[I_X] + (size_t)m * D, lane, hf[r]);
            else raw_row_bf16((const bf16*)HC + (size_t)m * D, lane, hr[r]);
            if (MODE != 0) {
                if (moe2) { raw_row_bf16(OS + (size_t)(sel8(base, rq[r].x) + rq[r].z) * D, lane, ya[r]); raw_row_bf16(OS + (size_t)(sel8(base, rq[r].y) + rq[r].w) * D, lane, yb[r]); }
                else raw_row_bf16(YOUT + (size_t)m * D, lane, ya[r]);
            } }
#pragma unroll
        for (int r = 0; r < TR; ++r) if (on[r]) { const int m = mm[r];
        const bool isc = m >= ML;
        const int mr = isc ? 8 : (m >> 11);
        if (mr != mr_cur) { mr_cur = mr;
            const float* md = MOD + ((size_t)L * 9 + mr) * 6144; const float* mdn = MOD + ((size_t)Ln * 9 + mr) * 6144;
            const float* gate = md + (MODE == 1 ? 2 : 5) * 1024; const float* sh = mdn + (MODE == 1 ? 3 : 0) * 1024; const float* sc = mdn + (MODE == 1 ? 4 : 1) * 1024;
#pragma unroll
            for (int j = 0; j < 4; ++j) { if (MODE != 0) vgate[j] = *(const f32x4*)(gate + 4 * lane + 256 * j); vsh[j] = *(const f32x4*)(sh + 4 * lane + 256 * j); vsc[j] = *(const f32x4*)(sc + 4 * lane + 256 * j); }
        }
        bf16* hb = (bf16*)HC + (size_t)m * D;
        f32x4 h[4];
        if (first) {
#pragma unroll
            for (int j = 0; j < 4; ++j) h[j] = hf[r][j];
        } else cvt_row_bf16(hr[r], h);
        if (MODE != 0) {
            f32x4 y[4];
            if (moe2) {
                const float w0 = __int_as_float(rw[r].x), w1 = __int_as_float(rw[r].y);
                f32x4 y0[4], y1[4]; cvt_row_bf16(ya[r], y0); cvt_row_bf16(yb[r], y1);
#pragma unroll
                for (int j = 0; j < 4; ++j) y[j] = y0[j] * w0 + y1[j] * w1;
            } else cvt_row_bf16(ya[r], y);
            const float rs = row_rstd(y);
#pragma unroll
            for (int j = 0; j < 4; ++j) h[j] = h[j] + vgate[j] * (y[j] * rs * vgy[j]);
            if (MODE == 2 && L == 3) {
#pragma unroll
                for (int j = 0; j < 4; ++j) *(f32x4*)(A.out + (size_t)m * D + 4 * lane + 256 * j) = h[j];
            } else st_row_bf16(hb, lane, h);
        }
        if (MODE == 2 && L == 3) continue;
        const float rs = row_rstd(h);
        f32x4 a[4];
#pragma unroll
        for (int j = 0; j < 4; ++j) a[j] = (h[j] * rs * vgx[j]) * (vsc[j] + 1.0f) + vsh[j];
        if ((MODE == 1 && ((L & 1) ? F8UP_M : F8UP_D)) || (MODE != 1 && F8IN)) {
#pragma unroll
            for (int j = 0; j < 4; ++j) *(unsigned*)((unsigned char*)XN + (size_t)m * D + 4 * lane + 256 * j) = pk4f8(a[j][0], a[j][1], a[j][2], a[j][3]);
        } else { st_row_bf16(XN + (size_t)m * D, lane, a);
            if (MODE != 1 && F8GATE) {
#pragma unroll
                for (int j = 0; j < 4; ++j) *(unsigned*)(ws + WS_XN8 + (size_t)m * D + 4 * lane + 256 * j) = pk4f8(a[j][0], a[j][1], a[j][2], a[j][3]); } }
        if (MODE == 1 && (L & 1)) {
            float lg[8];
#pragma unroll
            for (int e = 0; e < 8; ++e) lg[e] = 0.f;
#pragma unroll
            for (int j = 0; j < 4; ++j)
#pragma unroll
                for (int i = 0; i < 4; ++i) { if ((i & 1) == 0) __builtin_amdgcn_sched_barrier(0); const f32x4 w0 = WL[((j * 4 + i) * 2 + 0) * 64 + lane], w1 = WL[((j * 4 + i) * 2 + 1) * 64 + lane]; const float x = a[j][i];
                    lg[0] += x * w0[0]; lg[1] += x * w0[1]; lg[2] += x * w0[2]; lg[3] += x * w0[3]; lg[4] += x * w1[0]; lg[5] += x * w1[1]; lg[6] += x * w1[2]; lg[7] += x * w1[3]; }
#pragma unroll
            for (int e = 0; e < 8; ++e) lg[e] = wave_sum(lg[e]);
            int e0 = 0; float v0 = lg[0];
#pragma unroll
            for (int e = 1; e < 8; ++e) if (lg[e] > v0) { v0 = lg[e]; e0 = e; }
            int e1 = -1; float v1 = -INFINITY;
#pragma unroll
            for (int e = 0; e < 8; ++e) if (e != e0 && lg[e] > v1) { v1 = lg[e]; e1 = e; }
            const float ex = __expf(v1 - v0), w0 = 1.0f / (1.0f + ex), w1 = ex * w0;
            if (lane == 0) {
                const int r0 = (int)__hip_atomic_fetch_add(cnt + 64 * e0, 1u, __ATOMIC_RELAXED, __HIP_MEMORY_SCOPE_AGENT);
                const int r1 = (int)__hip_atomic_fetch_add(cnt + 64 * e1, 1u, __ATOMIC_RELAXED, __HIP_MEMORY_SCOPE_AGENT);
                int* rt = ROUTE + (size_t)m * 8; rt[0] = e0; rt[1] = e1; rt[2] = r0; rt[3] = r1; rt[4] = __float_as_int(w0); rt[5] = __float_as_int(w1);
            }
        }
        }
    }
    if (rout) __syncthreads();
}
DEV void gather_phase(const Args& A, int L, int vcu, int G, int tid) {
    const int wave = __builtin_amdgcn_readfirstlane(tid >> 6), lane = tid & 63;
    const int gw = vcu * NWAVES + wave, NGW = G * NWAVES;
    unsigned char* ws = A.ws;
    const int nrows = (L == 3) ? ML : MT, mi = L >> 1;
    const unsigned* cnt = (const unsigned*)(ws + WS_CTL) + CW_MOE + mi * 8 * 64;
    int base[8]; moe_bases(cnt, base);
    const bf16* XN = (const bf16*)(ws + WS_XN); bf16* AS = (bf16*)(ws + WS_ASORT); const int* ROUTE = (const int*)(ws + WS_ROUTE);
    constexpr int RB = F8UP_M ? D : 2 * D;
    const int t_beg = (int)(((long)gw * nrows) / NGW), t_end = (int)(((long)(gw + 1) * nrows) / NGW);
    for (int c0 = t_beg; c0 < t_end; c0 += 64) {
        const int c1 = (c0 + 64 < t_end) ? c0 + 64 : t_end;
        int d0, d1; { const int4 rq = *(const int4*)(ROUTE + (size_t)((c0 + lane < c1) ? c0 + lane : c0) * 8); d0 = sel8(base, rq.x) + rq.z; d1 = sel8(base, rq.y) + rq.w; }
        for (int k0 = c0; k0 < c1; k0 += 4) {
            u32x4 v[4], w[4];
#pragma unroll
            for (int q = 0; q < 4; ++q) { const int m = k0 + q; if (m < c1) { const u32x4* src = (const u32x4*)((const unsigned char*)XN + (size_t)m * RB); v[q] = src[lane]; if constexpr (!F8UP_M) w[q] = src[lane + 64]; } }
#pragma unroll
            for (int q = 0; q < 4; ++q) { const int m = k0 + q; if (m < c1) {
                const int e0 = __builtin_amdgcn_readlane(d0, m - c0), e1 = __builtin_amdgcn_readlane(d1, m - c0);
                u32x4* p0 = (u32x4*)((unsigned char*)AS + (size_t)e0 * RB); u32x4* p1 = (u32x4*)((unsigned char*)AS + (size_t)e1 * RB);
                p0[lane] = v[q]; p1[lane] = v[q]; if constexpr (!F8UP_M) { p0[lane + 64] = w[q]; p1[lane + 64] = w[q]; } } }
        }
    }
}

#ifndef MK_VTR
#define MK_VTR 1
#endif
constexpr float LOG2E = 1.4426950408889634f;
constexpr int KS_STRIDE = 144;
constexpr int VS_STRIDE = MK_VTR ? 160 : 144;
constexpr int AT_VT = 9216, AT_BUF = AT_VT + 64 * VS_STRIDE, AT_RPB = 2 * AT_BUF, AT_Q = AT_RPB + 8192;
static_assert(AT_Q + 65536 <= 131072, "attention LDS");
typedef short v4i16_t __attribute__((ext_vector_type(4)));
#define AT_SCHED() __builtin_amdgcn_sched_barrier(0)
DEV float xrow16_max(float x) {
    auto s = __builtin_amdgcn_permlane16_swap(__float_as_uint(x), __float_as_uint(x), false, false);
    x = fmaxf(__uint_as_float(s[0]), __uint_as_float(s[1]));
    auto t = __builtin_amdgcn_permlane32_swap(__float_as_uint(x), __float_as_uint(x), false, false);
    return fmaxf(__uint_as_float(t[0]), __uint_as_float(t[1]));
}
DEV float xrow16_sum(float x) {
    auto s = __builtin_amdgcn_permlane16_swap(__float_as_uint(x), __float_as_uint(x), false, false);
    x = __uint_as_float(s[0]) + __uint_as_float(s[1]);
    auto t = __builtin_amdgcn_permlane32_swap(__float_as_uint(x), __float_as_uint(x), false, false);
    return __uint_as_float(t[0]) + __uint_as_float(t[1]);
}
struct KVRegs { u32x4 k, v; };
DEV void kv_load(KVRegs& r, const bf16* kp, const bf16* vp, int tid) {
    const int row = tid >> 3, c = tid & 7;
    r.k = *(const u32x4*)(kp + (size_t)row * PS + 8 * c); r.v = *(const u32x4*)(vp + (size_t)row * PS + 8 * c);
}
DEV void kv_write(LAS unsigned char* buf, const KVRegs& r, int tid) {
    const int row = tid >> 3, c = tid & 7;
    *(LAS u32x4*)(buf + row * KS_STRIDE + c * 16) = r.k;
#if MK_VTR
    *(LAS u32x4*)(buf + AT_VT + row * VS_STRIDE + c * 16) = r.v;
#else
    LAS unsigned short* p = (LAS unsigned short*)(buf + AT_VT) + (8 * c) * (VS_STRIDE / 2) + row;
    p[0 * (VS_STRIDE / 2)] = (unsigned short)(r.v.x & 0xffffu); p[1 * (VS_STRIDE / 2)] = (unsigned short)(r.v.x >> 16);
    p[2 * (VS_STRIDE / 2)] = (unsigned short)(r.v.y & 0xffffu); p[3 * (VS_STRIDE / 2)] = (unsigned short)(r.v.y >> 16);
    p[4 * (VS_STRIDE / 2)] = (unsigned short)(r.v.z & 0xffffu); p[5 * (VS_STRIDE / 2)] = (unsigned short)(r.v.z >> 16);
    p[6 * (VS_STRIDE / 2)] = (unsigned short)(r.v.w & 0xffffu); p[7 * (VS_STRIDE / 2)] = (unsigned short)(r.v.w >> 16);
#endif
}
DEV bf16x8 v_frag(const LAS unsigned char* buf, int u, int dt, int c16, int q4) {
#if MK_VTR
    const LAS unsigned char* vr = buf + AT_VT + (32 * u + 4 * q4 + (c16 >> 2)) * VS_STRIDE + (16 * dt + 4 * (c16 & 3)) * 2;
    const s16x4 lo = __builtin_bit_cast(s16x4, __builtin_amdgcn_ds_read_tr16_b64_v4i16((LAS v4i16_t*)vr));
    const s16x4 hi = __builtin_bit_cast(s16x4, __builtin_amdgcn_ds_read_tr16_b64_v4i16((LAS v4i16_t*)(vr + 16 * VS_STRIDE)));
#else
    const LAS unsigned char* vr = buf + AT_VT + (16 * dt + c16) * VS_STRIDE + (32 * u + 4 * q4) * 2;
    const s16x4 lo = *(const LAS s16x4*)vr, hi = *(const LAS s16x4*)(vr + 32);
#endif
    return __builtin_shufflevector(lo, hi, 0, 1, 2, 3, 4, 5, 6, 7);
}
template <int NT, int TM0, int TM1, int TM2, int TM3, class F0, class F1, class F2, class F3>
DEV void chunk_tiles(const LAS unsigned char* buf, const LAS unsigned char* ql, float (&m_run)[NT], float (&l_run)[NT], f32x4 (&o)[NT][4], int c16, int q4, F0 mf0, F1 mf1, F2 mf2, F3 mf3) {
    constexpr int TM[4] = {TM0, TM1, TM2, TM3};
    constexpr int TMALL = TM0 | TM1 | (NT > 2 ? (TM2 | TM3) : 0);
    f32x4 s[NT][4];
    {
        bf16x8 kf[4][2];
#pragma unroll
        for (int t = 0; t < 4; ++t)
            if ((TMALL >> t) & 1) {
#pragma unroll
                for (int k = 0; k < 2; ++k) kf[t][k] = *(const LAS bf16x8*)(buf + (16 * t + c16) * KS_STRIDE + (32 * k + 8 * q4) * 2);
            }
#pragma unroll
        for (int j = 0; j < NT; ++j) {
            const bf16x8 q0 = *(const LAS bf16x8*)(ql + (2 * j) * 1024), q1 = *(const LAS bf16x8*)(ql + (2 * j + 1) * 1024);
#pragma unroll
            for (int t = 0; t < 4; ++t) {
                f32x4 acc = {0.f, 0.f, 0.f, 0.f};
                if ((TM[j] >> t) & 1) { acc = MFMA16(kf[t][0], q0, acc); acc = MFMA16(kf[t][1], q1, acc); }
                s[j][t] = acc;
            }
        }
    }
    bf16x8 bp[NT][2];
#pragma unroll
    for (int j = 0; j < NT; ++j) {
        float mx = m_run[j];
#pragma unroll
        for (int t = 0; t < 4; ++t)
            if ((TM[j] >> t) & 1) {
#pragma unroll
                for (int r = 0; r < 4; ++r) { const int kk = 16 * t + 4 * q4 + r; float v = s[j][t][r]; v = (j == 0) ? mf0(kk, v) : (j == 1) ? mf1(kk, v) : (j == 2) ? mf2(kk, v) : mf3(kk, v); s[j][t][r] = v; mx = fmaxf(mx, v); }
            }
        mx = xrow16_max(mx);
        const float alpha = __builtin_amdgcn_exp2f(m_run[j] - mx); m_run[j] = mx;
        float ls = 0.f;
#pragma unroll
        for (int t = 0; t < 4; ++t)
            if ((TM[j] >> t) & 1) {
#pragma unroll
                for (int r = 0; r < 4; ++r) { const float p = __builtin_amdgcn_exp2f(s[j][t][r] - mx); s[j][t][r] = p; ls += p; }
            }
        l_run[j] = l_run[j] * alpha + ls;
#pragma unroll
        for (int dt = 0; dt < 4; ++dt) o[j][dt] = o[j][dt] * alpha;
#pragma unroll
        for (int u = 0; u < 2; ++u) bp[j][u] = pack8(s[j][2 * u], s[j][2 * u + 1]);
    }
#pragma unroll
    for (int u = 0; u < 2; ++u)
        if ((TMALL >> (2 * u)) & 3) {
#pragma unroll
            for (int dt = 0; dt < 4; ++dt) { const bf16x8 vf = v_frag(buf, u, dt, c16, q4);
#pragma unroll
                for (int j = 0; j < NT; ++j) if ((TM[j] >> (2 * u)) & 3) o[j][dt] = MFMA16(vf, bp[j][u], o[j][dt]); }
        }
    AT_SCHED();
}
DEV void attn_store(bf16* dst, float l_run, const f32x4 (&o)[4], int q4) {
    const float inv = 1.0f / xrow16_sum(l_run);
#pragma unroll
    for (int dt = 0; dt < 4; ++dt) { u32x2 u; u.x = pk2(o[dt][0] * inv, o[dt][1] * inv); u.y = pk2(o[dt][2] * inv, o[dt][3] * inv); *(u32x2*)(dst + 16 * dt + 4 * q4) = u; }
}
DEV int na_start(int r) { return r - 4 < 0 ? 0 : (r - 4 > 24 ? 24 : r - 4); }
template <int MODE> DEV void attn4_unit(const Args& A, int L, int unit, LAS unsigned char* lds, int tid) {
    constexpr int NT = (MODE == 3) ? 2 : 4;
    const int w = __builtin_amdgcn_readfirstlane(tid >> 6), lane = tid & 63, c16 = lane & 15, q4 = lane >> 4;
    unsigned char* ws = A.ws;
    const bf16* proj = (const bf16*)(ws + WS_PROJ);
    bf16* ybr = (bf16*)(ws + WS_YBR);
    LAS float* RPB = (LAS float*)(lds + AT_RPB);
    int b, h = 0, kcol, vcol, nlat = 0, lat0 = 0, kr0 = 0, tq = 0, rq = 0;
    size_t qrow0; int qcol0; float m_run[NT], l_run[NT]; int kvh = 0;
    if (MODE == 0 || MODE == 2) {
        if (MODE == 0) { const int qb = unit & 15; kvh = (unit >> 4) & 1; b = unit >> 5; tq = qb * 128 + 16 * w + c16;
            const int lo = qb * 128 - 128 < 0 ? 0 : qb * 128 - 128, hi = qb * 128 + 256 > SEQ ? SEQ : qb * 128 + 256; lat0 = lo; nlat = (hi - lo) >> 6; }
        else { const int qb = unit & 1; kvh = (unit >> 1) & 1; b = unit >> 2; tq = qb * 128 + 16 * w + c16; }
        kcol = 2560 + kvh * 64; vcol = 2688 + kvh * 64;
#pragma unroll
        for (int j = 0; j < NT; ++j) { const int hq = kvh * 4 + j; m_run[j] = A.in[I_SINK][L * 8 + hq] * LOG2E; l_run[j] = q4 == 0 ? 1.f : 0.f; }
        qrow0 = (MODE == 0) ? (size_t)b * SEQ + tq : (size_t)ML + b * LC + tq; qcol0 = 2048 + kvh * 4 * 64;
    } else {
        if (MODE == 1) { const int rg = unit & 3; h = (unit >> 2) & 7; b = unit >> 5; rq = 8 * rg + w; kr0 = na_start(8 * rg); nlat = na_start(8 * rg + 7) + 8 - kr0; }
        else { h = unit & 7; b = unit >> 3; }
        kcol = 3328 + h * 64; vcol = 3840 + h * 64;
#pragma unroll
        for (int j = 0; j < NT; ++j) { m_run[j] = -1e30f; l_run[j] = 0.f; }
        qrow0 = (MODE == 1) ? (size_t)b * SEQ + rq * 64 + c16 : (size_t)ML + b * LC + 32 * w + c16; qcol0 = 2816 + h * 64;
    }
    f32x4 o[NT][4];
#pragma unroll
    for (int j = 0; j < NT; ++j)
#pragma unroll
        for (int dt = 0; dt < 4; ++dt) o[j][dt] = (f32x4){0.f, 0.f, 0.f, 0.f};
    constexpr size_t QSTRIDE = (MODE == 0 || MODE == 2) ? (size_t)64 : (size_t)16 * PS;
    const bf16* qb = proj + qrow0 * PS + qcol0 + 8 * q4;
    LAS unsigned char* ql = lds + AT_Q + w * 8192 + lane * 16;
    const int nch = 4 + nlat;
#define CH_ROW0(ci) ((ci) < 4 ? (size_t)ML + b * LC + (ci) * 64 : (MODE == 0 ? (size_t)b * SEQ + lat0 + ((ci) - 4) * 64 : (size_t)b * SEQ + (kr0 + (ci) - 4) * 64))
#define CH_LOAD(R, ci) do { const size_t r_ = CH_ROW0(ci); kv_load(R, proj + r_ * PS + kcol, proj + r_ * PS + vcol, tid); } while (0)
    KVRegs kvA, kvB;
    __syncthreads();
    if (MODE == 1) {
        for (int i = tid; i < 960; i += NTHREADS) { const int rw = i >> 6, dc = (i & 63) - 16; const bool in = dc >= 0 && dc <= 30;
            const float v = in ? A.in[I_RPB][(size_t)(L * 8 + h) * 465 + rw * 31 + dc] * LOG2E : 0.f;
            RPB[i] = v; RPB[960 + i] = (dc >= 7 && dc <= 22) ? v : -INFINITY; } }
    CH_LOAD(kvA, 0);
    CH_LOAD(kvB, 1);
#pragma unroll
    for (int j = 0; j < NT; ++j)
#pragma unroll
        for (int k = 0; k < 2; ++k) *(LAS u32x4*)(ql + (2 * j + k) * 1024) = *(const u32x4*)(qb + j * QSTRIDE + 32 * k);
    kv_write(lds, kvA, tid);
    CH_LOAD(kvA, 2);
    const int sw = na_start(rq);
    auto compute = [&](int ci) {
        const LAS unsigned char* buf = lds + (ci & 1) * AT_BUF;
        if (ci < 4) {
            auto nomask = [](int, float s) { return s; };
            chunk_tiles<NT, 15, 15, 15, 15>(buf, ql, m_run, l_run, o, c16, q4, nomask, nomask, nomask, nomask);
        } else if constexpr (MODE == 0) {
            const int k0 = lat0 + (ci - 4) * 64, tq0 = tq - c16;
            if (k0 >= tq0 + 15 - 128 && k0 + 63 <= tq0 + 128) {
                auto nomask = [](int, float s) { return s; };
                chunk_tiles<NT, 15, 15, 15, 15>(buf, ql, m_run, l_run, o, c16, q4, nomask, nomask, nomask, nomask);
            } else if (k0 + 63 >= tq0 - 128 && k0 <= tq0 + 15 + 128) {
                auto wmask = [=](int kk, float s) { const int d = tq - (k0 + kk); return (d <= 128 && d >= -128) ? s : -INFINITY; };
                chunk_tiles<NT, 15, 15, 15, 15>(buf, ql, m_run, l_run, o, c16, q4, wmask, wmask, wmask, wmask);
            }
        } else if constexpr (MODE == 1) {
            const int kr = kr0 + ci - 4;
            if (kr >= sw && kr < sw + 8) {
                const LAS float* brow = RPB + (kr - rq + 7) * 64 + 16 + 15 - c16;
#define NA_ME(j) [=](int ck, float s) { const int cq = 16 * (j) + c16; const int cs = cq - 8 < 0 ? 0 : (cq - 8 > 48 ? 48 : cq - 8); return ((unsigned)(ck - cs) < 16u) ? s + brow[ck - 16 * (j)] : -INFINITY; }
#define NA_MI(j) [=](int ck, float s) { return s + brow[960 + ck - 16 * (j)]; }
                chunk_tiles<NT, 3, 7, 14, 12>(buf, ql, m_run, l_run, o, c16, q4, NA_ME(0), NA_MI(1), NA_MI(2), NA_ME(3));
#undef NA_ME
#undef NA_MI
            }
        }
    };
    for (int ci = 0; ci < nch; ci += 2) {
        __syncthreads();
        if (ci + 1 < nch) { kv_write(lds + AT_BUF, kvB, tid); if (ci + 3 < nch) CH_LOAD(kvB, ci + 3); }
        AT_SCHED();
        compute(ci);
        if (ci + 1 >= nch) break;
        __syncthreads();
        if (ci + 2 < nch) { kv_write(lds, kvA, tid); if (ci + 4 < nch) CH_LOAD(kvA, ci + 4); }
        AT_SCHED();
        compute(ci + 1);
    }
#undef CH_LOAD
#undef CH_ROW0
#pragma unroll
    for (int j = 0; j < NT; ++j) {
        size_t qr; int oc, br;
        if (MODE == 0 || MODE == 2) { qr = (MODE == 0) ? (size_t)b * SEQ + tq : (size_t)ML + b * LC + tq; oc = (kvh * 4 + j) * 64; br = 1; }
        else { qr = (MODE == 1) ? (size_t)b * SEQ + rq * 64 + 16 * j + c16 : (size_t)ML + b * LC + 32 * w + 16 * j + c16; oc = h * 64; br = 2; }
        attn_store(ybr + ((size_t)br * MT + qr) * 512 + oc, l_run[j], o[j], q4);
    }
}

constexpr int RS = 136;
DEV void ret_unit_ids(int unit, int& b, int& h, int& ck, size_t& row0) {
    ck = unit % 18; const int bh = unit / 18; h = bh & 3; b = bh >> 2;
    row0 = ck < 16 ? (size_t)b * SEQ + ck * 128 : (size_t)ML + b * LC + (ck - 16) * 128;
}
DEV float log_gamma(const Args& A, int L, int dir, int h) { return log1pf(-__expf(A.in[I_DECAY][L * 8 + dir * 4 + h])); }
constexpr int SC_STRIDE = 288;
constexpr int SC_V = 128 * SC_STRIDE;
DEV void scan_unit(const Args& A, int L, int unit, LAS unsigned char* lds, int tid) {
    const int w = __builtin_amdgcn_readfirstlane(tid >> 6), lane = tid & 63, c16 = lane & 15, q4 = lane >> 4;
    const int dir = unit & 1, bh = unit >> 1, h = bh & 3, b = bh >> 2;
    unsigned char* ws = A.ws; const bf16* proj = (const bf16*)(ws + WS_PROJ);
    const float lg = log_gamma(A, L, dir, h), gC = __expf(lg * 128.0f);
    bf16* ST = (bf16*)(ws + WS_ST) + ((size_t)bh * 18 * 2 + dir) * 16384 + (size_t)(16 * w + c16) * 128 + 4 * q4;
#define SC_CK(s) (dir == 0 ? ((s) < 2 ? 16 + (s) : (s) - 2) : 17 - (s))
#define SC_ROW0(ck) ((ck) < 16 ? (size_t)b * SEQ + (ck) * 128 : (size_t)ML + b * LC + ((ck) - 16) * 128)
    u32x4 rk[4], rv[4];
#define SC_LOAD(s) do { const size_t r0_ = SC_ROW0(SC_CK(s)); _Pragma("unroll") for (int i = 0; i < 4; ++i) { const int q = tid + 512 * i, tk = q >> 4, dc = q & 15; \
        rk[i] = *(const u32x4*)(proj + (r0_ + tk) * PS + 512 + h * 128 + 8 * dc); rv[i] = *(const u32x4*)(proj + (r0_ + tk) * PS + 1024 + h * 128 + 8 * dc); } } while (0)
    f32x4 acc[8];
#pragma unroll
    for (int t = 0; t < 8; ++t) acc[t] = (f32x4){0.f, 0.f, 0.f, 0.f};
    SC_LOAD(0);
    for (int s = 0; s < 18; ++s) {
        { bf16* st = ST + (size_t)SC_CK(s) * 32768;
#pragma unroll
          for (int t = 0; t < 8; ++t) { u32x2 o; o.x = pk2(acc[t][0], acc[t][1]); o.y = pk2(acc[t][2], acc[t][3]); *(u32x2*)(st + 16 * t) = o; } }
        if (s == 17) break;
        __syncthreads();
#pragma unroll
        for (int i = 0; i < 4; ++i) { const int q = tid + 512 * i, tk = q >> 4, dc = q & 15;
            const float wt = dir == 0 ? __expf(lg * (float)(127 - tk)) : __expf(lg * (float)tk);
            u32x4 kw; kw.x = pk2(bflo(rk[i].x) * wt, bfhi(rk[i].x) * wt); kw.y = pk2(bflo(rk[i].y) * wt, bfhi(rk[i].y) * wt); kw.z = pk2(bflo(rk[i].z) * wt, bfhi(rk[i].z) * wt); kw.w = pk2(bflo(rk[i].w) * wt, bfhi(rk[i].w) * wt);
            *(LAS u32x4*)(lds + tk * SC_STRIDE + dc * 16) = kw; *(LAS u32x4*)(lds + SC_V + tk * SC_STRIDE + dc * 16) = rv[i]; }
        if (s + 1 < 17) SC_LOAD(s + 1);
        __syncthreads();
#pragma unroll
        for (int t = 0; t < 8; ++t) acc[t] = acc[t] * gC;
#pragma unroll
        for (int k = 0; k < 4; ++k) {
            const LAS unsigned char* vb = lds + SC_V + (32 * k + 4 * q4 + (c16 >> 2)) * SC_STRIDE + (16 * w + 4 * (c16 & 3)) * 2;
            const s16x4 vlo = __builtin_bit_cast(s16x4, __builtin_amdgcn_ds_read_tr16_b64_v4i16((LAS v4i16_t*)vb)), vhi = __builtin_bit_cast(s16x4, __builtin_amdgcn_ds_read_tr16_b64_v4i16((LAS v4i16_t*)(vb + 16 * SC_STRIDE)));
            const bf16x8 bfrag = __builtin_shufflevector(vlo, vhi, 0, 1, 2, 3, 4, 5, 6, 7);
#pragma unroll
            for (int t = 0; t < 8; ++t) {
                const LAS unsigned char* kb = lds + (32 * k + 4 * q4 + (c16 >> 2)) * SC_STRIDE + (16 * t + 4 * (c16 & 3)) * 2;
                const s16x4 klo = __builtin_bit_cast(s16x4, __builtin_amdgcn_ds_read_tr16_b64_v4i16((LAS v4i16_t*)kb)), khi = __builtin_bit_cast(s16x4, __builtin_amdgcn_ds_read_tr16_b64_v4i16((LAS v4i16_t*)(kb + 16 * SC_STRIDE)));
                acc[t] = MFMA16(__builtin_shufflevector(klo, khi, 0, 1, 2, 3, 4, 5, 6, 7), bfrag, acc[t]);
            }
        }
    }
#undef SC_LOAD
#undef SC_ROW0
#undef SC_CK
    asm volatile("s_waitcnt vmcnt(0)" ::: "memory");
    __syncthreads();
    if (tid == 0) { __builtin_amdgcn_fence(__ATOMIC_RELEASE, "agent"); asm volatile("s_waitcnt vmcnt(0)" ::: "memory");
        __hip_atomic_fetch_add((unsigned*)(ws + WS_CTL) + CW_RFLAG + (L * 32 + bh) * 64, 1u, __ATOMIC_RELAXED, __HIP_MEMORY_SCOPE_AGENT); }
}
DEV void r3_unit(const Args& A, int L, int unit, LAS unsigned char* lds, int tid) {
    const int w = __builtin_amdgcn_readfirstlane(tid >> 6), lane = tid & 63, c16 = lane & 15, q4 = lane >> 4;
    int b, h, ck; size_t row0; ret_unit_ids(unit, b, h, ck, row0);
    unsigned char* ws = A.ws; const bf16* proj = (const bf16*)(ws + WS_PROJ);
    const float lgf = log_gamma(A, L, 0, h), lgb = log_gamma(A, L, 1, h);
    LAS unsigned short* KS = (LAS unsigned short*)lds; LAS unsigned short* VT = KS + 128 * RS;
    if (tid == 0) {
        const unsigned* fl = (const unsigned*)(ws + WS_CTL) + CW_RFLAG + (L * 32 + b * 4 + h) * 64; unsigned sp = 0;
        while (__hip_atomic_load(fl, __ATOMIC_RELAXED, __HIP_MEMORY_SCOPE_AGENT) < 2u) { __builtin_amdgcn_s_sleep(2); if (++sp > (1u << 22)) break; }
        __builtin_amdgcn_fence(__ATOMIC_ACQUIRE, "agent"); asm volatile("s_waitcnt vmcnt(0)" ::: "memory");
    }
    __syncthreads();
    for (int q = tid; q < 2048; q += NTHREADS) { const int i = q >> 4, dc = q & 15;
        const u32x4 kv = *(const u32x4*)(proj + (row0 + i) * PS + 512 + h * 128 + 8 * dc), vv = *(const u32x4*)(proj + (row0 + i) * PS + 1024 + h * 128 + 8 * dc);
        *(LAS u32x4*)(KS + i * RS + 8 * dc) = kv;
        *(LAS u32x4*)((LAS unsigned char*)VT + i * 288 + 16 * dc) = vv; }
    __syncthreads();
    const int n = 16 * w + c16; const size_t row = row0 + n;
    bf16x8 qf[4];
#pragma unroll
    for (int k = 0; k < 4; ++k) qf[k] = *(const bf16x8*)(proj + row * PS + h * 128 + 32 * k + 8 * q4);
    f32x4 sT[8];
#pragma unroll
    for (int t = 0; t < 8; ++t) { f32x4 acc = {0.f, 0.f, 0.f, 0.f};
#pragma unroll
        for (int k = 0; k < 4; ++k) { const bf16x8 a = *(const LAS bf16x8*)(KS + (16 * t + c16) * RS + 32 * k + 8 * q4); acc = MFMA16(a, qf[k], acc); }
#pragma unroll
        for (int r = 0; r < 4; ++r) { const int d = n - (16 * t + 4 * q4 + r); acc[r] *= (d >= 0) ? __expf(lgf * (float)d) : __expf(-lgb * (float)d); }
        sT[t] = acc; }
    f32x4 y[8];
#pragma unroll
    for (int dt = 0; dt < 8; ++dt) y[dt] = (f32x4){0.f, 0.f, 0.f, 0.f};
#pragma unroll
    for (int u = 0; u < 4; ++u) { const bf16x8 bp = pack8(sT[2 * u], sT[2 * u + 1]);
#pragma unroll
        for (int dt = 0; dt < 8; ++dt) { const LAS unsigned char* vr = (const LAS unsigned char*)VT + (32 * u + 4 * q4 + (c16 >> 2)) * 288 + (16 * dt + 4 * (c16 & 3)) * 2;
            const s16x4 lo = __builtin_bit_cast(s16x4, __builtin_amdgcn_ds_read_tr16_b64_v4i16((LAS v4i16_t*)vr)), hi = __builtin_bit_cast(s16x4, __builtin_amdgcn_ds_read_tr16_b64_v4i16((LAS v4i16_t*)(vr + 16 * 288)));
            y[dt] = MFMA16(__builtin_shufflevector(lo, hi, 0, 1, 2, 3, 4, 5, 6, 7), bp, y[dt]); } }
    const float df = __expf(lgf * (float)(n + 1)), db = __expf(lgb * (float)(128 - n));
    bf16x8 qdf[4], qdb[4];
#pragma unroll
    for (int k = 0; k < 4; ++k) { const u32x4 qq = __builtin_bit_cast(u32x4, qf[k]); u32x4 f, g;
        f.x = pk2(bflo(qq.x) * df, bfhi(qq.x) * df); f.y = pk2(bflo(qq.y) * df, bfhi(qq.y) * df); f.z = pk2(bflo(qq.z) * df, bfhi(qq.z) * df); f.w = pk2(bflo(qq.w) * df, bfhi(qq.w) * df);
        g.x = pk2(bflo(qq.x) * db, bfhi(qq.x) * db); g.y = pk2(bflo(qq.y) * db, bfhi(qq.y) * db); g.z = pk2(bflo(qq.z) * db, bfhi(qq.z) * db); g.w = pk2(bflo(qq.w) * db, bfhi(qq.w) * db);
        qdf[k] = __builtin_bit_cast(bf16x8, f); qdb[k] = __builtin_bit_cast(bf16x8, g); }
    const bf16* STf = (const bf16*)(ws + WS_ST) + (size_t)unit * 2 * 16384; const bf16* STb = STf + 16384;
#pragma unroll
    for (int dt = 0; dt < 8; ++dt)
#pragma unroll
        for (int k = 0; k < 4; ++k) { const bf16x8 a = *(const bf16x8*)(STf + (16 * dt + c16) * 128 + 32 * k + 8 * q4), a2 = *(const bf16x8*)(STb + (16 * dt + c16) * 128 + 32 * k + 8 * q4);
            y[dt] = MFMA16(a, qdf[k], y[dt]); y[dt] = MFMA16(a2, qdb[k], y[dt]); }
    float s = 0.f;
#pragma unroll
    for (int dt = 0; dt < 8; ++dt) s += (y[dt][0] + y[dt][1]) + (y[dt][2] + y[dt][3]);
    s = xrow16_sum(s);
    const float mu = s * (1.0f / 128.0f); float v = 0.f;
#pragma unroll
    for (int dt = 0; dt < 8; ++dt) { const f32x4 d = y[dt] - mu; v += (d[0] * d[0] + d[1] * d[1]) + (d[2] * d[2] + d[3] * d[3]); }
    v = xrow16_sum(v);
    const float rstd = rsqrtf(v * (1.0f / 128.0f) + EPS);
    bf16* yo = (bf16*)(ws + WS_YBR) + row * 512 + h * 128;
#pragma unroll
    for (int dt = 0; dt < 8; ++dt) { const u32x2 g = *(const u32x2*)(proj + row * PS + 1536 + h * 128 + 16 * dt + 4 * q4);
        u32x2 o; o.x = pk2(bflo(g.x) * (y[dt][0] - mu) * rstd, bfhi(g.x) * (y[dt][1] - mu) * rstd); o.y = pk2(bflo(g.y) * (y[dt][2] - mu) * rstd, bfhi(g.y) * (y[dt][3] - mu) * rstd);
        *(u32x2*)(yo + 16 * dt + 4 * q4) = o; }
}


DEV void panel_signal(unsigned* flag) {
    asm volatile("s_waitcnt vmcnt(0)" ::: "memory");
    __syncthreads();
    if (threadIdx.x == 0) {
        __builtin_amdgcn_fence(__ATOMIC_RELEASE, "agent"); asm volatile("s_waitcnt vmcnt(0)" ::: "memory");
        __hip_atomic_fetch_add(flag, 1u, __ATOMIC_RELAXED, __HIP_MEMORY_SCOPE_AGENT);
    }
}
DEV void panel_wait(const unsigned* flag) {
    if (threadIdx.x == 0) {
        unsigned sp = 0;
        for (int p = 0; p < 8; ++p)
            while (__hip_atomic_load(flag + p * 64, __ATOMIC_RELAXED, __HIP_MEMORY_SCOPE_AGENT) < 4u) { __builtin_amdgcn_s_sleep(2); if (++sp > (1u << 22)) break; }
        __builtin_amdgcn_fence(__ATOMIC_ACQUIRE, "agent"); asm volatile("s_waitcnt vmcnt(0)" ::: "memory");
    }
    __syncthreads();
}
__global__ void __launch_bounds__(NTHREADS, 2) mk_fwd(Args args) {
    extern __shared__ __attribute__((aligned(16))) unsigned char lds_raw[];
    LAS unsigned char* lds = (LAS unsigned char*)lds_raw;
    const int tid = threadIdx.x, G = gridDim.x;
    const int bx = blockIdx.x, vcu = (G % 8 == 0) ? (bx % 8) * (G / 8) + bx / 8 : bx;
    unsigned char* ws = args.ws;
    volatile LAS unsigned* MISC = (volatile LAS unsigned*)(lds + MISC_OFF);
    for (int u = tid; u < (LDS_BYTES - 131072) / 4; u += NTHREADS) ((LAS unsigned*)(lds + 131072))[u] = 0u;
    __syncthreads();
    const int lo = args.ph_lo, hi = args.ph_hi;
    XcdBarrier bar; bar.bar = (unsigned*)(ws + WS_CTL) + CW_BAR; bar.x = 0; bar.st = nullptr;
    if (hi - lo > 1) bar = xcd_barrier_post((unsigned*)(ws + WS_CTL) + CW_BAR, MISC + 8);
#define IN(k) (lo <= (k) && (k) < hi)
#define EN(b) (((MK_EN) >> (b)) & 1u)
#define REP(b) for (int _rp = 0; _rp < 1 + (int)(((MK_REP) >> (b)) & 1u); ++_rp)
#define OT() ({ int _t = threadIdx.x; asm volatile("" : "+v"(_t)); _t; })
#define SEAM(k) do { if (IN(k) && IN((k) + 1)) xcd_barrier(bar); } while (0)
    const pg8::bf16_t* XN = (const pg8::bf16_t*)(ws + WS_XN);
    pg8::bf16_t* PROJ = (pg8::bf16_t*)(ws + WS_PROJ);
    const float* TAB = (const float*)(ws + WS_TAB);

    if (EN(0) && IN(0)) REP(0) { p0_prologue(args, lds, vcu, G, OT()); } SEAM(0);
    if (EN(1) && IN(1)) REP(1) { thin_phase<0>(args, 0, vcu, G, 0, MT, OT(), lds); } SEAM(1);
    for (int L = 0; L < DEPTH; ++L) {
        const int pb = 2 + 11 * L;
        const bool need_ctx = L < DEPTH - 1;
        const int Mact = need_ctx ? MT : ML;
        if (EN(2) && IN(pb + 0)) REP(2) {
            if constexpr (F8GATE) {
                { pg8::Gemm g{XN, (const pg8::bf16_t*)(ws + WS_WIN + (size_t)L * DIN * 1024 * 2), MT, 4352, 1024}; pg8::StaticOrder S; S.init(MT, 4352, G, bx);
                  pg8::EpiInProj<false> E{PROJ, TAB + TAB_RTC, TAB + TAB_RTS, TAB + TAB_AXC, TAB + TAB_AXS, 1.0f, 0};
                  pg8::gemm_phase<pg8::EpiInProj<false>, pg8::StaticOrder, true, true, false>(lds, g, S, E); }
                { pg8::Gemm g{(const pg8::bf16_t*)(ws + WS_XN8), (const pg8::bf16_t*)(ws + WS_WIN8 + (size_t)L * 3072 * 1024), MT, 3072, 512}; pg8::TailOrder S; S.init(MT, 3072, G, bx); S.cut = (72 * 17) % G; S.base = (72 * 12) / G; if (S.cut == 0) S.base = 1 << 20;
                  pg8::EpiGate E{ws + WS_G8};
                  pg8::gemm_phase<pg8::EpiGate, pg8::TailOrder, true, true, true>(lds, g, S, E); }
            } else {
            pg8::Gemm g{XN, (const pg8::bf16_t*)(ws + WS_WIN + (size_t)L * DIN * 1024 * (F8IN ? 1 : 2)), MT, DIN, F8IN ? 512 : 1024}; pg8::StaticOrder S; S.init(MT, DIN, G, bx);
            pg8::EpiInProj<true> E{PROJ, TAB + TAB_RTC, TAB + TAB_RTS, TAB + TAB_AXC, TAB + TAB_AXS, F8IN ? 0.015625f : 1.0f, 0};
            pg8::gemm_phase<pg8::EpiInProj<true>, pg8::StaticOrder, true, true, F8IN>(lds, g, S, E);
            }
        } SEAM(pb + 0);
        if (IN(pb + 1)) {
            unsigned* wq = (unsigned*)(ws + WS_CTL) + CW_WQ + L * 64;
            const int n_ctx = need_ctx ? 96 : 0, n_att = 64 + 256 + 256 + n_ctx, n_units = n_att + (need_ctx ? 576 : 512);
            for (;;) {
                if (threadIdx.x == 0) MISC[16] = __hip_atomic_fetch_add(wq, 1u, __ATOMIC_RELAXED, __HIP_MEMORY_SCOPE_AGENT);
                __syncthreads();
                const int u = (int)MISC[16];
                __syncthreads();
                if (u >= n_units) break;
                const int n_r3 = need_ctx ? 576 : 512;
                if (u < 64) { if (EN(6)) scan_unit(args, L, u, lds, OT()); }
                else if (u < 320) { if (EN(4)) attn4_unit<1>(args, L, u - 64, lds, OT()); }
                else if (u < 320 + n_r3) { const int v = u - 320; if (EN(8)) r3_unit(args, L, need_ctx ? v : (v >> 4) * 18 + (v & 15), lds, OT()); }
                else if (u < 576 + n_r3) { if (EN(3)) attn4_unit<0>(args, L, u - 320 - n_r3, lds, OT()); }
                else if (u < 608 + n_r3) { if (EN(5)) attn4_unit<2>(args, L, u - 576 - n_r3, lds, OT()); }
                else { if (EN(5)) attn4_unit<3>(args, L, u - 608 - n_r3, lds, OT()); }
            }
        } SEAM(pb + 1);
        if (EN(9) && IN(pb + 4)) REP(9) {
            pg8::Gemm g{(const pg8::bf16_t*)(ws + WS_YBR), (const pg8::bf16_t*)(ws + WS_WBR) + (size_t)L * 3 * 1024 * 512, 3 * MT, 3 * 1024, 512};
            { pg8::BranchOrder S{(ML / 256) * 4, G, vcu};
              pg8::EpiBranch E{ws + WS_G8, (pg8::bf16_t*)(ws + WS_MERGED)};
              pg8::gemm_phase<pg8::EpiBranch, pg8::BranchOrder, true, true>(lds, g, S, E); }
            if (need_ctx) { pg8::PartOrder S{G, vcu};
              pg8::EpiBranchPart E{ws + WS_G8, (pg8::bf16_t*)(ws + WS_PART)};
              pg8::gemm_phase<pg8::EpiBranchPart, pg8::PartOrder, true, true>(lds, g, S, E); }
        } SEAM(pb + 4);
#define BAR_ALWAYS() do { if (hi - lo > 1) xcd_barrier(bar); } while (0)
        if (EN(10) && IN(pb + 5)) {
            const pg8::bf16_t* Wo = (const pg8::bf16_t*)(ws + WS_WOUT) + (size_t)L * 1024 * 1024;
            if (need_ctx) {
                { pg8::Gemm g{(const pg8::bf16_t*)(ws + WS_MERGED), Wo, ML, 1024, 1024}; pg8::StaticOrder S; S.init(ML, 1024, G, bx);
                  pg8::EpiPlain E{(pg8::bf16_t*)(ws + WS_YOUT), 1024, 4, 1.0f};
                  pg8::gemm_phase<pg8::EpiPlain, pg8::StaticOrder, true, true>(lds, g, S, E); }
                { const int t_ = OT(), lane_ = t_ & 63;
                  for (int row = vcu * 8 + (t_ >> 6); row < MC; row += G * 8) {
                      const unsigned char* pp = ws + WS_PART + ((size_t)row * 1024 + lane_ * 16) * 2;
                      float f[16];
#pragma unroll
                      for (int r = 0; r < 3; ++r) {
                          const uint4 w0 = *(const uint4*)(pp + (size_t)r * MC * 2048), w1 = *(const uint4*)(pp + (size_t)r * MC * 2048 + 16);
                          const unsigned ww[8] = {w0.x, w0.y, w0.z, w0.w, w1.x, w1.y, w1.z, w1.w};
#pragma unroll
                          for (int k = 0; k < 8; ++k) { const float lo_ = __uint_as_float(ww[k] << 16), hi_ = __uint_as_float(ww[k] & 0xffff0000u);
                              if (r == 0) { f[2 * k] = lo_; f[2 * k + 1] = hi_; } else { f[2 * k] += lo_; f[2 * k + 1] += hi_; } }
                      }
                      uint4 o0, o1;
                      o0.x = pg8::cvt_pk_bf16(f[0], f[1]); o0.y = pg8::cvt_pk_bf16(f[2], f[3]); o0.z = pg8::cvt_pk_bf16(f[4], f[5]); o0.w = pg8::cvt_pk_bf16(f[6], f[7]);
                      o1.x = pg8::cvt_pk_bf16(f[8], f[9]); o1.y = pg8::cvt_pk_bf16(f[10], f[11]); o1.z = pg8::cvt_pk_bf16(f[12], f[13]); o1.w = pg8::cvt_pk_bf16(f[14], f[15]);
                      unsigned char* op = ws + WS_MERGED + ((size_t)(ML + row) * 1024 + lane_ * 16) * 2;
                      *(uint4*)op = o0; *(uint4*)(op + 16) = o1;
                  } }
                BAR_ALWAYS();
                if (vcu < 32) { pg8::Gemm g{(const pg8::bf16_t*)(ws + WS_MERGED) + (size_t)ML * 1024, Wo, MC, 1024, 1024}; pg8::StaticOrder S; S.init(MC, 1024, 32, vcu);
                  pg8::EpiPlain E{(pg8::bf16_t*)(ws + WS_YOUT) + (size_t)ML * 1024, 1024, 4, 1.0f};
                  pg8::gemm_phase<pg8::EpiPlain, pg8::StaticOrder, true, true>(lds, g, S, E);
                  panel_signal((unsigned*)(ws + WS_CTL) + CW_PFLAG + ((L * 2 + 0) * 8 + (((vcu % 8) * 4 + vcu / 8) & 7)) * 64); }
                else thin_phase<1>(args, L, vcu - 32, G - 32, 0, ML, OT(), lds);
                panel_wait((const unsigned*)(ws + WS_CTL) + CW_PFLAG + (L * 2 + 0) * 8 * 64);
                thin_phase<1>(args, L, vcu, G, ML, MT, OT(), lds);
            } else {
                pg8::Gemm g{(const pg8::bf16_t*)(ws + WS_MERGED), Wo, ML, 1024, 1024}; pg8::StaticOrder S; S.init(ML, 1024, G, bx);
                pg8::EpiPlain E{(pg8::bf16_t*)(ws + WS_YOUT), 1024, 4, 1.0f};
                pg8::gemm_phase<pg8::EpiPlain, pg8::StaticOrder, true, true>(lds, g, S, E);
            }
        } SEAM(pb + 5);
        if (EN(11) && IN(pb + 6)) { if (!need_ctx) thin_phase<1>(args, L, vcu, G, 0, ML, OT(), lds); } if (!need_ctx) SEAM(pb + 6);
        if (L & 1) {
            const int mi = L >> 1;
            const unsigned* cnt = (const unsigned*)(ws + WS_CTL) + CW_MOE + mi * 8 * 64;
            if (EN(12) && IN(pb + 7)) REP(12) { gather_phase(args, L, vcu, G, OT()); } SEAM(pb + 7);
            if (EN(13) && IN(pb + 8)) REP(13) {
                constexpr int EB = F8UP_M ? 1 : 2;
                pg8::Gemm g{(const pg8::bf16_t*)(ws + WS_ASORT), (const pg8::bf16_t*)(ws + WS_WM13 + (size_t)mi * 8 * 2 * FFE * 1024 * EB), MSORT, 8 * 2 * FFE, 512 * EB};
                pg8::MoeOrder S; S.init(cnt, 28, G, bx);
                pg8::EpiSwiGLUx<F8UP_M, F8DN_M> E{ws + WS_HID, FFE, 28};
                pg8::gemm_phase<pg8::EpiSwiGLUx<F8UP_M, F8DN_M>, pg8::MoeOrder, true, true, F8UP_M>(lds, g, S, E);
            } SEAM(pb + 8);
            if (EN(14) && IN(pb + 9)) REP(14) {
                constexpr int EB = F8DN_M ? 1 : 2;
                pg8::Gemm g{(const pg8::bf16_t*)(ws + WS_HID), (const pg8::bf16_t*)(ws + WS_WM2 + (size_t)mi * 8 * 1024 * FFE * EB), MSORT, 8 * 1024, FFE / 2 * EB};
                pg8::MoeOrder S; S.init(cnt, 4, G, bx);
                pg8::EpiPlain E{(pg8::bf16_t*)(ws + WS_OSORT), 1024, 4, F8DN_M ? 1.0f / 2048.0f : 1.0f};
                pg8::gemm_phase<pg8::EpiPlain, pg8::MoeOrder, true, true, F8DN_M>(lds, g, S, E);
            } SEAM(pb + 9);
        } else {
            const int fi = L >> 1;
            if (EN(15) && IN(pb + 8)) REP(15) {
                constexpr int EB = F8UP_D ? 1 : 2;
                pg8::Gemm g{XN, (const pg8::bf16_t*)(ws + WS_WF13 + (size_t)fi * 2 * FFD * 1024 * EB), Mact, 2 * FFD, 512 * EB}; pg8::StaticOrder S; S.init(Mact, 2 * FFD, G, bx);
                pg8::EpiSwiGLUx<F8UP_D, F8DN_D> E{ws + WS_HID, FFD, 22};
                pg8::gemm_phase<pg8::EpiSwiGLUx<F8UP_D, F8DN_D>, pg8::StaticOrder, true, true, F8UP_D>(lds, g, S, E);
            } SEAM(pb + 8);
            if (EN(16) && IN(pb + 9)) {
                constexpr int EB = F8DN_D ? 1 : 2; constexpr float sc = F8DN_D ? 1.0f / 2048.0f : 1.0f;
                const pg8::bf16_t* W2 = (const pg8::bf16_t*)(ws + WS_WF2 + (size_t)fi * 1024 * FFD * EB);
                { pg8::Gemm g{(const pg8::bf16_t*)(ws + WS_HID), W2, ML, 1024, FFD / 2 * EB}; pg8::StaticOrder S; S.init(ML, 1024, G, bx);
                  pg8::EpiPlain E{(pg8::bf16_t*)(ws + WS_YOUT), 1024, 4, sc};
                  pg8::gemm_phase<pg8::EpiPlain, pg8::StaticOrder, true, true, F8DN_D>(lds, g, S, E); }
                BAR_ALWAYS();
                if (vcu < 32) { pg8::Gemm g{(const pg8::bf16_t*)(ws + WS_HID + (size_t)ML * FFD * EB), W2, MC, 1024, FFD / 2 * EB}; pg8::StaticOrder S; S.init(MC, 1024, 32, vcu);
                  pg8::EpiPlain E{(pg8::bf16_t*)(ws + WS_YOUT) + (size_t)ML * 1024, 1024, 4, sc};
                  pg8::gemm_phase<pg8::EpiPlain, pg8::StaticOrder, true, true, F8DN_D>(lds, g, S, E);
                  panel_signal((unsigned*)(ws + WS_CTL) + CW_PFLAG + ((L * 2 + 1) * 8 + (((vcu % 8) * 4 + vcu / 8) & 7)) * 64); }
                else thin_phase<2>(args, L, vcu - 32, G - 32, 0, ML, OT(), lds);
                panel_wait((const unsigned*)(ws + WS_CTL) + CW_PFLAG + (L * 2 + 1) * 8 * 64);
                thin_phase<2>(args, L, vcu, G, ML, MT, OT(), lds);
            } SEAM(pb + 9);
        }
        if (EN(17) && IN(pb + 10)) { if (L & 1) thin_phase<2>(args, L, vcu, G, 0, Mact, OT(), lds); } if (L & 1) SEAM(pb + 10);
    }
#undef IN
#undef SEAM
}


extern "C" void kernel_launch(void* const* d_in, const int* in_sizes, int n_in, void* d_out, int out_size, void* d_ws, size_t ws_size, hipStream_t stream) {
    static int grid = 0;
    if (grid == 0) {
        if (n_in != 20 || out_size != ML * D || ws_size < WS_END) { fprintf(stderr, "kernel_launch: unexpected shapes (n_in %d out %d ws %zu need %zu)\n", n_in, out_size, ws_size, (size_t)WS_END); grid = -1; return; }
        int dev = 0, cus = 0;
        if (hipGetDevice(&dev) != hipSuccess || hipDeviceGetAttribute(&cus, hipDeviceAttributeMultiprocessorCount, dev) != hipSuccess) { grid = -1; return; }
        if (hipFuncSetAttribute((const void*)mk_fwd, hipFuncAttributeMaxDynamicSharedMemorySize, LDS_BYTES) != hipSuccess) { fprintf(stderr, "kernel_launch: hipFuncSetAttribute failed\n"); grid = -1; return; }
        int per_cu = 0;
        (void)hipOccupancyMaxActiveBlocksPerMultiprocessor(&per_cu, (const void*)mk_fwd, NTHREADS, LDS_BYTES);
        (void)hipGetLastError();
        grid = cus;
    }
    if (grid < 0) return;
    (void)hipMemsetAsync((char*)d_ws + WS_CTL, 0, CTL_ZERO_BYTES, stream);
    Args a{};
    for (int i = 0; i < 20; ++i) a.in[i] = (const float*)d_in[i];
    a.out = (float*)d_out; a.ws = (unsigned char*)d_ws; a.li = 0; a.pad = 0;
#if MK_PER_PHASE
    for (int ph = 0; ph < MK_NPH_RUN; ++ph) { a.ph_lo = ph; a.ph_hi = ph + 1; hipLaunchKernelGGL(mk_fwd, dim3(grid), dim3(NTHREADS), LDS_BYTES, stream, a); }
#else
    a.ph_lo = 0; a.ph_hi = MK_NPH_RUN;
    hipLaunchKernelGGL(mk_fwd, dim3(grid), dim3(NTHREADS), LDS_BYTES, stream, a);
#endif
}
```

```cpp
#include <hip/hip_runtime.h>
#include <cstdio>
#include <cstdint>
#include <cmath>
#define LAS __attribute__((address_space(3)))
namespace pg8 {
#define PG8_LAS __attribute__((address_space(3)))
typedef unsigned short bf16_t;
typedef short bf16x8 __attribute__((ext_vector_type(8)));
typedef float f32x4 __attribute__((ext_vector_type(4)));
typedef unsigned u32x4 __attribute__((ext_vector_type(4)));
constexpr int BM = 256, BK = 64, HALF = 128, HTB = HALF * BK * 2  , STAGE_BYTES = 8 * HTB, NXCD = 8, WGM = 8;

__host__ __device__ __forceinline__ int lds_byte(int r, int c) { const int st = (r >> 4) * 2 + (c >> 5), rr = r & 15, cc = c & 31, ob = rr * 64 + cc * 2; return st * 1024 + (ob ^ (((ob >> 9) & 1) << 5)); }
__host__ __device__ __forceinline__ void stage_rc(int b, int& R, int& C) { const int st = b / 1024, sb = b % 1024, swz = sb ^ (((sb >> 9) & 1) << 5); R = (st >> 1) * 16 + swz / 64; C = (st & 1) * 32 + (swz % 64) / 2; }
__host__ __device__ __forceinline__ int perm32(int rho) { const int n = rho >> 4, i = rho & 15; return 8 * (i >> 2) + 4 * n + (i & 3); }

typedef int v8i32 __attribute__((ext_vector_type(8))); typedef int v4i32 __attribute__((ext_vector_type(4)));
__device__ __forceinline__ v8i32 pg8_cat(bf16x8 lo, bf16x8 hi) { return __builtin_shufflevector(__builtin_bit_cast(v4i32, lo), __builtin_bit_cast(v4i32, hi), 0, 1, 2, 3, 4, 5, 6, 7); }
struct Unit { int pm, pn; };
struct Gemm { const bf16_t* A; const bf16_t* Bt; int M, N, K; };

struct StaticOrder {
    int nM, nN, nwg, G, c;
    __host__ __device__ void init(int M, int N, int G_, int c_) { nM = M / BM; nN = N / BM; nwg = nM * nN; G = G_; c = c_; }
    __host__ __device__ bool next(int i, Unit& u) const { return next_at((long)i * G + c, u); }
    __host__ __device__ bool next_at(long L, Unit& u) const {
        if (L >= nwg) return false;
        int wgid = (int)L; { const int q = nwg / NXCD, r = nwg % NXCD, xcd = wgid % NXCD, off = wgid / NXCD; wgid = (xcd < r ? xcd * (q + 1) : r * (q + 1) + (xcd - r) * q) + off; }
        const int nig = WGM * nN, gid = wgid / nig, fm = gid * WGM, gsz = (nM - fm) < WGM ? (nM - fm) : WGM;
        u.pm = fm + ((wgid % nig) % gsz); u.pn = (wgid % nig) / gsz; return true;
    }
    __device__ __forceinline__ void a_ready(const Unit&) const {}
    __device__ __forceinline__ void done(const Unit&) const {}
};

typedef float f32x2_t __attribute__((ext_vector_type(2))); typedef __bf16 bf16x2_t __attribute__((ext_vector_type(2)));
__device__ __forceinline__ unsigned cvt_pk_bf16(float lo, float hi) { const f32x2_t v = {lo, hi}; const bf16x2_t b = __builtin_convertvector(v, bf16x2_t); return __builtin_bit_cast(unsigned, b); }
typedef float f32x2 __attribute__((ext_vector_type(2)));

struct BranchOrder {
    int nT, G, c;
    __device__ __forceinline__ bool next(int i, Unit& u) const {
        const int rd = i / 3, r = i - rd * 3; const int t = rd * G + c; if (t >= nT) return false;
        u.pm = r * 72 + (t >> 2); u.pn = r * 4 + (t & 3); return true;
    }
    __device__ __forceinline__ void a_ready(const Unit&) const {}
    __device__ __forceinline__ void done(const Unit&) const {}
};
struct PartOrder {
    int G, c;
    __device__ __forceinline__ bool next(int i, Unit& u) const {
        const int j = i * G + c; if (j >= 96) return false;
        const int r = j >> 5, t = j & 31; u.pm = r * 72 + 64 + (t >> 2); u.pn = r * 4 + (t & 3); return true;
    }
    __device__ __forceinline__ void a_ready(const Unit&) const {}
    __device__ __forceinline__ void done(const Unit&) const {}
};
struct MoeOrder {
    int nM, nN, nwg, G, c; int ts[9];
    __device__ __forceinline__ void init(const unsigned* cnt, int nN_, int G_, int c_) {
        int acc = 0;
#pragma unroll
        for (int e = 0; e < 8; ++e) { ts[e] = acc; const unsigned ce = __hip_atomic_load(cnt + 64 * e, __ATOMIC_RELAXED, __HIP_MEMORY_SCOPE_AGENT); acc += (int)((ce + 255u) >> 8); }
        ts[8] = acc; nM = acc; nN = nN_; nwg = nM * nN; G = G_; c = c_;
    }
    __device__ __forceinline__ bool next(int i, Unit& u) const {
        const long L = (long)i * G + c; if (L >= nwg) return false;
        int wgid = (int)L; { const int q = nwg / NXCD, r = nwg % NXCD, xcd = wgid % NXCD, off = wgid / NXCD; wgid = (xcd < r ? xcd * (q + 1) : r * (q + 1) + (xcd - r) * q) + off; }
        const int nig = WGM * nN, gid = wgid / nig, fm = gid * WGM, gsz = (nM - fm) < WGM ? (nM - fm) : WGM;
        const int pm = fm + ((wgid % nig) % gsz), pnt = (wgid % nig) / gsz;
        int e = 0;
#pragma unroll
        for (int k = 1; k < 8; ++k) e += (pm >= ts[k]) ? 1 : 0;
        u.pm = pm; u.pn = e * nN + pnt; return true;
    }
    __device__ __forceinline__ void a_ready(const Unit&) const {}
    __device__ __forceinline__ void done(const Unit&) const {}
};


struct TailOrder : StaticOrder {
    int cut, base;
    __device__ __forceinline__ bool next(int i, Unit& u) const {
        long L;
        if (i < base) L = (long)i * G + c; else { if (c < cut) return false; L = (long)base * G + (long)(i - base) * (G - cut) + (c - cut); }
        if (L >= nwg) return false;
        return next_at(L, u);
    }
};
__device__ __forceinline__ void store8(bf16_t* p, const f32x4 a, const f32x4 b) {
    u32x4 w; w.x = cvt_pk_bf16(a[0], a[1]); w.y = cvt_pk_bf16(a[2], a[3]); w.z = cvt_pk_bf16(b[0], b[1]); w.w = cvt_pk_bf16(b[2], b[3]); *(u32x4*)p = w;
}
__device__ __forceinline__ float sigm(float x) { return __builtin_amdgcn_rcpf(1.0f + __expf(-x)); }
__device__ __forceinline__ f32x4 sigm4(f32x4 v) { f32x4 o; o[0] = sigm(v[0]); o[1] = sigm(v[1]); o[2] = sigm(v[2]); o[3] = sigm(v[3]); return o; }

struct EpiPlain {
    static constexpr bool PERM = true, AFTER_DRAIN = false, KEEP_ACC = false;
    bf16_t* O; int ldc; int pn_mod; float scale;
    __device__ __forceinline__ void operator()(const f32x4 (&acc)[2][2][4][2], const Unit& u, int wr, int wc, int fr, int fq) const {
        const int row0 = u.pm * BM + wr * 64 + fr, col0 = (u.pn % pn_mod) * BM + wc * 32 + 8 * fq;
#pragma unroll
        for (int ai = 0; ai < 2; ++ai)
#pragma unroll
            for (int m = 0; m < 4; ++m) { bf16_t* rowp = O + (size_t)(row0 + ai * HALF + m * 16) * ldc + col0;
#pragma unroll
                for (int bj = 0; bj < 2; ++bj) store8(rowp + bj * HALF, acc[ai][bj][m][0] * scale, acc[ai][bj][m][1] * scale); }
    }
};
__device__ __forceinline__ float clamp_f8(float v) { return __builtin_amdgcn_fmed3f(v, -448.0f, 448.0f); }
__device__ __forceinline__ unsigned pk4_fp8(float a, float b, float c, float d) { a = clamp_f8(a); b = clamp_f8(b); c = clamp_f8(c); d = clamp_f8(d); unsigned w = 0; w = __builtin_amdgcn_cvt_pk_fp8_f32(a, b, w, false); w = __builtin_amdgcn_cvt_pk_fp8_f32(c, d, w, true); return w; }
typedef unsigned u32x2_t __attribute__((ext_vector_type(2)));
template <bool IN8, bool OUT8> struct EpiSwiGLUx {
    static constexpr bool PERM = true, AFTER_DRAIN = false, KEEP_ACC = false;
    unsigned char* O; int ldc; int pn_mod;
    __device__ __forceinline__ void operator()(const f32x4 (&acc)[2][2][4][2], const Unit& u, int wr, int wc, int fr, int fq) const {
        const int row0 = u.pm * BM + wr * 64 + fr, col0 = (u.pn % pn_mod) * HALF + wc * 32 + 8 * fq;
        constexpr float s1 = IN8 ? 0.015625f : 1.0f, s3 = (IN8 ? 0.015625f : 1.0f) * (OUT8 ? 16.0f : 1.0f);
#pragma unroll
        for (int ai = 0; ai < 2; ++ai) {
#pragma unroll
            for (int m = 0; m < 4; ++m) {
                const size_t eoff = (size_t)(row0 + ai * HALF + m * 16) * ldc + col0;
                constexpr float k1 = -1.4426950408889634f * s1, ic = 1.0f / (s1 * s3);
                const f32x4 g0 = acc[ai][0][m][0], g1 = acc[ai][0][m][1];
                const f32x4 t0 = g0 * k1, t1 = g1 * k1; f32x4 e0, e1;
                e0[0] = __builtin_amdgcn_exp2f(t0[0]); e0[1] = __builtin_amdgcn_exp2f(t0[1]); e0[2] = __builtin_amdgcn_exp2f(t0[2]); e0[3] = __builtin_amdgcn_exp2f(t0[3]);
                e1[0] = __builtin_amdgcn_exp2f(t1[0]); e1[1] = __builtin_amdgcn_exp2f(t1[1]); e1[2] = __builtin_amdgcn_exp2f(t1[2]); e1[3] = __builtin_amdgcn_exp2f(t1[3]);
                const f32x4 d0 = e0 * ic + ic, d1 = e1 * ic + ic; f32x4 r0, r1;
                r0[0] = __builtin_amdgcn_rcpf(d0[0]); r0[1] = __builtin_amdgcn_rcpf(d0[1]); r0[2] = __builtin_amdgcn_rcpf(d0[2]); r0[3] = __builtin_amdgcn_rcpf(d0[3]);
                r1[0] = __builtin_amdgcn_rcpf(d1[0]); r1[1] = __builtin_amdgcn_rcpf(d1[1]); r1[2] = __builtin_amdgcn_rcpf(d1[2]); r1[3] = __builtin_amdgcn_rcpf(d1[3]);
                const f32x4 v0 = (g0 * acc[ai][1][m][0]) * r0, v1 = (g1 * acc[ai][1][m][1]) * r1;
                if constexpr (OUT8) { u32x2_t w; w.x = pk4_fp8(v0[0], v0[1], v0[2], v0[3]); w.y = pk4_fp8(v1[0], v1[1], v1[2], v1[3]); *(u32x2_t*)(O + eoff) = w; }
                else store8((bf16_t*)O + eoff, v0, v1);
            }
        }
    }
};
struct EpiBranch {
    static constexpr bool PERM = true, AFTER_DRAIN = false, KEEP_ACC = true;
    const unsigned char* P;
    bf16_t* Mg;
    static __device__ __forceinline__ void unpack8(const u32x2_t g, f32x4& g0, f32x4& g1) {
        constexpr float s = 1.0f / 255.0f;
        g0[0] = (float)(g.x & 0xffu) * s; g0[1] = (float)((g.x >> 8) & 0xffu) * s; g0[2] = (float)((g.x >> 16) & 0xffu) * s; g0[3] = (float)(g.x >> 24) * s;
        g1[0] = (float)(g.y & 0xffu) * s; g1[1] = (float)((g.y >> 8) & 0xffu) * s; g1[2] = (float)((g.y >> 16) & 0xffu) * s; g1[3] = (float)(g.y >> 24) * s; }
    static __device__ __forceinline__ f32x4 clampg(f32x4 v) { f32x4 o; o[0] = fmaxf(v[0], 1e-6f); o[1] = fmaxf(v[1], 1e-6f); o[2] = fmaxf(v[2], 1e-6f); o[3] = fmaxf(v[3], 1e-6f); return o; }
    static __device__ __forceinline__ f32x4 rcp4(f32x4 v) { f32x4 o; o[0] = __builtin_amdgcn_rcpf(v[0]); o[1] = __builtin_amdgcn_rcpf(v[1]); o[2] = __builtin_amdgcn_rcpf(v[2]); o[3] = __builtin_amdgcn_rcpf(v[3]); return o; }
    __device__ __forceinline__ void operator()(f32x4 (&acc)[2][2][4][2], const Unit& u, int wr, int wc, int fr, int fq) const {
        const int r = u.pn >> 2, pnn = u.pn & 3, pmm = u.pm - r * 72;
        const int row0 = pmm * BM + wr * 64 + fr, col0 = pnn * BM + wc * 32 + 8 * fq;
#pragma unroll
        for (int ai = 0; ai < 2; ++ai)
#pragma unroll
            for (int m = 0; m < 4; ++m) { const size_t row = (size_t)(row0 + ai * HALF + m * 16);
#pragma unroll
                for (int bj = 0; bj < 2; ++bj) { const int col = col0 + bj * HALF;
                    const unsigned char* gp = P + row * 3072 + r * 1024 + col;
                    f32x4 a0, a1; unpack8(*(const u32x2_t*)gp, a0, a1);
                    if (r < 2) { f32x4 b0, b1; unpack8(*(const u32x2_t*)(gp + 1024), b0, b1);
                        if (r == 1) { a0 = clampg(a0); a1 = clampg(a1); }
                        acc[ai][bj][m][0] = acc[ai][bj][m][0] * (a0 * rcp4(clampg(b0))); acc[ai][bj][m][1] = acc[ai][bj][m][1] * (a1 * rcp4(clampg(b1)));
                    } else { store8(Mg + row * 1024 + col, acc[ai][bj][m][0] * clampg(a0), acc[ai][bj][m][1] * clampg(a1));
                        acc[ai][bj][m][0] = (f32x4){0.f, 0.f, 0.f, 0.f}; acc[ai][bj][m][1] = (f32x4){0.f, 0.f, 0.f, 0.f}; } } }
    }
};
struct EpiBranchPart {
    static constexpr bool PERM = true, AFTER_DRAIN = false, KEEP_ACC = false;
    const unsigned char* P;
    bf16_t* O;
    __device__ __forceinline__ void operator()(const f32x4 (&acc)[2][2][4][2], const Unit& u, int wr, int wc, int fr, int fq) const {
        const int r = u.pn >> 2, pnn = u.pn & 3, pmm = u.pm - r * 72;
        const int row0 = pmm * BM + wr * 64 + fr, col0 = pnn * BM + wc * 32 + 8 * fq;
#pragma unroll
        for (int ai = 0; ai < 2; ++ai)
#pragma unroll
            for (int m = 0; m < 4; ++m) { const size_t row = (size_t)(row0 + ai * HALF + m * 16);
#pragma unroll
                for (int bj = 0; bj < 2; ++bj) { const int col = col0 + bj * HALF;
                    f32x4 a0, a1; EpiBranch::unpack8(*(const u32x2_t*)(P + row * 3072 + r * 1024 + col), a0, a1);
                    store8(O + ((size_t)r * 2048 + (row - 16384)) * 1024 + col, acc[ai][bj][m][0] * a0, acc[ai][bj][m][1] * a1); } }
    }
};
struct EpiGate {
    static constexpr bool PERM = true, AFTER_DRAIN = false, KEEP_ACC = false;
    unsigned char* O;
    static __device__ __forceinline__ unsigned q4(f32x4 g) { return (unsigned)(g[0] * 255.0f + 0.5f) | ((unsigned)(g[1] * 255.0f + 0.5f) << 8) | ((unsigned)(g[2] * 255.0f + 0.5f) << 16) | ((unsigned)(g[3] * 255.0f + 0.5f) << 24); }
    __device__ __forceinline__ void operator()(const f32x4 (&acc)[2][2][4][2], const Unit& u, int wr, int wc, int fr, int fq) const {
        const int row0 = u.pm * BM + wr * 64 + fr, col0 = u.pn * BM + wc * 32 + 8 * fq;
#pragma unroll
        for (int ai = 0; ai < 2; ++ai)
#pragma unroll
            for (int m = 0; m < 4; ++m) { unsigned char* rowp = O + (size_t)(row0 + ai * HALF + m * 16) * 3072 + col0;
#pragma unroll
                for (int bj = 0; bj < 2; ++bj) { u32x2_t w; w.x = q4(sigm4(acc[ai][bj][m][0] * 0.015625f)); w.y = q4(sigm4(acc[ai][bj][m][1] * 0.015625f)); *(u32x2_t*)(rowp + bj * HALF) = w; } }
    }
};
template <bool GATES> struct EpiInProj {
    static constexpr bool PERM = true, AFTER_DRAIN = false, KEEP_ACC = false;
    bf16_t* O; const float *rtc, *rts, *axc, *axs; float asc; int pn_off;
    __device__ __forceinline__ void operator()(const f32x4 (&acc)[2][2][4][2], const Unit& u, int wr, int wc, int fr, int fq) const {
        const int pn = u.pn + pn_off, i8 = 8 * fq;
#pragma unroll
        for (int ai = 0; ai < 2; ++ai)
#pragma unroll
            for (int m = 0; m < 4; ++m) {
                const int row = u.pm * BM + ai * HALF + wr * 64 + m * 16 + fr;
                bf16_t* rowp = O + (size_t)row * 4352;
                const f32x4 a0 = acc[ai][0][m][0] * asc, a1 = acc[ai][0][m][1] * asc, b0 = acc[ai][1][m][0] * asc, b1 = acc[ai][1][m][1] * asc;
                if (pn < 4) {
                    const int hl = wc >> 1, i = 32 * (wc & 1) + i8;
                    const int pos = row < 16384 ? 256 + (row & 2047) : ((row - 16384) & 255);
                    const f32x4 c0 = *(const f32x4*)(rtc + pos * 64 + i), c1 = *(const f32x4*)(rtc + pos * 64 + i + 4);
                    const f32x4 s0 = *(const f32x4*)(rts + pos * 64 + i), s1 = *(const f32x4*)(rts + pos * 64 + i + 4);
                    const float sc = pn < 2 ? 0.08838834764831845f : 1.0f;
                    bf16_t* dst = rowp + pn * 256 + hl * 128 + i;
                    store8(dst, (a0 * c0 - b0 * s0) * sc, (a1 * c1 - b1 * s1) * sc);
                    store8(dst + 64, (a0 * s0 + b0 * c0) * sc, (a1 * s1 + b1 * c1) * sc);
                } else if (pn == 8 || pn == 9 || (pn == 10 && wc < 2)) {
                    const bool lat = row < 16384; const int t = row & 2047;
                    f32x4 c0 = *(const f32x4*)(axc + t * 32 + i8), c1 = *(const f32x4*)(axc + t * 32 + i8 + 4);
                    f32x4 s0 = *(const f32x4*)(axs + t * 32 + i8), s1 = *(const f32x4*)(axs + t * 32 + i8 + 4);
                    if (!lat) { c0 = (f32x4){1.f, 1.f, 1.f, 1.f}; c1 = c0; s0 = (f32x4){0.f, 0.f, 0.f, 0.f}; s1 = s0; }
                    const float sc = pn < 10 ? 0.18033688011112042f : 1.0f;
                    bf16_t* dst = rowp + (pn < 10 ? pn * 256 : 2560) + wc * 64 + i8;
                    store8(dst, (a0 * c0 - b0 * s0) * sc, (a1 * c1 - b1 * s1) * sc);
                    store8(dst + 32, (a0 * s0 + b0 * c0) * sc, (a1 * s1 + b1 * c1) * sc);
                } else if (pn == 10) {
                    bf16_t* dst = rowp + 2688 + (wc - 2) * 64 + i8;
                    store8(dst, a0, a1); store8(dst + 32, b0, b1);
                } else {
                    bf16_t* dst = rowp + pn * 256 + wc * 32 + i8;
                    if (pn == 6 || pn == 7) { store8(dst, a0 * sigm4(a0), a1 * sigm4(a1)); store8(dst + 128, b0 * sigm4(b0), b1 * sigm4(b1)); }
                    else if (pn == 11 || pn == 12) { store8(dst, a0 * 0.18033688011112042f, a1 * 0.18033688011112042f); store8(dst + 128, b0 * 0.18033688011112042f, b1 * 0.18033688011112042f); }
                    else if (GATES && pn >= 17) { store8(dst, sigm4(a0), sigm4(a1)); store8(dst + 128, sigm4(b0), sigm4(b1)); }
                    else { store8(dst, a0, a1); store8(dst + 128, b0, b1); }
                }
            }
    }
};
template <class Epi, class Sched, bool ALIGN_EPI = false, bool SP2 = false, bool FP8 = false>
__device__ __forceinline__ void gemm_phase(PG8_LAS unsigned char* lds, const Gemm g, const Sched& S, const Epi& E) {
    int tid_ = threadIdx.x; asm volatile("" : "+v"(tid_));
    const int tid = tid_, wid = __builtin_amdgcn_readfirstlane(tid >> 6), lane = tid & 63, wr = wid >> 2, wc = wid & 3, fr = lane & 15, fq = lane >> 4;
    const int K = g.K, nt = K / BK;
    unsigned voffA[2], voffB[2];
#pragma unroll
    for (int i = 0; i < 2; ++i) { int R, C; stage_rc(tid * 16 + i * 8192, R, C); const int Rb = Epi::PERM ? ((R & ~31) + perm32(R & 31)) : R;
        voffA[i] = (unsigned)(R * K + C) * 2u; voffB[i] = (unsigned)(Rb * K + C) * 2u; }
    const size_t kstep = (size_t)(BK * 2);
    const size_t hstep = (size_t)HALF * K * 2;
    const size_t tstep = 2 * hstep;
    const unsigned ldsw = (unsigned)wid * 1024u;
    const int aoff = lds_byte(wr * 64 + fr, fq * 8), boff = lds_byte(wc * 32 + fr, fq * 8);
    const int cb8 = 32 * fq, rr8 = fr & 15;
    const int aoff8 = (((wr * 64 + fr) >> 4) * 2 + (cb8 >> 6)) * 1024 + ((rr8 * 64 + (cb8 & 63)) ^ ((rr8 >> 3) << 5));
    const int boff8 = (((wc * 32 + fr) >> 4) * 2 + (cb8 >> 6)) * 1024 + ((rr8 * 64 + (cb8 & 63)) ^ ((rr8 >> 3) << 5));
#define PG8_SA(b, h) (((b) * 2 + (h)) * HTB)
#define PG8_SB(b, h) ((4 + (b) * 2 + (h)) * HTB)
#define PG8_STAGE(bufoff, gbase, voff) do { _Pragma("unroll") for (int _i = 0; _i < 2; ++_i) \
        __builtin_amdgcn_global_load_lds((const unsigned*)((const char*)(gbase) + (voff)[_i]), (PG8_LAS unsigned*)(lds + (bufoff) + ldsw + _i * 8192), 16, 0, 0); } while (0)
#define PG8_LDA(dst, b, h) do { if constexpr (FP8) { _Pragma("unroll") for (int m = 0; m < 4; ++m) dst##8[m] = *(const PG8_LAS v8i32*)(lds + PG8_SA(b, h) + aoff8 + m * 2048); } else { _Pragma("unroll") for (int m = 0; m < 4; ++m) _Pragma("unroll") for (int k = 0; k < 2; ++k) dst[m][k] = *(const PG8_LAS bf16x8*)(lds + PG8_SA(b, h) + aoff + m * 2048 + k * 1024); } } while (0)
#define PG8_LDB(dst, b, h) do { if constexpr (FP8) { _Pragma("unroll") for (int n = 0; n < 2; ++n) dst##8[n] = *(const PG8_LAS v8i32*)(lds + PG8_SB(b, h) + boff8 + n * 2048); } else { _Pragma("unroll") for (int n = 0; n < 2; ++n) _Pragma("unroll") for (int k = 0; k < 2; ++k) dst[n][k] = *(const PG8_LAS bf16x8*)(lds + PG8_SB(b, h) + boff + n * 2048 + k * 1024); } } while (0)
#define PG8_MMA(ai, bj, At, Bt) do { __builtin_amdgcn_s_setprio(1); if constexpr (FP8) { _Pragma("unroll") for (int m = 0; m < 4; ++m) _Pragma("unroll") for (int n = 0; n < 2; ++n) \
        asm volatile("v_mfma_scale_f32_16x16x128_f8f6f4 %0, %1, %2, %0, %3, %3 op_sel_hi:[0,0,0]" : "+v"(acc[ai][bj][m][n]) : "v"(Bt##8[n]), "v"(At##8[m]), "v"(sc127)); } else { \
        _Pragma("unroll") for (int m = 0; m < 4; ++m) _Pragma("unroll") for (int n = 0; n < 2; ++n) _Pragma("unroll") for (int k = 0; k < 2; ++k) \
        acc[ai][bj][m][n] = __builtin_amdgcn_mfma_f32_16x16x32_bf16(Bt[n][k], At[m][k], acc[ai][bj][m][n], 0, 0, 0); } __builtin_amdgcn_s_setprio(0); } while (0)
#define PG8_WAIT_V(n) asm volatile("s_waitcnt vmcnt(" #n ")" ::: "memory")
#define PG8_WAIT_L(n) asm volatile("s_waitcnt lgkmcnt(" #n ")" ::: "memory")
#define PG8_BAR __builtin_amdgcn_s_barrier()
#define PG8_SCHED __builtin_amdgcn_sched_barrier(0)
    Unit cur, nxt; int ui = 0;
    if (!S.next(0, cur)) return;
    f32x4 acc[2][2][4][2];
#pragma unroll
    for (int a = 0; a < 2; ++a)
#pragma unroll
        for (int b = 0; b < 2; ++b)
#pragma unroll
            for (int m = 0; m < 4; ++m)
#pragma unroll
                for (int n = 0; n < 2; ++n) acc[a][b][m][n] = (f32x4){0.f, 0.f, 0.f, 0.f};
    bf16x8 At[4][2], B0[2][2], B1[2][2];
    v8i32 At8[4], B08[2], B18[2]; const int sc127 = 127;
    const char* cA = (const char*)g.A + (size_t)cur.pm * tstep; const char* cB = (const char*)g.Bt + (size_t)cur.pn * tstep;
    S.a_ready(cur);
    if constexpr (SP2) {
        PG8_STAGE(PG8_SB(0, 0), cB, voffB); PG8_STAGE(PG8_SB(0, 1), cB + hstep, voffB); PG8_STAGE(PG8_SA(0, 0), cA, voffA); PG8_STAGE(PG8_SA(0, 1), cA + hstep, voffA);
        if (wr == 1) PG8_BAR;
        PG8_WAIT_V(2); PG8_BAR;
        PG8_STAGE(PG8_SB(1, 0), cB + kstep, voffB); PG8_STAGE(PG8_SA(1, 0), cA + kstep, voffA); PG8_STAGE(PG8_SB(1, 1), cB + hstep + kstep, voffB);
        PG8_WAIT_V(6); PG8_BAR;
    } else {
        PG8_STAGE(PG8_SB(0, 0), cB, voffB); PG8_STAGE(PG8_SA(0, 0), cA, voffA); PG8_STAGE(PG8_SB(0, 1), cB + hstep, voffB); PG8_STAGE(PG8_SA(0, 1), cA + hstep, voffA);
        if (wr == 1) PG8_BAR;
        PG8_WAIT_V(4); PG8_BAR;
        PG8_STAGE(PG8_SB(1, 0), cB + kstep, voffB); PG8_STAGE(PG8_SA(1, 0), cA + kstep, voffA); PG8_STAGE(PG8_SB(1, 1), cB + hstep + kstep, voffB);
        PG8_WAIT_V(6); PG8_BAR;
    }
    for (;;) {
        const bool has_next = S.next(ui + 1, nxt);
        const char* nA = has_next ? (const char*)g.A + (size_t)nxt.pm * tstep : cA; const char* nB = has_next ? (const char*)g.Bt + (size_t)nxt.pn * tstep : cB;
        for (int t = 0; t < nt; t += 2) {
            const bool last = (t == nt - 2);
            const char* a1 = cA + (size_t)(t + 1) * kstep;
            const char* a2 = last ? nA : cA + (size_t)(t + 2) * kstep; const char* b2 = last ? nB : cB + (size_t)(t + 2) * kstep;
            const char* a3 = a2 + kstep; const char* b3 = b2 + kstep;
            if (last && has_next) S.a_ready(nxt);
            if constexpr (SP2) {
            PG8_LDB(B0, 0, 0); PG8_LDB(B1, 0, 1); PG8_SCHED; PG8_LDA(At, 0, 0); PG8_STAGE(PG8_SA(1, 1), a1 + hstep, voffA);
            PG8_WAIT_V(8); PG8_WAIT_L(0); PG8_BAR; PG8_MMA(0, 0, At, B0); PG8_MMA(0, 1, At, B1); PG8_BAR; PG8_SCHED;
            PG8_LDA(At, 0, 1); PG8_STAGE(PG8_SB(0, 0), b2, voffB); PG8_STAGE(PG8_SB(0, 1), b2 + hstep, voffB); PG8_STAGE(PG8_SA(0, 0), a2, voffA);
            PG8_WAIT_V(8); PG8_WAIT_L(0); PG8_BAR; PG8_MMA(1, 0, At, B0); PG8_MMA(1, 1, At, B1); PG8_BAR; PG8_SCHED;
            PG8_LDB(B0, 1, 0); PG8_LDB(B1, 1, 1); PG8_SCHED; PG8_LDA(At, 1, 0); PG8_STAGE(PG8_SA(0, 1), a2 + hstep, voffA);
            PG8_WAIT_V(8); PG8_WAIT_L(0); PG8_BAR; PG8_MMA(0, 0, At, B0); PG8_MMA(0, 1, At, B1); PG8_BAR; PG8_SCHED;
            PG8_LDA(At, 1, 1); PG8_STAGE(PG8_SB(1, 0), b3, voffB); PG8_STAGE(PG8_SB(1, 1), b3 + hstep, voffB); PG8_STAGE(PG8_SA(1, 0), a3, voffA);
            PG8_WAIT_V(8); PG8_WAIT_L(0); PG8_BAR; PG8_MMA(1, 0, At, B0); PG8_MMA(1, 1, At, B1); PG8_BAR; PG8_SCHED;
            } else {
            PG8_LDB(B0, 0, 0); PG8_SCHED; PG8_LDA(At, 0, 0); PG8_STAGE(PG8_SA(1, 1), a1 + hstep, voffA);
            PG8_WAIT_L(8); PG8_BAR; PG8_WAIT_L(0); PG8_MMA(0, 0, At, B0); PG8_BAR; PG8_SCHED;
            PG8_LDB(B1, 0, 1); PG8_STAGE(PG8_SB(0, 0), b2, voffB);
            PG8_BAR; PG8_WAIT_L(0); PG8_MMA(0, 1, At, B1); PG8_BAR;
            PG8_LDA(At, 0, 1); PG8_STAGE(PG8_SA(0, 0), a2, voffA);
            PG8_BAR; PG8_WAIT_L(0); PG8_MMA(1, 0, At, B0); PG8_BAR; PG8_SCHED;
            PG8_STAGE(PG8_SB(0, 1), b2 + hstep, voffB);
            PG8_WAIT_V(6); PG8_BAR; PG8_MMA(1, 1, At, B1); PG8_BAR;
            PG8_LDB(B0, 1, 0); PG8_SCHED; PG8_LDA(At, 1, 0); PG8_STAGE(PG8_SA(0, 1), a2 + hstep, voffA);
            PG8_WAIT_L(8); PG8_BAR; PG8_WAIT_L(0); PG8_MMA(0, 0, At, B0); PG8_BAR; PG8_SCHED;
            PG8_LDB(B1, 1, 1); PG8_STAGE(PG8_SB(1, 0), b3, voffB);
            PG8_BAR; PG8_WAIT_L(0); PG8_MMA(0, 1, At, B1); PG8_BAR;
            PG8_LDA(At, 1, 1); PG8_STAGE(PG8_SA(1, 0), a3, voffA);
            PG8_BAR; PG8_WAIT_L(0); PG8_MMA(1, 0, At, B0); PG8_BAR; PG8_SCHED;
            PG8_STAGE(PG8_SB(1, 1), b3 + hstep, voffB);
            PG8_WAIT_V(6); PG8_BAR; PG8_MMA(1, 1, At, B1); PG8_BAR;
            }
        }
        if constexpr (ALIGN_EPI) { if (wr == 0) PG8_BAR; }
        if constexpr (FP8) asm volatile("s_nop 15\n\ts_nop 7" ::: "memory");
        if constexpr (!Epi::AFTER_DRAIN) { E(acc, cur, wr, wc, fr, fq); S.done(cur); }
        if (!has_next) break;
        if constexpr (!Epi::KEEP_ACC) {
#pragma unroll
        for (int a = 0; a < 2; ++a)
#pragma unroll
            for (int b = 0; b < 2; ++b)
#pragma unroll
                for (int m = 0; m < 4; ++m)
#pragma unroll
                    for (int n = 0; n < 2; ++n) acc[a][b][m][n] = (f32x4){0.f, 0.f, 0.f, 0.f};
        }
        cur = nxt; cA = nA; cB = nB; ++ui;
        if constexpr (ALIGN_EPI) { if (wr == 1) PG8_BAR; }
    }
    PG8_WAIT_V(0);
    if constexpr (!ALIGN_EPI) { if (wr == 0) PG8_BAR; }
    PG8_BAR;
    if constexpr (Epi::AFTER_DRAIN) { E.fused(acc, cur, wr, wc, fr, fq, lds, wid, lane); S.done(cur); }
#undef PG8_SA
#undef PG8_SB
#undef PG8_STAGE
#undef PG8_LDA
#undef PG8_LDB
#undef PG8_MMA
#undef PG8_WAIT_V
#undef PG8_WAIT_L
#undef PG8_BAR
#undef PG8_SCHED
}
}

#define XB_TMO      128
#define XB_XCNT(j)  (256  + 64 * (j))
#define XB_XSUB(j)  (1280 + 64 * (j))
#define XB_XGEN(j)  (2304 + 64 * (j))
#define XB_TOP      3328
#define XB_TOPGEN   3392
#define XCD_BAR_WORDS 3456
#define XB_SPIN_CAP (1u << 18)

__device__ __forceinline__ unsigned xb_ld(unsigned* p)              { return __hip_atomic_load(p, __ATOMIC_RELAXED, __HIP_MEMORY_SCOPE_AGENT); }
__device__ __forceinline__ unsigned xb_add(unsigned* p, unsigned v) { return __hip_atomic_fetch_add(p, v, __ATOMIC_RELAXED, __HIP_MEMORY_SCOPE_AGENT); }
__device__ __forceinline__ unsigned xb_xcc_id() { return (unsigned)__builtin_amdgcn_s_getreg((3 << 11) | 20) & 0xFu; }
#define XB_SPIN(cond, bar) do { unsigned _sp = 0; while (cond) { __builtin_amdgcn_s_sleep(1); \
    if ((++_sp & 255u) == 0u) { if (xb_ld(&(bar)[XB_TMO])) break; if (_sp > XB_SPIN_CAP) { atomicAdd(&(bar)[XB_TMO], 1u); break; } } } } while (0)

struct XcdBarrier {
    unsigned* bar; unsigned x;
    volatile LAS unsigned* st;
};

__device__ __forceinline__ XcdBarrier xcd_barrier_post(unsigned* bar, volatile LAS unsigned* st) {
    XcdBarrier b; b.bar = bar; b.x = xb_xcc_id(); b.st = st;
    if (threadIdx.x == 0) (void)xb_add(&bar[XB_XCNT(b.x)], 1u);
    return b;
}
__device__ __forceinline__ void xcd_barrier_complete(unsigned* bar, unsigned x, unsigned& nloc, unsigned& nx) {
    const unsigned G = gridDim.x * gridDim.y * gridDim.z;
    unsigned sum, cnt, mine, sp = 0u;
    for (;;) {
        sum = 0u; cnt = 0u; mine = 0u;
#pragma unroll
        for (unsigned j = 0; j < 16; ++j) { const unsigned c = xb_ld(&bar[XB_XCNT(j)]); sum += c; cnt += (c > 0u) ? 1u : 0u; mine = (j == x) ? c : mine; }
        if (sum == G) break;
        __builtin_amdgcn_s_sleep(1);
        if ((++sp & 255u) == 0u) { if (xb_ld(&bar[XB_TMO])) break; if (sp > XB_SPIN_CAP) { atomicAdd(&bar[XB_TMO], 1u); break; } }
    }
    nloc = mine > 0u ? mine : 1u; nx = cnt > 0u ? cnt : 1u;
}

__device__ __forceinline__ void xcd_barrier(const XcdBarrier& b) {
    asm volatile("s_waitcnt vmcnt(0)" ::: "memory");
    __syncthreads();
    if (threadIdx.x == 0) {
        unsigned* bar = b.bar;
        __builtin_amdgcn_s_waitcnt(0);
        unsigned nloc = b.st[0], nx = b.st[1];
        if (nloc == 0u) { xcd_barrier_complete(bar, b.x, nloc, nx); b.st[0] = nloc; b.st[1] = nx; }
        const unsigned old = xb_add(&bar[XB_XSUB(b.x)], 1u);
        const unsigned gen = old / nloc;
        if (old + 1u == (gen + 1u) * nloc) {
            __builtin_amdgcn_fence(__ATOMIC_RELEASE, "agent");
            asm volatile("s_waitcnt vmcnt(0)" ::: "memory");
            const unsigned og = xb_add(&bar[XB_TOP], 1u);
            const unsigned tg = og / nx;
            if (og + 1u == (tg + 1u) * nx) xb_add(&bar[XB_TOPGEN], 1u);
            else XB_SPIN(xb_ld(&bar[XB_TOPGEN]) == tg, bar);
            __builtin_amdgcn_fence(__ATOMIC_ACQUIRE, "agent");
            xb_add(&bar[XB_XGEN(b.x)], 1u);
            asm volatile("s_waitcnt vmcnt(0)" ::: "memory");
        } else {
            XB_SPIN(xb_ld(&bar[XB_XGEN(b.x)]) == gen, bar);
            __builtin_amdgcn_fence(__ATOMIC_ACQUIRE, "agent");
            asm volatile("s_waitcnt vmcnt(0)" ::: "memory");
        }
    }
    __syncthreads();
}

constexpr int D = 1024, NB = 8, SEQ = 2048, LC = 256, DEPTH = 4;
constexpr int ML = NB * SEQ, MC = NB * LC, MT = ML + MC;
constexpr int DIN = 7424, FFD = 2816, FFE = 3584, NE = 8;
constexpr int PS = 4352;
constexpr int MSORT = 38912;
constexpr float EPS = 1e-6f;
constexpr int NWAVES = 8, NTHREADS = 512;
#ifndef MK_PER_PHASE
#define MK_PER_PHASE 0
#endif
constexpr int NPH = 2 + 11 * DEPTH;
#ifndef MK_EN
#define MK_EN 0xFFFFFFFFu
#endif
#ifndef MK_DUMP
#define MK_DUMP 0
#endif
#ifndef MK_F8
#define MK_F8 0x2F
#endif
constexpr bool F8IN = (MK_F8 & 16) != 0, F8GATE = (MK_F8 & 32) != 0;
constexpr bool F8UP_D = (MK_F8 & 1) != 0, F8DN_D = (MK_F8 & 2) != 0, F8UP_M = (MK_F8 & 4) != 0, F8DN_M = (MK_F8 & 8) != 0;
#ifndef MK_REP
#define MK_REP 0u
#endif
#ifndef MK_NPH_RUN
#define MK_NPH_RUN NPH
#endif

constexpr size_t MiB = (size_t)1 << 20;
constexpr size_t WS_CTL = 0, CTL_ZERO_BYTES = MiB;
constexpr size_t WS_MOD = 1 * MiB;
constexpr size_t WS_TAB = 2 * MiB;
constexpr size_t WS_ROUTE = 4 * MiB;
constexpr size_t WS_HC = 5 * MiB;
constexpr size_t WS_XN = 13 * MiB;
constexpr size_t WS_YOUT = 49 * MiB;
constexpr size_t WS_WIN = 85 * MiB, WS_WBR = 143 * MiB, WS_WOUT = 155 * MiB, WS_WF13 = 163 * MiB, WS_WF2 = 185 * MiB, WS_WM13 = 196 * MiB, WS_WM2 = 420 * MiB;
constexpr size_t WS_OVL = 532 * MiB;
constexpr size_t WS_PROJ = WS_OVL, WS_YBR = WS_OVL + 261 * MiB, WS_KV = WS_OVL + 315 * MiB, WS_ST = WS_OVL + 387 * MiB;
constexpr size_t WS_TMP = WS_KV, WS_MERGED = WS_ST;
constexpr size_t WS_PART = WS_OVL;
constexpr size_t WS_G8 = WS_OVL + 153 * MiB;
constexpr size_t WS_ASORT = WS_OVL, WS_HID = WS_OVL + 76 * MiB, WS_OSORT = WS_OVL + 342 * MiB;
constexpr size_t WS_HB = WS_OVL + 423 * MiB;
constexpr size_t WS_WIN8 = WS_HB + 36 * MiB;
constexpr size_t WS_XN8 = WS_WIN8 + 12 * MiB;
constexpr size_t WS_END = WS_XN8 + 18 * MiB;
static_assert(WS_OSORT + (size_t)MSORT * D * 2 <= WS_END && WS_ST + 36 * MiB <= WS_END, "map");
constexpr int TAB_RTC = 0, TAB_RTS = 2304 * 64, TAB_AXC = 2 * 2304 * 64, TAB_AXS = 2 * 2304 * 64 + 2048 * 32;
constexpr int CW_BAR = 4096, CW_MOE = 8192, CW_WQ = 12288, CW_RFLAG = 24576, CW_PFLAG = 32768;

constexpr int LDS_BYTES = 147456, MISC_OFF = 131072 + 320;

#define GAS __attribute__((address_space(1)))
#define DEV __device__ __forceinline__
typedef unsigned short bf16;
typedef float f32x4 __attribute__((ext_vector_type(4)));
typedef short bf16x8 __attribute__((ext_vector_type(8)));
typedef short s16x4 __attribute__((ext_vector_type(4)));
typedef unsigned u32x4 __attribute__((ext_vector_type(4)));
typedef unsigned u32x2 __attribute__((ext_vector_type(2)));
#define MFMA16(a, b, c) __builtin_amdgcn_mfma_f32_16x16x32_bf16((a), (b), (c), 0, 0, 0)
DEV float bf2f(unsigned short b) { return __uint_as_float(((unsigned)b) << 16); }
DEV float bflo(unsigned u) { return __uint_as_float(u << 16); }
DEV float bfhi(unsigned u) { return __uint_as_float(u & 0xffff0000u); }
DEV unsigned pk2(float lo, float hi) { return pg8::cvt_pk_bf16(lo, hi); }
DEV unsigned short f2bf(float f) { return (unsigned short)(pg8::cvt_pk_bf16(f, 0.f) & 0xffffu); }
template <int CTRL> DEV float dpp_add(float v) { return v + __int_as_float(__builtin_amdgcn_update_dpp(0, __float_as_int(v), CTRL, 0xf, 0xf, true)); }
DEV float wave_sum(float v) {
    v = dpp_add<0xB1>(v); v = dpp_add<0x4E>(v); v = dpp_add<0x141>(v); v = dpp_add<0x140>(v);
    const int iv = __float_as_int(v);
    return (__int_as_float(__builtin_amdgcn_readlane(iv, 0)) + __int_as_float(__builtin_amdgcn_readlane(iv, 16))) + (__int_as_float(__builtin_amdgcn_readlane(iv, 32)) + __int_as_float(__builtin_amdgcn_readlane(iv, 48)));
}
DEV bf16x8 pack8(const f32x4 a, const f32x4 b) { u32x4 w; w.x = pk2(a[0], a[1]); w.y = pk2(a[2], a[3]); w.z = pk2(b[0], b[1]); w.w = pk2(b[2], b[3]); return __builtin_bit_cast(bf16x8, w); }

struct Args { const float* in[20]; float* out; unsigned char* ws; int ph_lo, ph_hi, li, pad; };
enum { I_X = 0, I_C, I_CTX, I_CCTX, I_WMOD, I_BMOD, I_GAINS, I_WIN, I_DECAY, I_SINK, I_RPB, I_WBR, I_WOUT, I_F1, I_F3, I_F2, I_ROUTER, I_M1, I_M3, I_M2 };

DEV void p0_transpose_item(const float* W, int K, int N, bf16* WT, LAS float* scr, int kb, int n0, int drow0, int lane) {
    const int k0 = 64 * kb;
#pragma unroll 8
    for (int i = 0; i < 32; ++i) { const int kk = 2 * i + (lane >> 5); scr[kk * 33 + (lane & 31)] = __builtin_nontemporal_load(W + (size_t)(k0 + kk) * N + n0 + (lane & 31)); }
    asm volatile("s_waitcnt lgkmcnt(0)" ::: "memory");
    const int c = lane & 7;
#pragma unroll
    for (int j = 0; j < 4; ++j) { const int n = (lane >> 3) + 8 * j; const LAS float* s = scr + (8 * c) * 33 + n;
        u32x4 o; o.x = pk2(s[0 * 33], s[1 * 33]); o.y = pk2(s[2 * 33], s[3 * 33]); o.z = pk2(s[4 * 33], s[5 * 33]); o.w = pk2(s[6 * 33], s[7 * 33]);
        __builtin_nontemporal_store(o, (u32x4*)(WT + (size_t)(drow0 + n) * K + k0 + 8 * c)); }
    asm volatile("s_waitcnt lgkmcnt(0)" ::: "memory");
}

DEV float clampf8(float v) { return __builtin_amdgcn_fmed3f(v, -448.0f, 448.0f); }
DEV unsigned pk4f8(float a, float b, float c, float d) { a = clampf8(a); b = clampf8(b); c = clampf8(c); d = clampf8(d); unsigned w = 0; w = __builtin_amdgcn_cvt_pk_fp8_f32(a, b, w, false); w = __builtin_amdgcn_cvt_pk_fp8_f32(c, d, w, true); return w; }
DEV void p0_transpose_item_f8(const float* W, int K, int N, unsigned char* WT, LAS float* scr, int kb, int n0, int drow0, float scale, int lane) {
    const int k0 = 64 * kb;
#pragma unroll 8
    for (int i = 0; i < 32; ++i) { const int kk = 2 * i + (lane >> 5); scr[kk * 33 + (lane & 31)] = __builtin_nontemporal_load(W + (size_t)(k0 + kk) * N + n0 + (lane & 31)) * scale; }
    asm volatile("s_waitcnt lgkmcnt(0)" ::: "memory");
    const int c = lane & 3;
#pragma unroll
    for (int j = 0; j < 2; ++j) { const int n = (lane >> 2) + 16 * j; const LAS float* s = scr + (16 * c) * 33 + n;
        u32x4 o; o.x = pk4f8(s[0 * 33], s[1 * 33], s[2 * 33], s[3 * 33]); o.y = pk4f8(s[4 * 33], s[5 * 33], s[6 * 33], s[7 * 33]);
        o.z = pk4f8(s[8 * 33], s[9 * 33], s[10 * 33], s[11 * 33]); o.w = pk4f8(s[12 * 33], s[13 * 33], s[14 * 33], s[15 * 33]);
        __builtin_nontemporal_store(o, (u32x4*)(WT + (size_t)(drow0 + n) * K + k0 + 16 * c)); }
    asm volatile("s_waitcnt lgkmcnt(0)" ::: "memory");
}
DEV int inproj_dest_row(int n0) {
    const int pn = n0 >> 8, wi = n0 & 255;
    if (pn < 4) { const int hl = wi >> 7, rem = wi & 127, half = rem >> 6, i = rem & 63; return pn * 256 + half * 128 + hl * 64 + i; }
    if (pn == 8 || pn == 9) { const int hl = wi >> 6, rem = wi & 63, half = rem >> 5, i = rem & 31; return pn * 256 + half * 128 + hl * 32 + i; }
    if (pn == 10) { const int isv = wi >> 7, w2 = wi & 127, hl = w2 >> 6, half = (w2 & 63) >> 5, i = w2 & 31; return 2560 + half * 128 + (2 * isv + hl) * 32 + i; }
    return n0;
}
DEV void p0_prologue(const Args& A, LAS unsigned char* lds, int vcu, int G, int tid) {
    const int wave = __builtin_amdgcn_readfirstlane(tid >> 6), lane = tid & 63;
    unsigned char* ws = A.ws;
    {
        LAS float* sc = (LAS float*)lds;
        LAS float* red = (LAS float*)(lds + 9 * 1024 * 4);
        for (int i = tid; i < 9 * 1024; i += NTHREADS) { const int r = i >> 10, k = i & 1023; const float v = r < 8 ? A.in[I_C][r * 1024 + k] : A.in[I_CCTX][k]; sc[i] = v / (1.0f + __expf(-v)); }
        __syncthreads();
        float* MOD = (float*)(ws + WS_MOD);
        for (int it = vcu; it < 4 * 96; it += G) {
            const int l = it / 96, cg = it % 96, col = cg * 64 + lane;
            const float* W = A.in[I_WMOD] + (size_t)l * 1024 * 6144 + col;
            float acc[9];
#pragma unroll
            for (int r = 0; r < 9; ++r) acc[r] = 0.f;
#pragma unroll 4
            for (int kk = 0; kk < 128; ++kk) { const int k = wave * 128 + kk; const float w = __builtin_nontemporal_load(W + (size_t)k * 6144);
#pragma unroll
                for (int r = 0; r < 9; ++r) acc[r] += sc[r * 1024 + k] * w; }
#pragma unroll
            for (int r = 0; r < 9; ++r) red[(wave * 9 + r) * 64 + lane] = acc[r];
            __syncthreads();
            for (int o = tid; o < 9 * 64; o += NTHREADS) { const int r = o >> 6, ln = o & 63; float s = 0.f;
#pragma unroll
                for (int w = 0; w < 8; ++w) s += red[(w * 9 + r) * 64 + ln];
                MOD[((size_t)l * 9 + r) * 6144 + cg * 64 + ln] = s + A.in[I_BMOD][l * 6144 + cg * 64 + ln]; }
            __syncthreads();
        }
    }
    {
        float* TAB = (float*)(ws + WS_TAB);
        const int gt = vcu * NTHREADS + tid, NGT = G * NTHREADS;
        for (int i = gt; i < 2304 * 64; i += NGT) { const int pos = i >> 6, f = i & 63; const float inv = exp2f(-(float)f * (13.287712379549449f / 64.0f)); const float ang = (float)pos * inv; float s, c; sincosf(ang, &s, &c); TAB[TAB_RTC + i] = c; TAB[TAB_RTS + i] = s; }
        for (int i = gt; i < 2048 * 32; i += NGT) { const int t = i >> 5, f = i & 31; const float inv = exp2f(-(float)(f & 15) * (13.287712379549449f / 16.0f)); const float p = (f < 16) ? (float)(t >> 6) : (float)(t & 63); const float ang = p * inv; float s, c; sincosf(ang, &s, &c); TAB[TAB_AXC + i] = c; TAB[TAB_AXS + i] = s; }
    }
    __syncthreads();
    {
        LAS float* scr = (LAS float*)(lds + wave * 16384);
        const int gw = vcu * NWAVES + wave, NGW = G * NWAVES;
        constexpr int C_IN = 16 * 232, C_BR = 8 * 32, C_OUT = 16 * 32, C_F13 = 16 * 88, C_F2 = 44 * 32, C_M13 = 16 * 112, C_M2 = 56 * 32;
        constexpr int N_IN = 4 * C_IN, N_BR = 12 * C_BR, N_OUT = 4 * C_OUT, N_F13 = 4 * C_F13, N_F2 = 2 * C_F2, N_M13 = 32 * C_M13, N_M2 = 16 * C_M2;
        constexpr int NITEMS = N_IN + N_BR + N_OUT + N_F13 + N_F2 + N_M13 + N_M2;
        for (int it = gw; it < NITEMS; it += NGW) {
            int r = it;
            if (r < N_IN) { const int l = r / C_IN, q = r % C_IN, kb = q / 232, nb = q % 232;
                if constexpr (F8IN) p0_transpose_item_f8(A.in[I_WIN] + (size_t)l * 1024 * DIN, 1024, DIN, ws + WS_WIN + (size_t)l * DIN * 1024, scr, kb, 32 * nb, inproj_dest_row(32 * nb), 64.0f, lane);
                else if (F8GATE && 32 * nb >= 4352) p0_transpose_item_f8(A.in[I_WIN] + (size_t)l * 1024 * DIN, 1024, DIN, ws + WS_WIN8 + (size_t)l * 3072 * 1024, scr, kb, 32 * nb, 32 * nb - 4352, 64.0f, lane);
                else p0_transpose_item(A.in[I_WIN] + (size_t)l * 1024 * DIN, 1024, DIN, (bf16*)(ws + WS_WIN) + (size_t)l * DIN * 1024, scr, kb, 32 * nb, inproj_dest_row(32 * nb), lane);
                continue; } r -= N_IN;
            if (r < N_BR) { const int mtx = r / C_BR, q = r % C_BR, kb = q / 32, nb = q % 32;
                p0_transpose_item(A.in[I_WBR] + (size_t)mtx * 512 * 1024, 512, 1024, (bf16*)(ws + WS_WBR) + (size_t)mtx * 1024 * 512, scr, kb, 32 * nb, 32 * nb, lane); continue; } r -= N_BR;
            if (r < N_OUT) { const int l = r / C_OUT, q = r % C_OUT, kb = q / 32, nb = q % 32;
                p0_transpose_item(A.in[I_WOUT] + (size_t)l * 1024 * 1024, 1024, 1024, (bf16*)(ws + WS_WOUT) + (size_t)l * 1024 * 1024, scr, kb, 32 * nb, 32 * nb, lane); continue; } r -= N_OUT;
            if (r < N_F13) { const int mtx = r / C_F13, q = r % C_F13, kb = q / 88, nb = q % 88, i = mtx >> 1, which = mtx & 1, n0 = 32 * nb;
                if constexpr (F8UP_D) p0_transpose_item_f8(A.in[which ? I_F3 : I_F1] + (size_t)i * 1024 * FFD, 1024, FFD, ws + WS_WF13 + (size_t)i * 2 * FFD * 1024, scr, kb, n0, (n0 >> 7) * 256 + which * 128 + (n0 & 127), 64.0f, lane);
                else p0_transpose_item(A.in[which ? I_F3 : I_F1] + (size_t)i * 1024 * FFD, 1024, FFD, (bf16*)(ws + WS_WF13) + (size_t)i * 2 * FFD * 1024, scr, kb, n0, (n0 >> 7) * 256 + which * 128 + (n0 & 127), lane);
                continue; } r -= N_F13;
            if (r < N_F2) { const int i = r / C_F2, q = r % C_F2, kb = q / 32, nb = q % 32;
                if constexpr (F8DN_D) p0_transpose_item_f8(A.in[I_F2] + (size_t)i * FFD * 1024, FFD, 1024, ws + WS_WF2 + (size_t)i * 1024 * FFD, scr, kb, 32 * nb, 32 * nb, 128.0f, lane);
                else p0_transpose_item(A.in[I_F2] + (size_t)i * FFD * 1024, FFD, 1024, (bf16*)(ws + WS_WF2) + (size_t)i * 1024 * FFD, scr, kb, 32 * nb, 32 * nb, lane);
                continue; } r -= N_F2;
            if (r < N_M13) { const int mtx = r / C_M13, q = r % C_M13, kb = q / 112, nb = q % 112, ie = mtx >> 1, which = mtx & 1, n0 = 32 * nb;
                if constexpr (F8UP_M) p0_transpose_item_f8(A.in[which ? I_M3 : I_M1] + (size_t)ie * 1024 * FFE, 1024, FFE, ws + WS_WM13 + (size_t)ie * 2 * FFE * 1024, scr, kb, n0, (n0 >> 7) * 256 + which * 128 + (n0 & 127), 64.0f, lane);
                else p0_transpose_item(A.in[which ? I_M3 : I_M1] + (size_t)ie * 1024 * FFE, 1024, FFE, (bf16*)(ws + WS_WM13) + (size_t)ie * 2 * FFE * 1024, scr, kb, n0, (n0 >> 7) * 256 + which * 128 + (n0 & 127), lane);
                continue; } r -= N_M13;
            { const int ie = r / C_M2, q = r % C_M2, kb = q / 32, nb = q % 32;
                if constexpr (F8DN_M) p0_transpose_item_f8(A.in[I_M2] + (size_t)ie * FFE * 1024, FFE, 1024, ws + WS_WM2 + (size_t)ie * 1024 * FFE, scr, kb, 32 * nb, 32 * nb, 128.0f, lane);
                else p0_transpose_item(A.in[I_M2] + (size_t)ie * FFE * 1024, FFE, 1024, (bf16*)(ws + WS_WM2) + (size_t)ie * 1024 * FFE, scr, kb, 32 * nb, 32 * nb, lane); }
        }
    }
}

DEV void ld_row_f32(const float* p, int lane, f32x4 (&v)[4]) {
#pragma unroll
    for (int j = 0; j < 4; ++j) v[j] = __builtin_nontemporal_load((const f32x4*)(p + 4 * lane + 256 * j));
}
DEV void ld_row_bf16(const bf16* p, int lane, f32x4 (&v)[4]) {
#pragma unroll
    for (int j = 0; j < 4; ++j) { const u32x2 u = *(const u32x2*)(p + 4 * lane + 256 * j); v[j][0] = bflo(u.x); v[j][1] = bfhi(u.x); v[j][2] = bflo(u.y); v[j][3] = bfhi(u.y); }
}
DEV void st_row_bf16(bf16* p, int lane, const f32x4 (&v)[4]) {
#pragma unroll
    for (int j = 0; j < 4; ++j) { u32x2 u; u.x = pk2(v[j][0], v[j][1]); u.y = pk2(v[j][2], v[j][3]); *(u32x2*)(p + 4 * lane + 256 * j) = u; }
}
DEV float row_rstd(const f32x4 (&v)[4]) {
    float s = 0.f;
#pragma unroll
    for (int j = 0; j < 4; ++j) s += (v[j][0] * v[j][0] + v[j][1] * v[j][1]) + (v[j][2] * v[j][2] + v[j][3] * v[j][3]);
    return rsqrtf(wave_sum(s) * (1.0f / 1024.0f) + EPS);
}
DEV void moe_bases(const unsigned* cnt, int (&base)[8]) {
    int acc = 0;
#pragma unroll
    for (int e = 0; e < 8; ++e) { base[e] = acc; const unsigned ce = __hip_atomic_load(cnt + 64 * e, __ATOMIC_RELAXED, __HIP_MEMORY_SCOPE_AGENT); acc += (int)(((ce + 255u) >> 8) << 8); }
}
DEV int sel8(const int (&b)[8], int e) { int r = 0;
#pragma unroll
    for (int k = 0; k < 8; ++k) r = (e == k) ? b[k] : r;
    return r; }

DEV void raw_row_bf16(const bf16* p, int lane, u32x2 (&v)[4]) {
#pragma unroll
    for (int j = 0; j < 4; ++j) v[j] = *(const u32x2*)(p + 4 * lane + 256 * j);
}
DEV void cvt_row_bf16(const u32x2 (&u)[4], f32x4 (&v)[4]) {
#pragma unroll
    for (int j = 0; j < 4; ++j) { v[j][0] = bflo(u[j].x); v[j][1] = bfhi(u[j].x); v[j][2] = bflo(u[j].y); v[j][3] = bfhi(u[j].y); }
}
constexpr int TR = 2;
template <int MODE> DEV void thin_phase(const Args& A, int L, int wid, int nw, int row_lo, int row_hi, int tid, LAS unsigned char* lds) {
    const int wave = __builtin_amdgcn_readfirstlane(tid >> 6), lane = tid & 63;
    const int gw = wid * NWAVES + wave, NGW = nw * NWAVES;
    unsigned char* ws = A.ws;
    const float* MOD = (const float*)(ws + WS_MOD);
    const float* GN = A.in[I_GAINS];
    unsigned char* HC = ws + WS_HB;
    bf16* XN = (bf16*)(ws + WS_XN);
    const bf16* YOUT = (const bf16*)(ws + WS_YOUT);
    int* ROUTE = (int*)(ws + WS_ROUTE);
    const int mi = L >> 1;
    unsigned* cnt = (unsigned*)(ws + WS_CTL) + CW_MOE + mi * 8 * 64;
    int base[8];
    const bool moe2 = (MODE == 2) && (L & 1);
    if (moe2) moe_bases(cnt, base);
    const bool first = (L == 0 && MODE <= 1);
    const bool rout = (MODE == 1) && (L & 1);
    const LAS f32x4* WL = (const LAS f32x4*)lds;
    if (rout) {
        const f32x4* WR4 = (const f32x4*)(A.in[I_ROUTER] + (size_t)mi * 1024 * 8);
        for (int s4 = tid; s4 < 2048; s4 += NTHREADS) { const int k = s4 >> 1, hf_ = s4 & 1; ((LAS f32x4*)lds)[(((k >> 8) * 4 + (k & 3)) * 2 + hf_) * 64 + ((k & 255) >> 2)] = WR4[s4]; }
        __syncthreads();
    }
    const float* gn = GN + L * 4096;
    const bf16* OS = (const bf16*)(ws + WS_OSORT);
    const int nrows_ = row_hi - row_lo, r_beg = row_lo + (int)(((long)gw * nrows_) / NGW), r_end = row_lo + (int)(((long)(gw + 1) * nrows_) / NGW);
    const int Ln = (MODE == 2) ? L + 1 : L;
    f32x4 vgy[4], vgx[4], vgate[4], vsh[4], vsc[4]; int mr_cur = -1;
    if (r_beg < r_end) {
        const float* gy = gn + (MODE == 1 ? 1 : 3) * 1024; const float* gx = GN + Ln * 4096 + (MODE == 1 ? 2 : 0) * 1024;
#pragma unroll
        for (int j = 0; j < 4; ++j) { if (MODE != 0) vgy[j] = *(const f32x4*)(gy + 4 * lane + 256 * j); vgx[j] = *(const f32x4*)(gx + 4 * lane + 256 * j); }
    }
    const bool pre = moe2 && (r_end - r_beg <= 64);
    int4 prq = {0, 0, 0, 0}; int2 prw = {0, 0};
    if (pre && r_beg < r_end) { const int* rt = ROUTE + (size_t)((r_beg + lane < r_end) ? r_beg + lane : r_beg) * 8; prq = *(const int4*)rt; prw = *(const int2*)(rt + 4); }
    for (int m0 = r_beg; m0 < r_end; m0 += TR) {
        int mm[TR]; bool on[TR];
#pragma unroll
        for (int r = 0; r < TR; ++r) { const int m = m0 + r; on[r] = m < r_end; mm[r] = on[r] ? m : m0; }
        int4 rq[TR]; int2 rw[TR];
        if (moe2) {
#pragma unroll
            for (int r = 0; r < TR; ++r) {
                if (pre) { const int k = mm[r] - r_beg;
                    rq[r].x = __builtin_amdgcn_readlane(prq.x, k); rq[r].y = __builtin_amdgcn_readlane(prq.y, k); rq[r].z = __builtin_amdgcn_readlane(prq.z, k); rq[r].w = __builtin_amdgcn_readlane(prq.w, k);
                    rw[r].x = __builtin_amdgcn_readlane(prw.x, k); rw[r].y = __builtin_amdgcn_readlane(prw.y, k); }
                else { const int* rt = ROUTE + (size_t)mm[r] * 8; rq[r] = *(const int4*)rt; rw[r] = *(const int2*)(rt + 4); } }
        }
        f32x4 hf[TR][4]; u32x2 hr[TR][4], ya[TR][4], yb[TR][4];
#pragma unroll
        for (int r = 0; r < TR; ++r) { const int m = mm[r];
            if (first) ld_row_f32(m >= ML ? A.in[I_CTX] + (size_t)(m - ML) * D : A.in[I_X] + (size_t)m * D, lane, hf[r]);
            else raw_row_bf16((const bf16*)HC + (size_t)m * D, lane, hr[r]);
            if (MODE != 0) {
                if (moe2) { raw_row_bf16(OS + (size_t)(sel8(base, rq[r].x) + rq[r].z) * D, lane, ya[r]); raw_row_bf16(OS + (size_t)(sel8(base, rq[r].y) + rq[r].w) * D, lane, yb[r]); }
                else raw_row_bf16(YOUT + (size_t)m * D, lane, ya[r]);
            } }
#pragma unroll
        for (int r = 0; r < TR; ++r) if (on[r]) { const int m = mm[r];
        const bool isc = m >= ML;
        const int mr = isc ? 8 : (m >> 11);
        if (mr != mr_cur) { mr_cur = mr;
            const float* md = MOD + ((size_t)L * 9 + mr) * 6144; const float* mdn = MOD + ((size_t)Ln * 9 + mr) * 6144;
            const float* gate = md + (MODE == 1 ? 2 : 5) * 1024; const float* sh = mdn + (MODE == 1 ? 3 : 0) * 1024; const float* sc = mdn + (MODE == 1 ? 4 : 1) * 1024;
#pragma unroll
            for (int j = 0; j < 4; ++j) { if (MODE != 0) vgate[j] = *(const f32x4*)(gate + 4 * lane + 256 * j); vsh[j] = *(const f32x4*)(sh + 4 * lane + 256 * j); vsc[j] = *(const f32x4*)(sc + 4 * lane + 256 * j); }
        }
        bf16* hb = (bf16*)HC + (size_t)m * D;
        f32x4 h[4];
        if (first) {
#pragma unroll
            for (int j = 0; j < 4; ++j) h[j] = hf[r][j];
        } else cvt_row_bf16(hr[r], h);
        if (MODE != 0) {
            f32x4 y[4];
            if (moe2) {
                const float w0 = __int_as_float(rw[r].x), w1 = __int_as_float(rw[r].y);
                f32x4 y0[4], y1[4]; cvt_row_bf16(ya[r], y0); cvt_row_bf16(yb[r], y1);
#pragma unroll
                for (int j = 0; j < 4; ++j) y[j] = y0[j] * w0 + y1[j] * w1;
            } else cvt_row_bf16(ya[r], y);
            const float rs = row_rstd(y);
#pragma unroll
            for (int j = 0; j < 4; ++j) h[j] = h[j] + vgate[j] * (y[j] * rs * vgy[j]);
            if (MODE == 2 && L == 3) {
#pragma unroll
                for (int j = 0; j < 4; ++j) __builtin_nontemporal_store(h[j], (f32x4*)(A.out + (size_t)m * D + 4 * lane + 256 * j));
            } else st_row_bf16(hb, lane, h);
        }
        if (MODE == 2 && L == 3) continue;
        const float rs = row_rstd(h);
        f32x4 a[4];
#pragma unroll
        for (int j = 0; j < 4; ++j) a[j] = (h[j] * rs * vgx[j]) * (vsc[j] + 1.0f) + vsh[j];
        if ((MODE == 1 && ((L & 1) ? F8UP_M : F8UP_D)) || (MODE != 1 && F8IN)) {
#pragma unroll
            for (int j = 0; j < 4; ++j) *(unsigned*)((unsigned char*)XN + (size_t)m * D + 4 * lane + 256 * j) = pk4f8(a[j][0], a[j][1], a[j][2], a[j][3]);
        } else { st_row_bf16(XN + (size_t)m * D, lane, a);
            if (MODE != 1 && F8GATE) {
#pragma unroll
                for (int j = 0; j < 4; ++j) *(unsigned*)(ws + WS_XN8 + (size_t)m * D + 4 * lane + 256 * j) = pk4f8(a[j][0], a[j][1], a[j][2], a[j][3]); } }
        if (MODE == 1 && (L & 1)) {
            float lg[8];
#pragma unroll
            for (int e = 0; e < 8; ++e) lg[e] = 0.f;
#pragma unroll
            for (int j = 0; j < 4; ++j)
#pragma unroll
                for (int i = 0; i < 4; ++i) { if ((i & 1) == 0) __builtin_amdgcn_sched_barrier(0); const f32x4 w0 = WL[((j * 4 + i) * 2 + 0) * 64 + lane], w1 = WL[((j * 4 + i) * 2 + 1) * 64 + lane]; const float x = a[j][i];
                    lg[0] += x * w0[0]; lg[1] += x * w0[1]; lg[2] += x * w0[2]; lg[3] += x * w0[3]; lg[4] += x * w1[0]; lg[5] += x * w1[1]; lg[6] += x * w1[2]; lg[7] += x * w1[3]; }
#pragma unroll
            for (int e = 0; e < 8; ++e) lg[e] = wave_sum(lg[e]);
            int e0 = 0; float v0 = lg[0];
#pragma unroll
            for (int e = 1; e < 8; ++e) if (lg[e] > v0) { v0 = lg[e]; e0 = e; }
            int e1 = -1; float v1 = -INFINITY;
#pragma unroll
            for (int e = 0; e < 8; ++e) if (e != e0 && lg[e] > v1) { v1 = lg[e]; e1 = e; }
            const float ex = __expf(v1 - v0), w0 = 1.0f / (1.0f + ex), w1 = ex * w0;
            if (lane == 0) {
                const int r0 = (int)__hip_atomic_fetch_add(cnt + 64 * e0, 1u, __ATOMIC_RELAXED, __HIP_MEMORY_SCOPE_AGENT);
                const int r1 = (int)__hip_atomic_fetch_add(cnt + 64 * e1, 1u, __ATOMIC_RELAXED, __HIP_MEMORY_SCOPE_AGENT);
                int* rt = ROUTE + (size_t)m * 8; rt[0] = e0; rt[1] = e1; rt[2] = r0; rt[3] = r1; rt[4] = __float_as_int(w0); rt[5] = __float_as_int(w1);
            }
        }
        }
    }
    if (rout) __syncthreads();
}
DEV void gather_phase(const Args& A, int L, int vcu, int G, int tid) {
    const int wave = __builtin_amdgcn_readfirstlane(tid >> 6), lane = tid & 63;
    const int gw = vcu * NWAVES + wave, NGW = G * NWAVES;
    unsigned char* ws = A.ws;
    const int nrows = (L == 3) ? ML : MT, mi = L >> 1;
    const unsigned* cnt = (const unsigned*)(ws + WS_CTL) + CW_MOE + mi * 8 * 64;
    int base[8]; moe_bases(cnt, base);
    const bf16* XN = (const bf16*)(ws + WS_XN); bf16* AS = (bf16*)(ws + WS_ASORT); const int* ROUTE = (const int*)(ws + WS_ROUTE);
    constexpr int RB = F8UP_M ? D : 2 * D;
    const int t_beg = (int)(((long)gw * nrows) / NGW), t_end = (int)(((long)(gw + 1) * nrows) / NGW);
    for (int c0 = t_beg; c0 < t_end; c0 += 64) {
        const int c1 = (c0 + 64 < t_end) ? c0 + 64 : t_end;
        int d0, d1; { const int4 rq = *(const int4*)(ROUTE + (size_t)((c0 + lane < c1) ? c0 + lane : c0) * 8); d0 = sel8(base, rq.x) + rq.z; d1 = sel8(base, rq.y) + rq.w; }
        for (int k0 = c0; k0 < c1; k0 += 4) {
            u32x4 v[4], w[4];
#pragma unroll
            for (int q = 0; q < 4; ++q) { const int m = k0 + q; if (m < c1) { const u32x4* src = (const u32x4*)((const unsigned char*)XN + (size_t)m * RB); v[q] = src[lane]; if constexpr (!F8UP_M) w[q] = src[lane + 64]; } }
#pragma unroll
            for (int q = 0; q < 4; ++q) { const int m = k0 + q; if (m < c1) {
                const int e0 = __builtin_amdgcn_readlane(d0, m - c0), e1 = __builtin_amdgcn_readlane(d1, m - c0);
                u32x4* p0 = (u32x4*)((unsigned char*)AS + (size_t)e0 * RB); u32x4* p1 = (u32x4*)((unsigned char*)AS + (size_t)e1 * RB);
                p0[lane] = v[q]; p1[lane] = v[q]; if constexpr (!F8UP_M) { p0[lane + 64] = w[q]; p1[lane + 64] = w[q]; } } }
        }
    }
}

#ifndef MK_VTR
#define MK_VTR 1
#endif
constexpr float LOG2E = 1.4426950408889634f;
constexpr int KS_STRIDE = 144;
constexpr int VS_STRIDE = MK_VTR ? 160 : 144;
constexpr int AT_VT = 9216, AT_BUF = AT_VT + 64 * VS_STRIDE, AT_RPB = 2 * AT_BUF, AT_Q = AT_RPB + 8192;
static_assert(AT_Q + 65536 <= 131072, "attention LDS");
typedef short v4i16_t __attribute__((ext_vector_type(4)));
#define AT_SCHED() __builtin_amdgcn_sched_barrier(0)
DEV float xrow16_max(float x) {
    auto s = __builtin_amdgcn_permlane16_swap(__float_as_uint(x), __float_as_uint(x), false, false);
    x = fmaxf(__uint_as_float(s[0]), __uint_as_float(s[1]));
    auto t = __builtin_amdgcn_permlane32_swap(__float_as_uint(x), __float_as_uint(x), false, false);
    return fmaxf(__uint_as_float(t[0]), __uint_as_float(t[1]));
}
DEV float xrow16_sum(float x) {
    auto s = __builtin_amdgcn_permlane16_swap(__float_as_uint(x), __float_as_uint(x), false, false);
    x = __uint_as_float(s[0]) + __uint_as_float(s[1]);
    auto t = __builtin_amdgcn_permlane32_swap(__float_as_uint(x), __float_as_uint(x), false, false);
    return __uint_as_float(t[0]) + __uint_as_float(t[1]);
}
struct KVRegs { u32x4 k, v; };
DEV void kv_load(KVRegs& r, const bf16* kp, const bf16* vp, int tid) {
    const int row = tid >> 3, c = tid & 7;
    r.k = *(const u32x4*)(kp + (size_t)row * PS + 8 * c); r.v = *(const u32x4*)(vp + (size_t)row * PS + 8 * c);
}
DEV void kv_write(LAS unsigned char* buf, const KVRegs& r, int tid) {
    const int row = tid >> 3, c = tid & 7;
    *(LAS u32x4*)(buf + row * KS_STRIDE + c * 16) = r.k;
#if MK_VTR
    *(LAS u32x4*)(buf + AT_VT + row * VS_STRIDE + c * 16) = r.v;
#else
    LAS unsigned short* p = (LAS unsigned short*)(buf + AT_VT) + (8 * c) * (VS_STRIDE / 2) + row;
    p[0 * (VS_STRIDE / 2)] = (unsigned short)(r.v.x & 0xffffu); p[1 * (VS_STRIDE / 2)] = (unsigned short)(r.v.x >> 16);
    p[2 * (VS_STRIDE / 2)] = (unsigned short)(r.v.y & 0xffffu); p[3 * (VS_STRIDE / 2)] = (unsigned short)(r.v.y >> 16);
    p[4 * (VS_STRIDE / 2)] = (unsigned short)(r.v.z & 0xffffu); p[5 * (VS_STRIDE / 2)] = (unsigned short)(r.v.z >> 16);
    p[6 * (VS_STRIDE / 2)] = (unsigned short)(r.v.w & 0xffffu); p[7 * (VS_STRIDE / 2)] = (unsigned short)(r.v.w >> 16);
#endif
}
DEV bf16x8 v_frag(const LAS unsigned char* buf, int u, int dt, int c16, int q4) {
#if MK_VTR
    const LAS unsigned char* vr = buf + AT_VT + (32 * u + 4 * q4 + (c16 >> 2)) * VS_STRIDE + (16 * dt + 4 * (c16 & 3)) * 2;
    const s16x4 lo = __builtin_bit_cast(s16x4, __builtin_amdgcn_ds_read_tr16_b64_v4i16((LAS v4i16_t*)vr));
    const s16x4 hi = __builtin_bit_cast(s16x4, __builtin_amdgcn_ds_read_tr16_b64_v4i16((LAS v4i16_t*)(vr + 16 * VS_STRIDE)));
#else
    const LAS unsigned char* vr = buf + AT_VT + (16 * dt + c16) * VS_STRIDE + (32 * u + 4 * q4) * 2;
    const s16x4 lo = *(const LAS s16x4*)vr, hi = *(const LAS s16x4*)(vr + 32);
#endif
    return __builtin_shufflevector(lo, hi, 0, 1, 2, 3, 4, 5, 6, 7);
}
template <int NT, int TM0, int TM1, int TM2, int TM3, class F0, class F1, class F2, class F3>
DEV void chunk_tiles(const LAS unsigned char* buf, const LAS unsigned char* ql, float (&m_run)[NT], float (&l_run)[NT], f32x4 (&o)[NT][4], int c16, int q4, F0 mf0, F1 mf1, F2 mf2, F3 mf3) {
    constexpr int TM[4] = {TM0, TM1, TM2, TM3};
    constexpr int TMALL = TM0 | TM1 | (NT > 2 ? (TM2 | TM3) : 0);
    f32x4 s[NT][4];
    {
        bf16x8 kf[4][2];
#pragma unroll
        for (int t = 0; t < 4; ++t)
            if ((TMALL >> t) & 1) {
#pragma unroll
                for (int k = 0; k < 2; ++k) kf[t][k] = *(const LAS bf16x8*)(buf + (16 * t + c16) * KS_STRIDE + (32 * k + 8 * q4) * 2);
            }
#pragma unroll
        for (int j = 0; j < NT; ++j) {
            const bf16x8 q0 = *(const LAS bf16x8*)(ql + (2 * j) * 1024), q1 = *(const LAS bf16x8*)(ql + (2 * j + 1) * 1024);
#pragma unroll
            for (int t = 0; t < 4; ++t) {
                f32x4 acc = {0.f, 0.f, 0.f, 0.f};
                if ((TM[j] >> t) & 1) { acc = MFMA16(kf[t][0], q0, acc); acc = MFMA16(kf[t][1], q1, acc); }
                s[j][t] = acc;
            }
        }
    }
    bf16x8 bp[NT][2];
#pragma unroll
    for (int j = 0; j < NT; ++j) {
        float mx = m_run[j];
#pragma unroll
        for (int t = 0; t < 4; ++t)
            if ((TM[j] >> t) & 1) {
#pragma unroll
                for (int r = 0; r < 4; ++r) { const int kk = 16 * t + 4 * q4 + r; float v = s[j][t][r]; v = (j == 0) ? mf0(kk, v) : (j == 1) ? mf1(kk, v) : (j == 2) ? mf2(kk, v) : mf3(kk, v); s[j][t][r] = v; mx = fmaxf(mx, v); }
            }
        mx = xrow16_max(mx);
        const float alpha = __builtin_amdgcn_exp2f(m_run[j] - mx); m_run[j] = mx;
        float ls = 0.f;
#pragma unroll
        for (int t = 0; t < 4; ++t)
            if ((TM[j] >> t) & 1) {
#pragma unroll
                for (int r = 0; r < 4; ++r) { const float p = __builtin_amdgcn_exp2f(s[j][t][r] - mx); s[j][t][r] = p; ls += p; }
            }
        l_run[j] = l_run[j] * alpha + ls;
#pragma unroll
        for (int dt = 0; dt < 4; ++dt) o[j][dt] = o[j][dt] * alpha;
#pragma unroll
        for (int u = 0; u < 2; ++u) bp[j][u] = pack8(s[j][2 * u], s[j][2 * u + 1]);
    }
#pragma unroll
    for (int u = 0; u < 2; ++u)
        if ((TMALL >> (2 * u)) & 3) {
#pragma unroll
            for (int dt = 0; dt < 4; ++dt) { const bf16x8 vf = v_frag(buf, u, dt, c16, q4);
#pragma unroll
                for (int j = 0; j < NT; ++j) if ((TM[j] >> (2 * u)) & 3) o[j][dt] = MFMA16(vf, bp[j][u], o[j][dt]); }
        }
    AT_SCHED();
}
DEV void attn_store(bf16* dst, float l_run, const f32x4 (&o)[4], int q4) {
    const float inv = 1.0f / xrow16_sum(l_run);
#pragma unroll
    for (int dt = 0; dt < 4; ++dt) { u32x2 u; u.x = pk2(o[dt][0] * inv, o[dt][1] * inv); u.y = pk2(o[dt][2] * inv, o[dt][3] * inv); *(u32x2*)(dst + 16 * dt + 4 * q4) = u; }
}
DEV int na_start(int r) { return r - 4 < 0 ? 0 : (r - 4 > 24 ? 24 : r - 4); }
template <int MODE> DEV void attn4_unit(const Args& A, int L, int unit, LAS unsigned char* lds, int tid) {
    constexpr int NT = (MODE == 3) ? 2 : 4;
    const int w = __builtin_amdgcn_readfirstlane(tid >> 6), lane = tid & 63, c16 = lane & 15, q4 = lane >> 4;
    unsigned char* ws = A.ws;
    const bf16* proj = (const bf16*)(ws + WS_PROJ);
    bf16* ybr = (bf16*)(ws + WS_YBR);
    LAS float* RPB = (LAS float*)(lds + AT_RPB);
    int b, h = 0, kcol, vcol, nlat = 0, lat0 = 0, kr0 = 0, tq = 0, rq = 0;
    size_t qrow0; int qcol0; float m_run[NT], l_run[NT]; int kvh = 0;
    if (MODE == 0 || MODE == 2) {
        if (MODE == 0) { const int qb = unit & 15; kvh = (unit >> 4) & 1; b = unit >> 5; tq = qb * 128 + 16 * w + c16;
            const int lo = qb * 128 - 128 < 0 ? 0 : qb * 128 - 128, hi = qb * 128 + 256 > SEQ ? SEQ : qb * 128 + 256; lat0 = lo; nlat = (hi - lo) >> 6; }
        else { const int qb = unit & 1; kvh = (unit >> 1) & 1; b = unit >> 2; tq = qb * 128 + 16 * w + c16; }
        kcol = 2560 + kvh * 64; vcol = 2688 + kvh * 64;
#pragma unroll
        for (int j = 0; j < NT; ++j) { const int hq = kvh * 4 + j; m_run[j] = A.in[I_SINK][L * 8 + hq] * LOG2E; l_run[j] = q4 == 0 ? 1.f : 0.f; }
        qrow0 = (MODE == 0) ? (size_t)b * SEQ + tq : (size_t)ML + b * LC + tq; qcol0 = 2048 + kvh * 4 * 64;
    } else {
        if (MODE == 1) { const int rg = unit & 3; h = (unit >> 2) & 7; b = unit >> 5; rq = 8 * rg + w; kr0 = na_start(8 * rg); nlat = na_start(8 * rg + 7) + 8 - kr0; }
        else { h = unit & 7; b = unit >> 3; }
        kcol = 3328 + h * 64; vcol = 3840 + h * 64;
#pragma unroll
        for (int j = 0; j < NT; ++j) { m_run[j] = -1e30f; l_run[j] = 0.f; }
        qrow0 = (MODE == 1) ? (size_t)b * SEQ + rq * 64 + c16 : (size_t)ML + b * LC + 32 * w + c16; qcol0 = 2816 + h * 64;
    }
    f32x4 o[NT][4];
#pragma unroll
    for (int j = 0; j < NT; ++j)
#pragma unroll
        for (int dt = 0; dt < 4; ++dt) o[j][dt] = (f32x4){0.f, 0.f, 0.f, 0.f};
    constexpr size_t QSTRIDE = (MODE == 0 || MODE == 2) ? (size_t)64 : (size_t)16 * PS;
    const bf16* qb = proj + qrow0 * PS + qcol0 + 8 * q4;
    LAS unsigned char* ql = lds + AT_Q + w * 8192 + lane * 16;
    const int nch = 4 + nlat;
#define CH_ROW0(ci) ((ci) < 4 ? (size_t)ML + b * LC + (ci) * 64 : (MODE == 0 ? (size_t)b * SEQ + lat0 + ((ci) - 4) * 64 : (size_t)b * SEQ + (kr0 + (ci) - 4) * 64))
#define CH_LOAD(R, ci) do { const size_t r_ = CH_ROW0(ci); kv_load(R, proj + r_ * PS + kcol, proj + r_ * PS + vcol, tid); } while (0)
    KVRegs kvA, kvB;
    __syncthreads();
    if (MODE == 1) {
        for (int i = tid; i < 960; i += NTHREADS) { const int rw = i >> 6, dc = (i & 63) - 16; const bool in = dc >= 0 && dc <= 30;
            const float v = in ? A.in[I_RPB][(size_t)(L * 8 + h) * 465 + rw * 31 + dc] * LOG2E : 0.f;
            RPB[i] = v; RPB[960 + i] = (dc >= 7 && dc <= 22) ? v : -INFINITY; } }
    CH_LOAD(kvA, 0);
    CH_LOAD(kvB, 1);
#pragma unroll
    for (int j = 0; j < NT; ++j)
#pragma unroll
        for (int k = 0; k < 2; ++k) *(LAS u32x4*)(ql + (2 * j + k) * 1024) = *(const u32x4*)(qb + j * QSTRIDE + 32 * k);
    kv_write(lds, kvA, tid);
    CH_LOAD(kvA, 2);
    const int sw = na_start(rq);
    auto compute = [&](int ci) {
        const LAS unsigned char* buf = lds + (ci & 1) * AT_BUF;
        if (ci < 4) {
            auto nomask = [](int, float s) { return s; };
            chunk_tiles<NT, 15, 15, 15, 15>(buf, ql, m_run, l_run, o, c16, q4, nomask, nomask, nomask, nomask);
        } else if constexpr (MODE == 0) {
            const int k0 = lat0 + (ci - 4) * 64, tq0 = tq - c16;
            if (k0 >= tq0 + 15 - 128 && k0 + 63 <= tq0 + 128) {
                auto nomask = [](int, float s) { return s; };
                chunk_tiles<NT, 15, 15, 15, 15>(buf, ql, m_run, l_run, o, c16, q4, nomask, nomask, nomask, nomask);
            } else if (k0 + 63 >= tq0 - 128 && k0 <= tq0 + 15 + 128) {
                auto wmask = [=](int kk, float s) { const int d = tq - (k0 + kk); return (d <= 128 && d >= -128) ? s : -INFINITY; };
                chunk_tiles<NT, 15, 15, 15, 15>(buf, ql, m_run, l_run, o, c16, q4, wmask, wmask, wmask, wmask);
            }
        } else if constexpr (MODE == 1) {
            const int kr = kr0 + ci - 4;
            if (kr >= sw && kr < sw + 8) {
                const LAS float* brow = RPB + (kr - rq + 7) * 64 + 16 + 15 - c16;
#define NA_ME(j) [=](int ck, float s) { const int cq = 16 * (j) + c16; const int cs = cq - 8 < 0 ? 0 : (cq - 8 > 48 ? 48 : cq - 8); return ((unsigned)(ck - cs) < 16u) ? s + brow[ck - 16 * (j)] : -INFINITY; }
#define NA_MI(j) [=](int ck, float s) { return s + brow[960 + ck - 16 * (j)]; }
                chunk_tiles<NT, 3, 7, 14, 12>(buf, ql, m_run, l_run, o, c16, q4, NA_ME(0), NA_MI(1), NA_MI(2), NA_ME(3));
#undef NA_ME
#undef NA_MI
            }
        }
    };
    for (int ci = 0; ci < nch; ci += 2) {
        __syncthreads();
        if (ci + 1 < nch) { kv_write(lds + AT_BUF, kvB, tid); if (ci + 3 < nch) CH_LOAD(kvB, ci + 3); }
        AT_SCHED();
        compute(ci);
        if (ci + 1 >= nch) break;
        __syncthreads();
        if (ci + 2 < nch) { kv_write(lds, kvA, tid); if (ci + 4 < nch) CH_LOAD(kvA, ci + 4); }
        AT_SCHED();
        compute(ci + 1);
    }
#undef CH_LOAD
#undef CH_ROW0
#pragma unroll
    for (int j = 0; j < NT; ++j) {
        size_t qr; int oc, br;
        if (MODE == 0 || MODE == 2) { qr = (MODE == 0) ? (size_t)b * SEQ + tq : (size_t)ML + b * LC + tq; oc = (kvh * 4 + j) * 64; br = 1; }
        else { qr = (MODE == 1) ? (size_t)b * SEQ + rq * 64 + 16 * j + c16 : (size_t)ML + b * LC + 32 * w + 16 * j + c16; oc = h * 64; br = 2; }
        attn_store(ybr + ((size_t)br * MT + qr) * 512 + oc, l_run[j], o[j], q4);
    }
}

constexpr int RS = 136;
DEV void ret_unit_ids(int unit, int& b, int& h, int& ck, size_t& row0) {
    ck = unit % 18; const int bh = unit / 18; h = bh & 3; b = bh >> 2;
    row0 = ck < 16 ? (size_t)b * SEQ + ck * 128 : (size_t)ML + b * LC + (ck - 16) * 128;
}
DEV float log_gamma(const Args& A, int L, int dir, int h) { return log1pf(-__expf(A.in[I_DECAY][L * 8 + dir * 4 + h])); }
constexpr int SC_STRIDE = 288;
constexpr int SC_V = 128 * SC_STRIDE;
DEV void scan_unit(const Args& A, int L, int unit, LAS unsigned char* lds, int tid) {
    const int w = __builtin_amdgcn_readfirstlane(tid >> 6), lane = tid & 63, c16 = lane & 15, q4 = lane >> 4;
    const int dir = unit & 1, bh = unit >> 1, h = bh & 3, b = bh >> 2;
    unsigned char* ws = A.ws; const bf16* proj = (const bf16*)(ws + WS_PROJ);
    const float lg = log_gamma(A, L, dir, h), gC = __expf(lg * 128.0f);
    bf16* ST = (bf16*)(ws + WS_ST) + ((size_t)bh * 18 * 2 + dir) * 16384 + (size_t)(16 * w + c16) * 128 + 4 * q4;
#define SC_CK(s) (dir == 0 ? ((s) < 2 ? 16 + (s) : (s) - 2) : 17 - (s))
#define SC_ROW0(ck) ((ck) < 16 ? (size_t)b * SEQ + (ck) * 128 : (size_t)ML + b * LC + ((ck) - 16) * 128)
    u32x4 rk[4], rv[4];
#define SC_LOAD(s) do { const size_t r0_ = SC_ROW0(SC_CK(s)); _Pragma("unroll") for (int i = 0; i < 4; ++i) { const int q = tid + 512 * i, tk = q >> 4, dc = q & 15; \
        rk[i] = *(const u32x4*)(proj + (r0_ + tk) * PS + 512 + h * 128 + 8 * dc); rv[i] = *(const u32x4*)(proj + (r0_ + tk) * PS + 1024 + h * 128 + 8 * dc); } } while (0)
    f32x4 acc[8];
#pragma unroll
    for (int t = 0; t < 8; ++t) acc[t] = (f32x4){0.f, 0.f, 0.f, 0.f};
    SC_LOAD(0);
    for (int s = 0; s < 18; ++s) {
        { bf16* st = ST + (size_t)SC_CK(s) * 32768;
#pragma unroll
          for (int t = 0; t < 8; ++t) { u32x2 o; o.x = pk2(acc[t][0], acc[t][1]); o.y = pk2(acc[t][2], acc[t][3]); *(u32x2*)(st + 16 * t) = o; } }
        if (s == 17) break;
        __syncthreads();
#pragma unroll
        for (int i = 0; i < 4; ++i) { const int q = tid + 512 * i, tk = q >> 4, dc = q & 15;
            const float wt = dir == 0 ? __expf(lg * (float)(127 - tk)) : __expf(lg * (float)tk);
            u32x4 kw; kw.x = pk2(bflo(rk[i].x) * wt, bfhi(rk[i].x) * wt); kw.y = pk2(bflo(rk[i].y) * wt, bfhi(rk[i].y) * wt); kw.z = pk2(bflo(rk[i].z) * wt, bfhi(rk[i].z) * wt); kw.w = pk2(bflo(rk[i].w) * wt, bfhi(rk[i].w) * wt);
            *(LAS u32x4*)(lds + tk * SC_STRIDE + dc * 16) = kw; *(LAS u32x4*)(lds + SC_V + tk * SC_STRIDE + dc * 16) = rv[i]; }
        if (s + 1 < 17) SC_LOAD(s + 1);
        __syncthreads();
#pragma unroll
        for (int t = 0; t < 8; ++t) acc[t] = acc[t] * gC;
#pragma unroll
        for (int k = 0; k < 4; ++k) {
            const LAS unsigned char* vb = lds + SC_V + (32 * k + 4 * q4 + (c16 >> 2)) * SC_STRIDE + (16 * w + 4 * (c16 & 3)) * 2;
            const s16x4 vlo = __builtin_bit_cast(s16x4, __builtin_amdgcn_ds_read_tr16_b64_v4i16((LAS v4i16_t*)vb)), vhi = __builtin_bit_cast(s16x4, __builtin_amdgcn_ds_read_tr16_b64_v4i16((LAS v4i16_t*)(vb + 16 * SC_STRIDE)));
            const bf16x8 bfrag = __builtin_shufflevector(vlo, vhi, 0, 1, 2, 3, 4, 5, 6, 7);
#pragma unroll
            for (int t = 0; t < 8; ++t) {
                const LAS unsigned char* kb = lds + (32 * k + 4 * q4 + (c16 >> 2)) * SC_STRIDE + (16 * t + 4 * (c16 & 3)) * 2;
                const s16x4 klo = __builtin_bit_cast(s16x4, __builtin_amdgcn_ds_read_tr16_b64_v4i16((LAS v4i16_t*)kb)), khi = __builtin_bit_cast(s16x4, __builtin_amdgcn_ds_read_tr16_b64_v4i16((LAS v4i16_t*)(kb + 16 * SC_STRIDE)));
                acc[t] = MFMA16(__builtin_shufflevector(klo, khi, 0, 1, 2, 3, 4, 5, 6, 7), bfrag, acc[t]);
            }
        }
    }
#undef SC_LOAD
#undef SC_ROW0
#undef SC_CK
    asm volatile("s_waitcnt vmcnt(0)" ::: "memory");
    __syncthreads();
    if (tid == 0) { __builtin_amdgcn_fence(__ATOMIC_RELEASE, "agent"); asm volatile("s_waitcnt vmcnt(0)" ::: "memory");
        __hip_atomic_fetch_add((unsigned*)(ws + WS_CTL) + CW_RFLAG + (L * 32 + bh) * 64, 1u, __ATOMIC_RELAXED, __HIP_MEMORY_SCOPE_AGENT); }
}
DEV void r3_unit(const Args& A, int L, int unit, LAS unsigned char* lds, int tid) {
    const int w = __builtin_amdgcn_readfirstlane(tid >> 6), lane = tid & 63, c16 = lane & 15, q4 = lane >> 4;
    int b, h, ck; size_t row0; ret_unit_ids(unit, b, h, ck, row0);
    unsigned char* ws = A.ws; const bf16* proj = (const bf16*)(ws + WS_PROJ);
    const float lgf = log_gamma(A, L, 0, h), lgb = log_gamma(A, L, 1, h);
    LAS unsigned short* KS = (LAS unsigned short*)lds; LAS unsigned short* VT = KS + 128 * RS;
    if (tid == 0) {
        const unsigned* fl = (const unsigned*)(ws + WS_CTL) + CW_RFLAG + (L * 32 + b * 4 + h) * 64; unsigned sp = 0;
        while (__hip_atomic_load(fl, __ATOMIC_RELAXED, __HIP_MEMORY_SCOPE_AGENT) < 2u) { __builtin_amdgcn_s_sleep(2); if (++sp > (1u << 22)) break; }
        __builtin_amdgcn_fence(__ATOMIC_ACQUIRE, "agent"); asm volatile("s_waitcnt vmcnt(0)" ::: "memory");
    }
    __syncthreads();
    for (int q = tid; q < 2048; q += NTHREADS) { const int i = q >> 4, dc = q & 15;
        const u32x4 kv = *(const u32x4*)(proj + (row0 + i) * PS + 512 + h * 128 + 8 * dc), vv = *(const u32x4*)(proj + (row0 + i) * PS + 1024 + h * 128 + 8 * dc);
        *(LAS u32x4*)(KS + i * RS + 8 * dc) = kv;
        *(LAS u32x4*)((LAS unsigned char*)VT + i * 288 + 16 * dc) = vv; }
    __syncthreads();
    const int n = 16 * w + c16; const size_t row = row0 + n;
    bf16x8 qf[4];
#pragma unroll
    for (int k = 0; k < 4; ++k) qf[k] = *(const bf16x8*)(proj + row * PS + h * 128 + 32 * k + 8 * q4);
    f32x4 sT[8];
#pragma unroll
    for (int t = 0; t < 8; ++t) { f32x4 acc = {0.f, 0.f, 0.f, 0.f};
#pragma unroll
        for (int k = 0; k < 4; ++k) { const bf16x8 a = *(const LAS bf16x8*)(KS + (16 * t + c16) * RS + 32 * k + 8 * q4); acc = MFMA16(a, qf[k], acc); }
#pragma unroll
        for (int r = 0; r < 4; ++r) { const int d = n - (16 * t + 4 * q4 + r); acc[r] *= (d >= 0) ? __expf(lgf * (float)d) : __expf(-lgb * (float)d); }
        sT[t] = acc; }
    f32x4 y[8];
#pragma unroll
    for (int dt = 0; dt < 8; ++dt) y[dt] = (f32x4){0.f, 0.f, 0.f, 0.f};
#pragma unroll
    for (int u = 0; u < 4; ++u) { const bf16x8 bp = pack8(sT[2 * u], sT[2 * u + 1]);
#pragma unroll
        for (int dt = 0; dt < 8; ++dt) { const LAS unsigned char* vr = (const LAS unsigned char*)VT + (32 * u + 4 * q4 + (c16 >> 2)) * 288 + (16 * dt + 4 * (c16 & 3)) * 2;
            const s16x4 lo = __builtin_bit_cast(s16x4, __builtin_amdgcn_ds_read_tr16_b64_v4i16((LAS v4i16_t*)vr)), hi = __builtin_bit_cast(s16x4, __builtin_amdgcn_ds_read_tr16_b64_v4i16((LAS v4i16_t*)(vr + 16 * 288)));
            y[dt] = MFMA16(__builtin_shufflevector(lo, hi, 0, 1, 2, 3, 4, 5, 6, 7), bp, y[dt]); } }
    const float df = __expf(lgf * (float)(n + 1)), db = __expf(lgb * (float)(128 - n));
    bf16x8 qdf[4], qdb[4];
#pragma unroll
    for (int k = 0; k < 4; ++k) { const u32x4 qq = __builtin_bit_cast(u32x4, qf[k]); u32x4 f, g;
        f.x = pk2(bflo(qq.x) * df, bfhi(qq.x) * df); f.y = pk2(bflo(qq.y) * df, bfhi(qq.y) * df); f.z = pk2(bflo(qq.z) * df, bfhi(qq.z) * df); f.w = pk2(bflo(qq.w) * df, bfhi(qq.w) * df);
        g.x = pk2(bflo(qq.x) * db, bfhi(qq.x) * db); g.y = pk2(bflo(qq.y) * db, bfhi(qq.y) * db); g.z = pk2(bflo(qq.z) * db, bfhi(qq.z) * db); g.w = pk2(bflo(qq.w) * db, bfhi(qq.w) * db);
        qdf[k] = __builtin_bit_cast(bf16x8, f); qdb[k] = __builtin_bit_cast(bf16x8, g); }
    const bf16* STf = (const bf16*)(ws + WS_ST) + (size_t)unit * 2 * 16384; const bf16* STb = STf + 16384;
#pragma unroll
    for (int dt = 0; dt < 8; ++dt)
#pragma unroll
        for (int k = 0; k < 4; ++k) { const bf16x8 a = *(const bf16x8*)(STf + (16 * dt + c16) * 128 + 32 * k + 8 * q4), a2 = *(const bf16x8*)(STb + (16 * dt + c16) * 128 + 32 * k + 8 * q4);
            y[dt] = MFMA16(a, qdf[k], y[dt]); y[dt] = MFMA16(a2, qdb[k], y[dt]); }
    float s = 0.f;
#pragma unroll
    for (int dt = 0; dt < 8; ++dt) s += (y[dt][0] + y[dt][1]) + (y[dt][2] + y[dt][3]);
    s = xrow16_sum(s);
    const float mu = s * (1.0f / 128.0f); float v = 0.f;
#pragma unroll
    for (int dt = 0; dt < 8; ++dt) { const f32x4 d = y[dt] - mu; v += (d[0] * d[0] + d[1] * d[1]) + (d[2] * d[2] + d[3] * d[3]); }
    v = xrow16_sum(v);
    const float rstd = rsqrtf(v * (1.0f / 128.0f) + EPS);
    bf16* yo = (bf16*)(ws + WS_YBR) + row * 512 + h * 128;
#pragma unroll
    for (int dt = 0; dt < 8; ++dt) { const u32x2 g = *(const u32x2*)(proj + row * PS + 1536 + h * 128 + 16 * dt + 4 * q4);
        u32x2 o; o.x = pk2(bflo(g.x) * (y[dt][0] - mu) * rstd, bfhi(g.x) * (y[dt][1] - mu) * rstd); o.y = pk2(bflo(g.y) * (y[dt][2] - mu) * rstd, bfhi(g.y) * (y[dt][3] - mu) * rstd);
        *(u32x2*)(yo + 16 * dt + 4 * q4) = o; }
}


DEV void panel_signal(unsigned* flag) {
    asm volatile("s_waitcnt vmcnt(0)" ::: "memory");
    __syncthreads();
    if (threadIdx.x == 0) {
        __builtin_amdgcn_fence(__ATOMIC_RELEASE, "agent"); asm volatile("s_waitcnt vmcnt(0)" ::: "memory");
        __hip_atomic_fetch_add(flag, 1u, __ATOMIC_RELAXED, __HIP_MEMORY_SCOPE_AGENT);
    }
}
DEV void panel_wait(const unsigned* flag) {
    if (threadIdx.x == 0) {
        unsigned sp = 0;
        for (int p = 0; p < 8; ++p)
            while (__hip_atomic_load(flag + p * 64, __ATOMIC_RELAXED, __HIP_MEMORY_SCOPE_AGENT) < 4u) { __builtin_amdgcn_s_sleep(2); if (++sp > (1u << 22)) break; }
        __builtin_amdgcn_fence(__ATOMIC_ACQUIRE, "agent"); asm volatile("s_waitcnt vmcnt(0)" ::: "memory");
    }
    __syncthreads();
}
__global__ void __launch_bounds__(NTHREADS, 2) mk_fwd(Args args) {
    extern __shared__ __attribute__((aligned(16))) unsigned char lds_raw[];
    LAS unsigned char* lds = (LAS unsigned char*)lds_raw;
    const int tid = threadIdx.x, G = gridDim.x;
    const int bx = blockIdx.x, vcu = (G % 8 == 0) ? (bx % 8) * (G / 8) + bx / 8 : bx;
    unsigned char* ws = args.ws;
    volatile LAS unsigned* MISC = (volatile LAS unsigned*)(lds + MISC_OFF);
    for (int u = tid; u < (LDS_BYTES - 131072) / 4; u += NTHREADS) ((LAS unsigned*)(lds + 131072))[u] = 0u;
    __syncthreads();
    const int lo = args.ph_lo, hi = args.ph_hi;
    XcdBarrier bar; bar.bar = (unsigned*)(ws + WS_CTL) + CW_BAR; bar.x = 0; bar.st = nullptr;
    if (hi - lo > 1) bar = xcd_barrier_post((unsigned*)(ws + WS_CTL) + CW_BAR, MISC + 8);
#define IN(k) (lo <= (k) && (k) < hi)
#define EN(b) (((MK_EN) >> (b)) & 1u)
#define REP(b) for (int _rp = 0; _rp < 1 + (int)(((MK_REP) >> (b)) & 1u); ++_rp)
#define OT() ({ int _t = threadIdx.x; asm volatile("" : "+v"(_t)); _t; })
#define SEAM(k) do { if (IN(k) && IN((k) + 1)) xcd_barrier(bar); } while (0)
    const pg8::bf16_t* XN = (const pg8::bf16_t*)(ws + WS_XN);
    pg8::bf16_t* PROJ = (pg8::bf16_t*)(ws + WS_PROJ);
    const float* TAB = (const float*)(ws + WS_TAB);

    if (EN(0) && IN(0)) REP(0) { p0_prologue(args, lds, vcu, G, OT()); } SEAM(0);
    if (EN(1) && IN(1)) REP(1) { thin_phase<0>(args, 0, vcu, G, 0, MT, OT(), lds); } SEAM(1);
    for (int L = 0; L < DEPTH; ++L) {
        const int pb = 2 + 11 * L;
        const bool need_ctx = L < DEPTH - 1;
        const int Mact = need_ctx ? MT : ML;
        if (EN(2) && IN(pb + 0)) REP(2) {
            if constexpr (F8GATE) {
                { pg8::Gemm g{XN, (const pg8::bf16_t*)(ws + WS_WIN + (size_t)L * DIN * 1024 * 2), MT, 4352, 1024}; pg8::StaticOrder S; S.init(MT, 4352, G, bx);
                  pg8::EpiInProj<false> E{PROJ, TAB + TAB_RTC, TAB + TAB_RTS, TAB + TAB_AXC, TAB + TAB_AXS, 1.0f, 0};
                  pg8::gemm_phase<pg8::EpiInProj<false>, pg8::StaticOrder, true, true, false>(lds, g, S, E); }
                { pg8::Gemm g{(const pg8::bf16_t*)(ws + WS_XN8), (const pg8::bf16_t*)(ws + WS_WIN8 + (size_t)L * 3072 * 1024), MT, 3072, 512}; pg8::TailOrder S; S.init(MT, 3072, G, bx); S.cut = (72 * 17) % G; S.base = (72 * 12) / G; if (S.cut == 0) S.base = 1 << 20;
                  pg8::EpiGate E{ws + WS_G8};
                  pg8::gemm_phase<pg8::EpiGate, pg8::TailOrder, true, true, true>(lds, g, S, E); }
            } else {
            pg8::Gemm g{XN, (const pg8::bf16_t*)(ws + WS_WIN + (size_t)L * DIN * 1024 * (F8IN ? 1 : 2)), MT, DIN, F8IN ? 512 : 1024}; pg8::StaticOrder S; S.init(MT, DIN, G, bx);
            pg8::EpiInProj<true> E{PROJ, TAB + TAB_RTC, TAB + TAB_RTS, TAB + TAB_AXC, TAB + TAB_AXS, F8IN ? 0.015625f : 1.0f, 0};
            pg8::gemm_phase<pg8::EpiInProj<true>, pg8::StaticOrder, true, true, F8IN>(lds, g, S, E);
            }
        } SEAM(pb + 0);
        if (IN(pb + 1)) {
            unsigned* wq = (unsigned*)(ws + WS_CTL) + CW_WQ + L * 64;
            const int n_ctx = need_ctx ? 96 : 0, n_att = 64 + 256 + 256 + n_ctx, n_units = n_att + (need_ctx ? 576 : 512);
            for (;;) {
                if (threadIdx.x == 0) MISC[16] = __hip_atomic_fetch_add(wq, 1u, __ATOMIC_RELAXED, __HIP_MEMORY_SCOPE_AGENT);
                __syncthreads();
                const int u = (int)MISC[16];
                __syncthreads();
                if (u >= n_units) break;
                const int n_r3 = need_ctx ? 576 : 512;
                if (u < 64) { if (EN(6)) scan_unit(args, L, u, lds, OT()); }
                else if (u < 320) { if (EN(4)) attn4_unit<1>(args, L, u - 64, lds, OT()); }
                else if (u < 320 + n_r3) { const int v = u - 320; if (EN(8)) r3_unit(args, L, need_ctx ? v : (v >> 4) * 18 + (v & 15), lds, OT()); }
                else if (u < 576 + n_r3) { if (EN(3)) attn4_unit<0>(args, L, u - 320 - n_r3, lds, OT()); }
                else if (u < 608 + n_r3) { if (EN(5)) attn4_unit<2>(args, L, u - 576 - n_r3, lds, OT()); }
                else { if (EN(5)) attn4_unit<3>(args, L, u - 608 - n_r3, lds, OT()); }
            }
        } SEAM(pb + 1);
        if (EN(9) && IN(pb + 4)) REP(9) {
            pg8::Gemm g{(const pg8::bf16_t*)(ws + WS_YBR), (const pg8::bf16_t*)(ws + WS_WBR) + (size_t)L * 3 * 1024 * 512, 3 * MT, 3 * 1024, 512};
            { pg8::BranchOrder S{(ML / 256) * 4, G, vcu};
              pg8::EpiBranch E{ws + WS_G8, (pg8::bf16_t*)(ws + WS_MERGED)};
              pg8::gemm_phase<pg8::EpiBranch, pg8::BranchOrder, true, true>(lds, g, S, E); }
            if (need_ctx) { pg8::PartOrder S{G, vcu};
              pg8::EpiBranchPart E{ws + WS_G8, (pg8::bf16_t*)(ws + WS_PART)};
              pg8::gemm_phase<pg8::EpiBranchPart, pg8::PartOrder, true, true>(lds, g, S, E); }
        } SEAM(pb + 4);
#define BAR_ALWAYS() do { if (hi - lo > 1) xcd_barrier(bar); } while (0)
        if (EN(10) && IN(pb + 5)) {
            const pg8::bf16_t* Wo = (const pg8::bf16_t*)(ws + WS_WOUT) + (size_t)L * 1024 * 1024;
            if (need_ctx) {
                { pg8::Gemm g{(const pg8::bf16_t*)(ws + WS_MERGED), Wo, ML, 1024, 1024}; pg8::StaticOrder S; S.init(ML, 1024, G, bx);
                  pg8::EpiPlain E{(pg8::bf16_t*)(ws + WS_YOUT), 1024, 4, 1.0f};
                  pg8::gemm_phase<pg8::EpiPlain, pg8::StaticOrder, true, true>(lds, g, S, E); }
                { const int t_ = OT(), lane_ = t_ & 63;
                  for (int row = vcu * 8 + (t_ >> 6); row < MC; row += G * 8) {
                      const unsigned char* pp = ws + WS_PART + ((size_t)row * 1024 + lane_ * 16) * 2;
                      float f[16];
#pragma unroll
                      for (int r = 0; r < 3; ++r) {
                          const uint4 w0 = *(const uint4*)(pp + (size_t)r * MC * 2048), w1 = *(const uint4*)(pp + (size_t)r * MC * 2048 + 16);
                          const unsigned ww[8] = {w0.x, w0.y, w0.z, w0.w, w1.x, w1.y, w1.z, w1.w};
#pragma unroll
                          for (int k = 0; k < 8; ++k) { const float lo_ = __uint_as_float(ww[k] << 16), hi_ = __uint_as_float(ww[k] & 0xffff0000u);
                              if (r == 0) { f[2 * k] = lo_; f[2 * k + 1] = hi_; } else { f[2 * k] += lo_; f[2 * k + 1] += hi_; } }
                      }
                      uint4 o0, o1;
                      o0.x = pg8::cvt_pk_bf16(f[0], f[1]); o0.y = pg8::cvt_pk_bf16(f[2], f[3]); o0.z = pg8::cvt_pk_bf16(f[4], f[5]); o0.w = pg8::cvt_pk_bf16(f[6], f[7]);
                      o1.x = pg8::cvt_pk_bf16(f[8], f[9]); o1.y = pg8::cvt_pk_bf16(f[10], f[11]); o1.z = pg8::cvt_pk_bf16(f[12], f[13]); o1.w = pg8::cvt_pk_bf16(f[14], f[15]);
                      unsigned char* op = ws + WS_MERGED + ((size_t)(ML + row) * 1024 + lane_ * 16) * 2;
                      *(uint4*)op = o0; *(uint4*)(op + 16) = o1;
                  } }
                BAR_ALWAYS();
                if (vcu < 32) { pg8::Gemm g{(const pg8::bf16_t*)(ws + WS_MERGED) + (size_t)ML * 1024, Wo, MC, 1024, 1024}; pg8::StaticOrder S; S.init(MC, 1024, 32, vcu);
                  pg8::EpiPlain E{(pg8::bf16_t*)(ws + WS_YOUT) + (size_t)ML * 1024, 1024, 4, 1.0f};
                  pg8::gemm_phase<pg8::EpiPlain, pg8::StaticOrder, true, true>(lds, g, S, E);
                  panel_signal((unsigned*)(ws + WS_CTL) + CW_PFLAG + ((L * 2 + 0) * 8 + (((vcu % 8) * 4 + vcu / 8) & 7)) * 64); }
                else thin_phase<1>(args, L, vcu - 32, G - 32, 0, ML, OT(), lds);
                panel_wait((const unsigned*)(ws + WS_CTL) + CW_PFLAG + (L * 2 + 0) * 8 * 64);
                thin_phase<1>(args, L, vcu, G, ML, MT, OT(), lds);
            } else {
                pg8::Gemm g{(const pg8::bf16_t*)(ws + WS_MERGED), Wo, ML, 1024, 1024}; pg8::StaticOrder S; S.init(ML, 1024, G, bx);
                pg8::EpiPlain E{(pg8::bf16_t*)(ws + WS_YOUT), 1024, 4, 1.0f};
                pg8::gemm_phase<pg8::EpiPlain, pg8::StaticOrder, true, true>(lds, g, S, E);
            }
        } SEAM(pb + 5);
        if (EN(11) && IN(pb + 6)) { if (!need_ctx) thin_phase<1>(args, L, vcu, G, 0, ML, OT(), lds); } if (!need_ctx) SEAM(pb + 6);
        if (L & 1) {
            const int mi = L >> 1;
            const unsigned* cnt = (const unsigned*)(ws + WS_CTL) + CW_MOE + mi * 8 * 64;
            if (EN(12) && IN(pb + 7)) REP(12) { gather_phase(args, L, vcu, G, OT()); } SEAM(pb + 7);
            if (EN(13) && IN(pb + 8)) REP(13) {
                constexpr int EB = F8UP_M ? 1 : 2;
                pg8::Gemm g{(const pg8::bf16_t*)(ws + WS_ASORT), (const pg8::bf16_t*)(ws + WS_WM13 + (size_t)mi * 8 * 2 * FFE * 1024 * EB), MSORT, 8 * 2 * FFE, 512 * EB};
                pg8::MoeOrder S; S.init(cnt, 28, G, bx);
                pg8::EpiSwiGLUx<F8UP_M, F8DN_M> E{ws + WS_HID, FFE, 28};
                pg8::gemm_phase<pg8::EpiSwiGLUx<F8UP_M, F8DN_M>, pg8::MoeOrder, true, true, F8UP_M>(lds, g, S, E);
            } SEAM(pb + 8);
            if (EN(14) && IN(pb + 9)) REP(14) {
                constexpr int EB = F8DN_M ? 1 : 2;
                pg8::Gemm g{(const pg8::bf16_t*)(ws + WS_HID), (const pg8::bf16_t*)(ws + WS_WM2 + (size_t)mi * 8 * 1024 * FFE * EB), MSORT, 8 * 1024, FFE / 2 * EB};
                pg8::MoeOrder S; S.init(cnt, 4, G, bx);
                pg8::EpiPlain E{(pg8::bf16_t*)(ws + WS_OSORT), 1024, 4, F8DN_M ? 1.0f / 2048.0f : 1.0f};
                pg8::gemm_phase<pg8::EpiPlain, pg8::MoeOrder, true, true, F8DN_M>(lds, g, S, E);
            } SEAM(pb + 9);
        } else {
            const int fi = L >> 1;
            if (EN(15) && IN(pb + 8)) REP(15) {
                constexpr int EB = F8UP_D ? 1 : 2;
                pg8::Gemm g{XN, (const pg8::bf16_t*)(ws + WS_WF13 + (size_t)fi * 2 * FFD * 1024 * EB), Mact, 2 * FFD, 512 * EB}; pg8::StaticOrder S; S.init(Mact, 2 * FFD, G, bx);
                pg8::EpiSwiGLUx<F8UP_D, F8DN_D> E{ws + WS_HID, FFD, 22};
                pg8::gemm_phase<pg8::EpiSwiGLUx<F8UP_D, F8DN_D>, pg8::StaticOrder, true, true, F8UP_D>(lds, g, S, E);
            } SEAM(pb + 8);
            if (EN(16) && IN(pb + 9)) {
                constexpr int EB = F8DN_D ? 1 : 2; constexpr float sc = F8DN_D ? 1.0f / 2048.0f : 1.0f;
                const pg8::bf16_t* W2 = (const pg8::bf16_t*)(ws + WS_WF2 + (size_t)fi * 1024 * FFD * EB);
                { pg8::Gemm g{(const pg8::bf16_t*)(ws + WS_HID), W2, ML, 1024, FFD / 2 * EB}; pg8::StaticOrder S; S.init(ML, 1024, G, bx);
                  pg8::EpiPlain E{(pg8::bf16_t*)(ws + WS_YOUT), 1024, 4, sc};
                  pg8::gemm_phase<pg8::EpiPlain, pg8::StaticOrder, true, true, F8DN_D>(lds, g, S, E); }
                BAR_ALWAYS();
                if (vcu < 32) { pg8::Gemm g{(const pg8::bf16_t*)(ws + WS_HID + (size_t)ML * FFD * EB), W2, MC, 1024, FFD / 2 * EB}; pg8::StaticOrder S; S.init(MC, 1024, 32, vcu);
                  pg8::EpiPlain E{(pg8::bf16_t*)(ws + WS_YOUT) + (size_t)ML * 1024, 1024, 4, sc};
                  pg8::gemm_phase<pg8::EpiPlain, pg8::StaticOrder, true, true, F8DN_D>(lds, g, S, E);
                  panel_signal((unsigned*)(ws + WS_CTL) + CW_PFLAG + ((L * 2 + 1) * 8 + (((vcu % 8) * 4 + vcu / 8) & 7)) * 64); }
                else thin_phase<2>(args, L, vcu - 32, G - 32, 0, ML, OT(), lds);
                panel_wait((const unsigned*)(ws + WS_CTL) + CW_PFLAG + (L * 2 + 1) * 8 * 64);
                thin_phase<2>(args, L, vcu, G, ML, MT, OT(), lds);
            } SEAM(pb + 9);
        }
        if (EN(17) && IN(pb + 10)) { if (L & 1) thin_phase<2>(args, L, vcu, G, 0, Mact, OT(), lds); } if (L & 1) SEAM(pb + 10);
    }
#undef IN
#undef SEAM
}


extern "C" void kernel_launch(void* const* d_in, const int* in_sizes, int n_in, void* d_out, int out_size, void* d_ws, size_t ws_size, hipStream_t stream) {
    static int grid = 0;
    if (grid == 0) {
        if (n_in != 20 || out_size != ML * D || ws_size < WS_END) { fprintf(stderr, "kernel_launch: unexpected shapes (n_in %d out %d ws %zu need %zu)\n", n_in, out_size, ws_size, (size_t)WS_END); grid = -1; return; }
        int dev = 0, cus = 0;
        if (hipGetDevice(&dev) != hipSuccess || hipDeviceGetAttribute(&cus, hipDeviceAttributeMultiprocessorCount, dev) != hipSuccess) { grid = -1; return; }
        if (hipFuncSetAttribute((const void*)mk_fwd, hipFuncAttributeMaxDynamicSharedMemorySize, LDS_BYTES) != hipSuccess) { fprintf(stderr, "kernel_launch: hipFuncSetAttribute failed\n"); grid = -1; return; }
        int per_cu = 0;
        (void)hipOccupancyMaxActiveBlocksPerMultiprocessor(&per_cu, (const void*)mk_fwd, NTHREADS, LDS_BYTES);
        (void)hipGetLastError();
        grid = cus;
    }
    if (grid < 0) return;
    (void)hipMemsetAsync((char*)d_ws + WS_CTL, 0, CTL_ZERO_BYTES, stream);
    Args a{};
    for (int i = 0; i < 20; ++i) a.in[i] = (const float*)d_in[i];
    a.out = (float*)d_out; a.ws = (unsigned char*)d_ws; a.li = 0; a.pad = 0;
#if MK_PER_PHASE
    for (int ph = 0; ph < MK_NPH_RUN; ++ph) { a.ph_lo = ph; a.ph_hi = ph + 1; hipLaunchKernelGGL(mk_fwd, dim3(grid), dim3(NTHREADS), LDS_BYTES, stream, a); }
#else
    a.ph_lo = 0; a.ph_hi = MK_NPH_RUN;
    hipLaunchKernelGGL(mk_fwd, dim3(grid), dim3(NTHREADS), LDS_BYTES, stream, a);
#endif
}
```

```cpp
#include <hip/hip_runtime.h>
#include <cstdio>
#include <cstdint>
#include <cmath>
#define LAS __attribute__((address_space(3)))
namespace pg8 {
#define PG8_LAS __attribute__((address_space(3)))
typedef unsigned short bf16_t;
typedef short bf16x8 __attribute__((ext_vector_type(8)));
typedef float f32x4 __attribute__((ext_vector_type(4)));
typedef unsigned u32x4 __attribute__((ext_vector_type(4)));
constexpr int BM = 256, BK = 64, HALF = 128, HTB = HALF * BK * 2  , STAGE_BYTES = 8 * HTB, NXCD = 8, WGM = 8;

__host__ __device__ __forceinline__ int lds_byte(int r, int c) { const int st = (r >> 4) * 2 + (c >> 5), rr = r & 15, cc = c & 31, ob = rr * 64 + cc * 2; return st * 1024 + (ob ^ (((ob >> 9) & 1) << 5)); }
__host__ __device__ __forceinline__ void stage_rc(int b, int& R, int& C) { const int st = b / 1024, sb = b % 1024, swz = sb ^ (((sb >> 9) & 1) << 5); R = (st >> 1) * 16 + swz / 64; C = (st & 1) * 32 + (swz % 64) / 2; }
__host__ __device__ __forceinline__ int perm32(int rho) { const int n = rho >> 4, i = rho & 15; return 8 * (i >> 2) + 4 * n + (i & 3); }

typedef int v8i32 __attribute__((ext_vector_type(8))); typedef int v4i32 __attribute__((ext_vector_type(4)));
__device__ __forceinline__ v8i32 pg8_cat(bf16x8 lo, bf16x8 hi) { return __builtin_shufflevector(__builtin_bit_cast(v4i32, lo), __builtin_bit_cast(v4i32, hi), 0, 1, 2, 3, 4, 5, 6, 7); }
struct Unit { int pm, pn; };
struct Gemm { const bf16_t* A; const bf16_t* Bt; int M, N, K; };

struct StaticOrder {
    int nM, nN, nwg, G, c;
    __host__ __device__ void init(int M, int N, int G_, int c_) { nM = M / BM; nN = N / BM; nwg = nM * nN; G = G_; c = c_; }
    __host__ __device__ bool next(int i, Unit& u) const { return next_at((long)i * G + c, u); }
    __host__ __device__ bool next_at(long L, Unit& u) const {
        if (L >= nwg) return false;
        int wgid = (int)L; { const int q = nwg / NXCD, r = nwg % NXCD, xcd = wgid % NXCD, off = wgid / NXCD; wgid = (xcd < r ? xcd * (q + 1) : r * (q + 1) + (xcd - r) * q) + off; }
        const int nig = WGM * nN, gid = wgid / nig, fm = gid * WGM, gsz = (nM - fm) < WGM ? (nM - fm) : WGM;
        u.pm = fm + ((wgid % nig) % gsz); u.pn = (wgid % nig) / gsz; return true;
    }
    __device__ __forceinline__ void a_ready(const Unit&) const {}
    __device__ __forceinline__ void done(const Unit&) const {}
};

typedef float f32x2_t __attribute__((ext_vector_type(2))); typedef __bf16 bf16x2_t __attribute__((ext_vector_type(2)));
__device__ __forceinline__ unsigned cvt_pk_bf16(float lo, float hi) { const f32x2_t v = {lo, hi}; const bf16x2_t b = __builtin_convertvector(v, bf16x2_t); return __builtin_bit_cast(unsigned, b); }
typedef float f32x2 __attribute__((ext_vector_type(2)));

struct BranchOrder {
    int nT, G, c;
    __device__ __forceinline__ bool next(int i, Unit& u) const {
        const int rd = i / 3, r = i - rd * 3; const int t = rd * G + c; if (t >= nT) return false;
        u.pm = r * 72 + (t >> 2); u.pn = r * 4 + (t & 3); return true;
    }
    __device__ __forceinline__ void a_ready(const Unit&) const {}
    __device__ __forceinline__ void done(const Unit&) const {}
};
struct PartOrder {
    int G, c;
    __device__ __forceinline__ bool next(int i, Unit& u) const {
        const int j = i * G + c; if (j >= 96) return false;
        const int r = j >> 5, t = j & 31; u.pm = r * 72 + 64 + (t >> 2); u.pn = r * 4 + (t & 3); return true;
    }
    __device__ __forceinline__ void a_ready(const Unit&) const {}
    __device__ __forceinline__ void done(const Unit&) const {}
};
struct MoeOrder {
    int nM, nN, nwg, G, c; int ts[9];
    __device__ __forceinline__ void init(const unsigned* cnt, int nN_, int G_, int c_) {
        int acc = 0;
#pragma unroll
        for (int e = 0; e < 8; ++e) { ts[e] = acc; const unsigned ce = __hip_atomic_load(cnt + 64 * e, __ATOMIC_RELAXED, __HIP_MEMORY_SCOPE_AGENT); acc += (int)((ce + 255u) >> 8); }
        ts[8] = acc; nM = acc; nN = nN_; nwg = nM * nN; G = G_; c = c_;
    }
    __device__ __forceinline__ bool next(int i, Unit& u) const {
        const long L = (long)i * G + c; if (L >= nwg) return false;
        int wgid = (int)L; { const int q = nwg / NXCD, r = nwg % NXCD, xcd = wgid % NXCD, off = wgid / NXCD; wgid = (xcd < r ? xcd * (q + 1) : r * (q + 1) + (xcd - r) * q) + off; }
        const int nig = WGM * nN, gid = wgid / nig, fm = gid * WGM, gsz = (nM - fm) < WGM ? (nM - fm) : WGM;
        const int pm = fm + ((wgid % nig) % gsz), pnt = (wgid % nig) / gsz;
        int e = 0;
#pragma unroll
        for (int k = 1; k < 8; ++k) e += (pm >= ts[k]) ? 1 : 0;
        u.pm = pm; u.pn = e * nN + pnt; return true;
    }
    __device__ __forceinline__ void a_ready(const Unit&) const {}
    __device__ __forceinline__ void done(const Unit&) const {}
};


struct TailOrder : StaticOrder {
    int cut, base;
    __device__ __forceinline__ bool next(int i, Unit& u) const {
        long L;
        if (i < base) L = (long)i * G + c; else { if (c < cut) return false; L = (long)base * G + (long)(i - base) * (G - cut) + (c - cut); }
        if (L >= nwg) return false;
        return next_at(L, u);
    }
};
__device__ __forceinline__ void store8(bf16_t* p, const f32x4 a, const f32x4 b) {
    u32x4 w; w.x = cvt_pk_bf16(a[0], a[1]); w.y = cvt_pk_bf16(a[2], a[3]); w.z = cvt_pk_bf16(b[0], b[1]); w.w = cvt_pk_bf16(b[2], b[3]); *(u32x4*)p = w;
}
__device__ __forceinline__ float sigm(float x) { return __builtin_amdgcn_rcpf(1.0f + __expf(-x)); }
__device__ __forceinline__ f32x4 sigm4(f32x4 v) { f32x4 o; o[0] = sigm(v[0]); o[1] = sigm(v[1]); o[2] = sigm(v[2]); o[3] = sigm(v[3]); return o; }

struct EpiPlain {
    static constexpr bool PERM = true, AFTER_DRAIN = false, KEEP_ACC = false;
    bf16_t* O; int ldc; int pn_mod; float scale;
    __device__ __forceinline__ void operator()(const f32x4 (&acc)[2][2][4][2], const Unit& u, int wr, int wc, int fr, int fq) const {
        const int row0 = u.pm * BM + wr * 64 + fr, col0 = (u.pn % pn_mod) * BM + wc * 32 + 8 * fq;
#pragma unroll
        for (int ai = 0; ai < 2; ++ai)
#pragma unroll
            for (int m = 0; m < 4; ++m) { bf16_t* rowp = O + (size_t)(row0 + ai * HALF + m * 16) * ldc + col0;
#pragma unroll
                for (int bj = 0; bj < 2; ++bj) store8(rowp + bj * HALF, acc[ai][bj][m][0] * scale, acc[ai][bj][m][1] * scale); }
    }
};
__device__ __forceinline__ float clamp_f8(float v) { return __builtin_amdgcn_fmed3f(v, -448.0f, 448.0f); }
__device__ __forceinline__ unsigned pk4_fp8(float a, float b, float c, float d) { a = clamp_f8(a); b = clamp_f8(b); c = clamp_f8(c); d = clamp_f8(d); unsigned w = 0; w = __builtin_amdgcn_cvt_pk_fp8_f32(a, b, w, false); w = __builtin_amdgcn_cvt_pk_fp8_f32(c, d, w, true); return w; }
typedef unsigned u32x2_t __attribute__((ext_vector_type(2)));
template <bool IN8, bool OUT8> struct EpiSwiGLUx {
    static constexpr bool PERM = true, AFTER_DRAIN = false, KEEP_ACC = false;
    unsigned char* O; int ldc; int pn_mod;
    __device__ __forceinline__ void operator()(const f32x4 (&acc)[2][2][4][2], const Unit& u, int wr, int wc, int fr, int fq) const {
        const int row0 = u.pm * BM + wr * 64 + fr, col0 = (u.pn % pn_mod) * HALF + wc * 32 + 8 * fq;
        constexpr float s1 = IN8 ? 0.015625f : 1.0f, s3 = (IN8 ? 0.015625f : 1.0f) * (OUT8 ? 16.0f : 1.0f);
#pragma unroll
        for (int ai = 0; ai < 2; ++ai) {
#pragma unroll
            for (int m = 0; m < 4; ++m) {
                const size_t eoff = (size_t)(row0 + ai * HALF + m * 16) * ldc + col0;
                constexpr float k1 = -1.4426950408889634f * s1, ic = 1.0f / (s1 * s3);
                const f32x4 g0 = acc[ai][0][m][0], g1 = acc[ai][0][m][1];
                const f32x4 t0 = g0 * k1, t1 = g1 * k1; f32x4 e0, e1;
                e0[0] = __builtin_amdgcn_exp2f(t0[0]); e0[1] = __builtin_amdgcn_exp2f(t0[1]); e0[2] = __builtin_amdgcn_exp2f(t0[2]); e0[3] = __builtin_amdgcn_exp2f(t0[3]);
                e1[0] = __builtin_amdgcn_exp2f(t1[0]); e1[1] = __builtin_amdgcn_exp2f(t1[1]); e1[2] = __builtin_amdgcn_exp2f(t1[2]); e1[3] = __builtin_amdgcn_exp2f(t1[3]);
                const f32x4 d0 = e0 * ic + ic, d1 = e1 * ic + ic; f32x4 r0, r1;
                r0[0] = __builtin_amdgcn_rcpf(d0[0]); r0[1] = __builtin_amdgcn_rcpf(d0[1]); r0[2] = __builtin_amdgcn_rcpf(d0[2]); r0[3] = __builtin_amdgcn_rcpf(d0[3]);
                r1[0] = __builtin_amdgcn_rcpf(d1[0]); r1[1] = __builtin_amdgcn_rcpf(d1[1]); r1[2] = __builtin_amdgcn_rcpf(d1[2]); r1[3] = __builtin_amdgcn_rcpf(d1[3]);
                const f32x4 v0 = (g0 * acc[ai][1][m][0]) * r0, v1 = (g1 * acc[ai][1][m][1]) * r1;
                if constexpr (OUT8) { u32x2_t w; w.x = pk4_fp8(v0[0], v0[1], v0[2], v0[3]); w.y = pk4_fp8(v1[0], v1[1], v1[2], v1[3]); *(u32x2_t*)(O + eoff) = w; }
                else store8((bf16_t*)O + eoff, v0, v1);
            }
        }
    }
};
struct EpiBranch {
    static constexpr bool PERM = true, AFTER_DRAIN = false, KEEP_ACC = true;
    const unsigned char* P;
    bf16_t* Mg;
    static __device__ __forceinline__ void unpack8(const u32x2_t g, f32x4& g0, f32x4& g1) {
        constexpr float s = 1.0f / 255.0f;
        g0[0] = (float)(g.x & 0xffu) * s; g0[1] = (float)((g.x >> 8) & 0xffu) * s; g0[2] = (float)((g.x >> 16) & 0xffu) * s; g0[3] = (float)(g.x >> 24) * s;
        g1[0] = (float)(g.y & 0xffu) * s; g1[1] = (float)((g.y >> 8) & 0xffu) * s; g1[2] = (float)((g.y >> 16) & 0xffu) * s; g1[3] = (float)(g.y >> 24) * s; }
    static __device__ __forceinline__ f32x4 clampg(f32x4 v) { f32x4 o; o[0] = fmaxf(v[0], 1e-6f); o[1] = fmaxf(v[1], 1e-6f); o[2] = fmaxf(v[2], 1e-6f); o[3] = fmaxf(v[3], 1e-6f); return o; }
    static __device__ __forceinline__ f32x4 rcp4(f32x4 v) { f32x4 o; o[0] = __builtin_amdgcn_rcpf(v[0]); o[1] = __builtin_amdgcn_rcpf(v[1]); o[2] = __builtin_amdgcn_rcpf(v[2]); o[3] = __builtin_amdgcn_rcpf(v[3]); return o; }
    __device__ __forceinline__ void operator()(f32x4 (&acc)[2][2][4][2], const Unit& u, int wr, int wc, int fr, int fq) const {
        const int r = u.pn >> 2, pnn = u.pn & 3, pmm = u.pm - r * 72;
        const int row0 = pmm * BM + wr * 64 + fr, col0 = pnn * BM + wc * 32 + 8 * fq;
#pragma unroll
        for (int ai = 0; ai < 2; ++ai)
#pragma unroll
            for (int m = 0; m < 4; ++m) { const size_t row = (size_t)(row0 + ai * HALF + m * 16);
#pragma unroll
                for (int bj = 0; bj < 2; ++bj) { const int col = col0 + bj * HALF;
                    const unsigned char* gp = P + row * 3072 + r * 1024 + col;
                    f32x4 a0, a1; unpack8(*(const u32x2_t*)gp, a0, a1);
                    if (r < 2) { f32x4 b0, b1; unpack8(*(const u32x2_t*)(gp + 1024), b0, b1);
                        if (r == 1) { a0 = clampg(a0); a1 = clampg(a1); }
                        acc[ai][bj][m][0] = acc[ai][bj][m][0] * (a0 * rcp4(clampg(b0))); acc[ai][bj][m][1] = acc[ai][bj][m][1] * (a1 * rcp4(clampg(b1)));
                    } else { store8(Mg + row * 1024 + col, acc[ai][bj][m][0] * clampg(a0), acc[ai][bj][m][1] * clampg(a1));
                        acc[ai][bj][m][0] = (f32x4){0.f, 0.f, 0.f, 0.f}; acc[ai][bj][m][1] = (f32x4){0.f, 0.f, 0.f, 0.f}; } } }
    }
};
struct EpiBranchPart {
    static constexpr bool PERM = true, AFTER_DRAIN = false, KEEP_ACC = false;
    const unsigned char* P;
    bf16_t* O;
    __device__ __forceinline__ void operator()(const f32x4 (&acc)[2][2][4][2], const Unit& u, int wr, int wc, int fr, int fq) const {
        const int r = u.pn >> 2, pnn = u.pn & 3, pmm = u.pm - r * 72;
        const int row0 = pmm * BM + wr * 64 + fr, col0 = pnn * BM + wc * 32 + 8 * fq;
#pragma unroll
        for (int ai = 0; ai < 2; ++ai)
#pragma unroll
            for (int m = 0; m < 4; ++m) { const size_t row = (size_t)(row0 + ai * HALF + m * 16);
#pragma unroll
                for (int bj = 0; bj < 2; ++bj) { const int col = col0 + bj * HALF;
                    f32x4 a0, a1; EpiBranch::unpack8(*(const u32x2_t*)(P + row * 3072 + r * 1024 + col), a0, a1);
                    store8(O + ((size_t)r * 2048 + (row - 16384)) * 1024 + col, acc[ai][bj][m][0] * a0, acc[ai][bj][m][1] * a1); } }
    }
};
struct EpiGate {
    static constexpr bool PERM = true, AFTER_DRAIN = false, KEEP_ACC = false;
    unsigned char* O;
    static __device__ __forceinline__ unsigned q4(f32x4 g) { return (unsigned)(g[0] * 255.0f + 0.5f) | ((unsigned)(g[1] * 255.0f + 0.5f) << 8) | ((unsigned)(g[2] * 255.0f + 0.5f) << 16) | ((unsigned)(g[3] * 255.0f + 0.5f) << 24); }
    __device__ __forceinline__ void operator()(const f32x4 (&acc)[2][2][4][2], const Unit& u, int wr, int wc, int fr, int fq) const {
        const int row0 = u.pm * BM + wr * 64 + fr, col0 = u.pn * BM + wc * 32 + 8 * fq;
#pragma unroll
        for (int ai = 0; ai < 2; ++ai)
#pragma unroll
            for (int m = 0; m < 4; ++m) { unsigned char* rowp = O + (size_t)(row0 + ai * HALF + m * 16) * 3072 + col0;
#pragma unroll
                for (int bj = 0; bj < 2; ++bj) { u32x2_t w; w.x = q4(sigm4(acc[ai][bj][m][0] * 0.015625f)); w.y = q4(sigm4(acc[ai][bj][m][1] * 0.015625f)); *(u32x2_t*)(rowp + bj * HALF) = w; } }
    }
};
template <bool GATES> struct EpiInProj {
    static constexpr bool PERM = true, AFTER_DRAIN = false, KEEP_ACC = false;
    bf16_t* O; const float *rtc, *rts, *axc, *axs; float asc; int pn_off;
    __device__ __forceinline__ void operator()(const f32x4 (&acc)[2][2][4][2], const Unit& u, int wr, int wc, int fr, int fq) const {
        const int pn = u.pn + pn_off, i8 = 8 * fq;
#pragma unroll
        for (int ai = 0; ai < 2; ++ai)
#pragma unroll
            for (int m = 0; m < 4; ++m) {
                const int row = u.pm * BM + ai * HALF + wr * 64 + m * 16 + fr;
                bf16_t* rowp = O + (size_t)row * 4352;
                const f32x4 a0 = acc[ai][0][m][0] * asc, a1 = acc[ai][0][m][1] * asc, b0 = acc[ai][1][m][0] * asc, b1 = acc[ai][1][m][1] * asc;
                if (pn < 4) {
                    const int hl = wc >> 1, i = 32 * (wc & 1) + i8;
                    const int pos = row < 16384 ? 256 + (row & 2047) : ((row - 16384) & 255);
                    const f32x4 c0 = *(const f32x4*)(rtc + pos * 64 + i), c1 = *(const f32x4*)(rtc + pos * 64 + i + 4);
                    const f32x4 s0 = *(const f32x4*)(rts + pos * 64 + i), s1 = *(const f32x4*)(rts + pos * 64 + i + 4);
                    const float sc = pn < 2 ? 0.08838834764831845f : 1.0f;
                    bf16_t* dst = rowp + pn * 256 + hl * 128 + i;
                    store8(dst, (a0 * c0 - b0 * s0) * sc, (a1 * c1 - b1 * s1) * sc);
                    store8(dst + 64, (a0 * s0 + b0 * c0) * sc, (a1 * s1 + b1 * c1) * sc);
                } else if (pn == 8 || pn == 9 || (pn == 10 && wc < 2)) {
                    const bool lat = row < 16384; const int t = row & 2047;
                    f32x4 c0 = *(const f32x4*)(axc + t * 32 + i8), c1 = *(const f32x4*)(axc + t * 32 + i8 + 4);
                    f32x4 s0 = *(const f32x4*)(axs + t * 32 + i8), s1 = *(const f32x4*)(axs + t * 32 + i8 + 4);
                    if (!lat) { c0 = (f32x4){1.f, 1.f, 1.f, 1.f}; c1 = c0; s0 = (f32x4){0.f, 0.f, 0.f, 0.f}; s1 = s0; }
                    const float sc = pn < 10 ? 0.18033688011112042f : 1.0f;
                    bf16_t* dst = rowp + (pn < 10 ? pn * 256 : 2560) + wc * 64 + i8;
                    store8(dst, (a0 * c0 - b0 * s0) * sc, (a1 * c1 - b1 * s1) * sc);
                    store8(dst + 32, (a0 * s0 + b0 * c0) * sc, (a1 * s1 + b1 * c1) * sc);
                } else if (pn == 10) {
                    bf16_t* dst = rowp + 2688 + (wc - 2) * 64 + i8;
                    store8(dst, a0, a1); store8(dst + 32, b0, b1);
                } else {
                    bf16_t* dst = rowp + pn * 256 + wc * 32 + i8;
                    if (pn == 6 || pn == 7) { store8(dst, a0 * sigm4(a0), a1 * sigm4(a1)); store8(dst + 128, b0 * sigm4(b0), b1 * sigm4(b1)); }
                    else if (pn == 11 || pn == 12) { store8(dst, a0 * 0.18033688011112042f, a1 * 0.18033688011112042f); store8(dst + 128, b0 * 0.18033688011112042f, b1 * 0.18033688011112042f); }
                    else if (GATES && pn >= 17) { store8(dst, sigm4(a0), sigm4(a1)); store8(dst + 128, sigm4(b0), sigm4(b1)); }
                    else { store8(dst, a0, a1); store8(dst + 128, b0, b1); }
                }
            }
    }
};
template <class Epi, class Sched, bool ALIGN_EPI = false, bool SP2 = false, bool FP8 = false>
__device__ __forceinline__ void gemm_phase(PG8_LAS unsigned char* lds, const Gemm g, const Sched& S, const Epi& E) {
    int tid_ = threadIdx.x; asm volatile("" : "+v"(tid_));
    const int tid = tid_, wid = __builtin_amdgcn_readfirstlane(tid >> 6), lane = tid & 63, wr = wid >> 2, wc = wid & 3, fr = lane & 15, fq = lane >> 4;
    const int K = g.K, nt = K / BK;
    unsigned voffA[2], voffB[2];
#pragma unroll
    for (int i = 0; i < 2; ++i) { int R, C; stage_rc(tid * 16 + i * 8192, R, C); const int Rb = Epi::PERM ? ((R & ~31) + perm32(R & 31)) : R;
        voffA[i] = (unsigned)(R * K + C) * 2u; voffB[i] = (unsigned)(Rb * K + C) * 2u; }
    const size_t kstep = (size_t)(BK * 2);
    const size_t hstep = (size_t)HALF * K * 2;
    const size_t tstep = 2 * hstep;
    const unsigned ldsw = (unsigned)wid * 1024u;
    const int aoff = lds_byte(wr * 64 + fr, fq * 8), boff = lds_byte(wc * 32 + fr, fq * 8);
    const int cb8 = 32 * fq, rr8 = fr & 15;
    const int aoff8 = (((wr * 64 + fr) >> 4) * 2 + (cb8 >> 6)) * 1024 + ((rr8 * 64 + (cb8 & 63)) ^ ((rr8 >> 3) << 5));
    const int boff8 = (((wc * 32 + fr) >> 4) * 2 + (cb8 >> 6)) * 1024 + ((rr8 * 64 + (cb8 & 63)) ^ ((rr8 >> 3) << 5));
#define PG8_SA(b, h) (((b) * 2 + (h)) * HTB)
#define PG8_SB(b, h) ((4 + (b) * 2 + (h)) * HTB)
#define PG8_STAGE(bufoff, gbase, voff) do { _Pragma("unroll") for (int _i = 0; _i < 2; ++_i) \
        __builtin_amdgcn_global_load_lds((const unsigned*)((const char*)(gbase) + (voff)[_i]), (PG8_LAS unsigned*)(lds + (bufoff) + ldsw + _i * 8192), 16, 0, 0); } while (0)
#define PG8_LDA(dst, b, h) do { if constexpr (FP8) { _Pragma("unroll") for (int m = 0; m < 4; ++m) dst##8[m] = *(const PG8_LAS v8i32*)(lds + PG8_SA(b, h) + aoff8 + m * 2048); } else { _Pragma("unroll") for (int m = 0; m < 4; ++m) _Pragma("unroll") for (int k = 0; k < 2; ++k) dst[m][k] = *(const PG8_LAS bf16x8*)(lds + PG8_SA(b, h) + aoff + m * 2048 + k * 1024); } } while (0)
#define PG8_LDB(dst, b, h) do { if constexpr (FP8) { _Pragma("unroll") for (int n = 0; n < 2; ++n) dst##8[n] = *(const PG8_LAS v8i32*)(lds + PG8_SB(b, h) + boff8 + n * 2048); } else { _Pragma("unroll") for (int n = 0; n < 2; ++n) _Pragma("unroll") for (int k = 0; k < 2; ++k) dst[n][k] = *(const PG8_LAS bf16x8*)(lds + PG8_SB(b, h) + boff + n * 2048 + k * 1024); } } while (0)
#define PG8_MMA(ai, bj, At, Bt) do { __builtin_amdgcn_s_setprio(1); if constexpr (FP8) { _Pragma("unroll") for (int m = 0; m < 4; ++m) _Pragma("unroll") for (int n = 0; n < 2; ++n) \
        asm volatile("v_mfma_scale_f32_16x16x128_f8f6f4 %0, %1, %2, %0, %3, %3 op_sel_hi:[0,0,0]" : "+v"(acc[ai][bj][m][n]) : "v"(Bt##8[n]), "v"(At##8[m]), "v"(sc127)); } else { \
        _Pragma("unroll") for (int m = 0; m < 4; ++m) _Pragma("unroll") for (int n = 0; n < 2; ++n) _Pragma("unroll") for (int k = 0; k < 2; ++k) \
        acc[ai][bj][m][n] = __builtin_amdgcn_mfma_f32_16x16x32_bf16(Bt[n][k], At[m][k], acc[ai][bj][m][n], 0, 0, 0); } __builtin_amdgcn_s_setprio(0); } while (0)
#define PG8_WAIT_V(n) asm volatile("s_waitcnt vmcnt(" #n ")" ::: "memory")
#define PG8_WAIT_L(n) asm volatile("s_waitcnt lgkmcnt(" #n ")" ::: "memory")
#define PG8_BAR __builtin_amdgcn_s_barrier()
#define PG8_SCHED __builtin_amdgcn_sched_barrier(0)
    Unit cur, nxt; int ui = 0;
    if (!S.next(0, cur)) return;
    f32x4 acc[2][2][4][2];
#pragma unroll
    for (int a = 0; a < 2; ++a)
#pragma unroll
        for (int b = 0; b < 2; ++b)
#pragma unroll
            for (int m = 0; m < 4; ++m)
#pragma unroll
                for (int n = 0; n < 2; ++n) acc[a][b][m][n] = (f32x4){0.f, 0.f, 0.f, 0.f};
    bf16x8 At[4][2], B0[2][2], B1[2][2];
    v8i32 At8[4], B08[2], B18[2]; const int sc127 = 127;
    const char* cA = (const char*)g.A + (size_t)cur.pm * tstep; const char* cB = (const char*)g.Bt + (size_t)cur.pn * tstep;
    S.a_ready(cur);
    if constexpr (SP2) {
        PG8_STAGE(PG8_SB(0, 0), cB, voffB); PG8_STAGE(PG8_SB(0, 1), cB + hstep, voffB); PG8_STAGE(PG8_SA(0, 0), cA, voffA); PG8_STAGE(PG8_SA(0, 1), cA + hstep, voffA);
        if (wr == 1) PG8_BAR;
        PG8_WAIT_V(2); PG8_BAR;
        PG8_STAGE(PG8_SB(1, 0), cB + kstep, voffB); PG8_STAGE(PG8_SA(1, 0), cA + kstep, voffA); PG8_STAGE(PG8_SB(1, 1), cB + hstep + kstep, voffB);
        PG8_WAIT_V(6); PG8_BAR;
    } else {
        PG8_STAGE(PG8_SB(0, 0), cB, voffB); PG8_STAGE(PG8_SA(0, 0), cA, voffA); PG8_STAGE(PG8_SB(0, 1), cB + hstep, voffB); PG8_STAGE(PG8_SA(0, 1), cA + hstep, voffA);
        if (wr == 1) PG8_BAR;
        PG8_WAIT_V(4); PG8_BAR;
        PG8_STAGE(PG8_SB(1, 0), cB + kstep, voffB); PG8_STAGE(PG8_SA(1, 0), cA + kstep, voffA); PG8_STAGE(PG8_SB(1, 1), cB + hstep + kstep, voffB);
        PG8_WAIT_V(6); PG8_BAR;
    }
    for (;;) {
        const bool has_next = S.next(ui + 1, nxt);
        const char* nA = has_next ? (const char*)g.A + (size_t)nxt.pm * tstep : cA; const char* nB = has_next ? (const char*)g.Bt + (size_t)nxt.pn * tstep : cB;
        for (int t = 0; t < nt; t += 2) {
            const bool last = (t == nt - 2);
            const char* a1 = cA + (size_t)(t + 1) * kstep;
            const char* a2 = last ? nA : cA + (size_t)(t + 2) * kstep; const char* b2 = last ? nB : cB + (size_t)(t + 2) * kstep;
            const char* a3 = a2 + kstep; const char* b3 = b2 + kstep;
            if (last && has_next) S.a_ready(nxt);
            if constexpr (SP2) {
            PG8_LDB(B0, 0, 0); PG8_LDB(B1, 0, 1); PG8_SCHED; PG8_LDA(At, 0, 0); PG8_STAGE(PG8_SA(1, 1), a1 + hstep, voffA);
            PG8_WAIT_V(8); PG8_WAIT_L(0); PG8_BAR; PG8_MMA(0, 0, At, B0); PG8_MMA(0, 1, At, B1); PG8_BAR; PG8_SCHED;
            PG8_LDA(At, 0, 1); PG8_STAGE(PG8_SB(0, 0), b2, voffB); PG8_STAGE(PG8_SB(0, 1), b2 + hstep, voffB); PG8_STAGE(PG8_SA(0, 0), a2, voffA);
            PG8_WAIT_V(8); PG8_WAIT_L(0); PG8_BAR; PG8_MMA(1, 0, At, B0); PG8_MMA(1, 1, At, B1); PG8_BAR; PG8_SCHED;
            PG8_LDB(B0, 1, 0); PG8_LDB(B1, 1, 1); PG8_SCHED; PG8_LDA(At, 1, 0); PG8_STAGE(PG8_SA(0, 1), a2 + hstep, voffA);
            PG8_WAIT_V(8); PG8_WAIT_L(0); PG8_BAR; PG8_MMA(0, 0, At, B0); PG8_MMA(0, 1, At, B1); PG8_BAR; PG8_SCHED;
            PG8_LDA(At, 1, 1); PG8_STAGE(PG8_SB(1, 0), b3, voffB); PG8_STAGE(PG8_SB(1, 1), b3 + hstep, voffB); PG8_STAGE(PG8_SA(1, 0), a3, voffA);
            PG8_WAIT_V(8); PG8_WAIT_L(0); PG8_BAR; PG8_MMA(1, 0, At, B0); PG8_MMA(1, 1, At, B1); PG8_BAR; PG8_SCHED;
            } else {
            PG8_LDB(B0, 0, 0); PG8_SCHED; PG8_LDA(At, 0, 0); PG8_STAGE(PG8_SA(1, 1), a1 + hstep, voffA);
            PG8_WAIT_L(8); PG8_BAR; PG8_WAIT_L(0); PG8_MMA(0, 0, At, B0); PG8_BAR; PG8_SCHED;
            PG8_LDB(B1, 0, 1); PG8_STAGE(PG8_SB(0, 0), b2, voffB);
            PG8_BAR; PG8_WAIT_L(0); PG8_MMA(0, 1, At, B1); PG8_BAR;
            PG8_LDA(At, 0, 1); PG8_STAGE(PG8_SA(0, 0), a2, voffA);
            PG8_BAR; PG8_WAIT_L(0); PG8_MMA(1, 0, At, B0); PG8_BAR; PG8_SCHED;
            PG8_STAGE(PG8_SB(0, 1), b2 + hstep, voffB);
            PG8_WAIT_V(6); PG8_BAR; PG8_MMA(1, 1, At, B1); PG8_BAR;
            PG8_LDB(B0, 1, 0); PG8_SCHED; PG8_LDA(At, 1, 0); PG8_STAGE(PG8_SA(0, 1), a2 + hstep, voffA);
            PG8_WAIT_L(8); PG8_BAR; PG8_WAIT_L(0); PG8_MMA(0, 0, At, B0); PG8_BAR; PG8_SCHED;
            PG8_LDB(B1, 1, 1); PG8_STAGE(PG8_SB(1, 0), b3, voffB);
            PG8_BAR; PG8_WAIT_L(0); PG8_MMA(0, 1, At, B1); PG8_BAR;
            PG8_LDA(At, 1, 1); PG8_STAGE(PG8_SA(1, 0), a3, voffA);
            PG8_BAR; PG8_WAIT_L(0); PG8_MMA(1, 0, At, B0); PG8_BAR; PG8_SCHED;
            PG8_STAGE(PG8_SB(1, 1), b3 + hstep, voffB);
            PG8_WAIT_V(6); PG8_BAR; PG8_MMA(1, 1, At, B1); PG8_BAR;
            }
        }
        if constexpr (ALIGN_EPI) { if (wr == 0) PG8_BAR; }
        if constexpr (FP8) asm volatile("s_nop 15\n\ts_nop 7" ::: "memory");
        if constexpr (!Epi::AFTER_DRAIN) { E(acc, cur, wr, wc, fr, fq); S.done(cur); }
        if (!has_next) break;
        if constexpr (!Epi::KEEP_ACC) {
#pragma unroll
        for (int a = 0; a < 2; ++a)
#pragma unroll
            for (int b = 0; b < 2; ++b)
#pragma unroll
                for (int m = 0; m < 4; ++m)
#pragma unroll
                    for (int n = 0; n < 2; ++n) acc[a][b][m][n] = (f32x4){0.f, 0.f, 0.f, 0.f};
        }
        cur = nxt; cA = nA; cB = nB; ++ui;
        if constexpr (ALIGN_EPI) { if (wr == 1) PG8_BAR; }
    }
    PG8_WAIT_V(0);
    if constexpr (!ALIGN_EPI) { if (wr == 0) PG8_BAR; }
    PG8_BAR;
    if constexpr (Epi::AFTER_DRAIN) { E.fused(acc, cur, wr, wc, fr, fq, lds, wid, lane); S.done(cur); }
#undef PG8_SA
#undef PG8_SB
#undef PG8_STAGE
#undef PG8_LDA
#undef PG8_LDB
#undef PG8_MMA
#undef PG8_WAIT_V
#undef PG8_WAIT_L
#undef PG8_BAR
#undef PG8_SCHED
}
}

#define XB_TMO      128
#define XB_XCNT(j)  (256  + 64 * (j))
#define XB_XSUB(j)  (1280 + 64 * (j))
#define XB_XGEN(j)  (2304 + 64 * (j))
#define XB_TOP      3328
#define XB_TOPGEN   3392
#define XCD_BAR_WORDS 3456
#define XB_SPIN_CAP (1u << 18)

__device__ __forceinline__ unsigned xb_ld(unsigned* p)              { return __hip_atomic_load(p, __ATOMIC_RELAXED, __HIP_MEMORY_SCOPE_AGENT); }
__device__ __forceinline__ unsigned xb_add(unsigned* p, unsigned v) { return __hip_atomic_fetch_add(p, v, __ATOMIC_RELAXED, __HIP_MEMORY_SCOPE_AGENT); }
__device__ __forceinline__ unsigned xb_xcc_id() { return (unsigned)__builtin_amdgcn_s_getreg((3 << 11) | 20) & 0xFu; }
#define XB_SPIN(cond, bar) do { unsigned _sp = 0; while (cond) { __builtin_amdgcn_s_sleep(1); \
    if ((++_sp & 255u) == 0u) { if (xb_ld(&(bar)[XB_TMO])) break; if (_sp > XB_SPIN_CAP) { atomicAdd(&(bar)[XB_TMO], 1u); break; } } } } while (0)

struct XcdBarrier {
    unsigned* bar; unsigned x;
    volatile LAS unsigned* st;
};

__device__ __forceinline__ XcdBarrier xcd_barrier_post(unsigned* bar, volatile LAS unsigned* st) {
    XcdBarrier b; b.bar = bar; b.x = xb_xcc_id(); b.st = st;
    if (threadIdx.x == 0) (void)xb_add(&bar[XB_XCNT(b.x)], 1u);
    return b;
}
__device__ __forceinline__ void xcd_barrier_complete(unsigned* bar, unsigned x, unsigned& nloc, unsigned& nx) {
    const unsigned G = gridDim.x * gridDim.y * gridDim.z;
    unsigned sum, cnt, mine, sp = 0u;
    for (;;) {
        sum = 0u; cnt = 0u; mine = 0u;
#pragma unroll
        for (unsigned j = 0; j < 16; ++j) { const unsigned c = xb_ld(&bar[XB_XCNT(j)]); sum += c; cnt += (c > 0u) ? 1u : 0u; mine = (j == x) ? c : mine; }
        if (sum == G) break;
        __builtin_amdgcn_s_sleep(1);
        if ((++sp & 255u) == 0u) { if (xb_ld(&bar[XB_TMO])) break; if (sp > XB_SPIN_CAP) { atomicAdd(&bar[XB_TMO], 1u); break; } }
    }
    nloc = mine > 0u ? mine : 1u; nx = cnt > 0u ? cnt : 1u;
}

__device__ __forceinline__ void xcd_barrier(const XcdBarrier& b) {
    asm volatile("s_waitcnt vmcnt(0)" ::: "memory");
    __syncthreads();
    if (threadIdx.x == 0) {
        unsigned* bar = b.bar;
        __builtin_amdgcn_s_waitcnt(0);
        unsigned nloc = b.st[0], nx = b.st[1];
        if (nloc == 0u) { xcd_barrier_complete(bar, b.x, nloc, nx); b.st[0] = nloc; b.st[1] = nx; }
        const unsigned old = xb_add(&bar[XB_XSUB(b.x)], 1u);
        const unsigned gen = old / nloc;
        if (old + 1u == (gen + 1u) * nloc) {
            __builtin_amdgcn_fence(__ATOMIC_RELEASE, "agent");
            asm volatile("s_waitcnt vmcnt(0)" ::: "memory");
            const unsigned og = xb_add(&bar[XB_TOP], 1u);
            const unsigned tg = og / nx;
            if (og + 1u == (tg + 1u) * nx) xb_add(&bar[XB_TOPGEN], 1u);
            else XB_SPIN(xb_ld(&bar[XB_TOPGEN]) == tg, bar);
            __builtin_amdgcn_fence(__ATOMIC_ACQUIRE, "agent");
            xb_add(&bar[XB_XGEN(b.x)], 1u);
            asm volatile("s_waitcnt vmcnt(0)" ::: "memory");
        } else {
            XB_SPIN(xb_ld(&bar[XB_XGEN(b.x)]) == gen, bar);
            __builtin_amdgcn_fence(__ATOMIC_ACQUIRE, "agent");
            asm volatile("s_waitcnt vmcnt(0)" ::: "memory");
        }
    }
    __syncthreads();
}

constexpr int D = 1024, NB = 8, SEQ = 2048, LC = 256, DEPTH = 4;
constexpr int ML = NB * SEQ, MC = NB * LC, MT = ML + MC;
constexpr int DIN = 7424, FFD = 2816, FFE = 3584, NE = 8;
constexpr int PS = 4352;
constexpr int MSORT = 38912;
constexpr float EPS = 1e-6f;
constexpr int NWAVES = 8, NTHREADS = 512;
#ifndef MK_PER_PHASE
#define MK_PER_PHASE 0
#endif
constexpr int NPH = 2 + 11 * DEPTH;
#ifndef MK_EN
#define MK_EN 0xFFFFFFFFu
#endif
#ifndef MK_DUMP
#define MK_DUMP 0
#endif
#ifndef MK_F8
#define MK_F8 0x2F
#endif
constexpr bool F8IN = (MK_F8 & 16) != 0, F8GATE = (MK_F8 & 32) != 0;
constexpr bool F8UP_D = (MK_F8 & 1) != 0, F8DN_D = (MK_F8 & 2) != 0, F8UP_M = (MK_F8 & 4) != 0, F8DN_M = (MK_F8 & 8) != 0;
#ifndef MK_REP
#define MK_REP 0u
#endif
#ifndef MK_NPH_RUN
#define MK_NPH_RUN NPH
#endif

constexpr size_t MiB = (size_t)1 << 20;
constexpr size_t WS_CTL = 0, CTL_ZERO_BYTES = MiB;
constexpr size_t WS_MOD = 1 * MiB;
constexpr size_t WS_TAB = 2 * MiB;
constexpr size_t WS_ROUTE = 4 * MiB;
constexpr size_t WS_HC = 5 * MiB;
constexpr size_t WS_XN = 13 * MiB;
constexpr size_t WS_YOUT = 49 * MiB;
constexpr size_t WS_WIN = 85 * MiB, WS_WBR = 143 * MiB, WS_WOUT = 155 * MiB, WS_WF13 = 163 * MiB, WS_WF2 = 185 * MiB, WS_WM13 = 196 * MiB, WS_WM2 = 420 * MiB;
constexpr size_t WS_OVL = 532 * MiB;
constexpr size_t WS_PROJ = WS_OVL, WS_YBR = WS_OVL + 261 * MiB, WS_KV = WS_OVL + 315 * MiB, WS_ST = WS_OVL + 387 * MiB;
constexpr size_t WS_TMP = WS_KV, WS_MERGED = WS_ST;
constexpr size_t WS_PART = WS_OVL;
constexpr size_t WS_G8 = WS_OVL + 153 * MiB;
constexpr size_t WS_ASORT = WS_OVL, WS_HID = WS_OVL + 76 * MiB, WS_OSORT = WS_OVL + 342 * MiB;
constexpr size_t WS_HB = WS_OVL + 423 * MiB;
constexpr size_t WS_WIN8 = WS_HB + 36 * MiB;
constexpr size_t WS_XN8 = WS_WIN8 + 12 * MiB;
constexpr size_t WS_END = WS_XN8 + 18 * MiB;
static_assert(WS_OSORT + (size_t)MSORT * D * 2 <= WS_END && WS_ST + 36 * MiB <= WS_END, "map");
constexpr int TAB_RTC = 0, TAB_RTS = 2304 * 64, TAB_AXC = 2 * 2304 * 64, TAB_AXS = 2 * 2304 * 64 + 2048 * 32;
constexpr int CW_BAR = 4096, CW_MOE = 8192, CW_WQ = 12288, CW_RFLAG = 24576, CW_PFLAG = 32768;

constexpr int LDS_BYTES = 147456, MISC_OFF = 131072 + 320;

#define GAS __attribute__((address_space(1)))
#define DEV __device__ __forceinline__
typedef unsigned short bf16;
typedef float f32x4 __attribute__((ext_vector_type(4)));
typedef short bf16x8 __attribute__((ext_vector_type(8)));
typedef short s16x4 __attribute__((ext_vector_type(4)));
typedef unsigned u32x4 __attribute__((ext_vector_type(4)));
typedef unsigned u32x2 __attribute__((ext_vector_type(2)));
#define MFMA16(a, b, c) __builtin_amdgcn_mfma_f32_16x16x32_bf16((a), (b), (c), 0, 0, 0)
DEV float bf2f(unsigned short b) { return __uint_as_float(((unsigned)b) << 16); }
DEV float bflo(unsigned u) { return __uint_as_float(u << 16); }
DEV float bfhi(unsigned u) { return __uint_as_float(u & 0xffff0000u); }
DEV unsigned pk2(float lo, float hi) { return pg8::cvt_pk_bf16(lo, hi); }
DEV unsigned short f2bf(float f) { return (unsigned short)(pg8::cvt_pk_bf16(f, 0.f) & 0xffffu); }
template <int CTRL> DEV float dpp_add(float v) { return v + __int_as_float(__builtin_amdgcn_update_dpp(0, __float_as_int(v), CTRL, 0xf, 0xf, true)); }
DEV float wave_sum(float v) {
    v = dpp_add<0xB1>(v); v = dpp_add<0x4E>(v); v = dpp_add<0x141>(v); v = dpp_add<0x140>(v);
    const int iv = __float_as_int(v);
    return (__int_as_float(__builtin_amdgcn_readlane(iv, 0)) + __int_as_float(__builtin_amdgcn_readlane(iv, 16))) + (__int_as_float(__builtin_amdgcn_readlane(iv, 32)) + __int_as_float(__builtin_amdgcn_readlane(iv, 48)));
}
DEV bf16x8 pack8(const f32x4 a, const f32x4 b) { u32x4 w; w.x = pk2(a[0], a[1]); w.y = pk2(a[2], a[3]); w.z = pk2(b[0], b[1]); w.w = pk2(b[2], b[3]); return __builtin_bit_cast(bf16x8, w); }

struct Args { const float* in[20]; float* out; unsigned char* ws; int ph_lo, ph_hi, li, pad; };
enum { I_X = 0, I_C, I_CTX, I_CCTX, I_WMOD, I_BMOD, I_GAINS, I_WIN, I_DECAY, I_SINK, I_RPB, I_WBR, I_WOUT, I_F1, I_F3, I_F2, I_ROUTER, I_M1, I_M3, I_M2 };

DEV void p0_transpose_item(const float* W, int K, int N, bf16* WT, LAS float* scr, int kb, int n0, int drow0, int lane) {
    const int k0 = 64 * kb;
#pragma unroll 8
    for (int i = 0; i < 32; ++i) { const int kk = 2 * i + (lane >> 5); scr[kk * 33 + (lane & 31)] = __builtin_nontemporal_load(W + (size_t)(k0 + kk) * N + n0 + (lane & 31)); }
    asm volatile("s_waitcnt lgkmcnt(0)" ::: "memory");
    const int c = lane & 7;
#pragma unroll
    for (int j = 0; j < 4; ++j) { const int n = (lane >> 3) + 8 * j; const LAS float* s = scr + (8 * c) * 33 + n;
        u32x4 o; o.x = pk2(s[0 * 33], s[1 * 33]); o.y = pk2(s[2 * 33], s[3 * 33]); o.z = pk2(s[4 * 33], s[5 * 33]); o.w = pk2(s[6 * 33], s[7 * 33]);
        __builtin_nontemporal_store(o, (u32x4*)(WT + (size_t)(drow0 + n) * K + k0 + 8 * c)); }
    asm volatile("s_waitcnt lgkmcnt(0)" ::: "memory");
}

DEV float clampf8(float v) { return __builtin_amdgcn_fmed3f(v, -448.0f, 448.0f); }
DEV unsigned pk4f8(float a, float b, float c, float d) { a = clampf8(a); b = clampf8(b); c = clampf8(c); d = clampf8(d); unsigned w = 0; w = __builtin_amdgcn_cvt_pk_fp8_f32(a, b, w, false); w = __builtin_amdgcn_cvt_pk_fp8_f32(c, d, w, true); return w; }
DEV void p0_transpose_item_f8(const float* W, int K, int N, unsigned char* WT, LAS float* scr, int kb, int n0, int drow0, float scale, int lane) {
    const int k0 = 64 * kb;
#pragma unroll 8
    for (int i = 0; i < 32; ++i) { const int kk = 2 * i + (lane >> 5); scr[kk * 33 + (lane & 31)] = __builtin_nontemporal_load(W + (size_t)(k0 + kk) * N + n0 + (lane & 31)) * scale; }
    asm volatile("s_waitcnt lgkmcnt(0)" ::: "memory");
    const int c = lane & 3;
#pragma unroll
    for (int j = 0; j < 2; ++j) { const int n = (lane >> 2) + 16 * j; const LAS float* s = scr + (16 * c) * 33 + n;
        u32x4 o; o.x = pk4f8(s[0 * 33], s[1 * 33], s[2 * 33], s[3 * 33]); o.y = pk4f8(s[4 * 33], s[5 * 33], s[6 * 33], s[7 * 33]);
        o.z = pk4f8(s[8 * 33], s[9 * 33], s[10 * 33], s[11 * 33]); o.w = pk4f8(s[12 * 33], s[13 * 33], s[14 * 33], s[15 * 33]);
        __builtin_nontemporal_store(o, (u32x4*)(WT + (size_t)(drow0 + n) * K + k0 + 16 * c)); }
    asm volatile("s_waitcnt lgkmcnt(0)" ::: "memory");
}
DEV int inproj_dest_row(int n0) {
    const int pn = n0 >> 8, wi = n0 & 255;
    if (pn < 4) { const int hl = wi >> 7, rem = wi & 127, half = rem >> 6, i = rem & 63; return pn * 256 + half * 128 + hl * 64 + i; }
    if (pn == 8 || pn == 9) { const int hl = wi >> 6, rem = wi & 63, half = rem >> 5, i = rem & 31; return pn * 256 + half * 128 + hl * 32 + i; }
    if (pn == 10) { const int isv = wi >> 7, w2 = wi & 127, hl = w2 >> 6, half = (w2 & 63) >> 5, i = w2 & 31; return 2560 + half * 128 + (2 * isv + hl) * 32 + i; }
    return n0;
}
DEV void p0_prologue(const Args& A, LAS unsigned char* lds, int vcu, int G, int tid) {
    const int wave = __builtin_amdgcn_readfirstlane(tid >> 6), lane = tid & 63;
    unsigned char* ws = A.ws;
    {
        LAS float* sc = (LAS float*)lds;
        LAS float* red = (LAS float*)(lds + 9 * 1024 * 4);
        for (int i = tid; i < 9 * 1024; i += NTHREADS) { const int r = i >> 10, k = i & 1023; const float v = r < 8 ? A.in[I_C][r * 1024 + k] : A.in[I_CCTX][k]; sc[i] = v / (1.0f + __expf(-v)); }
        __syncthreads();
        float* MOD = (float*)(ws + WS_MOD);
        for (int it = vcu; it < 4 * 96; it += G) {
            const int l = it / 96, cg = it % 96, col = cg * 64 + lane;
            const float* W = A.in[I_WMOD] + (size_t)l * 1024 * 6144 + col;
            float acc[9];
#pragma unroll
            for (int r = 0; r < 9; ++r) acc[r] = 0.f;
#pragma unroll 4
            for (int kk = 0; kk < 128; ++kk) { const int k = wave * 128 + kk; const float w = __builtin_nontemporal_load(W + (size_t)k * 6144);
#pragma unroll
                for (int r = 0; r < 9; ++r) acc[r] += sc[r * 1024 + k] * w; }
#pragma unroll
            for (int r = 0; r < 9; ++r) red[(wave * 9 + r) * 64 + lane] = acc[r];
            __syncthreads();
            for (int o = tid; o < 9 * 64; o += NTHREADS) { const int r = o >> 6, ln = o & 63; float s = 0.f;
#pragma unroll
                for (int w = 0; w < 8; ++w) s += red[(w * 9 + r) * 64 + ln];
                MOD[((size_t)l * 9 + r) * 6144 + cg * 64 + ln] = s + A.in[I_BMOD][l * 6144 + cg * 64 + ln]; }
            __syncthreads();
        }
    }
    {
        float* TAB = (float*)(ws + WS_TAB);
        const int gt = vcu * NTHREADS + tid, NGT = G * NTHREADS;
        for (int i = gt; i < 2304 * 64; i += NGT) { const int pos = i >> 6, f = i & 63; const float inv = exp2f(-(float)f * (13.287712379549449f / 64.0f)); const float ang = (float)pos * inv; float s, c; sincosf(ang, &s, &c); TAB[TAB_RTC + i] = c; TAB[TAB_RTS + i] = s; }
        for (int i = gt; i < 2048 * 32; i += NGT) { const int t = i >> 5, f = i & 31; const float inv = exp2f(-(float)(f & 15) * (13.287712379549449f / 16.0f)); const float p = (f < 16) ? (float)(t >> 6) : (float)(t & 63); const float ang = p * inv; float s, c; sincosf(ang, &s, &c); TAB[TAB_AXC + i] = c; TAB[TAB_AXS + i] = s; }
    }
    __syncthreads();
    {
        LAS float* scr = (LAS float*)(lds + wave * 16384);
        const int gw = vcu * NWAVES + wave, NGW = G * NWAVES;
        constexpr int C_IN = 16 * 232, C_BR = 8 * 32, C_OUT = 16 * 32, C_F13 = 16 * 88, C_F2 = 44 * 32, C_M13 = 16 * 112, C_M2 = 56 * 32;
        constexpr int N_IN = 4 * C_IN, N_BR = 12 * C_BR, N_OUT = 4 * C_OUT, N_F13 = 4 * C_F13, N_F2 = 2 * C_F2, N_M13 = 32 * C_M13, N_M2 = 16 * C_M2;
        constexpr int NITEMS = N_IN + N_BR + N_OUT + N_F13 + N_F2 + N_M13 + N_M2;
        for (int it = gw; it < NITEMS; it += NGW) {
            int r = it;
            if (r < N_IN) { const int l = r / C_IN, q = r % C_IN, kb = q / 232, nb = q % 232;
                if constexpr (F8IN) p0_transpose_item_f8(A.in[I_WIN] + (size_t)l * 1024 * DIN, 1024, DIN, ws + WS_WIN + (size_t)l * DIN * 1024, scr, kb, 32 * nb, inproj_dest_row(32 * nb), 64.0f, lane);
                else if (F8GATE && 32 * nb >= 4352) p0_transpose_item_f8(A.in[I_WIN] + (size_t)l * 1024 * DIN, 1024, DIN, ws + WS_WIN8 + (size_t)l * 3072 * 1024, scr, kb, 32 * nb, 32 * nb - 4352, 64.0f, lane);
                else p0_transpose_item(A.in[I_WIN] + (size_t)l * 1024 * DIN, 1024, DIN, (bf16*)(ws + WS_WIN) + (size_t)l * DIN * 1024, scr, kb, 32 * nb, inproj_dest_row(32 * nb), lane);
                continue; } r -= N_IN;
            if (r < N_BR) { const int mtx = r / C_BR, q = r % C_BR, kb = q / 32, nb = q % 32;
                p0_transpose_item(A.in[I_WBR] + (size_t)mtx * 512 * 1024, 512, 1024, (bf16*)(ws + WS_WBR) + (size_t)mtx * 1024 * 512, scr, kb, 32 * nb, 32 * nb, lane); continue; } r -= N_BR;
            if (r < N_OUT) { const int l = r / C_OUT, q = r % C_OUT, kb = q / 32, nb = q % 32;
                p0_transpose_item(A.in[I_WOUT] + (size_t)l * 1024 * 1024, 1024, 1024, (bf16*)(ws + WS_WOUT) + (size_t)l * 1024 * 1024, scr, kb, 32 * nb, 32 * nb, lane); continue; } r -= N_OUT;
            if (r < N_F13) { const int mtx = r / C_F13, q = r % C_F13, kb = q / 88, nb = q % 88, i = mtx >> 1, which = mtx & 1, n0 = 32 * nb;
                if constexpr (F8UP_D) p0_transpose_item_f8(A.in[which ? I_F3 : I_F1] + (size_t)i * 1024 * FFD, 1024, FFD, ws + WS_WF13 + (size_t)i * 2 * FFD * 1024, scr, kb, n0, (n0 >> 7) * 256 + which * 128 + (n0 & 127), 64.0f, lane);
                else p0_transpose_item(A.in[which ? I_F3 : I_F1] + (size_t)i * 1024 * FFD, 1024, FFD, (bf16*)(ws + WS_WF13) + (size_t)i * 2 * FFD * 1024, scr, kb, n0, (n0 >> 7) * 256 + which * 128 + (n0 & 127), lane);
                continue; } r -= N_F13;
            if (r < N_F2) { const int i = r / C_F2, q = r % C_F2, kb = q / 32, nb = q % 32;
                if constexpr (F8DN_D) p0_transpose_item_f8(A.in[I_F2] + (size_t)i * FFD * 1024, FFD, 1024, ws + WS_WF2 + (size_t)i * 1024 * FFD, scr, kb, 32 * nb, 32 * nb, 128.0f, lane);
                else p0_transpose_item(A.in[I_F2] + (size_t)i * FFD * 1024, FFD, 1024, (bf16*)(ws + WS_WF2) + (size_t)i * 1024 * FFD, scr, kb, 32 * nb, 32 * nb, lane);
                continue; } r -= N_F2;
            if (r < N_M13) { const int mtx = r / C_M13, q = r % C_M13, kb = q / 112, nb = q % 112, ie = mtx >> 1, which = mtx & 1, n0 = 32 * nb;
                if constexpr (F8UP_M) p0_transpose_item_f8(A.in[which ? I_M3 : I_M1] + (size_t)ie * 1024 * FFE, 1024, FFE, ws + WS_WM13 + (size_t)ie * 2 * FFE * 1024, scr, kb, n0, (n0 >> 7) * 256 + which * 128 + (n0 & 127), 64.0f, lane);
                else p0_transpose_item(A.in[which ? I_M3 : I_M1] + (size_t)ie * 1024 * FFE, 1024, FFE, (bf16*)(ws + WS_WM13) + (size_t)ie * 2 * FFE * 1024, scr, kb, n0, (n0 >> 7) * 256 + which * 128 + (n0 & 127), lane);
                continue; } r -= N_M13;
            { const int ie = r / C_M2, q = r % C_M2, kb = q / 32, nb = q % 32;
                if constexpr (F8DN_M) p0_transpose_item_f8(A.in[I_M2] + (size_t)ie * FFE * 1024, FFE, 1024, ws + WS_WM2 + (size_t)ie * 1024 * FFE, scr, kb, 32 * nb, 32 * nb, 128.0f, lane);
                else p0_transpose_item(A.in[I_M2] + (size_t)ie * FFE * 1024, FFE, 1024, (bf16*)(ws + WS_WM2) + (size_t)ie * 1024 * FFE, scr, kb, 32 * nb, 32 * nb, lane); }
        }
    }
}

DEV void ld_row_f32(const float* p, int lane, f32x4 (&v)[4]) {
#pragma unroll
    for (int j = 0; j < 4; ++j) v[j] = __builtin_nontemporal_load((const f32x4*)(p + 4 * lane + 256 * j));
}
DEV void ld_row_bf16(const bf16* p, int lane, f32x4 (&v)[4]) {
#pragma unroll
    for (int j = 0; j < 4; ++j) { const u32x2 u = *(const u32x2*)(p + 4 * lane + 256 * j); v[j][0] = bflo(u.x); v[j][1] = bfhi(u.x); v[j][2] = bflo(u.y); v[j][3] = bfhi(u.y); }
}
DEV void st_row_bf16(bf16* p, int lane, const f32x4 (&v)[4]) {
#pragma unroll
    for (int j = 0; j < 4; ++j) { u32x2 u; u.x = pk2(v[j][0], v[j][1]); u.y = pk2(v[j][2], v[j][3]); *(u32x2*)(p + 4 * lane + 256 * j) = u; }
}
DEV void st_row_bf16_nt(bf16* p, int lane, const f32x4 (&v)[4]) {
#pragma unroll
    for (int j = 0; j < 4; ++j) { u32x2 u; u.x = pk2(v[j][0], v[j][1]); u.y = pk2(v[j][2], v[j][3]); __builtin_nontemporal_store(u, (u32x2*)(p + 4 * lane + 256 * j)); }
}
DEV float row_rstd(const f32x4 (&v)[4]) {
    float s = 0.f;
#pragma unroll
    for (int j = 0; j < 4; ++j) s += (v[j][0] * v[j][0] + v[j][1] * v[j][1]) + (v[j][2] * v[j][2] + v[j][3] * v[j][3]);
    return rsqrtf(wave_sum(s) * (1.0f / 1024.0f) + EPS);
}
DEV void moe_bases(const unsigned* cnt, int (&base)[8]) {
    int acc = 0;
#pragma unroll
    for (int e = 0; e < 8; ++e) { base[e] = acc; const unsigned ce = __hip_atomic_load(cnt + 64 * e, __ATOMIC_RELAXED, __HIP_MEMORY_SCOPE_AGENT); acc += (int)(((ce + 255u) >> 8) << 8); }
}
DEV int sel8(const int (&b)[8], int e) { int r = 0;
#pragma unroll
    for (int k = 0; k < 8; ++k) r = (e == k) ? b[k] : r;
    return r; }

DEV void raw_row_bf16(const bf16* p, int lane, u32x2 (&v)[4]) {
#pragma unroll
    for (int j = 0; j < 4; ++j) v[j] = __builtin_nontemporal_load((const u32x2*)(p + 4 * lane + 256 * j));
}
DEV void cvt_row_bf16(const u32x2 (&u)[4], f32x4 (&v)[4]) {
#pragma unroll
    for (int j = 0; j < 4; ++j) { v[j][0] = bflo(u[j].x); v[j][1] = bfhi(u[j].x); v[j][2] = bflo(u[j].y); v[j][3] = bfhi(u[j].y); }
}
constexpr int TR = 2;
template <int MODE> DEV void thin_phase(const Args& A, int L, int wid, int nw, int row_lo, int row_hi, int tid, LAS unsigned char* lds) {
    const int wave = __builtin_amdgcn_readfirstlane(tid >> 6), lane = tid & 63;
    const int gw = wid * NWAVES + wave, NGW = nw * NWAVES;
    unsigned char* ws = A.ws;
    const float* MOD = (const float*)(ws + WS_MOD);
    const float* GN = A.in[I_GAINS];
    unsigned char* HC = ws + WS_HB;
    bf16* XN = (bf16*)(ws + WS_XN);
    const bf16* YOUT = (const bf16*)(ws + WS_YOUT);
    int* ROUTE = (int*)(ws + WS_ROUTE);
    const int mi = L >> 1;
    unsigned* cnt = (unsigned*)(ws + WS_CTL) + CW_MOE + mi * 8 * 64;
    int base[8];
    const bool moe2 = (MODE == 2) && (L & 1);
    if (moe2) moe_bases(cnt, base);
    const bool first = (L == 0 && MODE <= 1);
    const bool rout = (MODE == 1) && (L & 1);
    const LAS f32x4* WL = (const LAS f32x4*)lds;
    if (rout) {
        const f32x4* WR4 = (const f32x4*)(A.in[I_ROUTER] + (size_t)mi * 1024 * 8);
        for (int s4 = tid; s4 < 2048; s4 += NTHREADS) { const int k = s4 >> 1, hf_ = s4 & 1; ((LAS f32x4*)lds)[(((k >> 8) * 4 + (k & 3)) * 2 + hf_) * 64 + ((k & 255) >> 2)] = WR4[s4]; }
        __syncthreads();
    }
    const float* gn = GN + L * 4096;
    const bf16* OS = (const bf16*)(ws + WS_OSORT);
    const int nrows_ = row_hi - row_lo, r_beg = row_lo + (int)(((long)gw * nrows_) / NGW), r_end = row_lo + (int)(((long)(gw + 1) * nrows_) / NGW);
    const int Ln = (MODE == 2) ? L + 1 : L;
    f32x4 vgy[4], vgx[4], vgate[4], vsh[4], vsc[4]; int mr_cur = -1;
    if (r_beg < r_end) {
        const float* gy = gn + (MODE == 1 ? 1 : 3) * 1024; const float* gx = GN + Ln * 4096 + (MODE == 1 ? 2 : 0) * 1024;
#pragma unroll
        for (int j = 0; j < 4; ++j) { if (MODE != 0) vgy[j] = *(const f32x4*)(gy + 4 * lane + 256 * j); vgx[j] = *(const f32x4*)(gx + 4 * lane + 256 * j); }
    }
    const bool pre = moe2 && (r_end - r_beg <= 64);
    int4 prq = {0, 0, 0, 0}; int2 prw = {0, 0};
    if (pre && r_beg < r_end) { const int* rt = ROUTE + (size_t)((r_beg + lane < r_end) ? r_beg + lane : r_beg) * 8; prq = *(const int4*)rt; prw = *(const int2*)(rt + 4); }
    for (int m0 = r_beg; m0 < r_end; m0 += TR) {
        int mm[TR]; bool on[TR];
#pragma unroll
        for (int r = 0; r < TR; ++r) { const int m = m0 + r; on[r] = m < r_end; mm[r] = on[r] ? m : m0; }
        int4 rq[TR]; int2 rw[TR];
        if (moe2) {
#pragma unroll
            for (int r = 0; r < TR; ++r) {
                if (pre) { const int k = mm[r] - r_beg;
                    rq[r].x = __builtin_amdgcn_readlane(prq.x, k); rq[r].y = __builtin_amdgcn_readlane(prq.y, k); rq[r].z = __builtin_amdgcn_readlane(prq.z, k); rq[r].w = __builtin_amdgcn_readlane(prq.w, k);
                    rw[r].x = __builtin_amdgcn_readlane(prw.x, k); rw[r].y = __builtin_amdgcn_readlane(prw.y, k); }
                else { const int* rt = ROUTE + (size_t)mm[r] * 8; rq[r] = *(const int4*)rt; rw[r] = *(const int2*)(rt + 4); } }
        }
        f32x4 hf[TR][4]; u32x2 hr[TR][4], ya[TR][4], yb[TR][4];
#pragma unroll
        for (int r = 0; r < TR; ++r) { const int m = mm[r];
            if (first) ld_row_f32(m >= ML ? A.in[I_CTX] + (size_t)(m - ML) * D : A.in[I_X] + (size_t)m * D, lane, hf[r]);
            else raw_row_bf16((const bf16*)HC + (size_t)m * D, lane, hr[r]);
            if (MODE != 0) {
                if (moe2) { raw_row_bf16(OS + (size_t)(sel8(base, rq[r].x) + rq[r].z) * D, lane, ya[r]); raw_row_bf16(OS + (size_t)(sel8(base, rq[r].y) + rq[r].w) * D, lane, yb[r]); }
                else raw_row_bf16(YOUT + (size_t)m * D, lane, ya[r]);
            } }
#pragma unroll
        for (int r = 0; r < TR; ++r) if (on[r]) { const int m = mm[r];
        const bool isc = m >= ML;
        const int mr = isc ? 8 : (m >> 11);
        if (mr != mr_cur) { mr_cur = mr;
            const float* md = MOD + ((size_t)L * 9 + mr) * 6144; const float* mdn = MOD + ((size_t)Ln * 9 + mr) * 6144;
            const float* gate = md + (MODE == 1 ? 2 : 5) * 1024; const float* sh = mdn + (MODE == 1 ? 3 : 0) * 1024; const float* sc = mdn + (MODE == 1 ? 4 : 1) * 1024;
#pragma unroll
            for (int j = 0; j < 4; ++j) { if (MODE != 0) vgate[j] = *(const f32x4*)(gate + 4 * lane + 256 * j); vsh[j] = *(const f32x4*)(sh + 4 * lane + 256 * j); vsc[j] = *(const f32x4*)(sc + 4 * lane + 256 * j); }
        }
        bf16* hb = (bf16*)HC + (size_t)m * D;
        f32x4 h[4];
        if (first) {
#pragma unroll
            for (int j = 0; j < 4; ++j) h[j] = hf[r][j];
        } else cvt_row_bf16(hr[r], h);
        if (MODE != 0) {
            f32x4 y[4];
            if (moe2) {
                const float w0 = __int_as_float(rw[r].x), w1 = __int_as_float(rw[r].y);
                f32x4 y0[4], y1[4]; cvt_row_bf16(ya[r], y0); cvt_row_bf16(yb[r], y1);
#pragma unroll
                for (int j = 0; j < 4; ++j) y[j] = y0[j] * w0 + y1[j] * w1;
            } else cvt_row_bf16(ya[r], y);
            const float rs = row_rstd(y);
#pragma unroll
            for (int j = 0; j < 4; ++j) h[j] = h[j] + vgate[j] * (y[j] * rs * vgy[j]);
            if (MODE == 2 && L == 3) {
#pragma unroll
                for (int j = 0; j < 4; ++j) __builtin_nontemporal_store(h[j], (f32x4*)(A.out + (size_t)m * D + 4 * lane + 256 * j));
            } else st_row_bf16_nt(hb, lane, h);
        }
        if (MODE == 2 && L == 3) continue;
        const float rs = row_rstd(h);
        f32x4 a[4];
#pragma unroll
        for (int j = 0; j < 4; ++j) a[j] = (h[j] * rs * vgx[j]) * (vsc[j] + 1.0f) + vsh[j];
        if ((MODE == 1 && ((L & 1) ? F8UP_M : F8UP_D)) || (MODE != 1 && F8IN)) {
#pragma unroll
            for (int j = 0; j < 4; ++j) *(unsigned*)((unsigned char*)XN + (size_t)m * D + 4 * lane + 256 * j) = pk4f8(a[j][0], a[j][1], a[j][2], a[j][3]);
        } else { st_row_bf16(XN + (size_t)m * D, lane, a);
            if (MODE != 1 && F8GATE) {
#pragma unroll
                for (int j = 0; j < 4; ++j) *(unsigned*)(ws + WS_XN8 + (size_t)m * D + 4 * lane + 256 * j) = pk4f8(a[j][0], a[j][1], a[j][2], a[j][3]); } }
        if (MODE == 1 && (L & 1)) {
            float lg[8];
#pragma unroll
            for (int e = 0; e < 8; ++e) lg[e] = 0.f;
#pragma unroll
            for (int j = 0; j < 4; ++j)
#pragma unroll
                for (int i = 0; i < 4; ++i) { if ((i & 1) == 0) __builtin_amdgcn_sched_barrier(0); const f32x4 w0 = WL[((j * 4 + i) * 2 + 0) * 64 + lane], w1 = WL[((j * 4 + i) * 2 + 1) * 64 + lane]; const float x = a[j][i];
                    lg[0] += x * w0[0]; lg[1] += x * w0[1]; lg[2] += x * w0[2]; lg[3] += x * w0[3]; lg[4] += x * w1[0]; lg[5] += x * w1[1]; lg[6] += x * w1[2]; lg[7] += x * w1[3]; }
#pragma unroll
            for (int e = 0; e < 8; ++e) lg[e] = wave_sum(lg[e]);
            int e0 = 0; float v0 = lg[0];
#pragma unroll
            for (int e = 1; e < 8; ++e) if (lg[e] > v0) { v0 = lg[e]; e0 = e; }
            int e1 = -1; float v1 = -INFINITY;
#pragma unroll
            for (int e = 0; e < 8; ++e) if (e != e0 && lg[e] > v1) { v1 = lg[e]; e1 = e; }
            const float ex = __expf(v1 - v0), w0 = 1.0f / (1.0f + ex), w1 = ex * w0;
            if (lane == 0) {
                const int r0 = (int)__hip_atomic_fetch_add(cnt + 64 * e0, 1u, __ATOMIC_RELAXED, __HIP_MEMORY_SCOPE_AGENT);
                const int r1 = (int)__hip_atomic_fetch_add(cnt + 64 * e1, 1u, __ATOMIC_RELAXED, __HIP_MEMORY_SCOPE_AGENT);
                int* rt = ROUTE + (size_t)m * 8; rt[0] = e0; rt[1] = e1; rt[2] = r0; rt[3] = r1; rt[4] = __float_as_int(w0); rt[5] = __float_as_int(w1);
            }
        }
        }
    }
    if (rout) __syncthreads();
}
DEV void gather_phase(const Args& A, int L, int vcu, int G, int tid) {
    const int wave = __builtin_amdgcn_readfirstlane(tid >> 6), lane = tid & 63;
    const int gw = vcu * NWAVES + wave, NGW = G * NWAVES;
    unsigned char* ws = A.ws;
    const int nrows = (L == 3) ? ML : MT, mi = L >> 1;
    const unsigned* cnt = (const unsigned*)(ws + WS_CTL) + CW_MOE + mi * 8 * 64;
    int base[8]; moe_bases(cnt, base);
    const bf16* XN = (const bf16*)(ws + WS_XN); bf16* AS = (bf16*)(ws + WS_ASORT); const int* ROUTE = (const int*)(ws + WS_ROUTE);
    constexpr int RB = F8UP_M ? D : 2 * D;
    const int t_beg = (int)(((long)gw * nrows) / NGW), t_end = (int)(((long)(gw + 1) * nrows) / NGW);
    for (int c0 = t_beg; c0 < t_end; c0 += 64) {
        const int c1 = (c0 + 64 < t_end) ? c0 + 64 : t_end;
        int d0, d1; { const int4 rq = *(const int4*)(ROUTE + (size_t)((c0 + lane < c1) ? c0 + lane : c0) * 8); d0 = sel8(base, rq.x) + rq.z; d1 = sel8(base, rq.y) + rq.w; }
        for (int k0 = c0; k0 < c1; k0 += 4) {
            u32x4 v[4], w[4];
#pragma unroll
            for (int q = 0; q < 4; ++q) { const int m = k0 + q; if (m < c1) { const u32x4* src = (const u32x4*)((const unsigned char*)XN + (size_t)m * RB); v[q] = src[lane]; if constexpr (!F8UP_M) w[q] = src[lane + 64]; } }
#pragma unroll
            for (int q = 0; q < 4; ++q) { const int m = k0 + q; if (m < c1) {
                const int e0 = __builtin_amdgcn_readlane(d0, m - c0), e1 = __builtin_amdgcn_readlane(d1, m - c0);
                u32x4* p0 = (u32x4*)((unsigned char*)AS + (size_t)e0 * RB); u32x4* p1 = (u32x4*)((unsigned char*)AS + (size_t)e1 * RB);
                p0[lane] = v[q]; p1[lane] = v[q]; if constexpr (!F8UP_M) { p0[lane + 64] = w[q]; p1[lane + 64] = w[q]; } } }
        }
    }
}

#ifndef MK_VTR
#define MK_VTR 1
#endif
constexpr float LOG2E = 1.4426950408889634f;
constexpr int KS_STRIDE = 144;
constexpr int VS_STRIDE = MK_VTR ? 160 : 144;
constexpr int AT_VT = 9216, AT_BUF = AT_VT + 64 * VS_STRIDE, AT_RPB = 2 * AT_BUF, AT_Q = AT_RPB + 8192;
static_assert(AT_Q + 65536 <= 131072, "attention LDS");
typedef short v4i16_t __attribute__((ext_vector_type(4)));
#define AT_SCHED() __builtin_amdgcn_sched_barrier(0)
DEV float xrow16_max(float x) {
    auto s = __builtin_amdgcn_permlane16_swap(__float_as_uint(x), __float_as_uint(x), false, false);
    x = fmaxf(__uint_as_float(s[0]), __uint_as_float(s[1]));
    auto t = __builtin_amdgcn_permlane32_swap(__float_as_uint(x), __float_as_uint(x), false, false);
    return fmaxf(__uint_as_float(t[0]), __uint_as_float(t[1]));
}
DEV float xrow16_sum(float x) {
    auto s = __builtin_amdgcn_permlane16_swap(__float_as_uint(x), __float_as_uint(x), false, false);
    x = __uint_as_float(s[0]) + __uint_as_float(s[1]);
    auto t = __builtin_amdgcn_permlane32_swap(__float_as_uint(x), __float_as_uint(x), false, false);
    return __uint_as_float(t[0]) + __uint_as_float(t[1]);
}
struct KVRegs { u32x4 k, v; };
DEV void kv_load(KVRegs& r, const bf16* kp, const bf16* vp, int tid) {
    const int row = tid >> 3, c = tid & 7;
    r.k = *(const u32x4*)(kp + (size_t)row * PS + 8 * c); r.v = *(const u32x4*)(vp + (size_t)row * PS + 8 * c);
}
DEV void kv_write(LAS unsigned char* buf, const KVRegs& r, int tid) {
    const int row = tid >> 3, c = tid & 7;
    *(LAS u32x4*)(buf + row * KS_STRIDE + c * 16) = r.k;
#if MK_VTR
    *(LAS u32x4*)(buf + AT_VT + row * VS_STRIDE + c * 16) = r.v;
#else
    LAS unsigned short* p = (LAS unsigned short*)(buf + AT_VT) + (8 * c) * (VS_STRIDE / 2) + row;
    p[0 * (VS_STRIDE / 2)] = (unsigned short)(r.v.x & 0xffffu); p[1 * (VS_STRIDE / 2)] = (unsigned short)(r.v.x >> 16);
    p[2 * (VS_STRIDE / 2)] = (unsigned short)(r.v.y & 0xffffu); p[3 * (VS_STRIDE / 2)] = (unsigned short)(r.v.y >> 16);
    p[4 * (VS_STRIDE / 2)] = (unsigned short)(r.v.z & 0xffffu); p[5 * (VS_STRIDE / 2)] = (unsigned short)(r.v.z >> 16);
    p[6 * (VS_STRIDE / 2)] = (unsigned short)(r.v.w & 0xffffu); p[7 * (VS_STRIDE / 2)] = (unsigned short)(r.v.w >> 16);
#endif
}
DEV bf16x8 v_frag(const LAS unsigned char* buf, int u, int dt, int c16, int q4) {
#if MK_VTR
    const LAS unsigned char* vr = buf + AT_VT + (32 * u + 4 * q4 + (c16 >> 2)) * VS_STRIDE + (16 * dt + 4 * (c16 & 3)) * 2;
    const s16x4 lo = __builtin_bit_cast(s16x4, __builtin_amdgcn_ds_read_tr16_b64_v4i16((LAS v4i16_t*)vr));
    const s16x4 hi = __builtin_bit_cast(s16x4, __builtin_amdgcn_ds_read_tr16_b64_v4i16((LAS v4i16_t*)(vr + 16 * VS_STRIDE)));
#else
    const LAS unsigned char* vr = buf + AT_VT + (16 * dt + c16) * VS_STRIDE + (32 * u + 4 * q4) * 2;
    const s16x4 lo = *(const LAS s16x4*)vr, hi = *(const LAS s16x4*)(vr + 32);
#endif
    return __builtin_shufflevector(lo, hi, 0, 1, 2, 3, 4, 5, 6, 7);
}
template <int NT, int TM0, int TM1, int TM2, int TM3, class F0, class F1, class F2, class F3>
DEV void chunk_tiles(const LAS unsigned char* buf, const LAS unsigned char* ql, float (&m_run)[NT], float (&l_run)[NT], f32x4 (&o)[NT][4], int c16, int q4, F0 mf0, F1 mf1, F2 mf2, F3 mf3) {
    constexpr int TM[4] = {TM0, TM1, TM2, TM3};
    constexpr int TMALL = TM0 | TM1 | (NT > 2 ? (TM2 | TM3) : 0);
    f32x4 s[NT][4];
    {
        bf16x8 kf[4][2];
#pragma unroll
        for (int t = 0; t < 4; ++t)
            if ((TMALL >> t) & 1) {
#pragma unroll
                for (int k = 0; k < 2; ++k) kf[t][k] = *(const LAS bf16x8*)(buf + (16 * t + c16) * KS_STRIDE + (32 * k + 8 * q4) * 2);
            }
#pragma unroll
        for (int j = 0; j < NT; ++j) {
            const bf16x8 q0 = *(const LAS bf16x8*)(ql + (2 * j) * 1024), q1 = *(const LAS bf16x8*)(ql + (2 * j + 1) * 1024);
#pragma unroll
            for (int t = 0; t < 4; ++t) {
                f32x4 acc = {0.f, 0.f, 0.f, 0.f};
                if ((TM[j] >> t) & 1) { acc = MFMA16(kf[t][0], q0, acc); acc = MFMA16(kf[t][1], q1, acc); }
                s[j][t] = acc;
            }
        }
    }
    bf16x8 bp[NT][2];
#pragma unroll
    for (int j = 0; j < NT; ++j) {
        float mx = m_run[j];
#pragma unroll
        for (int t = 0; t < 4; ++t)
            if ((TM[j] >> t) & 1) {
#pragma unroll
                for (int r = 0; r < 4; ++r) { const int kk = 16 * t + 4 * q4 + r; float v = s[j][t][r]; v = (j == 0) ? mf0(kk, v) : (j == 1) ? mf1(kk, v) : (j == 2) ? mf2(kk, v) : mf3(kk, v); s[j][t][r] = v; mx = fmaxf(mx, v); }
            }
        mx = xrow16_max(mx);
        const float alpha = __builtin_amdgcn_exp2f(m_run[j] - mx); m_run[j] = mx;
        float ls = 0.f;
#pragma unroll
        for (int t = 0; t < 4; ++t)
            if ((TM[j] >> t) & 1) {
#pragma unroll
                for (int r = 0; r < 4; ++r) { const float p = __builtin_amdgcn_exp2f(s[j][t][r] - mx); s[j][t][r] = p; ls += p; }
            }
        l_run[j] = l_run[j] * alpha + ls;
#pragma unroll
        for (int dt = 0; dt < 4; ++dt) o[j][dt] = o[j][dt] * alpha;
#pragma unroll
        for (int u = 0; u < 2; ++u) bp[j][u] = pack8(s[j][2 * u], s[j][2 * u + 1]);
    }
#pragma unroll
    for (int u = 0; u < 2; ++u)
        if ((TMALL >> (2 * u)) & 3) {
#pragma unroll
            for (int dt = 0; dt < 4; ++dt) { const bf16x8 vf = v_frag(buf, u, dt, c16, q4);
#pragma unroll
                for (int j = 0; j < NT; ++j) if ((TM[j] >> (2 * u)) & 3) o[j][dt] = MFMA16(vf, bp[j][u], o[j][dt]); }
        }
    AT_SCHED();
}
DEV void attn_store(bf16* dst, float l_run, const f32x4 (&o)[4], int q4) {
    const float inv = 1.0f / xrow16_sum(l_run);
#pragma unroll
    for (int dt = 0; dt < 4; ++dt) { u32x2 u; u.x = pk2(o[dt][0] * inv, o[dt][1] * inv); u.y = pk2(o[dt][2] * inv, o[dt][3] * inv); *(u32x2*)(dst + 16 * dt + 4 * q4) = u; }
}
DEV int na_start(int r) { return r - 4 < 0 ? 0 : (r - 4 > 24 ? 24 : r - 4); }
template <int MODE> DEV void attn4_unit(const Args& A, int L, int unit, LAS unsigned char* lds, int tid) {
    constexpr int NT = (MODE == 3) ? 2 : 4;
    const int w = __builtin_amdgcn_readfirstlane(tid >> 6), lane = tid & 63, c16 = lane & 15, q4 = lane >> 4;
    unsigned char* ws = A.ws;
    const bf16* proj = (const bf16*)(ws + WS_PROJ);
    bf16* ybr = (bf16*)(ws + WS_YBR);
    LAS float* RPB = (LAS float*)(lds + AT_RPB);
    int b, h = 0, kcol, vcol, nlat = 0, lat0 = 0, kr0 = 0, tq = 0, rq = 0;
    size_t qrow0; int qcol0; float m_run[NT], l_run[NT]; int kvh = 0;
    if (MODE == 0 || MODE == 2) {
        if (MODE == 0) { const int qb = unit & 15; kvh = (unit >> 4) & 1; b = unit >> 5; tq = qb * 128 + 16 * w + c16;
            const int lo = qb * 128 - 128 < 0 ? 0 : qb * 128 - 128, hi = qb * 128 + 256 > SEQ ? SEQ : qb * 128 + 256; lat0 = lo; nlat = (hi - lo) >> 6; }
        else { const int qb = unit & 1; kvh = (unit >> 1) & 1; b = unit >> 2; tq = qb * 128 + 16 * w + c16; }
        kcol = 2560 + kvh * 64; vcol = 2688 + kvh * 64;
#pragma unroll
        for (int j = 0; j < NT; ++j) { const int hq = kvh * 4 + j; m_run[j] = A.in[I_SINK][L * 8 + hq] * LOG2E; l_run[j] = q4 == 0 ? 1.f : 0.f; }
        qrow0 = (MODE == 0) ? (size_t)b * SEQ + tq : (size_t)ML + b * LC + tq; qcol0 = 2048 + kvh * 4 * 64;
    } else {
        if (MODE == 1) { const int rg = unit & 3; h = (unit >> 2) & 7; b = unit >> 5; rq = 8 * rg + w; kr0 = na_start(8 * rg); nlat = na_start(8 * rg + 7) + 8 - kr0; }
        else { h = unit & 7; b = unit >> 3; }
        kcol = 3328 + h * 64; vcol = 3840 + h * 64;
#pragma unroll
        for (int j = 0; j < NT; ++j) { m_run[j] = -1e30f; l_run[j] = 0.f; }
        qrow0 = (MODE == 1) ? (size_t)b * SEQ + rq * 64 + c16 : (size_t)ML + b * LC + 32 * w + c16; qcol0 = 2816 + h * 64;
    }
    f32x4 o[NT][4];
#pragma unroll
    for (int j = 0; j < NT; ++j)
#pragma unroll
        for (int dt = 0; dt < 4; ++dt) o[j][dt] = (f32x4){0.f, 0.f, 0.f, 0.f};
    constexpr size_t QSTRIDE = (MODE == 0 || MODE == 2) ? (size_t)64 : (size_t)16 * PS;
    const bf16* qb = proj + qrow0 * PS + qcol0 + 8 * q4;
    LAS unsigned char* ql = lds + AT_Q + w * 8192 + lane * 16;
    const int nch = 4 + nlat;
#define CH_ROW0(ci) ((ci) < 4 ? (size_t)ML + b * LC + (ci) * 64 : (MODE == 0 ? (size_t)b * SEQ + lat0 + ((ci) - 4) * 64 : (size_t)b * SEQ + (kr0 + (ci) - 4) * 64))
#define CH_LOAD(R, ci) do { const size_t r_ = CH_ROW0(ci); kv_load(R, proj + r_ * PS + kcol, proj + r_ * PS + vcol, tid); } while (0)
    KVRegs kvA, kvB;
    __syncthreads();
    if (MODE == 1) {
        for (int i = tid; i < 960; i += NTHREADS) { const int rw = i >> 6, dc = (i & 63) - 16; const bool in = dc >= 0 && dc <= 30;
            const float v = in ? A.in[I_RPB][(size_t)(L * 8 + h) * 465 + rw * 31 + dc] * LOG2E : 0.f;
            RPB[i] = v; RPB[960 + i] = (dc >= 7 && dc <= 22) ? v : -INFINITY; } }
    CH_LOAD(kvA, 0);
    CH_LOAD(kvB, 1);
#pragma unroll
    for (int j = 0; j < NT; ++j)
#pragma unroll
        for (int k = 0; k < 2; ++k) *(LAS u32x4*)(ql + (2 * j + k) * 1024) = *(const u32x4*)(qb + j * QSTRIDE + 32 * k);
    kv_write(lds, kvA, tid);
    CH_LOAD(kvA, 2);
    const int sw = na_start(rq);
    auto compute = [&](int ci) {
        const LAS unsigned char* buf = lds + (ci & 1) * AT_BUF;
        if (ci < 4) {
            auto nomask = [](int, float s) { return s; };
            chunk_tiles<NT, 15, 15, 15, 15>(buf, ql, m_run, l_run, o, c16, q4, nomask, nomask, nomask, nomask);
        } else if constexpr (MODE == 0) {
            const int k0 = lat0 + (ci - 4) * 64, tq0 = tq - c16;
            if (k0 >= tq0 + 15 - 128 && k0 + 63 <= tq0 + 128) {
                auto nomask = [](int, float s) { return s; };
                chunk_tiles<NT, 15, 15, 15, 15>(buf, ql, m_run, l_run, o, c16, q4, nomask, nomask, nomask, nomask);
            } else if (k0 + 63 >= tq0 - 128 && k0 <= tq0 + 15 + 128) {
                auto wmask = [=](int kk, float s) { const int d = tq - (k0 + kk); return (d <= 128 && d >= -128) ? s : -INFINITY; };
                chunk_tiles<NT, 15, 15, 15, 15>(buf, ql, m_run, l_run, o, c16, q4, wmask, wmask, wmask, wmask);
            }
        } else if constexpr (MODE == 1) {
            const int kr = kr0 + ci - 4;
            if (kr >= sw && kr < sw + 8) {
                const LAS float* brow = RPB + (kr - rq + 7) * 64 + 16 + 15 - c16;
#define NA_ME(j) [=](int ck, float s) { const int cq = 16 * (j) + c16; const int cs = cq - 8 < 0 ? 0 : (cq - 8 > 48 ? 48 : cq - 8); return ((unsigned)(ck - cs) < 16u) ? s + brow[ck - 16 * (j)] : -INFINITY; }
#define NA_MI(j) [=](int ck, float s) { return s + brow[960 + ck - 16 * (j)]; }
                chunk_tiles<NT, 3, 7, 14, 12>(buf, ql, m_run, l_run, o, c16, q4, NA_ME(0), NA_MI(1), NA_MI(2), NA_ME(3));
#undef NA_ME
#undef NA_MI
            }
        }
    };
    for (int ci = 0; ci < nch; ci += 2) {
        __syncthreads();
        if (ci + 1 < nch) { kv_write(lds + AT_BUF, kvB, tid); if (ci + 3 < nch) CH_LOAD(kvB, ci + 3); }
        AT_SCHED();
        compute(ci);
        if (ci + 1 >= nch) break;
        __syncthreads();
        if (ci + 2 < nch) { kv_write(lds, kvA, tid); if (ci + 4 < nch) CH_LOAD(kvA, ci + 4); }
        AT_SCHED();
        compute(ci + 1);
    }
#undef CH_LOAD
#undef CH_ROW0
#pragma unroll
    for (int j = 0; j < NT; ++j) {
        size_t qr; int oc, br;
        if (MODE == 0 || MODE == 2) { qr = (MODE == 0) ? (size_t)b * SEQ + tq : (size_t)ML + b * LC + tq; oc = (kvh * 4 + j) * 64; br = 1; }
        else { qr = (MODE == 1) ? (size_t)b * SEQ + rq * 64 + 16 * j + c16 : (size_t)ML + b * LC + 32 * w + 16 * j + c16; oc = h * 64; br = 2; }
        attn_store(ybr + ((size_t)br * MT + qr) * 512 + oc, l_run[j], o[j], q4);
    }
}

constexpr int RS = 136;
DEV void ret_unit_ids(int unit, int& b, int& h, int& ck, size_t& row0) {
    ck = unit % 18; const int bh = unit / 18; h = bh & 3; b = bh >> 2;
    row0 = ck < 16 ? (size_t)b * SEQ + ck * 128 : (size_t)ML + b * LC + (ck - 16) * 128;
}
DEV float log_gamma(const Args& A, int L, int dir, int h) { return log1pf(-__expf(A.in[I_DECAY][L * 8 + dir * 4 + h])); }
constexpr int SC_STRIDE = 288;
constexpr int SC_V = 128 * SC_STRIDE;
DEV void scan_unit(const Args& A, int L, int unit, LAS unsigned char* lds, int tid) {
    const int w = __builtin_amdgcn_readfirstlane(tid >> 6), lane = tid & 63, c16 = lane & 15, q4 = lane >> 4;
    const int dir = unit & 1, bh = unit >> 1, h = bh & 3, b = bh >> 2;
    unsigned char* ws = A.ws; const bf16* proj = (const bf16*)(ws + WS_PROJ);
    const float lg = log_gamma(A, L, dir, h), gC = __expf(lg * 128.0f);
    bf16* ST = (bf16*)(ws + WS_ST) + ((size_t)bh * 18 * 2 + dir) * 16384 + (size_t)(16 * w + c16) * 128 + 4 * q4;
#define SC_CK(s) (dir == 0 ? ((s) < 2 ? 16 + (s) : (s) - 2) : 17 - (s))
#define SC_ROW0(ck) ((ck) < 16 ? (size_t)b * SEQ + (ck) * 128 : (size_t)ML + b * LC + ((ck) - 16) * 128)
    u32x4 rk[4], rv[4];
#define SC_LOAD(s) do { const size_t r0_ = SC_ROW0(SC_CK(s)); _Pragma("unroll") for (int i = 0; i < 4; ++i) { const int q = tid + 512 * i, tk = q >> 4, dc = q & 15; \
        rk[i] = *(const u32x4*)(proj + (r0_ + tk) * PS + 512 + h * 128 + 8 * dc); rv[i] = *(const u32x4*)(proj + (r0_ + tk) * PS + 1024 + h * 128 + 8 * dc); } } while (0)
    f32x4 acc[8];
#pragma unroll
    for (int t = 0; t < 8; ++t) acc[t] = (f32x4){0.f, 0.f, 0.f, 0.f};
    SC_LOAD(0);
    for (int s = 0; s < 18; ++s) {
        { bf16* st = ST + (size_t)SC_CK(s) * 32768;
#pragma unroll
          for (int t = 0; t < 8; ++t) { u32x2 o; o.x = pk2(acc[t][0], acc[t][1]); o.y = pk2(acc[t][2], acc[t][3]); *(u32x2*)(st + 16 * t) = o; } }
        if (s == 17) break;
        __syncthreads();
#pragma unroll
        for (int i = 0; i < 4; ++i) { const int q = tid + 512 * i, tk = q >> 4, dc = q & 15;
            const float wt = dir == 0 ? __expf(lg * (float)(127 - tk)) : __expf(lg * (float)tk);
            u32x4 kw; kw.x = pk2(bflo(rk[i].x) * wt, bfhi(rk[i].x) * wt); kw.y = pk2(bflo(rk[i].y) * wt, bfhi(rk[i].y) * wt); kw.z = pk2(bflo(rk[i].z) * wt, bfhi(rk[i].z) * wt); kw.w = pk2(bflo(rk[i].w) * wt, bfhi(rk[i].w) * wt);
            *(LAS u32x4*)(lds + tk * SC_STRIDE + dc * 16) = kw; *(LAS u32x4*)(lds + SC_V + tk * SC_STRIDE + dc * 16) = rv[i]; }
        if (s + 1 < 17) SC_LOAD(s + 1);
        __syncthreads();
#pragma unroll
        for (int t = 0; t < 8; ++t) acc[t] = acc[t] * gC;
#pragma unroll
        for (int k = 0; k < 4; ++k) {
            const LAS unsigned char* vb = lds + SC_V + (32 * k + 4 * q4 + (c16 >> 2)) * SC_STRIDE + (16 * w + 4 * (c16 & 3)) * 2;
            const s16x4 vlo = __builtin_bit_cast(s16x4, __builtin_amdgcn_ds_read_tr16_b64_v4i16((LAS v4i16_t*)vb)), vhi = __builtin_bit_cast(s16x4, __builtin_amdgcn_ds_read_tr16_b64_v4i16((LAS v4i16_t*)(vb + 16 * SC_STRIDE)));
            const bf16x8 bfrag = __builtin_shufflevector(vlo, vhi, 0, 1, 2, 3, 4, 5, 6, 7);
#pragma unroll
            for (int t = 0; t < 8; ++t) {
                const LAS unsigned char* kb = lds + (32 * k + 4 * q4 + (c16 >> 2)) * SC_STRIDE + (16 * t + 4 * (c16 & 3)) * 2;
                const s16x4 klo = __builtin_bit_cast(s16x4, __builtin_amdgcn_ds_read_tr16_b64_v4i16((LAS v4i16_t*)kb)), khi = __builtin_bit_cast(s16x4, __builtin_amdgcn_ds_read_tr16_b64_v4i16((LAS v4i16_t*)(kb + 16 * SC_STRIDE)));
                acc[t] = MFMA16(__builtin_shufflevector(klo, khi, 0, 1, 2, 3, 4, 5, 6, 7), bfrag, acc[t]);
            }
        }
    }
#undef SC_LOAD
#undef SC_ROW0
#undef SC_CK
    asm volatile("s_waitcnt vmcnt(0)" ::: "memory");
    __syncthreads();
    if (tid == 0) { __builtin_amdgcn_fence(__ATOMIC_RELEASE, "agent"); asm volatile("s_waitcnt vmcnt(0)" ::: "memory");
        __hip_atomic_fetch_add((unsigned*)(ws + WS_CTL) + CW_RFLAG + (L * 32 + bh) * 64, 1u, __ATOMIC_RELAXED, __HIP_MEMORY_SCOPE_AGENT); }
}
DEV void r3_unit(const Args& A, int L, int unit, LAS unsigned char* lds, int tid) {
    const int w = __builtin_amdgcn_readfirstlane(tid >> 6), lane = tid & 63, c16 = lane & 15, q4 = lane >> 4;
    int b, h, ck; size_t row0; ret_unit_ids(unit, b, h, ck, row0);
    unsigned char* ws = A.ws; const bf16* proj = (const bf16*)(ws + WS_PROJ);
    const float lgf = log_gamma(A, L, 0, h), lgb = log_gamma(A, L, 1, h);
    LAS unsigned short* KS = (LAS unsigned short*)lds; LAS unsigned short* VT = KS + 128 * RS;
    if (tid == 0) {
        const unsigned* fl = (const unsigned*)(ws + WS_CTL) + CW_RFLAG + (L * 32 + b * 4 + h) * 64; unsigned sp = 0;
        while (__hip_atomic_load(fl, __ATOMIC_RELAXED, __HIP_MEMORY_SCOPE_AGENT) < 2u) { __builtin_amdgcn_s_sleep(2); if (++sp > (1u << 22)) break; }
        __builtin_amdgcn_fence(__ATOMIC_ACQUIRE, "agent"); asm volatile("s_waitcnt vmcnt(0)" ::: "memory");
    }
    __syncthreads();
    for (int q = tid; q < 2048; q += NTHREADS) { const int i = q >> 4, dc = q & 15;
        const u32x4 kv = *(const u32x4*)(proj + (row0 + i) * PS + 512 + h * 128 + 8 * dc), vv = *(const u32x4*)(proj + (row0 + i) * PS + 1024 + h * 128 + 8 * dc);
        *(LAS u32x4*)(KS + i * RS + 8 * dc) = kv;
        *(LAS u32x4*)((LAS unsigned char*)VT + i * 288 + 16 * dc) = vv; }
    __syncthreads();
    const int n = 16 * w + c16; const size_t row = row0 + n;
    bf16x8 qf[4];
#pragma unroll
    for (int k = 0; k < 4; ++k) qf[k] = *(const bf16x8*)(proj + row * PS + h * 128 + 32 * k + 8 * q4);
    f32x4 sT[8];
#pragma unroll
    for (int t = 0; t < 8; ++t) { f32x4 acc = {0.f, 0.f, 0.f, 0.f};
#pragma unroll
        for (int k = 0; k < 4; ++k) { const bf16x8 a = *(const LAS bf16x8*)(KS + (16 * t + c16) * RS + 32 * k + 8 * q4); acc = MFMA16(a, qf[k], acc); }
#pragma unroll
        for (int r = 0; r < 4; ++r) { const int d = n - (16 * t + 4 * q4 + r); acc[r] *= (d >= 0) ? __expf(lgf * (float)d) : __expf(-lgb * (float)d); }
        sT[t] = acc; }
    f32x4 y[8];
#pragma unroll
    for (int dt = 0; dt < 8; ++dt) y[dt] = (f32x4){0.f, 0.f, 0.f, 0.f};
#pragma unroll
    for (int u = 0; u < 4; ++u) { const bf16x8 bp = pack8(sT[2 * u], sT[2 * u + 1]);
#pragma unroll
        for (int dt = 0; dt < 8; ++dt) { const LAS unsigned char* vr = (const LAS unsigned char*)VT + (32 * u + 4 * q4 + (c16 >> 2)) * 288 + (16 * dt + 4 * (c16 & 3)) * 2;
            const s16x4 lo = __builtin_bit_cast(s16x4, __builtin_amdgcn_ds_read_tr16_b64_v4i16((LAS v4i16_t*)vr)), hi = __builtin_bit_cast(s16x4, __builtin_amdgcn_ds_read_tr16_b64_v4i16((LAS v4i16_t*)(vr + 16 * 288)));
            y[dt] = MFMA16(__builtin_shufflevector(lo, hi, 0, 1, 2, 3, 4, 5, 6, 7), bp, y[dt]); } }
    const float df = __expf(lgf * (float)(n + 1)), db = __expf(lgb * (float)(128 - n));
    bf16x8 qdf[4], qdb[4];
#pragma unroll
    for (int k = 0; k < 4; ++k) { const u32x4 qq = __builtin_bit_cast(u32x4, qf[k]); u32x4 f, g;
        f.x = pk2(bflo(qq.x) * df, bfhi(qq.x) * df); f.y = pk2(bflo(qq.y) * df, bfhi(qq.y) * df); f.z = pk2(bflo(qq.z) * df, bfhi(qq.z) * df); f.w = pk2(bflo(qq.w) * df, bfhi(qq.w) * df);
        g.x = pk2(bflo(qq.x) * db, bfhi(qq.x) * db); g.y = pk2(bflo(qq.y) * db, bfhi(qq.y) * db); g.z = pk2(bflo(qq.z) * db, bfhi(qq.z) * db); g.w = pk2(bflo(qq.w) * db, bfhi(qq.w) * db);
        qdf[k] = __builtin_bit_cast(bf16x8, f); qdb[k] = __builtin_bit_cast(bf16x8, g); }
    const bf16* STf = (const bf16*)(ws + WS_ST) + (size_t)unit * 2 * 16384; const bf16* STb = STf + 16384;
#pragma unroll
    for (int dt = 0; dt < 8; ++dt)
#pragma unroll
        for (int k = 0; k < 4; ++k) { const bf16x8 a = *(const bf16x8*)(STf + (16 * dt + c16) * 128 + 32 * k + 8 * q4), a2 = *(const bf16x8*)(STb + (16 * dt + c16) * 128 + 32 * k + 8 * q4);
            y[dt] = MFMA16(a, qdf[k], y[dt]); y[dt] = MFMA16(a2, qdb[k], y[dt]); }
    float s = 0.f;
#pragma unroll
    for (int dt = 0; dt < 8; ++dt) s += (y[dt][0] + y[dt][1]) + (y[dt][2] + y[dt][3]);
    s = xrow16_sum(s);
    const float mu = s * (1.0f / 128.0f); float v = 0.f;
#pragma unroll
    for (int dt = 0; dt < 8; ++dt) { const f32x4 d = y[dt] - mu; v += (d[0] * d[0] + d[1] * d[1]) + (d[2] * d[2] + d[3] * d[3]); }
    v = xrow16_sum(v);
    const float rstd = rsqrtf(v * (1.0f / 128.0f) + EPS);
    bf16* yo = (bf16*)(ws + WS_YBR) + row * 512 + h * 128;
#pragma unroll
    for (int dt = 0; dt < 8; ++dt) { const u32x2 g = *(const u32x2*)(proj + row * PS + 1536 + h * 128 + 16 * dt + 4 * q4);
        u32x2 o; o.x = pk2(bflo(g.x) * (y[dt][0] - mu) * rstd, bfhi(g.x) * (y[dt][1] - mu) * rstd); o.y = pk2(bflo(g.y) * (y[dt][2] - mu) * rstd, bfhi(g.y) * (y[dt][3] - mu) * rstd);
        *(u32x2*)(yo + 16 * dt + 4 * q4) = o; }
}


DEV void panel_signal(unsigned* flag) {
    asm volatile("s_waitcnt vmcnt(0)" ::: "memory");
    __syncthreads();
    if (threadIdx.x == 0) {
        __builtin_amdgcn_fence(__ATOMIC_RELEASE, "agent"); asm volatile("s_waitcnt vmcnt(0)" ::: "memory");
        __hip_atomic_fetch_add(flag, 1u, __ATOMIC_RELAXED, __HIP_MEMORY_SCOPE_AGENT);
    }
}
DEV void panel_wait(const unsigned* flag) {
    if (threadIdx.x == 0) {
        unsigned sp = 0;
        for (int p = 0; p < 8; ++p)
            while (__hip_atomic_load(flag + p * 64, __ATOMIC_RELAXED, __HIP_MEMORY_SCOPE_AGENT) < 4u) { __builtin_amdgcn_s_sleep(2); if (++sp > (1u << 22)) break; }
        __builtin_amdgcn_fence(__ATOMIC_ACQUIRE, "agent"); asm volatile("s_waitcnt vmcnt(0)" ::: "memory");
    }
    __syncthreads();
}
__global__ void __launch_bounds__(NTHREADS, 2) mk_fwd(Args args) {
    extern __shared__ __attribute__((aligned(16))) unsigned char lds_raw[];
    LAS unsigned char* lds = (LAS unsigned char*)lds_raw;
    const int tid = threadIdx.x, G = gridDim.x;
    const int bx = blockIdx.x, vcu = (G % 8 == 0) ? (bx % 8) * (G / 8) + bx / 8 : bx;
    unsigned char* ws = args.ws;
    volatile LAS unsigned* MISC = (volatile LAS unsigned*)(lds + MISC_OFF);
    for (int u = tid; u < (LDS_BYTES - 131072) / 4; u += NTHREADS) ((LAS unsigned*)(lds + 131072))[u] = 0u;
    __syncthreads();
    const int lo = args.ph_lo, hi = args.ph_hi;
    XcdBarrier bar; bar.bar = (unsigned*)(ws + WS_CTL) + CW_BAR; bar.x = 0; bar.st = nullptr;
    if (hi - lo > 1) bar = xcd_barrier_post((unsigned*)(ws + WS_CTL) + CW_BAR, MISC + 8);
#define IN(k) (lo <= (k) && (k) < hi)
#define EN(b) (((MK_EN) >> (b)) & 1u)
#define REP(b) for (int _rp = 0; _rp < 1 + (int)(((MK_REP) >> (b)) & 1u); ++_rp)
#define OT() ({ int _t = threadIdx.x; asm volatile("" : "+v"(_t)); _t; })
#define SEAM(k) do { if (IN(k) && IN((k) + 1)) xcd_barrier(bar); } while (0)
    const pg8::bf16_t* XN = (const pg8::bf16_t*)(ws + WS_XN);
    pg8::bf16_t* PROJ = (pg8::bf16_t*)(ws + WS_PROJ);
    const float* TAB = (const float*)(ws + WS_TAB);

    if (EN(0) && IN(0)) REP(0) { p0_prologue(args, lds, vcu, G, OT()); } SEAM(0);
    if (EN(1) && IN(1)) REP(1) { thin_phase<0>(args, 0, vcu, G, 0, MT, OT(), lds); } SEAM(1);
    for (int L = 0; L < DEPTH; ++L) {
        const int pb = 2 + 11 * L;
        const bool need_ctx = L < DEPTH - 1;
        const int Mact = need_ctx ? MT : ML;
        if (EN(2) && IN(pb + 0)) REP(2) {
            if constexpr (F8GATE) {
                { pg8::Gemm g{XN, (const pg8::bf16_t*)(ws + WS_WIN + (size_t)L * DIN * 1024 * 2), MT, 4352, 1024}; pg8::StaticOrder S; S.init(MT, 4352, G, bx);
                  pg8::EpiInProj<false> E{PROJ, TAB + TAB_RTC, TAB + TAB_RTS, TAB + TAB_AXC, TAB + TAB_AXS, 1.0f, 0};
                  pg8::gemm_phase<pg8::EpiInProj<false>, pg8::StaticOrder, true, true, false>(lds, g, S, E); }
                { pg8::Gemm g{(const pg8::bf16_t*)(ws + WS_XN8), (const pg8::bf16_t*)(ws + WS_WIN8 + (size_t)L * 3072 * 1024), MT, 3072, 512}; pg8::TailOrder S; S.init(MT, 3072, G, bx); S.cut = (72 * 17) % G; S.base = (72 * 12) / G; if (S.cut == 0) S.base = 1 << 20;
                  pg8::EpiGate E{ws + WS_G8};
                  pg8::gemm_phase<pg8::EpiGate, pg8::TailOrder, true, true, true>(lds, g, S, E); }
            } else {
            pg8::Gemm g{XN, (const pg8::bf16_t*)(ws + WS_WIN + (size_t)L * DIN * 1024 * (F8IN ? 1 : 2)), MT, DIN, F8IN ? 512 : 1024}; pg8::StaticOrder S; S.init(MT, DIN, G, bx);
            pg8::EpiInProj<true> E{PROJ, TAB + TAB_RTC, TAB + TAB_RTS, TAB + TAB_AXC, TAB + TAB_AXS, F8IN ? 0.015625f : 1.0f, 0};
            pg8::gemm_phase<pg8::EpiInProj<true>, pg8::StaticOrder, true, true, F8IN>(lds, g, S, E);
            }
        } SEAM(pb + 0);
        if (IN(pb + 1)) {
            unsigned* wq = (unsigned*)(ws + WS_CTL) + CW_WQ + L * 64;
            const int n_ctx = need_ctx ? 96 : 0, n_att = 64 + 256 + 256 + n_ctx, n_units = n_att + (need_ctx ? 576 : 512);
            for (;;) {
                if (threadIdx.x == 0) MISC[16] = __hip_atomic_fetch_add(wq, 1u, __ATOMIC_RELAXED, __HIP_MEMORY_SCOPE_AGENT);
                __syncthreads();
                const int u = (int)MISC[16];
                __syncthreads();
                if (u >= n_units) break;
                const int n_r3 = need_ctx ? 576 : 512;
                if (u < 64) { if (EN(6)) scan_unit(args, L, u, lds, OT()); }
                else if (u < 320) { if (EN(4)) attn4_unit<1>(args, L, u - 64, lds, OT()); }
                else if (u < 320 + n_r3) { const int v = u - 320; if (EN(8)) r3_unit(args, L, need_ctx ? v : (v >> 4) * 18 + (v & 15), lds, OT()); }
                else if (u < 576 + n_r3) { if (EN(3)) attn4_unit<0>(args, L, u - 320 - n_r3, lds, OT()); }
                else if (u < 608 + n_r3) { if (EN(5)) attn4_unit<2>(args, L, u - 576 - n_r3, lds, OT()); }
                else { if (EN(5)) attn4_unit<3>(args, L, u - 608 - n_r3, lds, OT()); }
            }
        } SEAM(pb + 1);
        if (EN(9) && IN(pb + 4)) REP(9) {
            pg8::Gemm g{(const pg8::bf16_t*)(ws + WS_YBR), (const pg8::bf16_t*)(ws + WS_WBR) + (size_t)L * 3 * 1024 * 512, 3 * MT, 3 * 1024, 512};
            { pg8::BranchOrder S{(ML / 256) * 4, G, vcu};
              pg8::EpiBranch E{ws + WS_G8, (pg8::bf16_t*)(ws + WS_MERGED)};
              pg8::gemm_phase<pg8::EpiBranch, pg8::BranchOrder, true, true>(lds, g, S, E); }
            if (need_ctx) { pg8::PartOrder S{G, vcu};
              pg8::EpiBranchPart E{ws + WS_G8, (pg8::bf16_t*)(ws + WS_PART)};
              pg8::gemm_phase<pg8::EpiBranchPart, pg8::PartOrder, true, true>(lds, g, S, E); }
        } SEAM(pb + 4);
#define BAR_ALWAYS() do { if (hi - lo > 1) xcd_barrier(bar); } while (0)
        if (EN(10) && IN(pb + 5)) {
            const pg8::bf16_t* Wo = (const pg8::bf16_t*)(ws + WS_WOUT) + (size_t)L * 1024 * 1024;
            if (need_ctx) {
                { pg8::Gemm g{(const pg8::bf16_t*)(ws + WS_MERGED), Wo, ML, 1024, 1024}; pg8::StaticOrder S; S.init(ML, 1024, G, bx);
                  pg8::EpiPlain E{(pg8::bf16_t*)(ws + WS_YOUT), 1024, 4, 1.0f};
                  pg8::gemm_phase<pg8::EpiPlain, pg8::StaticOrder, true, true>(lds, g, S, E); }
                { const int t_ = OT(), lane_ = t_ & 63;
                  for (int row = vcu * 8 + (t_ >> 6); row < MC; row += G * 8) {
                      const unsigned char* pp = ws + WS_PART + ((size_t)row * 1024 + lane_ * 16) * 2;
                      float f[16];
#pragma unroll
                      for (int r = 0; r < 3; ++r) {
                          const uint4 w0 = *(const uint4*)(pp + (size_t)r * MC * 2048), w1 = *(const uint4*)(pp + (size_t)r * MC * 2048 + 16);
                          const unsigned ww[8] = {w0.x, w0.y, w0.z, w0.w, w1.x, w1.y, w1.z, w1.w};
#pragma unroll
                          for (int k = 0; k < 8; ++k) { const float lo_ = __uint_as_float(ww[k] << 16), hi_ = __uint_as_float(ww[k] & 0xffff0000u);
                              if (r == 0) { f[2 * k] = lo_; f[2 * k + 1] = hi_; } else { f[2 * k] += lo_; f[2 * k + 1] += hi_; } }
                      }
                      uint4 o0, o1;
                      o0.x = pg8::cvt_pk_bf16(f[0], f[1]); o0.y = pg8::cvt_pk_bf16(f[2], f[3]); o0.z = pg8::cvt_pk_bf16(f[4], f[5]); o0.w = pg8::cvt_pk_bf16(f[6], f[7]);
                      o1.x = pg8::cvt_pk_bf16(f[8], f[9]); o1.y = pg8::cvt_pk_bf16(f[10], f[11]); o1.z = pg8::cvt_pk_bf16(f[12], f[13]); o1.w = pg8::cvt_pk_bf16(f[14], f[15]);
                      unsigned char* op = ws + WS_MERGED + ((size_t)(ML + row) * 1024 + lane_ * 16) * 2;
                      *(uint4*)op = o0; *(uint4*)(op + 16) = o1;
                  } }
                BAR_ALWAYS();
                if (vcu < 32) { pg8::Gemm g{(const pg8::bf16_t*)(ws + WS_MERGED) + (size_t)ML * 1024, Wo, MC, 1024, 1024}; pg8::StaticOrder S; S.init(MC, 1024, 32, vcu);
                  pg8::EpiPlain E{(pg8::bf16_t*)(ws + WS_YOUT) + (size_t)ML * 1024, 1024, 4, 1.0f};
                  pg8::gemm_phase<pg8::EpiPlain, pg8::StaticOrder, true, true>(lds, g, S, E);
                  panel_signal((unsigned*)(ws + WS_CTL) + CW_PFLAG + ((L * 2 + 0) * 8 + (((vcu % 8) * 4 + vcu / 8) & 7)) * 64); }
                else thin_phase<1>(args, L, vcu - 32, G - 32, 0, ML, OT(), lds);
                panel_wait((const unsigned*)(ws + WS_CTL) + CW_PFLAG + (L * 2 + 0) * 8 * 64);
                thin_phase<1>(args, L, vcu, G, ML, MT, OT(), lds);
            } else {
                pg8::Gemm g{(const pg8::bf16_t*)(ws + WS_MERGED), Wo, ML, 1024, 1024}; pg8::StaticOrder S; S.init(ML, 1024, G, bx);
                pg8::EpiPlain E{(pg8::bf16_t*)(ws + WS_YOUT), 1024, 4, 1.0f};
                pg8::gemm_phase<pg8::EpiPlain, pg8::StaticOrder, true, true>(lds, g, S, E);
            }
        } SEAM(pb + 5);
        if (EN(11) && IN(pb + 6)) { if (!need_ctx) thin_phase<1>(args, L, vcu, G, 0, ML, OT(), lds); } if (!need_ctx) SEAM(pb + 6);
        if (L & 1) {
            const int mi = L >> 1;
            const unsigned* cnt = (const unsigned*)(ws + WS_CTL) + CW_MOE + mi * 8 * 64;
            if (EN(12) && IN(pb + 7)) REP(12) { gather_phase(args, L, vcu, G, OT()); } SEAM(pb + 7);
            if (EN(13) && IN(pb + 8)) REP(13) {
                constexpr int EB = F8UP_M ? 1 : 2;
                pg8::Gemm g{(const pg8::bf16_t*)(ws + WS_ASORT), (const pg8::bf16_t*)(ws + WS_WM13 + (size_t)mi * 8 * 2 * FFE * 1024 * EB), MSORT, 8 * 2 * FFE, 512 * EB};
                pg8::MoeOrder S; S.init(cnt, 28, G, bx);
                pg8::EpiSwiGLUx<F8UP_M, F8DN_M> E{ws + WS_HID, FFE, 28};
                pg8::gemm_phase<pg8::EpiSwiGLUx<F8UP_M, F8DN_M>, pg8::MoeOrder, true, true, F8UP_M>(lds, g, S, E);
            } SEAM(pb + 8);
            if (EN(14) && IN(pb + 9)) REP(14) {
                constexpr int EB = F8DN_M ? 1 : 2;
                pg8::Gemm g{(const pg8::bf16_t*)(ws + WS_HID), (const pg8::bf16_t*)(ws + WS_WM2 + (size_t)mi * 8 * 1024 * FFE * EB), MSORT, 8 * 1024, FFE / 2 * EB};
                pg8::MoeOrder S; S.init(cnt, 4, G, bx);
                pg8::EpiPlain E{(pg8::bf16_t*)(ws + WS_OSORT), 1024, 4, F8DN_M ? 1.0f / 2048.0f : 1.0f};
                pg8::gemm_phase<pg8::EpiPlain, pg8::MoeOrder, true, true, F8DN_M>(lds, g, S, E);
            } SEAM(pb + 9);
        } else {
            const int fi = L >> 1;
            if (EN(15) && IN(pb + 8)) REP(15) {
                constexpr int EB = F8UP_D ? 1 : 2;
                pg8::Gemm g{XN, (const pg8::bf16_t*)(ws + WS_WF13 + (size_t)fi * 2 * FFD * 1024 * EB), Mact, 2 * FFD, 512 * EB}; pg8::StaticOrder S; S.init(Mact, 2 * FFD, G, bx);
                pg8::EpiSwiGLUx<F8UP_D, F8DN_D> E{ws + WS_HID, FFD, 22};
                pg8::gemm_phase<pg8::EpiSwiGLUx<F8UP_D, F8DN_D>, pg8::StaticOrder, true, true, F8UP_D>(lds, g, S, E);
            } SEAM(pb + 8);
            if (EN(16) && IN(pb + 9)) {
                constexpr int EB = F8DN_D ? 1 : 2; constexpr float sc = F8DN_D ? 1.0f / 2048.0f : 1.0f;
                const pg8::bf16_t* W2 = (const pg8::bf16_t*)(ws + WS_WF2 + (size_t)fi * 1024 * FFD * EB);
                { pg8::Gemm g{(const pg8::bf16_t*)(ws + WS_HID), W2, ML, 1024, FFD / 2 * EB}; pg8::StaticOrder S; S.init(ML, 1024, G, bx);
                  pg8::EpiPlain E{(pg8::bf16_t*)(ws + WS_YOUT), 1024, 4, sc};
                  pg8::gemm_phase<pg8::EpiPlain, pg8::StaticOrder, true, true, F8DN_D>(lds, g, S, E); }
                BAR_ALWAYS();
                if (vcu < 32) { pg8::Gemm g{(const pg8::bf16_t*)(ws + WS_HID + (size_t)ML * FFD * EB), W2, MC, 1024, FFD / 2 * EB}; pg8::StaticOrder S; S.init(MC, 1024, 32, vcu);
                  pg8::EpiPlain E{(pg8::bf16_t*)(ws + WS_YOUT) + (size_t)ML * 1024, 1024, 4, sc};
                  pg8::gemm_phase<pg8::EpiPlain, pg8::StaticOrder, true, true, F8DN_D>(lds, g, S, E);
                  panel_signal((unsigned*)(ws + WS_CTL) + CW_PFLAG + ((L * 2 + 1) * 8 + (((vcu % 8) * 4 + vcu / 8) & 7)) * 64); }
                else thin_phase<2>(args, L, vcu - 32, G - 32, 0, ML, OT(), lds);
                panel_wait((const unsigned*)(ws + WS_CTL) + CW_PFLAG + (L * 2 + 1) * 8 * 64);
                thin_phase<2>(args, L, vcu, G, ML, MT, OT(), lds);
            } SEAM(pb + 9);
        }
        if (EN(17) && IN(pb + 10)) { if (L & 1) thin_phase<2>(args, L, vcu, G, 0, Mact, OT(), lds); } if (L & 1) SEAM(pb + 10);
    }
#undef IN
#undef SEAM
}


extern "C" void kernel_launch(void* const* d_in, const int* in_sizes, int n_in, void* d_out, int out_size, void* d_ws, size_t ws_size, hipStream_t stream) {
    static int grid = 0;
    if (grid == 0) {
        if (n_in != 20 || out_size != ML * D || ws_size < WS_END) { fprintf(stderr, "kernel_launch: unexpected shapes (n_in %d out %d ws %zu need %zu)\n", n_in, out_size, ws_size, (size_t)WS_END); grid = -1; return; }
        int dev = 0, cus = 0;
        if (hipGetDevice(&dev) != hipSuccess || hipDeviceGetAttribute(&cus, hipDeviceAttributeMultiprocessorCount, dev) != hipSuccess) { grid = -1; return; }
        if (hipFuncSetAttribute((const void*)mk_fwd, hipFuncAttributeMaxDynamicSharedMemorySize, LDS_BYTES) != hipSuccess) { fprintf(stderr, "kernel_launch: hipFuncSetAttribute failed\n"); grid = -1; return; }
        int per_cu = 0;
        (void)hipOccupancyMaxActiveBlocksPerMultiprocessor(&per_cu, (const void*)mk_fwd, NTHREADS, LDS_BYTES);
        (void)hipGetLastError();
        grid = cus;
    }
    if (grid < 0) return;
    (void)hipMemsetAsync((char*)d_ws + WS_CTL, 0, CTL_ZERO_BYTES, stream);
    Args a{};
    for (int i = 0; i < 20; ++i) a.in[i] = (const float*)d_in[i];
    a.out = (float*)d_out; a.ws = (unsigned char*)d_ws; a.li = 0; a.pad = 0;
#if MK_PER_PHASE
    for (int ph = 0; ph < MK_NPH_RUN; ++ph) { a.ph_lo = ph; a.ph_hi = ph + 1; hipLaunchKernelGGL(mk_fwd, dim3(grid), dim3(NTHREADS), LDS_BYTES, stream, a); }
#else
    a.ph_lo = 0; a.ph_hi = MK_NPH_RUN;
    hipLaunchKernelGGL(mk_fwd, dim3(grid), dim3(NTHREADS), LDS_BYTES, stream, a);
#endif
}
```

```cpp
#include <hip/hip_runtime.h>
#include <cstdio>
#include <cstdint>
#include <cmath>
#define LAS __attribute__((address_space(3)))
namespace pg8 {
#define PG8_LAS __attribute__((address_space(3)))
typedef unsigned short bf16_t;
typedef short bf16x8 __attribute__((ext_vector_type(8)));
typedef float f32x4 __attribute__((ext_vector_type(4)));
typedef unsigned u32x4 __attribute__((ext_vector_type(4)));
constexpr int BM = 256, BK = 64, HALF = 128, HTB = HALF * BK * 2  , STAGE_BYTES = 8 * HTB, NXCD = 8, WGM = 8;

__host__ __device__ __forceinline__ int lds_byte(int r, int c) { const int st = (r >> 4) * 2 + (c >> 5), rr = r & 15, cc = c & 31, ob = rr * 64 + cc * 2; return st * 1024 + (ob ^ (((ob >> 9) & 1) << 5)); }
__host__ __device__ __forceinline__ void stage_rc(int b, int& R, int& C) { const int st = b / 1024, sb = b % 1024, swz = sb ^ (((sb >> 9) & 1) << 5); R = (st >> 1) * 16 + swz / 64; C = (st & 1) * 32 + (swz % 64) / 2; }
__host__ __device__ __forceinline__ int perm32(int rho) { const int n = rho >> 4, i = rho & 15; return 8 * (i >> 2) + 4 * n + (i & 3); }

typedef int v8i32 __attribute__((ext_vector_type(8))); typedef int v4i32 __attribute__((ext_vector_type(4)));
__device__ __forceinline__ v8i32 pg8_cat(bf16x8 lo, bf16x8 hi) { return __builtin_shufflevector(__builtin_bit_cast(v4i32, lo), __builtin_bit_cast(v4i32, hi), 0, 1, 2, 3, 4, 5, 6, 7); }
struct Unit { int pm, pn; };
struct Gemm { const bf16_t* A; const bf16_t* Bt; int M, N, K; };

struct StaticOrder {
    int nM, nN, nwg, G, c;
    __host__ __device__ void init(int M, int N, int G_, int c_) { nM = M / BM; nN = N / BM; nwg = nM * nN; G = G_; c = c_; }
    __host__ __device__ bool next(int i, Unit& u) const { return next_at((long)i * G + c, u); }
    __host__ __device__ bool next_at(long L, Unit& u) const {
        if (L >= nwg) return false;
        int wgid = (int)L; { const int q = nwg / NXCD, r = nwg % NXCD, xcd = wgid % NXCD, off = wgid / NXCD; wgid = (xcd < r ? xcd * (q + 1) : r * (q + 1) + (xcd - r) * q) + off; }
        const int nig = WGM * nN, gid = wgid / nig, fm = gid * WGM, gsz = (nM - fm) < WGM ? (nM - fm) : WGM;
        u.pm = fm + ((wgid % nig) % gsz); u.pn = (wgid % nig) / gsz; return true;
    }
    __device__ __forceinline__ void a_ready(const Unit&) const {}
    __device__ __forceinline__ void done(const Unit&) const {}
};

typedef float f32x2_t __attribute__((ext_vector_type(2))); typedef __bf16 bf16x2_t __attribute__((ext_vector_type(2)));
__device__ __forceinline__ unsigned cvt_pk_bf16(float lo, float hi) { const f32x2_t v = {lo, hi}; const bf16x2_t b = __builtin_convertvector(v, bf16x2_t); return __builtin_bit_cast(unsigned, b); }
typedef float f32x2 __attribute__((ext_vector_type(2)));

struct BranchOrder {
    int nT, G, c;
    __device__ __forceinline__ bool next(int i, Unit& u) const {
        const int rd = i / 3, r = i - rd * 3; const int t = rd * G + c; if (t >= nT) return false;
        u.pm = r * 72 + (t >> 2); u.pn = r * 4 + (t & 3); return true;
    }
    __device__ __forceinline__ void a_ready(const Unit&) const {}
    __device__ __forceinline__ void done(const Unit&) const {}
};
struct PartOrder {
    int G, c;
    __device__ __forceinline__ bool next(int i, Unit& u) const {
        const int j = i * G + c; if (j >= 96) return false;
        const int r = j >> 5, t = j & 31; u.pm = r * 72 + 64 + (t >> 2); u.pn = r * 4 + (t & 3); return true;
    }
    __device__ __forceinline__ void a_ready(const Unit&) const {}
    __device__ __forceinline__ void done(const Unit&) const {}
};
struct MoeOrder {
    int nM, nN, nwg, G, c; int ts[9];
    __device__ __forceinline__ void init(const unsigned* cnt, int nN_, int G_, int c_) {
        int acc = 0;
#pragma unroll
        for (int e = 0; e < 8; ++e) { ts[e] = acc; const unsigned ce = __hip_atomic_load(cnt + 64 * e, __ATOMIC_RELAXED, __HIP_MEMORY_SCOPE_AGENT); acc += (int)((ce + 255u) >> 8); }
        ts[8] = acc; nM = acc; nN = nN_; nwg = nM * nN; G = G_; c = c_;
    }
    __device__ __forceinline__ bool next(int i, Unit& u) const {
        const long L = (long)i * G + c; if (L >= nwg) return false;
        int wgid = (int)L; { const int q = nwg / NXCD, r = nwg % NXCD, xcd = wgid % NXCD, off = wgid / NXCD; wgid = (xcd < r ? xcd * (q + 1) : r * (q + 1) + (xcd - r) * q) + off; }
        const int nig = WGM * nN, gid = wgid / nig, fm = gid * WGM, gsz = (nM - fm) < WGM ? (nM - fm) : WGM;
        const int pm = fm + ((wgid % nig) % gsz), pnt = (wgid % nig) / gsz;
        int e = 0;
#pragma unroll
        for (int k = 1; k < 8; ++k) e += (pm >= ts[k]) ? 1 : 0;
        u.pm = pm; u.pn = e * nN + pnt; return true;
    }
    __device__ __forceinline__ void a_ready(const Unit&) const {}
    __device__ __forceinline__ void done(const Unit&) const {}
};


struct TailOrder : StaticOrder {
    int cut, base;
    __device__ __forceinline__ bool next(int i, Unit& u) const {
        long L;
        if (i < base) L = (long)i * G + c; else { if (c < cut) return false; L = (long)base * G + (long)(i - base) * (G - cut) + (c - cut); }
        if (L >= nwg) return false;
        return next_at(L, u);
    }
};
__device__ __forceinline__ void store8(bf16_t* p, const f32x4 a, const f32x4 b) {
    u32x4 w; w.x = cvt_pk_bf16(a[0], a[1]); w.y = cvt_pk_bf16(a[2], a[3]); w.z = cvt_pk_bf16(b[0], b[1]); w.w = cvt_pk_bf16(b[2], b[3]); *(u32x4*)p = w;
}
__device__ __forceinline__ float sigm(float x) { return __builtin_amdgcn_rcpf(1.0f + __expf(-x)); }
__device__ __forceinline__ f32x4 sigm4(f32x4 v) { f32x4 o; o[0] = sigm(v[0]); o[1] = sigm(v[1]); o[2] = sigm(v[2]); o[3] = sigm(v[3]); return o; }

struct EpiPlain {
    static constexpr bool PERM = true, AFTER_DRAIN = false, KEEP_ACC = false;
    bf16_t* O; int ldc; int pn_mod; float scale;
    __device__ __forceinline__ void operator()(const f32x4 (&acc)[2][2][4][2], const Unit& u, int wr, int wc, int fr, int fq) const {
        const int row0 = u.pm * BM + wr * 64 + fr, col0 = (u.pn % pn_mod) * BM + wc * 32 + 8 * fq;
#pragma unroll
        for (int ai = 0; ai < 2; ++ai)
#pragma unroll
            for (int m = 0; m < 4; ++m) { bf16_t* rowp = O + (size_t)(row0 + ai * HALF + m * 16) * ldc + col0;
#pragma unroll
                for (int bj = 0; bj < 2; ++bj) store8(rowp + bj * HALF, acc[ai][bj][m][0] * scale, acc[ai][bj][m][1] * scale); }
    }
};
__device__ __forceinline__ float clamp_f8(float v) { return __builtin_amdgcn_fmed3f(v, -448.0f, 448.0f); }
__device__ __forceinline__ unsigned pk4_fp8(float a, float b, float c, float d) { a = clamp_f8(a); b = clamp_f8(b); c = clamp_f8(c); d = clamp_f8(d); unsigned w = 0; w = __builtin_amdgcn_cvt_pk_fp8_f32(a, b, w, false); w = __builtin_amdgcn_cvt_pk_fp8_f32(c, d, w, true); return w; }
typedef unsigned u32x2_t __attribute__((ext_vector_type(2)));
template <bool IN8, bool OUT8> struct EpiSwiGLUx {
    static constexpr bool PERM = true, AFTER_DRAIN = false, KEEP_ACC = false;
    unsigned char* O; int ldc; int pn_mod;
    __device__ __forceinline__ void operator()(const f32x4 (&acc)[2][2][4][2], const Unit& u, int wr, int wc, int fr, int fq) const {
        const int row0 = u.pm * BM + wr * 64 + fr, col0 = (u.pn % pn_mod) * HALF + wc * 32 + 8 * fq;
        constexpr float s1 = IN8 ? 0.015625f : 1.0f, s3 = (IN8 ? 0.015625f : 1.0f) * (OUT8 ? 16.0f : 1.0f);
#pragma unroll
        for (int ai = 0; ai < 2; ++ai) {
#pragma unroll
            for (int m = 0; m < 4; ++m) {
                const size_t eoff = (size_t)(row0 + ai * HALF + m * 16) * ldc + col0;
                constexpr float k1 = -1.4426950408889634f * s1, ic = 1.0f / (s1 * s3);
                const f32x4 g0 = acc[ai][0][m][0], g1 = acc[ai][0][m][1];
                const f32x4 t0 = g0 * k1, t1 = g1 * k1; f32x4 e0, e1;
                e0[0] = __builtin_amdgcn_exp2f(t0[0]); e0[1] = __builtin_amdgcn_exp2f(t0[1]); e0[2] = __builtin_amdgcn_exp2f(t0[2]); e0[3] = __builtin_amdgcn_exp2f(t0[3]);
                e1[0] = __builtin_amdgcn_exp2f(t1[0]); e1[1] = __builtin_amdgcn_exp2f(t1[1]); e1[2] = __builtin_amdgcn_exp2f(t1[2]); e1[3] = __builtin_amdgcn_exp2f(t1[3]);
                const f32x4 d0 = e0 * ic + ic, d1 = e1 * ic + ic; f32x4 r0, r1;
                r0[0] = __builtin_amdgcn_rcpf(d0[0]); r0[1] = __builtin_amdgcn_rcpf(d0[1]); r0[2] = __builtin_amdgcn_rcpf(d0[2]); r0[3] = __builtin_amdgcn_rcpf(d0[3]);
                r1[0] = __builtin_amdgcn_rcpf(d1[0]); r1[1] = __builtin_amdgcn_rcpf(d1[1]); r1[2] = __builtin_amdgcn_rcpf(d1[2]); r1[3] = __builtin_amdgcn_rcpf(d1[3]);
                const f32x4 v0 = (g0 * acc[ai][1][m][0]) * r0, v1 = (g1 * acc[ai][1][m][1]) * r1;
                if constexpr (OUT8) { u32x2_t w; w.x = pk4_fp8(v0[0], v0[1], v0[2], v0[3]); w.y = pk4_fp8(v1[0], v1[1], v1[2], v1[3]); *(u32x2_t*)(O + eoff) = w; }
                else store8((bf16_t*)O + eoff, v0, v1);
            }
        }
    }
};
struct EpiBranch {
    static constexpr bool PERM = true, AFTER_DRAIN = false, KEEP_ACC = true;
    const unsigned char* P;
    bf16_t* Mg;
    static __device__ __forceinline__ void unpack8(const u32x2_t g, f32x4& g0, f32x4& g1) {
        constexpr float s = 1.0f / 255.0f;
        g0[0] = (float)(g.x & 0xffu) * s; g0[1] = (float)((g.x >> 8) & 0xffu) * s; g0[2] = (float)((g.x >> 16) & 0xffu) * s; g0[3] = (float)(g.x >> 24) * s;
        g1[0] = (float)(g.y & 0xffu) * s; g1[1] = (float)((g.y >> 8) & 0xffu) * s; g1[2] = (float)((g.y >> 16) & 0xffu) * s; g1[3] = (float)(g.y >> 24) * s; }
    static __device__ __forceinline__ void unpack8raw(const u32x2_t g, f32x4& g0, f32x4& g1) {
        g0[0] = (float)(g.x & 0xffu); g0[1] = (float)((g.x >> 8) & 0xffu); g0[2] = (float)((g.x >> 16) & 0xffu); g0[3] = (float)(g.x >> 24);
        g1[0] = (float)(g.y & 0xffu); g1[1] = (float)((g.y >> 8) & 0xffu); g1[2] = (float)((g.y >> 16) & 0xffu); g1[3] = (float)(g.y >> 24); }
    static __device__ __forceinline__ f32x4 clampr(f32x4 v) { f32x4 o; o[0] = fmaxf(v[0], 255e-6f); o[1] = fmaxf(v[1], 255e-6f); o[2] = fmaxf(v[2], 255e-6f); o[3] = fmaxf(v[3], 255e-6f); return o; }
    static __device__ __forceinline__ f32x4 clampg(f32x4 v) { f32x4 o; o[0] = fmaxf(v[0], 1e-6f); o[1] = fmaxf(v[1], 1e-6f); o[2] = fmaxf(v[2], 1e-6f); o[3] = fmaxf(v[3], 1e-6f); return o; }
    static __device__ __forceinline__ f32x4 rcp4(f32x4 v) { f32x4 o; o[0] = __builtin_amdgcn_rcpf(v[0]); o[1] = __builtin_amdgcn_rcpf(v[1]); o[2] = __builtin_amdgcn_rcpf(v[2]); o[3] = __builtin_amdgcn_rcpf(v[3]); return o; }
    __device__ __forceinline__ void operator()(f32x4 (&acc)[2][2][4][2], const Unit& u, int wr, int wc, int fr, int fq) const {
        const int r = u.pn >> 2, pnn = u.pn & 3, pmm = u.pm - r * 72;
        const int row0 = pmm * BM + wr * 64 + fr, col0 = pnn * BM + wc * 32 + 8 * fq;
#pragma unroll
        for (int ai = 0; ai < 2; ++ai)
#pragma unroll
            for (int m = 0; m < 4; ++m) { const size_t row = (size_t)(row0 + ai * HALF + m * 16);
#pragma unroll
                for (int bj = 0; bj < 2; ++bj) { const int col = col0 + bj * HALF;
                    const unsigned char* gp = P + row * 3072 + r * 1024 + col;
                    f32x4 a0, a1; unpack8raw(*(const u32x2_t*)gp, a0, a1);
                    if (r < 2) { f32x4 b0, b1; unpack8raw(*(const u32x2_t*)(gp + 1024), b0, b1);
                        if (r == 1) { a0 = clampr(a0); a1 = clampr(a1); }
                        acc[ai][bj][m][0] = acc[ai][bj][m][0] * (a0 * rcp4(clampr(b0))); acc[ai][bj][m][1] = acc[ai][bj][m][1] * (a1 * rcp4(clampr(b1)));
                    } else { store8(Mg + row * 1024 + col, acc[ai][bj][m][0] * (clampr(a0) * (1.0f / 255.0f)), acc[ai][bj][m][1] * (clampr(a1) * (1.0f / 255.0f)));
                        acc[ai][bj][m][0] = (f32x4){0.f, 0.f, 0.f, 0.f}; acc[ai][bj][m][1] = (f32x4){0.f, 0.f, 0.f, 0.f}; } } }
    }
};
struct EpiBranchPart {
    static constexpr bool PERM = true, AFTER_DRAIN = false, KEEP_ACC = false;
    const unsigned char* P;
    bf16_t* O;
    __device__ __forceinline__ void operator()(const f32x4 (&acc)[2][2][4][2], const Unit& u, int wr, int wc, int fr, int fq) const {
        const int r = u.pn >> 2, pnn = u.pn & 3, pmm = u.pm - r * 72;
        const int row0 = pmm * BM + wr * 64 + fr, col0 = pnn * BM + wc * 32 + 8 * fq;
#pragma unroll
        for (int ai = 0; ai < 2; ++ai)
#pragma unroll
            for (int m = 0; m < 4; ++m) { const size_t row = (size_t)(row0 + ai * HALF + m * 16);
#pragma unroll
                for (int bj = 0; bj < 2; ++bj) { const int col = col0 + bj * HALF;
                    f32x4 a0, a1; EpiBranch::unpack8(*(const u32x2_t*)(P + row * 3072 + r * 1024 + col), a0, a1);
                    store8(O + ((size_t)r * 2048 + (row - 16384)) * 1024 + col, acc[ai][bj][m][0] * a0, acc[ai][bj][m][1] * a1); } }
    }
};
struct EpiGate {
    static constexpr bool PERM = true, AFTER_DRAIN = false, KEEP_ACC = false;
    unsigned char* O;
    static __device__ __forceinline__ unsigned q4(f32x4 g) { return (unsigned)(g[0] * 255.0f + 0.5f) | ((unsigned)(g[1] * 255.0f + 0.5f) << 8) | ((unsigned)(g[2] * 255.0f + 0.5f) << 16) | ((unsigned)(g[3] * 255.0f + 0.5f) << 24); }
    static __device__ __forceinline__ unsigned g4(f32x4 a) {
        const f32x4 t = a * (-1.4426950408889634f * 0.015625f); f32x4 e;
        e[0] = __builtin_amdgcn_exp2f(t[0]); e[1] = __builtin_amdgcn_exp2f(t[1]); e[2] = __builtin_amdgcn_exp2f(t[2]); e[3] = __builtin_amdgcn_exp2f(t[3]);
        const f32x4 d = e * (1.0f / 255.0f) + (1.0f / 255.0f);
        unsigned w = 0;
        w = __builtin_amdgcn_cvt_pk_u8_f32(__builtin_amdgcn_rcpf(d[0]), 0, w); w = __builtin_amdgcn_cvt_pk_u8_f32(__builtin_amdgcn_rcpf(d[1]), 1, w);
        w = __builtin_amdgcn_cvt_pk_u8_f32(__builtin_amdgcn_rcpf(d[2]), 2, w); w = __builtin_amdgcn_cvt_pk_u8_f32(__builtin_amdgcn_rcpf(d[3]), 3, w);
        return w; }
    __device__ __forceinline__ void operator()(const f32x4 (&acc)[2][2][4][2], const Unit& u, int wr, int wc, int fr, int fq) const {
        const int row0 = u.pm * BM + wr * 64 + fr, col0 = u.pn * BM + wc * 32 + 8 * fq;
#pragma unroll
        for (int ai = 0; ai < 2; ++ai)
#pragma unroll
            for (int m = 0; m < 4; ++m) { unsigned char* rowp = O + (size_t)(row0 + ai * HALF + m * 16) * 3072 + col0;
#pragma unroll
                for (int bj = 0; bj < 2; ++bj) { u32x2_t w; w.x = g4(acc[ai][bj][m][0]); w.y = g4(acc[ai][bj][m][1]); *(u32x2_t*)(rowp + bj * HALF) = w; } }
    }
};
template <bool GATES> struct EpiInProj {
    static constexpr bool PERM = true, AFTER_DRAIN = false, KEEP_ACC = false;
    bf16_t* O; const float *rtc, *rts, *axc, *axs; float asc; int pn_off;
    __device__ __forceinline__ void operator()(const f32x4 (&acc)[2][2][4][2], const Unit& u, int wr, int wc, int fr, int fq) const {
        const int pn = u.pn + pn_off, i8 = 8 * fq;
#pragma unroll
        for (int ai = 0; ai < 2; ++ai)
#pragma unroll
            for (int m = 0; m < 4; ++m) {
                const int row = u.pm * BM + ai * HALF + wr * 64 + m * 16 + fr;
                bf16_t* rowp = O + (size_t)row * 4352;
                const f32x4 a0 = acc[ai][0][m][0] * asc, a1 = acc[ai][0][m][1] * asc, b0 = acc[ai][1][m][0] * asc, b1 = acc[ai][1][m][1] * asc;
                if (pn < 4) {
                    const int hl = wc >> 1, i = 32 * (wc & 1) + i8;
                    const int pos = row < 16384 ? 256 + (row & 2047) : ((row - 16384) & 255);
                    const f32x4 c0 = *(const f32x4*)(rtc + pos * 64 + i), c1 = *(const f32x4*)(rtc + pos * 64 + i + 4);
                    const f32x4 s0 = *(const f32x4*)(rts + pos * 64 + i), s1 = *(const f32x4*)(rts + pos * 64 + i + 4);
                    const float sc = pn < 2 ? 0.08838834764831845f : 1.0f;
                    bf16_t* dst = rowp + pn * 256 + hl * 128 + i;
                    store8(dst, (a0 * c0 - b0 * s0) * sc, (a1 * c1 - b1 * s1) * sc);
                    store8(dst + 64, (a0 * s0 + b0 * c0) * sc, (a1 * s1 + b1 * c1) * sc);
                } else if (pn == 8 || pn == 9 || (pn == 10 && wc < 2)) {
                    const bool lat = row < 16384; const int t = row & 2047;
                    f32x4 c0 = *(const f32x4*)(axc + t * 32 + i8), c1 = *(const f32x4*)(axc + t * 32 + i8 + 4);
                    f32x4 s0 = *(const f32x4*)(axs + t * 32 + i8), s1 = *(const f32x4*)(axs + t * 32 + i8 + 4);
                    if (!lat) { c0 = (f32x4){1.f, 1.f, 1.f, 1.f}; c1 = c0; s0 = (f32x4){0.f, 0.f, 0.f, 0.f}; s1 = s0; }
                    const float sc = pn < 10 ? 0.18033688011112042f : 1.0f;
                    bf16_t* dst = rowp + (pn < 10 ? pn * 256 : 2560) + wc * 64 + i8;
                    store8(dst, (a0 * c0 - b0 * s0) * sc, (a1 * c1 - b1 * s1) * sc);
                    store8(dst + 32, (a0 * s0 + b0 * c0) * sc, (a1 * s1 + b1 * c1) * sc);
                } else if (pn == 10) {
                    bf16_t* dst = rowp + 2688 + (wc - 2) * 64 + i8;
                    store8(dst, a0, a1); store8(dst + 32, b0, b1);
                } else {
                    bf16_t* dst = rowp + pn * 256 + wc * 32 + i8;
                    if (pn == 6 || pn == 7) { store8(dst, a0 * sigm4(a0), a1 * sigm4(a1)); store8(dst + 128, b0 * sigm4(b0), b1 * sigm4(b1)); }
                    else if (pn == 11 || pn == 12) { store8(dst, a0 * 0.18033688011112042f, a1 * 0.18033688011112042f); store8(dst + 128, b0 * 0.18033688011112042f, b1 * 0.18033688011112042f); }
                    else if (GATES && pn >= 17) { store8(dst, sigm4(a0), sigm4(a1)); store8(dst + 128, sigm4(b0), sigm4(b1)); }
                    else { store8(dst, a0, a1); store8(dst + 128, b0, b1); }
                }
            }
    }
};
template <class Epi, class Sched, bool ALIGN_EPI = false, bool SP2 = false, bool FP8 = false>
__device__ __forceinline__ void gemm_phase(PG8_LAS unsigned char* lds, const Gemm g, const Sched& S, const Epi& E) {
    int tid_ = threadIdx.x; asm volatile("" : "+v"(tid_));
    const int tid = tid_, wid = __builtin_amdgcn_readfirstlane(tid >> 6), lane = tid & 63, wr = wid >> 2, wc = wid & 3, fr = lane & 15, fq = lane >> 4;
    const int K = g.K, nt = K / BK;
    unsigned voffA[2], voffB[2];
#pragma unroll
    for (int i = 0; i < 2; ++i) { int R, C; stage_rc(tid * 16 + i * 8192, R, C); const int Rb = Epi::PERM ? ((R & ~31) + perm32(R & 31)) : R;
        voffA[i] = (unsigned)(R * K + C) * 2u; voffB[i] = (unsigned)(Rb * K + C) * 2u; }
    const size_t kstep = (size_t)(BK * 2);
    const size_t hstep = (size_t)HALF * K * 2;
    const size_t tstep = 2 * hstep;
    const unsigned ldsw = (unsigned)wid * 1024u;
    const int aoff = lds_byte(wr * 64 + fr, fq * 8), boff = lds_byte(wc * 32 + fr, fq * 8);
    const int cb8 = 32 * fq, rr8 = fr & 15;
    const int aoff8 = (((wr * 64 + fr) >> 4) * 2 + (cb8 >> 6)) * 1024 + ((rr8 * 64 + (cb8 & 63)) ^ ((rr8 >> 3) << 5));
    const int boff8 = (((wc * 32 + fr) >> 4) * 2 + (cb8 >> 6)) * 1024 + ((rr8 * 64 + (cb8 & 63)) ^ ((rr8 >> 3) << 5));
#define PG8_SA(b, h) (((b) * 2 + (h)) * HTB)
#define PG8_SB(b, h) ((4 + (b) * 2 + (h)) * HTB)
#define PG8_STAGE(bufoff, gbase, voff) do { _Pragma("unroll") for (int _i = 0; _i < 2; ++_i) \
        __builtin_amdgcn_global_load_lds((const unsigned*)((const char*)(gbase) + (voff)[_i]), (PG8_LAS unsigned*)(lds + (bufoff) + ldsw + _i * 8192), 16, 0, 0); } while (0)
#define PG8_LDA(dst, b, h) do { if constexpr (FP8) { _Pragma("unroll") for (int m = 0; m < 4; ++m) dst##8[m] = *(const PG8_LAS v8i32*)(lds + PG8_SA(b, h) + aoff8 + m * 2048); } else { _Pragma("unroll") for (int m = 0; m < 4; ++m) _Pragma("unroll") for (int k = 0; k < 2; ++k) dst[m][k] = *(const PG8_LAS bf16x8*)(lds + PG8_SA(b, h) + aoff + m * 2048 + k * 1024); } } while (0)
#define PG8_LDB(dst, b, h) do { if constexpr (FP8) { _Pragma("unroll") for (int n = 0; n < 2; ++n) dst##8[n] = *(const PG8_LAS v8i32*)(lds + PG8_SB(b, h) + boff8 + n * 2048); } else { _Pragma("unroll") for (int n = 0; n < 2; ++n) _Pragma("unroll") for (int k = 0; k < 2; ++k) dst[n][k] = *(const PG8_LAS bf16x8*)(lds + PG8_SB(b, h) + boff + n * 2048 + k * 1024); } } while (0)
#define PG8_MMA(ai, bj, At, Bt) do { __builtin_amdgcn_s_setprio(1); if constexpr (FP8) { _Pragma("unroll") for (int m = 0; m < 4; ++m) _Pragma("unroll") for (int n = 0; n < 2; ++n) \
        asm volatile("v_mfma_scale_f32_16x16x128_f8f6f4 %0, %1, %2, %0, %3, %3 op_sel_hi:[0,0,0]" : "+v"(acc[ai][bj][m][n]) : "v"(Bt##8[n]), "v"(At##8[m]), "v"(sc127)); } else { \
        _Pragma("unroll") for (int m = 0; m < 4; ++m) _Pragma("unroll") for (int n = 0; n < 2; ++n) _Pragma("unroll") for (int k = 0; k < 2; ++k) \
        acc[ai][bj][m][n] = __builtin_amdgcn_mfma_f32_16x16x32_bf16(Bt[n][k], At[m][k], acc[ai][bj][m][n], 0, 0, 0); } __builtin_amdgcn_s_setprio(0); } while (0)
#define PG8_WAIT_V(n) asm volatile("s_waitcnt vmcnt(" #n ")" ::: "memory")
#define PG8_WAIT_L(n) asm volatile("s_waitcnt lgkmcnt(" #n ")" ::: "memory")
#define PG8_BAR __builtin_amdgcn_s_barrier()
#define PG8_SCHED __builtin_amdgcn_sched_barrier(0)
    Unit cur, nxt; int ui = 0;
    if (!S.next(0, cur)) return;
    f32x4 acc[2][2][4][2];
#pragma unroll
    for (int a = 0; a < 2; ++a)
#pragma unroll
        for (int b = 0; b < 2; ++b)
#pragma unroll
            for (int m = 0; m < 4; ++m)
#pragma unroll
                for (int n = 0; n < 2; ++n) acc[a][b][m][n] = (f32x4){0.f, 0.f, 0.f, 0.f};
    bf16x8 At[4][2], B0[2][2], B1[2][2];
    v8i32 At8[4], B08[2], B18[2]; const int sc127 = 127;
    const char* cA = (const char*)g.A + (size_t)cur.pm * tstep; const char* cB = (const char*)g.Bt + (size_t)cur.pn * tstep;
    S.a_ready(cur);
    if constexpr (SP2) {
        PG8_STAGE(PG8_SB(0, 0), cB, voffB); PG8_STAGE(PG8_SB(0, 1), cB + hstep, voffB); PG8_STAGE(PG8_SA(0, 0), cA, voffA); PG8_STAGE(PG8_SA(0, 1), cA + hstep, voffA);
        if (wr == 1) PG8_BAR;
        PG8_WAIT_V(2); PG8_BAR;
        PG8_STAGE(PG8_SB(1, 0), cB + kstep, voffB); PG8_STAGE(PG8_SA(1, 0), cA + kstep, voffA); PG8_STAGE(PG8_SB(1, 1), cB + hstep + kstep, voffB);
        PG8_WAIT_V(6); PG8_BAR;
    } else {
        PG8_STAGE(PG8_SB(0, 0), cB, voffB); PG8_STAGE(PG8_SA(0, 0), cA, voffA); PG8_STAGE(PG8_SB(0, 1), cB + hstep, voffB); PG8_STAGE(PG8_SA(0, 1), cA + hstep, voffA);
        if (wr == 1) PG8_BAR;
        PG8_WAIT_V(4); PG8_BAR;
        PG8_STAGE(PG8_SB(1, 0), cB + kstep, voffB); PG8_STAGE(PG8_SA(1, 0), cA + kstep, voffA); PG8_STAGE(PG8_SB(1, 1), cB + hstep + kstep, voffB);
        PG8_WAIT_V(6); PG8_BAR;
    }
    for (;;) {
        const bool has_next = S.next(ui + 1, nxt);
        const char* nA = has_next ? (const char*)g.A + (size_t)nxt.pm * tstep : cA; const char* nB = has_next ? (const char*)g.Bt + (size_t)nxt.pn * tstep : cB;
        for (int t = 0; t < nt; t += 2) {
            const bool last = (t == nt - 2);
            const char* a1 = cA + (size_t)(t + 1) * kstep;
            const char* a2 = last ? nA : cA + (size_t)(t + 2) * kstep; const char* b2 = last ? nB : cB + (size_t)(t + 2) * kstep;
            const char* a3 = a2 + kstep; const char* b3 = b2 + kstep;
            if (last && has_next) S.a_ready(nxt);
            if constexpr (SP2) {
            PG8_LDB(B0, 0, 0); PG8_LDB(B1, 0, 1); PG8_SCHED; PG8_LDA(At, 0, 0); PG8_STAGE(PG8_SA(1, 1), a1 + hstep, voffA);
            PG8_WAIT_V(8); PG8_WAIT_L(0); PG8_BAR; PG8_MMA(0, 0, At, B0); PG8_MMA(0, 1, At, B1); PG8_BAR; PG8_SCHED;
            PG8_LDA(At, 0, 1); PG8_STAGE(PG8_SB(0, 0), b2, voffB); PG8_STAGE(PG8_SB(0, 1), b2 + hstep, voffB); PG8_STAGE(PG8_SA(0, 0), a2, voffA);
            PG8_WAIT_V(8); PG8_WAIT_L(0); PG8_BAR; PG8_MMA(1, 0, At, B0); PG8_MMA(1, 1, At, B1); PG8_BAR; PG8_SCHED;
            PG8_LDB(B0, 1, 0); PG8_LDB(B1, 1, 1); PG8_SCHED; PG8_LDA(At, 1, 0); PG8_STAGE(PG8_SA(0, 1), a2 + hstep, voffA);
            PG8_WAIT_V(8); PG8_WAIT_L(0); PG8_BAR; PG8_MMA(0, 0, At, B0); PG8_MMA(0, 1, At, B1); PG8_BAR; PG8_SCHED;
            PG8_LDA(At, 1, 1); PG8_STAGE(PG8_SB(1, 0), b3, voffB); PG8_STAGE(PG8_SB(1, 1), b3 + hstep, voffB); PG8_STAGE(PG8_SA(1, 0), a3, voffA);
            PG8_WAIT_V(8); PG8_WAIT_L(0); PG8_BAR; PG8_MMA(1, 0, At, B0); PG8_MMA(1, 1, At, B1); PG8_BAR; PG8_SCHED;
            } else {
            PG8_LDB(B0, 0, 0); PG8_SCHED; PG8_LDA(At, 0, 0); PG8_STAGE(PG8_SA(1, 1), a1 + hstep, voffA);
            PG8_WAIT_L(8); PG8_BAR; PG8_WAIT_L(0); PG8_MMA(0, 0, At, B0); PG8_BAR; PG8_SCHED;
            PG8_LDB(B1, 0, 1); PG8_STAGE(PG8_SB(0, 0), b2, voffB);
            PG8_BAR; PG8_WAIT_L(0); PG8_MMA(0, 1, At, B1); PG8_BAR;
            PG8_LDA(At, 0, 1); PG8_STAGE(PG8_SA(0, 0), a2, voffA);
            PG8_BAR; PG8_WAIT_L(0); PG8_MMA(1, 0, At, B0); PG8_BAR; PG8_SCHED;
            PG8_STAGE(PG8_SB(0, 1), b2 + hstep, voffB);
            PG8_WAIT_V(6); PG8_BAR; PG8_MMA(1, 1, At, B1); PG8_BAR;
            PG8_LDB(B0, 1, 0); PG8_SCHED; PG8_LDA(At, 1, 0); PG8_STAGE(PG8_SA(0, 1), a2 + hstep, voffA);
            PG8_WAIT_L(8); PG8_BAR; PG8_WAIT_L(0); PG8_MMA(0, 0, At, B0); PG8_BAR; PG8_SCHED;
            PG8_LDB(B1, 1, 1); PG8_STAGE(PG8_SB(1, 0), b3, voffB);
            PG8_BAR; PG8_WAIT_L(0); PG8_MMA(0, 1, At, B1); PG8_BAR;
            PG8_LDA(At, 1, 1); PG8_STAGE(PG8_SA(1, 0), a3, voffA);
            PG8_BAR; PG8_WAIT_L(0); PG8_MMA(1, 0, At, B0); PG8_BAR; PG8_SCHED;
            PG8_STAGE(PG8_SB(1, 1), b3 + hstep, voffB);
            PG8_WAIT_V(6); PG8_BAR; PG8_MMA(1, 1, At, B1); PG8_BAR;
            }
        }
        if constexpr (ALIGN_EPI) { if (wr == 0) PG8_BAR; }
        if constexpr (FP8) asm volatile("s_nop 15\n\ts_nop 7" ::: "memory");
        if constexpr (!Epi::AFTER_DRAIN) { E(acc, cur, wr, wc, fr, fq); S.done(cur); }
        if (!has_next) break;
        if constexpr (!Epi::KEEP_ACC) {
#pragma unroll
        for (int a = 0; a < 2; ++a)
#pragma unroll
            for (int b = 0; b < 2; ++b)
#pragma unroll
                for (int m = 0; m < 4; ++m)
#pragma unroll
                    for (int n = 0; n < 2; ++n) acc[a][b][m][n] = (f32x4){0.f, 0.f, 0.f, 0.f};
        }
        cur = nxt; cA = nA; cB = nB; ++ui;
        if constexpr (ALIGN_EPI) { if (wr == 1) PG8_BAR; }
    }
    PG8_WAIT_V(0);
    if constexpr (!ALIGN_EPI) { if (wr == 0) PG8_BAR; }
    PG8_BAR;
    if constexpr (Epi::AFTER_DRAIN) { E.fused(acc, cur, wr, wc, fr, fq, lds, wid, lane); S.done(cur); }
#undef PG8_SA
#undef PG8_SB
#undef PG8_STAGE
#undef PG8_LDA
#undef PG8_LDB
#undef PG8_MMA
#undef PG8_WAIT_V
#undef PG8_WAIT_L
#undef PG8_BAR
#undef PG8_SCHED
}
}

#define XB_TMO      128
#define XB_XCNT(j)  (256  + 64 * (j))
#define XB_XSUB(j)  (1280 + 64 * (j))
#define XB_XGEN(j)  (2304 + 64 * (j))
#define XB_TOP      3328
#define XB_TOPGEN   3392
#define XCD_BAR_WORDS 3456
#define XB_SPIN_CAP (1u << 18)

__device__ __forceinline__ unsigned xb_ld(unsigned* p)              { return __hip_atomic_load(p, __ATOMIC_RELAXED, __HIP_MEMORY_SCOPE_AGENT); }
__device__ __forceinline__ unsigned xb_add(unsigned* p, unsigned v) { return __hip_atomic_fetch_add(p, v, __ATOMIC_RELAXED, __HIP_MEMORY_SCOPE_AGENT); }
__device__ __forceinline__ unsigned xb_xcc_id() { return (unsigned)__builtin_amdgcn_s_getreg((3 << 11) | 20) & 0xFu; }
#define XB_SPIN(cond, bar) do { unsigned _sp = 0; while (cond) { __builtin_amdgcn_s_sleep(1); \
    if ((++_sp & 255u) == 0u) { if (xb_ld(&(bar)[XB_TMO])) break; if (_sp > XB_SPIN_CAP) { atomicAdd(&(bar)[XB_TMO], 1u); break; } } } } while (0)

struct XcdBarrier {
    unsigned* bar; unsigned x;
    volatile LAS unsigned* st;
};

__device__ __forceinline__ XcdBarrier xcd_barrier_post(unsigned* bar, volatile LAS unsigned* st) {
    XcdBarrier b; b.bar = bar; b.x = xb_xcc_id(); b.st = st;
    if (threadIdx.x == 0) (void)xb_add(&bar[XB_XCNT(b.x)], 1u);
    return b;
}
__device__ __forceinline__ void xcd_barrier_complete(unsigned* bar, unsigned x, unsigned& nloc, unsigned& nx) {
    const unsigned G = gridDim.x * gridDim.y * gridDim.z;
    unsigned sum, cnt, mine, sp = 0u;
    for (;;) {
        sum = 0u; cnt = 0u; mine = 0u;
#pragma unroll
        for (unsigned j = 0; j < 16; ++j) { const unsigned c = xb_ld(&bar[XB_XCNT(j)]); sum += c; cnt += (c > 0u) ? 1u : 0u; mine = (j == x) ? c : mine; }
        if (sum == G) break;
        __builtin_amdgcn_s_sleep(1);
        if ((++sp & 255u) == 0u) { if (xb_ld(&bar[XB_TMO])) break; if (sp > XB_SPIN_CAP) { atomicAdd(&bar[XB_TMO], 1u); break; } }
    }
    nloc = mine > 0u ? mine : 1u; nx = cnt > 0u ? cnt : 1u;
}

__device__ __forceinline__ void xcd_barrier(const XcdBarrier& b) {
    asm volatile("s_waitcnt vmcnt(0)" ::: "memory");
    __syncthreads();
    if (threadIdx.x == 0) {
        unsigned* bar = b.bar;
        __builtin_amdgcn_s_waitcnt(0);
        unsigned nloc = b.st[0], nx = b.st[1];
        if (nloc == 0u) { xcd_barrier_complete(bar, b.x, nloc, nx); b.st[0] = nloc; b.st[1] = nx; }
        const unsigned old = xb_add(&bar[XB_XSUB(b.x)], 1u);
        const unsigned gen = old / nloc;
        if (old + 1u == (gen + 1u) * nloc) {
            __builtin_amdgcn_fence(__ATOMIC_RELEASE, "agent");
            asm volatile("s_waitcnt vmcnt(0)" ::: "memory");
            const unsigned og = xb_add(&bar[XB_TOP], 1u);
            const unsigned tg = og / nx;
            if (og + 1u == (tg + 1u) * nx) xb_add(&bar[XB_TOPGEN], 1u);
            else XB_SPIN(xb_ld(&bar[XB_TOPGEN]) == tg, bar);
            __builtin_amdgcn_fence(__ATOMIC_ACQUIRE, "agent");
            xb_add(&bar[XB_XGEN(b.x)], 1u);
            asm volatile("s_waitcnt vmcnt(0)" ::: "memory");
        } else {
            XB_SPIN(xb_ld(&bar[XB_XGEN(b.x)]) == gen, bar);
            __builtin_amdgcn_fence(__ATOMIC_ACQUIRE, "agent");
            asm volatile("s_waitcnt vmcnt(0)" ::: "memory");
        }
    }
    __syncthreads();
}

constexpr int D = 1024, NB = 8, SEQ = 2048, LC = 256, DEPTH = 4;
constexpr int ML = NB * SEQ, MC = NB * LC, MT = ML + MC;
constexpr int DIN = 7424, FFD = 2816, FFE = 3584, NE = 8;
constexpr int PS = 4352;
constexpr int MSORT = 38912;
constexpr float EPS = 1e-6f;
constexpr int NWAVES = 8, NTHREADS = 512;
#ifndef MK_PER_PHASE
#define MK_PER_PHASE 0
#endif
constexpr int NPH = 2 + 11 * DEPTH;
#ifndef MK_EN
#define MK_EN 0xFFFFFFFFu
#endif
#ifndef MK_DUMP
#define MK_DUMP 0
#endif
#ifndef MK_F8
#define MK_F8 0x2F
#endif
constexpr bool F8IN = (MK_F8 & 16) != 0, F8GATE = (MK_F8 & 32) != 0;
constexpr bool F8UP_D = (MK_F8 & 1) != 0, F8DN_D = (MK_F8 & 2) != 0, F8UP_M = (MK_F8 & 4) != 0, F8DN_M = (MK_F8 & 8) != 0;
#ifndef MK_REP
#define MK_REP 0u
#endif
#ifndef MK_NPH_RUN
#define MK_NPH_RUN NPH
#endif

constexpr size_t MiB = (size_t)1 << 20;
constexpr size_t WS_CTL = 0, CTL_ZERO_BYTES = MiB;
constexpr size_t WS_MOD = 1 * MiB;
constexpr size_t WS_TAB = 2 * MiB;
constexpr size_t WS_ROUTE = 4 * MiB;
constexpr size_t WS_HC = 5 * MiB;
constexpr size_t WS_XN = 13 * MiB;
constexpr size_t WS_YOUT = 49 * MiB;
constexpr size_t WS_WIN = 85 * MiB, WS_WBR = 143 * MiB, WS_WOUT = 155 * MiB, WS_WF13 = 163 * MiB, WS_WF2 = 185 * MiB, WS_WM13 = 196 * MiB, WS_WM2 = 420 * MiB;
constexpr size_t WS_OVL = 532 * MiB;
constexpr size_t WS_PROJ = WS_OVL, WS_YBR = WS_OVL + 261 * MiB, WS_KV = WS_OVL + 315 * MiB, WS_ST = WS_OVL + 387 * MiB;
constexpr size_t WS_TMP = WS_KV, WS_MERGED = WS_ST;
constexpr size_t WS_PART = WS_OVL;
constexpr size_t WS_G8 = WS_OVL + 153 * MiB;
constexpr size_t WS_ASORT = WS_OVL, WS_HID = WS_OVL + 76 * MiB, WS_OSORT = WS_OVL + 342 * MiB;
constexpr size_t WS_HB = WS_OVL + 423 * MiB;
constexpr size_t WS_WIN8 = WS_HB + 36 * MiB;
constexpr size_t WS_XN8 = WS_WIN8 + 12 * MiB;
constexpr size_t WS_END = WS_XN8 + 18 * MiB;
static_assert(WS_OSORT + (size_t)MSORT * D * 2 <= WS_END && WS_ST + 36 * MiB <= WS_END, "map");
constexpr int TAB_RTC = 0, TAB_RTS = 2304 * 64, TAB_AXC = 2 * 2304 * 64, TAB_AXS = 2 * 2304 * 64 + 2048 * 32;
constexpr int CW_BAR = 4096, CW_MOE = 8192, CW_WQ = 12288, CW_RFLAG = 24576, CW_PFLAG = 32768;

constexpr int LDS_BYTES = 147456, MISC_OFF = 131072 + 320;

#define GAS __attribute__((address_space(1)))
#define DEV __device__ __forceinline__
typedef unsigned short bf16;
typedef float f32x4 __attribute__((ext_vector_type(4)));
typedef short bf16x8 __attribute__((ext_vector_type(8)));
typedef short s16x4 __attribute__((ext_vector_type(4)));
typedef unsigned u32x4 __attribute__((ext_vector_type(4)));
typedef unsigned u32x2 __attribute__((ext_vector_type(2)));
#define MFMA16(a, b, c) __builtin_amdgcn_mfma_f32_16x16x32_bf16((a), (b), (c), 0, 0, 0)
DEV float bf2f(unsigned short b) { return __uint_as_float(((unsigned)b) << 16); }
DEV float bflo(unsigned u) { return __uint_as_float(u << 16); }
DEV float bfhi(unsigned u) { return __uint_as_float(u & 0xffff0000u); }
DEV unsigned pk2(float lo, float hi) { return pg8::cvt_pk_bf16(lo, hi); }
DEV unsigned short f2bf(float f) { return (unsigned short)(pg8::cvt_pk_bf16(f, 0.f) & 0xffffu); }
template <int CTRL> DEV float dpp_add(float v) { return v + __int_as_float(__builtin_amdgcn_update_dpp(0, __float_as_int(v), CTRL, 0xf, 0xf, true)); }
DEV float wave_sum(float v) {
    v = dpp_add<0xB1>(v); v = dpp_add<0x4E>(v); v = dpp_add<0x141>(v); v = dpp_add<0x140>(v);
    const int iv = __float_as_int(v);
    return (__int_as_float(__builtin_amdgcn_readlane(iv, 0)) + __int_as_float(__builtin_amdgcn_readlane(iv, 16))) + (__int_as_float(__builtin_amdgcn_readlane(iv, 32)) + __int_as_float(__builtin_amdgcn_readlane(iv, 48)));
}
DEV bf16x8 pack8(const f32x4 a, const f32x4 b) { u32x4 w; w.x = pk2(a[0], a[1]); w.y = pk2(a[2], a[3]); w.z = pk2(b[0], b[1]); w.w = pk2(b[2], b[3]); return __builtin_bit_cast(bf16x8, w); }

struct Args { const float* in[20]; float* out; unsigned char* ws; int ph_lo, ph_hi, li, pad; };
enum { I_X = 0, I_C, I_CTX, I_CCTX, I_WMOD, I_BMOD, I_GAINS, I_WIN, I_DECAY, I_SINK, I_RPB, I_WBR, I_WOUT, I_F1, I_F3, I_F2, I_ROUTER, I_M1, I_M3, I_M2 };

DEV void p0_transpose_item(const float* W, int K, int N, bf16* WT, LAS float* scr, int kb, int n0, int drow0, int lane) {
    const int k0 = 64 * kb;
#pragma unroll 8
    for (int i = 0; i < 32; ++i) { const int kk = 2 * i + (lane >> 5); scr[kk * 33 + (lane & 31)] = __builtin_nontemporal_load(W + (size_t)(k0 + kk) * N + n0 + (lane & 31)); }
    asm volatile("s_waitcnt lgkmcnt(0)" ::: "memory");
    const int c = lane & 7;
#pragma unroll
    for (int j = 0; j < 4; ++j) { const int n = (lane >> 3) + 8 * j; const LAS float* s = scr + (8 * c) * 33 + n;
        u32x4 o; o.x = pk2(s[0 * 33], s[1 * 33]); o.y = pk2(s[2 * 33], s[3 * 33]); o.z = pk2(s[4 * 33], s[5 * 33]); o.w = pk2(s[6 * 33], s[7 * 33]);
        __builtin_nontemporal_store(o, (u32x4*)(WT + (size_t)(drow0 + n) * K + k0 + 8 * c)); }
    asm volatile("s_waitcnt lgkmcnt(0)" ::: "memory");
}

DEV float clampf8(float v) { return __builtin_amdgcn_fmed3f(v, -448.0f, 448.0f); }
DEV unsigned pk4f8(float a, float b, float c, float d) { a = clampf8(a); b = clampf8(b); c = clampf8(c); d = clampf8(d); unsigned w = 0; w = __builtin_amdgcn_cvt_pk_fp8_f32(a, b, w, false); w = __builtin_amdgcn_cvt_pk_fp8_f32(c, d, w, true); return w; }
DEV void p0_transpose_item_f8(const float* W, int K, int N, unsigned char* WT, LAS float* scr, int kb, int n0, int drow0, float scale, int lane) {
    const int k0 = 64 * kb;
#pragma unroll 8
    for (int i = 0; i < 32; ++i) { const int kk = 2 * i + (lane >> 5); scr[kk * 33 + (lane & 31)] = __builtin_nontemporal_load(W + (size_t)(k0 + kk) * N + n0 + (lane & 31)) * scale; }
    asm volatile("s_waitcnt lgkmcnt(0)" ::: "memory");
    const int c = lane & 3;
#pragma unroll
    for (int j = 0; j < 2; ++j) { const int n = (lane >> 2) + 16 * j; const LAS float* s = scr + (16 * c) * 33 + n;
        u32x4 o; o.x = pk4f8(s[0 * 33], s[1 * 33], s[2 * 33], s[3 * 33]); o.y = pk4f8(s[4 * 33], s[5 * 33], s[6 * 33], s[7 * 33]);
        o.z = pk4f8(s[8 * 33], s[9 * 33], s[10 * 33], s[11 * 33]); o.w = pk4f8(s[12 * 33], s[13 * 33], s[14 * 33], s[15 * 33]);
        __builtin_nontemporal_store(o, (u32x4*)(WT + (size_t)(drow0 + n) * K + k0 + 16 * c)); }
    asm volatile("s_waitcnt lgkmcnt(0)" ::: "memory");
}
DEV int inproj_dest_row(int n0) {
    const int pn = n0 >> 8, wi = n0 & 255;
    if (pn < 4) { const int hl = wi >> 7, rem = wi & 127, half = rem >> 6, i = rem & 63; return pn * 256 + half * 128 + hl * 64 + i; }
    if (pn == 8 || pn == 9) { const int hl = wi >> 6, rem = wi & 63, half = rem >> 5, i = rem & 31; return pn * 256 + half * 128 + hl * 32 + i; }
    if (pn == 10) { const int isv = wi >> 7, w2 = wi & 127, hl = w2 >> 6, half = (w2 & 63) >> 5, i = w2 & 31; return 2560 + half * 128 + (2 * isv + hl) * 32 + i; }
    return n0;
}
DEV void p0_prologue(const Args& A, LAS unsigned char* lds, int vcu, int G, int tid) {
    const int wave = __builtin_amdgcn_readfirstlane(tid >> 6), lane = tid & 63;
    unsigned char* ws = A.ws;
    {
        LAS float* sc = (LAS float*)lds;
        LAS float* red = (LAS float*)(lds + 9 * 1024 * 4);
        for (int i = tid; i < 9 * 1024; i += NTHREADS) { const int r = i >> 10, k = i & 1023; const float v = r < 8 ? A.in[I_C][r * 1024 + k] : A.in[I_CCTX][k]; sc[i] = v / (1.0f + __expf(-v)); }
        __syncthreads();
        float* MOD = (float*)(ws + WS_MOD);
        for (int it = vcu; it < 4 * 96; it += G) {
            const int l = it / 96, cg = it % 96, col = cg * 64 + lane;
            const float* W = A.in[I_WMOD] + (size_t)l * 1024 * 6144 + col;
            float acc[9];
#pragma unroll
            for (int r = 0; r < 9; ++r) acc[r] = 0.f;
#pragma unroll 4
            for (int kk = 0; kk < 128; ++kk) { const int k = wave * 128 + kk; const float w = __builtin_nontemporal_load(W + (size_t)k * 6144);
#pragma unroll
                for (int r = 0; r < 9; ++r) acc[r] += sc[r * 1024 + k] * w; }
#pragma unroll
            for (int r = 0; r < 9; ++r) red[(wave * 9 + r) * 64 + lane] = acc[r];
            __syncthreads();
            for (int o = tid; o < 9 * 64; o += NTHREADS) { const int r = o >> 6, ln = o & 63; float s = 0.f;
#pragma unroll
                for (int w = 0; w < 8; ++w) s += red[(w * 9 + r) * 64 + ln];
                MOD[((size_t)l * 9 + r) * 6144 + cg * 64 + ln] = s + A.in[I_BMOD][l * 6144 + cg * 64 + ln]; }
            __syncthreads();
        }
    }
    {
        float* TAB = (float*)(ws + WS_TAB);
        const int gt = vcu * NTHREADS + tid, NGT = G * NTHREADS;
        for (int i = gt; i < 2304 * 64; i += NGT) { const int pos = i >> 6, f = i & 63; const float inv = exp2f(-(float)f * (13.287712379549449f / 64.0f)); const float ang = (float)pos * inv; float s, c; sincosf(ang, &s, &c); TAB[TAB_RTC + i] = c; TAB[TAB_RTS + i] = s; }
        for (int i = gt; i < 2048 * 32; i += NGT) { const int t = i >> 5, f = i & 31; const float inv = exp2f(-(float)(f & 15) * (13.287712379549449f / 16.0f)); const float p = (f < 16) ? (float)(t >> 6) : (float)(t & 63); const float ang = p * inv; float s, c; sincosf(ang, &s, &c); TAB[TAB_AXC + i] = c; TAB[TAB_AXS + i] = s; }
    }
    __syncthreads();
    {
        LAS float* scr = (LAS float*)(lds + wave * 16384);
        const int gw = vcu * NWAVES + wave, NGW = G * NWAVES;
        constexpr int C_IN = 16 * 232, C_BR = 8 * 32, C_OUT = 16 * 32, C_F13 = 16 * 88, C_F2 = 44 * 32, C_M13 = 16 * 112, C_M2 = 56 * 32;
        constexpr int N_IN = 4 * C_IN, N_BR = 12 * C_BR, N_OUT = 4 * C_OUT, N_F13 = 4 * C_F13, N_F2 = 2 * C_F2, N_M13 = 32 * C_M13, N_M2 = 16 * C_M2;
        constexpr int NITEMS = N_IN + N_BR + N_OUT + N_F13 + N_F2 + N_M13 + N_M2;
        for (int it = gw; it < NITEMS; it += NGW) {
            int r = it;
            if (r < N_IN) { const int l = r / C_IN, q = r % C_IN, kb = q / 232, nb = q % 232;
                if constexpr (F8IN) p0_transpose_item_f8(A.in[I_WIN] + (size_t)l * 1024 * DIN, 1024, DIN, ws + WS_WIN + (size_t)l * DIN * 1024, scr, kb, 32 * nb, inproj_dest_row(32 * nb), 64.0f, lane);
                else if (F8GATE && 32 * nb >= 4352) p0_transpose_item_f8(A.in[I_WIN] + (size_t)l * 1024 * DIN, 1024, DIN, ws + WS_WIN8 + (size_t)l * 3072 * 1024, scr, kb, 32 * nb, 32 * nb - 4352, 64.0f, lane);
                else p0_transpose_item(A.in[I_WIN] + (size_t)l * 1024 * DIN, 1024, DIN, (bf16*)(ws + WS_WIN) + (size_t)l * DIN * 1024, scr, kb, 32 * nb, inproj_dest_row(32 * nb), lane);
                continue; } r -= N_IN;
            if (r < N_BR) { const int mtx = r / C_BR, q = r % C_BR, kb = q / 32, nb = q % 32;
                p0_transpose_item(A.in[I_WBR] + (size_t)mtx * 512 * 1024, 512, 1024, (bf16*)(ws + WS_WBR) + (size_t)mtx * 1024 * 512, scr, kb, 32 * nb, 32 * nb, lane); continue; } r -= N_BR;
            if (r < N_OUT) { const int l = r / C_OUT, q = r % C_OUT, kb = q / 32, nb = q % 32;
                p0_transpose_item(A.in[I_WOUT] + (size_t)l * 1024 * 1024, 1024, 1024, (bf16*)(ws + WS_WOUT) + (size_t)l * 1024 * 1024, scr, kb, 32 * nb, 32 * nb, lane); continue; } r -= N_OUT;
            if (r < N_F13) { const int mtx = r / C_F13, q = r % C_F13, kb = q / 88, nb = q % 88, i = mtx >> 1, which = mtx & 1, n0 = 32 * nb;
                if constexpr (F8UP_D) p0_transpose_item_f8(A.in[which ? I_F3 : I_F1] + (size_t)i * 1024 * FFD, 1024, FFD, ws + WS_WF13 + (size_t)i * 2 * FFD * 1024, scr, kb, n0, (n0 >> 7) * 256 + which * 128 + (n0 & 127), 64.0f, lane);
                else p0_transpose_item(A.in[which ? I_F3 : I_F1] + (size_t)i * 1024 * FFD, 1024, FFD, (bf16*)(ws + WS_WF13) + (size_t)i * 2 * FFD * 1024, scr, kb, n0, (n0 >> 7) * 256 + which * 128 + (n0 & 127), lane);
                continue; } r -= N_F13;
            if (r < N_F2) { const int i = r / C_F2, q = r % C_F2, kb = q / 32, nb = q % 32;
                if constexpr (F8DN_D) p0_transpose_item_f8(A.in[I_F2] + (size_t)i * FFD * 1024, FFD, 1024, ws + WS_WF2 + (size_t)i * 1024 * FFD, scr, kb, 32 * nb, 32 * nb, 128.0f, lane);
                else p0_transpose_item(A.in[I_F2] + (size_t)i * FFD * 1024, FFD, 1024, (bf16*)(ws + WS_WF2) + (size_t)i * 1024 * FFD, scr, kb, 32 * nb, 32 * nb, lane);
                continue; } r -= N_F2;
            if (r < N_M13) { const int mtx = r / C_M13, q = r % C_M13, kb = q / 112, nb = q % 112, ie = mtx >> 1, which = mtx & 1, n0 = 32 * nb;
                if constexpr (F8UP_M) p0_transpose_item_f8(A.in[which ? I_M3 : I_M1] + (size_t)ie * 1024 * FFE, 1024, FFE, ws + WS_WM13 + (size_t)ie * 2 * FFE * 1024, scr, kb, n0, (n0 >> 7) * 256 + which * 128 + (n0 & 127), 64.0f, lane);
                else p0_transpose_item(A.in[which ? I_M3 : I_M1] + (size_t)ie * 1024 * FFE, 1024, FFE, (bf16*)(ws + WS_WM13) + (size_t)ie * 2 * FFE * 1024, scr, kb, n0, (n0 >> 7) * 256 + which * 128 + (n0 & 127), lane);
                continue; } r -= N_M13;
            { const int ie = r / C_M2, q = r % C_M2, kb = q / 32, nb = q % 32;
                if constexpr (F8DN_M) p0_transpose_item_f8(A.in[I_M2] + (size_t)ie * FFE * 1024, FFE, 1024, ws + WS_WM2 + (size_t)ie * 1024 * FFE, scr, kb, 32 * nb, 32 * nb, 128.0f, lane);
                else p0_transpose_item(A.in[I_M2] + (size_t)ie * FFE * 1024, FFE, 1024, (bf16*)(ws + WS_WM2) + (size_t)ie * 1024 * FFE, scr, kb, 32 * nb, 32 * nb, lane); }
        }
    }
}

DEV void ld_row_f32(const float* p, int lane, f32x4 (&v)[4]) {
#pragma unroll
    for (int j = 0; j < 4; ++j) v[j] = __builtin_nontemporal_load((const f32x4*)(p + 4 * lane + 256 * j));
}
DEV void ld_row_bf16(const bf16* p, int lane, f32x4 (&v)[4]) {
#pragma unroll
    for (int j = 0; j < 4; ++j) { const u32x2 u = *(const u32x2*)(p + 4 * lane + 256 * j); v[j][0] = bflo(u.x); v[j][1] = bfhi(u.x); v[j][2] = bflo(u.y); v[j][3] = bfhi(u.y); }
}
DEV void st_row_bf16(bf16* p, int lane, const f32x4 (&v)[4]) {
#pragma unroll
    for (int j = 0; j < 4; ++j) { u32x2 u; u.x = pk2(v[j][0], v[j][1]); u.y = pk2(v[j][2], v[j][3]); *(u32x2*)(p + 4 * lane + 256 * j) = u; }
}
DEV void st_row_bf16_nt(bf16* p, int lane, const f32x4 (&v)[4]) {
#pragma unroll
    for (int j = 0; j < 4; ++j) { u32x2 u; u.x = pk2(v[j][0], v[j][1]); u.y = pk2(v[j][2], v[j][3]); __builtin_nontemporal_store(u, (u32x2*)(p + 4 * lane + 256 * j)); }
}
DEV float row_rstd(const f32x4 (&v)[4]) {
    float s = 0.f;
#pragma unroll
    for (int j = 0; j < 4; ++j) s += (v[j][0] * v[j][0] + v[j][1] * v[j][1]) + (v[j][2] * v[j][2] + v[j][3] * v[j][3]);
    return rsqrtf(wave_sum(s) * (1.0f / 1024.0f) + EPS);
}
DEV void moe_bases(const unsigned* cnt, int (&base)[8]) {
    int acc = 0;
#pragma unroll
    for (int e = 0; e < 8; ++e) { base[e] = acc; const unsigned ce = __hip_atomic_load(cnt + 64 * e, __ATOMIC_RELAXED, __HIP_MEMORY_SCOPE_AGENT); acc += (int)(((ce + 255u) >> 8) << 8); }
}
DEV int sel8(const int (&b)[8], int e) { int r = 0;
#pragma unroll
    for (int k = 0; k < 8; ++k) r = (e == k) ? b[k] : r;
    return r; }

DEV void raw_row_bf16(const bf16* p, int lane, u32x2 (&v)[4]) {
#pragma unroll
    for (int j = 0; j < 4; ++j) v[j] = __builtin_nontemporal_load((const u32x2*)(p + 4 * lane + 256 * j));
}
DEV void cvt_row_bf16(const u32x2 (&u)[4], f32x4 (&v)[4]) {
#pragma unroll
    for (int j = 0; j < 4; ++j) { v[j][0] = bflo(u[j].x); v[j][1] = bfhi(u[j].x); v[j][2] = bflo(u[j].y); v[j][3] = bfhi(u[j].y); }
}
constexpr int TR = 2;
template <int MODE> DEV void thin_phase(const Args& A, int L, int wid, int nw, int row_lo, int row_hi, int tid, LAS unsigned char* lds) {
    const int wave = __builtin_amdgcn_readfirstlane(tid >> 6), lane = tid & 63;
    const int gw = wid * NWAVES + wave, NGW = nw * NWAVES;
    unsigned char* ws = A.ws;
    const float* MOD = (const float*)(ws + WS_MOD);
    const float* GN = A.in[I_GAINS];
    unsigned char* HC = ws + WS_HB;
    bf16* XN = (bf16*)(ws + WS_XN);
    const bf16* YOUT = (const bf16*)(ws + WS_YOUT);
    int* ROUTE = (int*)(ws + WS_ROUTE);
    const int mi = L >> 1;
    unsigned* cnt = (unsigned*)(ws + WS_CTL) + CW_MOE + mi * 8 * 64;
    int base[8];
    const bool moe2 = (MODE == 2) && (L & 1);
    if (moe2) moe_bases(cnt, base);
    const bool first = (L == 0 && MODE <= 1);
    const bool rout = (MODE == 1) && (L & 1);
    const LAS f32x4* WL = (const LAS f32x4*)lds;
    if (rout) {
        const f32x4* WR4 = (const f32x4*)(A.in[I_ROUTER] + (size_t)mi * 1024 * 8);
        for (int s4 = tid; s4 < 2048; s4 += NTHREADS) { const int k = s4 >> 1, hf_ = s4 & 1; ((LAS f32x4*)lds)[(((k >> 8) * 4 + (k & 3)) * 2 + hf_) * 64 + ((k & 255) >> 2)] = WR4[s4]; }
        __syncthreads();
    }
    const float* gn = GN + L * 4096;
    const bf16* OS = (const bf16*)(ws + WS_OSORT);
    const int nrows_ = row_hi - row_lo, r_beg = row_lo + (int)(((long)gw * nrows_) / NGW), r_end = row_lo + (int)(((long)(gw + 1) * nrows_) / NGW);
    const int Ln = (MODE == 2) ? L + 1 : L;
    f32x4 vgy[4], vgx[4], vgate[4], vsh[4], vsc[4]; int mr_cur = -1;
    if (r_beg < r_end) {
        const float* gy = gn + (MODE == 1 ? 1 : 3) * 1024; const float* gx = GN + Ln * 4096 + (MODE == 1 ? 2 : 0) * 1024;
#pragma unroll
        for (int j = 0; j < 4; ++j) { if (MODE != 0) vgy[j] = *(const f32x4*)(gy + 4 * lane + 256 * j); vgx[j] = *(const f32x4*)(gx + 4 * lane + 256 * j); }
    }
    const bool pre = moe2 && (r_end - r_beg <= 64);
    int4 prq = {0, 0, 0, 0}; int2 prw = {0, 0};
    if (pre && r_beg < r_end) { const int* rt = ROUTE + (size_t)((r_beg + lane < r_end) ? r_beg + lane : r_beg) * 8; prq = *(const int4*)rt; prw = *(const int2*)(rt + 4); }
    for (int m0 = r_beg; m0 < r_end; m0 += TR) {
        int mm[TR]; bool on[TR];
#pragma unroll
        for (int r = 0; r < TR; ++r) { const int m = m0 + r; on[r] = m < r_end; mm[r] = on[r] ? m : m0; }
        int4 rq[TR]; int2 rw[TR];
        if (moe2) {
#pragma unroll
            for (int r = 0; r < TR; ++r) {
                if (pre) { const int k = mm[r] - r_beg;
                    rq[r].x = __builtin_amdgcn_readlane(prq.x, k); rq[r].y = __builtin_amdgcn_readlane(prq.y, k); rq[r].z = __builtin_amdgcn_readlane(prq.z, k); rq[r].w = __builtin_amdgcn_readlane(prq.w, k);
                    rw[r].x = __builtin_amdgcn_readlane(prw.x, k); rw[r].y = __builtin_amdgcn_readlane(prw.y, k); }
                else { const int* rt = ROUTE + (size_t)mm[r] * 8; rq[r] = *(const int4*)rt; rw[r] = *(const int2*)(rt + 4); } }
        }
        f32x4 hf[TR][4]; u32x2 hr[TR][4], ya[TR][4], yb[TR][4];
#pragma unroll
        for (int r = 0; r < TR; ++r) { const int m = mm[r];
            if (first) ld_row_f32(m >= ML ? A.in[I_CTX] + (size_t)(m - ML) * D : A.in[I_X] + (size_t)m * D, lane, hf[r]);
            else raw_row_bf16((const bf16*)HC + (size_t)m * D, lane, hr[r]);
            if (MODE != 0) {
                if (moe2) { raw_row_bf16(OS + (size_t)(sel8(base, rq[r].x) + rq[r].z) * D, lane, ya[r]); raw_row_bf16(OS + (size_t)(sel8(base, rq[r].y) + rq[r].w) * D, lane, yb[r]); }
                else raw_row_bf16(YOUT + (size_t)m * D, lane, ya[r]);
            } }
#pragma unroll
        for (int r = 0; r < TR; ++r) if (on[r]) { const int m = mm[r];
        const bool isc = m >= ML;
        const int mr = isc ? 8 : (m >> 11);
        if (mr != mr_cur) { mr_cur = mr;
            const float* md = MOD + ((size_t)L * 9 + mr) * 6144; const float* mdn = MOD + ((size_t)Ln * 9 + mr) * 6144;
            const float* gate = md + (MODE == 1 ? 2 : 5) * 1024; const float* sh = mdn + (MODE == 1 ? 3 : 0) * 1024; const float* sc = mdn + (MODE == 1 ? 4 : 1) * 1024;
#pragma unroll
            for (int j = 0; j < 4; ++j) { if (MODE != 0) vgate[j] = *(const f32x4*)(gate + 4 * lane + 256 * j); vsh[j] = *(const f32x4*)(sh + 4 * lane + 256 * j); vsc[j] = *(const f32x4*)(sc + 4 * lane + 256 * j); }
        }
        bf16* hb = (bf16*)HC + (size_t)m * D;
        f32x4 h[4];
        if (first) {
#pragma unroll
            for (int j = 0; j < 4; ++j) h[j] = hf[r][j];
        } else cvt_row_bf16(hr[r], h);
        if (MODE != 0) {
            f32x4 y[4];
            if (moe2) {
                const float w0 = __int_as_float(rw[r].x), w1 = __int_as_float(rw[r].y);
                f32x4 y0[4], y1[4]; cvt_row_bf16(ya[r], y0); cvt_row_bf16(yb[r], y1);
#pragma unroll
                for (int j = 0; j < 4; ++j) y[j] = y0[j] * w0 + y1[j] * w1;
            } else cvt_row_bf16(ya[r], y);
            const float rs = row_rstd(y);
#pragma unroll
            for (int j = 0; j < 4; ++j) h[j] = h[j] + vgate[j] * (y[j] * rs * vgy[j]);
            if (MODE == 2 && L == 3) {
#pragma unroll
                for (int j = 0; j < 4; ++j) __builtin_nontemporal_store(h[j], (f32x4*)(A.out + (size_t)m * D + 4 * lane + 256 * j));
            } else st_row_bf16_nt(hb, lane, h);
        }
        if (MODE == 2 && L == 3) continue;
        const float rs = row_rstd(h);
        f32x4 a[4];
#pragma unroll
        for (int j = 0; j < 4; ++j) a[j] = (h[j] * rs * vgx[j]) * (vsc[j] + 1.0f) + vsh[j];
        if ((MODE == 1 && ((L & 1) ? F8UP_M : F8UP_D)) || (MODE != 1 && F8IN)) {
#pragma unroll
            for (int j = 0; j < 4; ++j) *(unsigned*)((unsigned char*)XN + (size_t)m * D + 4 * lane + 256 * j) = pk4f8(a[j][0], a[j][1], a[j][2], a[j][3]);
        } else { st_row_bf16(XN + (size_t)m * D, lane, a);
            if (MODE != 1 && F8GATE) {
#pragma unroll
                for (int j = 0; j < 4; ++j) *(unsigned*)(ws + WS_XN8 + (size_t)m * D + 4 * lane + 256 * j) = pk4f8(a[j][0], a[j][1], a[j][2], a[j][3]); } }
        if (MODE == 1 && (L & 1)) {
            float lg[8];
#pragma unroll
            for (int e = 0; e < 8; ++e) lg[e] = 0.f;
#pragma unroll
            for (int j = 0; j < 4; ++j)
#pragma unroll
                for (int i = 0; i < 4; ++i) { if ((i & 1) == 0) __builtin_amdgcn_sched_barrier(0); const f32x4 w0 = WL[((j * 4 + i) * 2 + 0) * 64 + lane], w1 = WL[((j * 4 + i) * 2 + 1) * 64 + lane]; const float x = a[j][i];
                    lg[0] += x * w0[0]; lg[1] += x * w0[1]; lg[2] += x * w0[2]; lg[3] += x * w0[3]; lg[4] += x * w1[0]; lg[5] += x * w1[1]; lg[6] += x * w1[2]; lg[7] += x * w1[3]; }
#pragma unroll
            for (int e = 0; e < 8; ++e) lg[e] = wave_sum(lg[e]);
            int e0 = 0; float v0 = lg[0];
#pragma unroll
            for (int e = 1; e < 8; ++e) if (lg[e] > v0) { v0 = lg[e]; e0 = e; }
            int e1 = -1; float v1 = -INFINITY;
#pragma unroll
            for (int e = 0; e < 8; ++e) if (e != e0 && lg[e] > v1) { v1 = lg[e]; e1 = e; }
            const float ex = __expf(v1 - v0), w0 = 1.0f / (1.0f + ex), w1 = ex * w0;
            if (lane == 0) {
                const int r0 = (int)__hip_atomic_fetch_add(cnt + 64 * e0, 1u, __ATOMIC_RELAXED, __HIP_MEMORY_SCOPE_AGENT);
                const int r1 = (int)__hip_atomic_fetch_add(cnt + 64 * e1, 1u, __ATOMIC_RELAXED, __HIP_MEMORY_SCOPE_AGENT);
                int* rt = ROUTE + (size_t)m * 8; rt[0] = e0; rt[1] = e1; rt[2] = r0; rt[3] = r1; rt[4] = __float_as_int(w0); rt[5] = __float_as_int(w1);
            }
        }
        }
    }
    if (rout) __syncthreads();
}
DEV void gather_phase(const Args& A, int L, int vcu, int G, int tid) {
    const int wave = __builtin_amdgcn_readfirstlane(tid >> 6), lane = tid & 63;
    const int gw = vcu * NWAVES + wave, NGW = G * NWAVES;
    unsigned char* ws = A.ws;
    const int nrows = (L == 3) ? ML : MT, mi = L >> 1;
    const unsigned* cnt = (const unsigned*)(ws + WS_CTL) + CW_MOE + mi * 8 * 64;
    int base[8]; moe_bases(cnt, base);
    const bf16* XN = (const bf16*)(ws + WS_XN); bf16* AS = (bf16*)(ws + WS_ASORT); const int* ROUTE = (const int*)(ws + WS_ROUTE);
    constexpr int RB = F8UP_M ? D : 2 * D;
    const int t_beg = (int)(((long)gw * nrows) / NGW), t_end = (int)(((long)(gw + 1) * nrows) / NGW);
    for (int c0 = t_beg; c0 < t_end; c0 += 64) {
        const int c1 = (c0 + 64 < t_end) ? c0 + 64 : t_end;
        int d0, d1; { const int4 rq = *(const int4*)(ROUTE + (size_t)((c0 + lane < c1) ? c0 + lane : c0) * 8); d0 = sel8(base, rq.x) + rq.z; d1 = sel8(base, rq.y) + rq.w; }
        for (int k0 = c0; k0 < c1; k0 += 4) {
            u32x4 v[4], w[4];
#pragma unroll
            for (int q = 0; q < 4; ++q) { const int m = k0 + q; if (m < c1) { const u32x4* src = (const u32x4*)((const unsigned char*)XN + (size_t)m * RB); v[q] = __builtin_nontemporal_load(src + lane); if constexpr (!F8UP_M) w[q] = __builtin_nontemporal_load(src + lane + 64); } }
#pragma unroll
            for (int q = 0; q < 4; ++q) { const int m = k0 + q; if (m < c1) {
                const int e0 = __builtin_amdgcn_readlane(d0, m - c0), e1 = __builtin_amdgcn_readlane(d1, m - c0);
                u32x4* p0 = (u32x4*)((unsigned char*)AS + (size_t)e0 * RB); u32x4* p1 = (u32x4*)((unsigned char*)AS + (size_t)e1 * RB);
                p0[lane] = v[q]; p1[lane] = v[q]; if constexpr (!F8UP_M) { p0[lane + 64] = w[q]; p1[lane + 64] = w[q]; } } }
        }
    }
}

#ifndef MK_VTR
#define MK_VTR 1
#endif
constexpr float LOG2E = 1.4426950408889634f;
constexpr int KS_STRIDE = 144;
constexpr int VS_STRIDE = MK_VTR ? 160 : 144;
constexpr int AT_VT = 9216, AT_BUF = AT_VT + 64 * VS_STRIDE, AT_RPB = 2 * AT_BUF, AT_Q = AT_RPB + 8192;
static_assert(AT_Q + 65536 <= 131072, "attention LDS");
typedef short v4i16_t __attribute__((ext_vector_type(4)));
#define AT_SCHED() __builtin_amdgcn_sched_barrier(0)
DEV float xrow16_max(float x) {
    auto s = __builtin_amdgcn_permlane16_swap(__float_as_uint(x), __float_as_uint(x), false, false);
    x = fmaxf(__uint_as_float(s[0]), __uint_as_float(s[1]));
    auto t = __builtin_amdgcn_permlane32_swap(__float_as_uint(x), __float_as_uint(x), false, false);
    return fmaxf(__uint_as_float(t[0]), __uint_as_float(t[1]));
}
DEV float xrow16_sum(float x) {
    auto s = __builtin_amdgcn_permlane16_swap(__float_as_uint(x), __float_as_uint(x), false, false);
    x = __uint_as_float(s[0]) + __uint_as_float(s[1]);
    auto t = __builtin_amdgcn_permlane32_swap(__float_as_uint(x), __float_as_uint(x), false, false);
    return __uint_as_float(t[0]) + __uint_as_float(t[1]);
}
struct KVRegs { u32x4 k, v; };
DEV void kv_load(KVRegs& r, const bf16* kp, const bf16* vp, int tid) {
    const int row = tid >> 3, c = tid & 7;
    r.k = *(const u32x4*)(kp + (size_t)row * PS + 8 * c); r.v = *(const u32x4*)(vp + (size_t)row * PS + 8 * c);
}
DEV void kv_write(LAS unsigned char* buf, const KVRegs& r, int tid) {
    const int row = tid >> 3, c = tid & 7;
    *(LAS u32x4*)(buf + row * KS_STRIDE + c * 16) = r.k;
#if MK_VTR
    *(LAS u32x4*)(buf + AT_VT + row * VS_STRIDE + c * 16) = r.v;
#else
    LAS unsigned short* p = (LAS unsigned short*)(buf + AT_VT) + (8 * c) * (VS_STRIDE / 2) + row;
    p[0 * (VS_STRIDE / 2)] = (unsigned short)(r.v.x & 0xffffu); p[1 * (VS_STRIDE / 2)] = (unsigned short)(r.v.x >> 16);
    p[2 * (VS_STRIDE / 2)] = (unsigned short)(r.v.y & 0xffffu); p[3 * (VS_STRIDE / 2)] = (unsigned short)(r.v.y >> 16);
    p[4 * (VS_STRIDE / 2)] = (unsigned short)(r.v.z & 0xffffu); p[5 * (VS_STRIDE / 2)] = (unsigned short)(r.v.z >> 16);
    p[6 * (VS_STRIDE / 2)] = (unsigned short)(r.v.w & 0xffffu); p[7 * (VS_STRIDE / 2)] = (unsigned short)(r.v.w >> 16);
#endif
}
DEV bf16x8 v_frag(const LAS unsigned char* buf, int u, int dt, int c16, int q4) {
#if MK_VTR
    const LAS unsigned char* vr = buf + AT_VT + (32 * u + 4 * q4 + (c16 >> 2)) * VS_STRIDE + (16 * dt + 4 * (c16 & 3)) * 2;
    const s16x4 lo = __builtin_bit_cast(s16x4, __builtin_amdgcn_ds_read_tr16_b64_v4i16((LAS v4i16_t*)vr));
    const s16x4 hi = __builtin_bit_cast(s16x4, __builtin_amdgcn_ds_read_tr16_b64_v4i16((LAS v4i16_t*)(vr + 16 * VS_STRIDE)));
#else
    const LAS unsigned char* vr = buf + AT_VT + (16 * dt + c16) * VS_STRIDE + (32 * u + 4 * q4) * 2;
    const s16x4 lo = *(const LAS s16x4*)vr, hi = *(const LAS s16x4*)(vr + 32);
#endif
    return __builtin_shufflevector(lo, hi, 0, 1, 2, 3, 4, 5, 6, 7);
}
template <int NT, int TM0, int TM1, int TM2, int TM3, class F0, class F1, class F2, class F3>
DEV void chunk_tiles(const LAS unsigned char* buf, const LAS unsigned char* ql, float (&m_run)[NT], float (&l_run)[NT], f32x4 (&o)[NT][4], int c16, int q4, F0 mf0, F1 mf1, F2 mf2, F3 mf3) {
    constexpr int TM[4] = {TM0, TM1, TM2, TM3};
    constexpr int TMALL = TM0 | TM1 | (NT > 2 ? (TM2 | TM3) : 0);
    f32x4 s[NT][4];
    {
        bf16x8 kf[4][2];
#pragma unroll
        for (int t = 0; t < 4; ++t)
            if ((TMALL >> t) & 1) {
#pragma unroll
                for (int k = 0; k < 2; ++k) kf[t][k] = *(const LAS bf16x8*)(buf + (16 * t + c16) * KS_STRIDE + (32 * k + 8 * q4) * 2);
            }
#pragma unroll
        for (int j = 0; j < NT; ++j) {
            const bf16x8 q0 = *(const LAS bf16x8*)(ql + (2 * j) * 1024), q1 = *(const LAS bf16x8*)(ql + (2 * j + 1) * 1024);
#pragma unroll
            for (int t = 0; t < 4; ++t) {
                f32x4 acc = {0.f, 0.f, 0.f, 0.f};
                if ((TM[j] >> t) & 1) { acc = MFMA16(kf[t][0], q0, acc); acc = MFMA16(kf[t][1], q1, acc); }
                s[j][t] = acc;
            }
        }
    }
    bf16x8 bp[NT][2];
#pragma unroll
    for (int j = 0; j < NT; ++j) {
        float mx = m_run[j];
#pragma unroll
        for (int t = 0; t < 4; ++t)
            if ((TM[j] >> t) & 1) {
#pragma unroll
                for (int r = 0; r < 4; ++r) { const int kk = 16 * t + 4 * q4 + r; float v = s[j][t][r]; v = (j == 0) ? mf0(kk, v) : (j == 1) ? mf1(kk, v) : (j == 2) ? mf2(kk, v) : mf3(kk, v); s[j][t][r] = v; mx = fmaxf(mx, v); }
            }
        mx = xrow16_max(mx);
        const float alpha = __builtin_amdgcn_exp2f(m_run[j] - mx); m_run[j] = mx;
        float ls = 0.f;
#pragma unroll
        for (int t = 0; t < 4; ++t)
            if ((TM[j] >> t) & 1) {
#pragma unroll
                for (int r = 0; r < 4; ++r) { const float p = __builtin_amdgcn_exp2f(s[j][t][r] - mx); s[j][t][r] = p; ls += p; }
            }
        l_run[j] = l_run[j] * alpha + ls;
#pragma unroll
        for (int dt = 0; dt < 4; ++dt) o[j][dt] = o[j][dt] * alpha;
#pragma unroll
        for (int u = 0; u < 2; ++u) bp[j][u] = pack8(s[j][2 * u], s[j][2 * u + 1]);
    }
#pragma unroll
    for (int u = 0; u < 2; ++u)
        if ((TMALL >> (2 * u)) & 3) {
#pragma unroll
            for (int dt = 0; dt < 4; ++dt) { const bf16x8 vf = v_frag(buf, u, dt, c16, q4);
#pragma unroll
                for (int j = 0; j < NT; ++j) if ((TM[j] >> (2 * u)) & 3) o[j][dt] = MFMA16(vf, bp[j][u], o[j][dt]); }
        }
    AT_SCHED();
}
DEV void attn_store(bf16* dst, float l_run, const f32x4 (&o)[4], int q4) {
    const float inv = 1.0f / xrow16_sum(l_run);
#pragma unroll
    for (int dt = 0; dt < 4; ++dt) { u32x2 u; u.x = pk2(o[dt][0] * inv, o[dt][1] * inv); u.y = pk2(o[dt][2] * inv, o[dt][3] * inv); *(u32x2*)(dst + 16 * dt + 4 * q4) = u; }
}
DEV int na_start(int r) { return r - 4 < 0 ? 0 : (r - 4 > 24 ? 24 : r - 4); }
template <int MODE> DEV void attn4_unit(const Args& A, int L, int unit, LAS unsigned char* lds, int tid) {
    constexpr int NT = (MODE == 3) ? 2 : 4;
    const int w = __builtin_amdgcn_readfirstlane(tid >> 6), lane = tid & 63, c16 = lane & 15, q4 = lane >> 4;
    unsigned char* ws = A.ws;
    const bf16* proj = (const bf16*)(ws + WS_PROJ);
    bf16* ybr = (bf16*)(ws + WS_YBR);
    LAS float* RPB = (LAS float*)(lds + AT_RPB);
    int b, h = 0, kcol, vcol, nlat = 0, lat0 = 0, kr0 = 0, tq = 0, rq = 0;
    size_t qrow0; int qcol0; float m_run[NT], l_run[NT]; int kvh = 0;
    if (MODE == 0 || MODE == 2) {
        if (MODE == 0) { const int qb = unit & 15; kvh = (unit >> 4) & 1; b = unit >> 5; tq = qb * 128 + 16 * w + c16;
            const int lo = qb * 128 - 128 < 0 ? 0 : qb * 128 - 128, hi = qb * 128 + 256 > SEQ ? SEQ : qb * 128 + 256; lat0 = lo; nlat = (hi - lo) >> 6; }
        else { const int qb = unit & 1; kvh = (unit >> 1) & 1; b = unit >> 2; tq = qb * 128 + 16 * w + c16; }
        kcol = 2560 + kvh * 64; vcol = 2688 + kvh * 64;
#pragma unroll
        for (int j = 0; j < NT; ++j) { const int hq = kvh * 4 + j; m_run[j] = A.in[I_SINK][L * 8 + hq] * LOG2E; l_run[j] = q4 == 0 ? 1.f : 0.f; }
        qrow0 = (MODE == 0) ? (size_t)b * SEQ + tq : (size_t)ML + b * LC + tq; qcol0 = 2048 + kvh * 4 * 64;
    } else {
        if (MODE == 1) { const int rg = unit & 3; h = (unit >> 2) & 7; b = unit >> 5; rq = 8 * rg + w; kr0 = na_start(8 * rg); nlat = na_start(8 * rg + 7) + 8 - kr0; }
        else { h = unit & 7; b = unit >> 3; }
        kcol = 3328 + h * 64; vcol = 3840 + h * 64;
#pragma unroll
        for (int j = 0; j < NT; ++j) { m_run[j] = -1e30f; l_run[j] = 0.f; }
        qrow0 = (MODE == 1) ? (size_t)b * SEQ + rq * 64 + c16 : (size_t)ML + b * LC + 32 * w + c16; qcol0 = 2816 + h * 64;
    }
    f32x4 o[NT][4];
#pragma unroll
    for (int j = 0; j < NT; ++j)
#pragma unroll
        for (int dt = 0; dt < 4; ++dt) o[j][dt] = (f32x4){0.f, 0.f, 0.f, 0.f};
    constexpr size_t QSTRIDE = (MODE == 0 || MODE == 2) ? (size_t)64 : (size_t)16 * PS;
    const bf16* qb = proj + qrow0 * PS + qcol0 + 8 * q4;
    LAS unsigned char* ql = lds + AT_Q + w * 8192 + lane * 16;
    const int nch = 4 + nlat;
#define CH_ROW0(ci) ((ci) < 4 ? (size_t)ML + b * LC + (ci) * 64 : (MODE == 0 ? (size_t)b * SEQ + lat0 + ((ci) - 4) * 64 : (size_t)b * SEQ + (kr0 + (ci) - 4) * 64))
#define CH_LOAD(R, ci) do { const size_t r_ = CH_ROW0(ci); kv_load(R, proj + r_ * PS + kcol, proj + r_ * PS + vcol, tid); } while (0)
    KVRegs kvA, kvB;
    __syncthreads();
    if (MODE == 1) {
        for (int i = tid; i < 960; i += NTHREADS) { const int rw = i >> 6, dc = (i & 63) - 16; const bool in = dc >= 0 && dc <= 30;
            const float v = in ? A.in[I_RPB][(size_t)(L * 8 + h) * 465 + rw * 31 + dc] * LOG2E : 0.f;
            RPB[i] = v; RPB[960 + i] = (dc >= 7 && dc <= 22) ? v : -INFINITY; } }
    CH_LOAD(kvA, 0);
    CH_LOAD(kvB, 1);
#pragma unroll
    for (int j = 0; j < NT; ++j)
#pragma unroll
        for (int k = 0; k < 2; ++k) *(LAS u32x4*)(ql + (2 * j + k) * 1024) = *(const u32x4*)(qb + j * QSTRIDE + 32 * k);
    kv_write(lds, kvA, tid);
    CH_LOAD(kvA, 2);
    const int sw = na_start(rq);
    auto compute = [&](int ci) {
        const LAS unsigned char* buf = lds + (ci & 1) * AT_BUF;
        if (ci < 4) {
            auto nomask = [](int, float s) { return s; };
            chunk_tiles<NT, 15, 15, 15, 15>(buf, ql, m_run, l_run, o, c16, q4, nomask, nomask, nomask, nomask);
        } else if constexpr (MODE == 0) {
            const int k0 = lat0 + (ci - 4) * 64, tq0 = tq - c16;
            if (k0 >= tq0 + 15 - 128 && k0 + 63 <= tq0 + 128) {
                auto nomask = [](int, float s) { return s; };
                chunk_tiles<NT, 15, 15, 15, 15>(buf, ql, m_run, l_run, o, c16, q4, nomask, nomask, nomask, nomask);
            } else if (k0 + 63 >= tq0 - 128 && k0 <= tq0 + 15 + 128) {
                auto wmask = [=](int kk, float s) { const int d = tq - (k0 + kk); return (d <= 128 && d >= -128) ? s : -INFINITY; };
                chunk_tiles<NT, 15, 15, 15, 15>(buf, ql, m_run, l_run, o, c16, q4, wmask, wmask, wmask, wmask);
            }
        } else if constexpr (MODE == 1) {
            const int kr = kr0 + ci - 4;
            if (kr >= sw && kr < sw + 8) {
                const LAS float* brow = RPB + (kr - rq + 7) * 64 + 16 + 15 - c16;
#define NA_ME(j) [=](int ck, float s) { const int cq = 16 * (j) + c16; const int cs = cq - 8 < 0 ? 0 : (cq - 8 > 48 ? 48 : cq - 8); return ((unsigned)(ck - cs) < 16u) ? s + brow[ck - 16 * (j)] : -INFINITY; }
#define NA_MI(j) [=](int ck, float s) { return s + brow[960 + ck - 16 * (j)]; }
                chunk_tiles<NT, 3, 7, 14, 12>(buf, ql, m_run, l_run, o, c16, q4, NA_ME(0), NA_MI(1), NA_MI(2), NA_ME(3));
#undef NA_ME
#undef NA_MI
            }
        }
    };
    for (int ci = 0; ci < nch; ci += 2) {
        __syncthreads();
        if (ci + 1 < nch) { kv_write(lds + AT_BUF, kvB, tid); if (ci + 3 < nch) CH_LOAD(kvB, ci + 3); }
        AT_SCHED();
        compute(ci);
        if (ci + 1 >= nch) break;
        __syncthreads();
        if (ci + 2 < nch) { kv_write(lds, kvA, tid); if (ci + 4 < nch) CH_LOAD(kvA, ci + 4); }
        AT_SCHED();
        compute(ci + 1);
    }
#undef CH_LOAD
#undef CH_ROW0
#pragma unroll
    for (int j = 0; j < NT; ++j) {
        size_t qr; int oc, br;
        if (MODE == 0 || MODE == 2) { qr = (MODE == 0) ? (size_t)b * SEQ + tq : (size_t)ML + b * LC + tq; oc = (kvh * 4 + j) * 64; br = 1; }
        else { qr = (MODE == 1) ? (size_t)b * SEQ + rq * 64 + 16 * j + c16 : (size_t)ML + b * LC + 32 * w + 16 * j + c16; oc = h * 64; br = 2; }
        attn_store(ybr + ((size_t)br * MT + qr) * 512 + oc, l_run[j], o[j], q4);
    }
}

constexpr int RS = 136;
DEV void ret_unit_ids(int unit, int& b, int& h, int& ck, size_t& row0) {
    ck = unit % 18; const int bh = unit / 18; h = bh & 3; b = bh >> 2;
    row0 = ck < 16 ? (size_t)b * SEQ + ck * 128 : (size_t)ML + b * LC + (ck - 16) * 128;
}
DEV float log_gamma(const Args& A, int L, int dir, int h) { return log1pf(-__expf(A.in[I_DECAY][L * 8 + dir * 4 + h])); }
constexpr int SC_STRIDE = 288;
constexpr int SC_V = 128 * SC_STRIDE;
DEV void scan_unit(const Args& A, int L, int unit, LAS unsigned char* lds, int tid) {
    const int w = __builtin_amdgcn_readfirstlane(tid >> 6), lane = tid & 63, c16 = lane & 15, q4 = lane >> 4;
    const int dir = unit & 1, bh = unit >> 1, h = bh & 3, b = bh >> 2;
    unsigned char* ws = A.ws; const bf16* proj = (const bf16*)(ws + WS_PROJ);
    const float lg = log_gamma(A, L, dir, h), gC = __expf(lg * 128.0f);
    bf16* ST = (bf16*)(ws + WS_ST) + ((size_t)bh * 18 * 2 + dir) * 16384 + (size_t)(16 * w + c16) * 128 + 4 * q4;
#define SC_CK(s) (dir == 0 ? ((s) < 2 ? 16 + (s) : (s) - 2) : 17 - (s))
#define SC_ROW0(ck) ((ck) < 16 ? (size_t)b * SEQ + (ck) * 128 : (size_t)ML + b * LC + ((ck) - 16) * 128)
    u32x4 rk[4], rv[4];
#define SC_LOAD(s) do { const size_t r0_ = SC_ROW0(SC_CK(s)); _Pragma("unroll") for (int i = 0; i < 4; ++i) { const int q = tid + 512 * i, tk = q >> 4, dc = q & 15; \
        rk[i] = *(const u32x4*)(proj + (r0_ + tk) * PS + 512 + h * 128 + 8 * dc); rv[i] = *(const u32x4*)(proj + (r0_ + tk) * PS + 1024 + h * 128 + 8 * dc); } } while (0)
    f32x4 acc[8];
#pragma unroll
    for (int t = 0; t < 8; ++t) acc[t] = (f32x4){0.f, 0.f, 0.f, 0.f};
    SC_LOAD(0);
    for (int s = 0; s < 18; ++s) {
        { bf16* st = ST + (size_t)SC_CK(s) * 32768;
#pragma unroll
          for (int t = 0; t < 8; ++t) { u32x2 o; o.x = pk2(acc[t][0], acc[t][1]); o.y = pk2(acc[t][2], acc[t][3]); *(u32x2*)(st + 16 * t) = o; } }
        if (s == 17) break;
        __syncthreads();
#pragma unroll
        for (int i = 0; i < 4; ++i) { const int q = tid + 512 * i, tk = q >> 4, dc = q & 15;
            const float wt = dir == 0 ? __expf(lg * (float)(127 - tk)) : __expf(lg * (float)tk);
            u32x4 kw; kw.x = pk2(bflo(rk[i].x) * wt, bfhi(rk[i].x) * wt); kw.y = pk2(bflo(rk[i].y) * wt, bfhi(rk[i].y) * wt); kw.z = pk2(bflo(rk[i].z) * wt, bfhi(rk[i].z) * wt); kw.w = pk2(bflo(rk[i].w) * wt, bfhi(rk[i].w) * wt);
            *(LAS u32x4*)(lds + tk * SC_STRIDE + dc * 16) = kw; *(LAS u32x4*)(lds + SC_V + tk * SC_STRIDE + dc * 16) = rv[i]; }
        if (s + 1 < 17) SC_LOAD(s + 1);
        __syncthreads();
#pragma unroll
        for (int t = 0; t < 8; ++t) acc[t] = acc[t] * gC;
#pragma unroll
        for (int k = 0; k < 4; ++k) {
            const LAS unsigned char* vb = lds + SC_V + (32 * k + 4 * q4 + (c16 >> 2)) * SC_STRIDE + (16 * w + 4 * (c16 & 3)) * 2;
            const s16x4 vlo = __builtin_bit_cast(s16x4, __builtin_amdgcn_ds_read_tr16_b64_v4i16((LAS v4i16_t*)vb)), vhi = __builtin_bit_cast(s16x4, __builtin_amdgcn_ds_read_tr16_b64_v4i16((LAS v4i16_t*)(vb + 16 * SC_STRIDE)));
            const bf16x8 bfrag = __builtin_shufflevector(vlo, vhi, 0, 1, 2, 3, 4, 5, 6, 7);
#pragma unroll
            for (int t = 0; t < 8; ++t) {
                const LAS unsigned char* kb = lds + (32 * k + 4 * q4 + (c16 >> 2)) * SC_STRIDE + (16 * t + 4 * (c16 & 3)) * 2;
                const s16x4 klo = __builtin_bit_cast(s16x4, __builtin_amdgcn_ds_read_tr16_b64_v4i16((LAS v4i16_t*)kb)), khi = __builtin_bit_cast(s16x4, __builtin_amdgcn_ds_read_tr16_b64_v4i16((LAS v4i16_t*)(kb + 16 * SC_STRIDE)));
                acc[t] = MFMA16(__builtin_shufflevector(klo, khi, 0, 1, 2, 3, 4, 5, 6, 7), bfrag, acc[t]);
            }
        }
    }
#undef SC_LOAD
#undef SC_ROW0
#undef SC_CK
    asm volatile("s_waitcnt vmcnt(0)" ::: "memory");
    __syncthreads();
    if (tid == 0) { __builtin_amdgcn_fence(__ATOMIC_RELEASE, "agent"); asm volatile("s_waitcnt vmcnt(0)" ::: "memory");
        __hip_atomic_fetch_add((unsigned*)(ws + WS_CTL) + CW_RFLAG + (L * 32 + bh) * 64, 1u, __ATOMIC_RELAXED, __HIP_MEMORY_SCOPE_AGENT); }
}
DEV void r3_unit(const Args& A, int L, int unit, LAS unsigned char* lds, int tid) {
    const int w = __builtin_amdgcn_readfirstlane(tid >> 6), lane = tid & 63, c16 = lane & 15, q4 = lane >> 4;
    int b, h, ck; size_t row0; ret_unit_ids(unit, b, h, ck, row0);
    unsigned char* ws = A.ws; const bf16* proj = (const bf16*)(ws + WS_PROJ);
    const float lgf = log_gamma(A, L, 0, h), lgb = log_gamma(A, L, 1, h);
    LAS unsigned short* KS = (LAS unsigned short*)lds; LAS unsigned short* VT = KS + 128 * RS;
    if (tid == 0) {
        const unsigned* fl = (const unsigned*)(ws + WS_CTL) + CW_RFLAG + (L * 32 + b * 4 + h) * 64; unsigned sp = 0;
        while (__hip_atomic_load(fl, __ATOMIC_RELAXED, __HIP_MEMORY_SCOPE_AGENT) < 2u) { __builtin_amdgcn_s_sleep(2); if (++sp > (1u << 22)) break; }
        __builtin_amdgcn_fence(__ATOMIC_ACQUIRE, "agent"); asm volatile("s_waitcnt vmcnt(0)" ::: "memory");
    }
    __syncthreads();
    for (int q = tid; q < 2048; q += NTHREADS) { const int i = q >> 4, dc = q & 15;
        const u32x4 kv = *(const u32x4*)(proj + (row0 + i) * PS + 512 + h * 128 + 8 * dc), vv = *(const u32x4*)(proj + (row0 + i) * PS + 1024 + h * 128 + 8 * dc);
        *(LAS u32x4*)(KS + i * RS + 8 * dc) = kv;
        *(LAS u32x4*)((LAS unsigned char*)VT + i * 288 + 16 * dc) = vv; }
    __syncthreads();
    const int n = 16 * w + c16; const size_t row = row0 + n;
    bf16x8 qf[4];
#pragma unroll
    for (int k = 0; k < 4; ++k) qf[k] = *(const bf16x8*)(proj + row * PS + h * 128 + 32 * k + 8 * q4);
    f32x4 sT[8];
#pragma unroll
    for (int t = 0; t < 8; ++t) { f32x4 acc = {0.f, 0.f, 0.f, 0.f};
#pragma unroll
        for (int k = 0; k < 4; ++k) { const bf16x8 a = *(const LAS bf16x8*)(KS + (16 * t + c16) * RS + 32 * k + 8 * q4); acc = MFMA16(a, qf[k], acc); }
#pragma unroll
        for (int r = 0; r < 4; ++r) { const int d = n - (16 * t + 4 * q4 + r); acc[r] *= (d >= 0) ? __expf(lgf * (float)d) : __expf(-lgb * (float)d); }
        sT[t] = acc; }
    f32x4 y[8];
#pragma unroll
    for (int dt = 0; dt < 8; ++dt) y[dt] = (f32x4){0.f, 0.f, 0.f, 0.f};
#pragma unroll
    for (int u = 0; u < 4; ++u) { const bf16x8 bp = pack8(sT[2 * u], sT[2 * u + 1]);
#pragma unroll
        for (int dt = 0; dt < 8; ++dt) { const LAS unsigned char* vr = (const LAS unsigned char*)VT + (32 * u + 4 * q4 + (c16 >> 2)) * 288 + (16 * dt + 4 * (c16 & 3)) * 2;
            const s16x4 lo = __builtin_bit_cast(s16x4, __builtin_amdgcn_ds_read_tr16_b64_v4i16((LAS v4i16_t*)vr)), hi = __builtin_bit_cast(s16x4, __builtin_amdgcn_ds_read_tr16_b64_v4i16((LAS v4i16_t*)(vr + 16 * 288)));
            y[dt] = MFMA16(__builtin_shufflevector(lo, hi, 0, 1, 2, 3, 4, 5, 6, 7), bp, y[dt]); } }
    const float df = __expf(lgf * (float)(n + 1)), db = __expf(lgb * (float)(128 - n));
    bf16x8 qdf[4], qdb[4];
#pragma unroll
    for (int k = 0; k < 4; ++k) { const u32x4 qq = __builtin_bit_cast(u32x4, qf[k]); u32x4 f, g;
        f.x = pk2(bflo(qq.x) * df, bfhi(qq.x) * df); f.y = pk2(bflo(qq.y) * df, bfhi(qq.y) * df); f.z = pk2(bflo(qq.z) * df, bfhi(qq.z) * df); f.w = pk2(bflo(qq.w) * df, bfhi(qq.w) * df);
        g.x = pk2(bflo(qq.x) * db, bfhi(qq.x) * db); g.y = pk2(bflo(qq.y) * db, bfhi(qq.y) * db); g.z = pk2(bflo(qq.z) * db, bfhi(qq.z) * db); g.w = pk2(bflo(qq.w) * db, bfhi(qq.w) * db);
        qdf[k] = __builtin_bit_cast(bf16x8, f); qdb[k] = __builtin_bit_cast(bf16x8, g); }
    const bf16* STf = (const bf16*)(ws + WS_ST) + (size_t)unit * 2 * 16384; const bf16* STb = STf + 16384;
#pragma unroll
    for (int dt = 0; dt < 8; ++dt)
#pragma unroll
        for (int k = 0; k < 4; ++k) { const bf16x8 a = *(const bf16x8*)(STf + (16 * dt + c16) * 128 + 32 * k + 8 * q4), a2 = *(const bf16x8*)(STb + (16 * dt + c16) * 128 + 32 * k + 8 * q4);
            y[dt] = MFMA16(a, qdf[k], y[dt]); y[dt] = MFMA16(a2, qdb[k], y[dt]); }
    float s = 0.f;
#pragma unroll
    for (int dt = 0; dt < 8; ++dt) s += (y[dt][0] + y[dt][1]) + (y[dt][2] + y[dt][3]);
    s = xrow16_sum(s);
    const float mu = s * (1.0f / 128.0f); float v = 0.f;
#pragma unroll
    for (int dt = 0; dt < 8; ++dt) { const f32x4 d = y[dt] - mu; v += (d[0] * d[0] + d[1] * d[1]) + (d[2] * d[2] + d[3] * d[3]); }
    v = xrow16_sum(v);
    const float rstd = rsqrtf(v * (1.0f / 128.0f) + EPS);
    bf16* yo = (bf16*)(ws + WS_YBR) + row * 512 + h * 128;
#pragma unroll
    for (int dt = 0; dt < 8; ++dt) { const u32x2 g = *(const u32x2*)(proj + row * PS + 1536 + h * 128 + 16 * dt + 4 * q4);
        u32x2 o; o.x = pk2(bflo(g.x) * (y[dt][0] - mu) * rstd, bfhi(g.x) * (y[dt][1] - mu) * rstd); o.y = pk2(bflo(g.y) * (y[dt][2] - mu) * rstd, bfhi(g.y) * (y[dt][3] - mu) * rstd);
        *(u32x2*)(yo + 16 * dt + 4 * q4) = o; }
}


DEV void panel_signal(unsigned* flag) {
    asm volatile("s_waitcnt vmcnt(0)" ::: "memory");
    __syncthreads();
    if (threadIdx.x == 0) {
        __builtin_amdgcn_fence(__ATOMIC_RELEASE, "agent"); asm volatile("s_waitcnt vmcnt(0)" ::: "memory");
        __hip_atomic_fetch_add(flag, 1u, __ATOMIC_RELAXED, __HIP_MEMORY_SCOPE_AGENT);
    }
}
DEV void panel_wait(const unsigned* flag) {
    if (threadIdx.x == 0) {
        unsigned sp = 0;
        for (int p = 0; p < 8; ++p)
            while (__hip_atomic_load(flag + p * 64, __ATOMIC_RELAXED, __HIP_MEMORY_SCOPE_AGENT) < 4u) { __builtin_amdgcn_s_sleep(2); if (++sp > (1u << 22)) break; }
        __builtin_amdgcn_fence(__ATOMIC_ACQUIRE, "agent"); asm volatile("s_waitcnt vmcnt(0)" ::: "memory");
    }
    __syncthreads();
}
__global__ void __launch_bounds__(NTHREADS, 2) mk_fwd(Args args) {
    extern __shared__ __attribute__((aligned(16))) unsigned char lds_raw[];
    LAS unsigned char* lds = (LAS unsigned char*)lds_raw;
    const int tid = threadIdx.x, G = gridDim.x;
    const int bx = blockIdx.x, vcu = (G % 8 == 0) ? (bx % 8) * (G / 8) + bx / 8 : bx;
    unsigned char* ws = args.ws;
    volatile LAS unsigned* MISC = (volatile LAS unsigned*)(lds + MISC_OFF);
    for (int u = tid; u < (LDS_BYTES - 131072) / 4; u += NTHREADS) ((LAS unsigned*)(lds + 131072))[u] = 0u;
    __syncthreads();
    const int lo = args.ph_lo, hi = args.ph_hi;
    XcdBarrier bar; bar.bar = (unsigned*)(ws + WS_CTL) + CW_BAR; bar.x = 0; bar.st = nullptr;
    if (hi - lo > 1) bar = xcd_barrier_post((unsigned*)(ws + WS_CTL) + CW_BAR, MISC + 8);
#define IN(k) (lo <= (k) && (k) < hi)
#define EN(b) (((MK_EN) >> (b)) & 1u)
#define REP(b) for (int _rp = 0; _rp < 1 + (int)(((MK_REP) >> (b)) & 1u); ++_rp)
#define OT() ({ int _t = threadIdx.x; asm volatile("" : "+v"(_t)); _t; })
#define SEAM(k) do { if (IN(k) && IN((k) + 1)) xcd_barrier(bar); } while (0)
    const pg8::bf16_t* XN = (const pg8::bf16_t*)(ws + WS_XN);
    pg8::bf16_t* PROJ = (pg8::bf16_t*)(ws + WS_PROJ);
    const float* TAB = (const float*)(ws + WS_TAB);

    if (EN(0) && IN(0)) REP(0) { p0_prologue(args, lds, vcu, G, OT()); } SEAM(0);
    if (EN(1) && IN(1)) REP(1) { thin_phase<0>(args, 0, vcu, G, 0, MT, OT(), lds); } SEAM(1);
    for (int L = 0; L < DEPTH; ++L) {
        const int pb = 2 + 11 * L;
        const bool need_ctx = L < DEPTH - 1;
        const int Mact = need_ctx ? MT : ML;
        if (EN(2) && IN(pb + 0)) REP(2) {
            if constexpr (F8GATE) {
                { pg8::Gemm g{XN, (const pg8::bf16_t*)(ws + WS_WIN + (size_t)L * DIN * 1024 * 2), MT, 4352, 1024}; pg8::StaticOrder S; S.init(MT, 4352, G, bx);
                  pg8::EpiInProj<false> E{PROJ, TAB + TAB_RTC, TAB + TAB_RTS, TAB + TAB_AXC, TAB + TAB_AXS, 1.0f, 0};
                  pg8::gemm_phase<pg8::EpiInProj<false>, pg8::StaticOrder, true, true, false>(lds, g, S, E); }
                { pg8::Gemm g{(const pg8::bf16_t*)(ws + WS_XN8), (const pg8::bf16_t*)(ws + WS_WIN8 + (size_t)L * 3072 * 1024), MT, 3072, 512}; pg8::TailOrder S; S.init(MT, 3072, G, bx); S.cut = (72 * 17) % G; S.base = (72 * 12) / G; if (S.cut == 0) S.base = 1 << 20;
                  pg8::EpiGate E{ws + WS_G8};
                  pg8::gemm_phase<pg8::EpiGate, pg8::TailOrder, true, true, true>(lds, g, S, E); }
            } else {
            pg8::Gemm g{XN, (const pg8::bf16_t*)(ws + WS_WIN + (size_t)L * DIN * 1024 * (F8IN ? 1 : 2)), MT, DIN, F8IN ? 512 : 1024}; pg8::StaticOrder S; S.init(MT, DIN, G, bx);
            pg8::EpiInProj<true> E{PROJ, TAB + TAB_RTC, TAB + TAB_RTS, TAB + TAB_AXC, TAB + TAB_AXS, F8IN ? 0.015625f : 1.0f, 0};
            pg8::gemm_phase<pg8::EpiInProj<true>, pg8::StaticOrder, true, true, F8IN>(lds, g, S, E);
            }
        } SEAM(pb + 0);
        if (IN(pb + 1)) {
            unsigned* wq = (unsigned*)(ws + WS_CTL) + CW_WQ + L * 64;
            const int n_ctx = need_ctx ? 96 : 0, n_att = 64 + 256 + 256 + n_ctx, n_units = n_att + (need_ctx ? 576 : 512);
            for (;;) {
                if (threadIdx.x == 0) MISC[16] = __hip_atomic_fetch_add(wq, 1u, __ATOMIC_RELAXED, __HIP_MEMORY_SCOPE_AGENT);
                __syncthreads();
                const int u = (int)MISC[16];
                __syncthreads();
                if (u >= n_units) break;
                const int n_r3 = need_ctx ? 576 : 512;
                if (u < 64) { if (EN(6)) scan_unit(args, L, u, lds, OT()); }
                else if (u < 320) { if (EN(4)) attn4_unit<1>(args, L, u - 64, lds, OT()); }
                else if (u < 320 + n_r3) { const int v = u - 320; if (EN(8)) r3_unit(args, L, need_ctx ? v : (v >> 4) * 18 + (v & 15), lds, OT()); }
                else if (u < 576 + n_r3) { if (EN(3)) attn4_unit<0>(args, L, u - 320 - n_r3, lds, OT()); }
                else if (u < 608 + n_r3) { if (EN(5)) attn4_unit<2>(args, L, u - 576 - n_r3, lds, OT()); }
                else { if (EN(5)) attn4_unit<3>(args, L, u - 608 - n_r3, lds, OT()); }
            }
        } SEAM(pb + 1);
        if (EN(9) && IN(pb + 4)) REP(9) {
            pg8::Gemm g{(const pg8::bf16_t*)(ws + WS_YBR), (const pg8::bf16_t*)(ws + WS_WBR) + (size_t)L * 3 * 1024 * 512, 3 * MT, 3 * 1024, 512};
            { pg8::BranchOrder S{(ML / 256) * 4, G, vcu};
              pg8::EpiBranch E{ws + WS_G8, (pg8::bf16_t*)(ws + WS_MERGED)};
              pg8::gemm_phase<pg8::EpiBranch, pg8::BranchOrder, true, true>(lds, g, S, E); }
            if (need_ctx) { pg8::PartOrder S{G, vcu};
              pg8::EpiBranchPart E{ws + WS_G8, (pg8::bf16_t*)(ws + WS_PART)};
              pg8::gemm_phase<pg8::EpiBranchPart, pg8::PartOrder, true, true>(lds, g, S, E); }
        } SEAM(pb + 4);
#define BAR_ALWAYS() do { if (hi - lo > 1) xcd_barrier(bar); } while (0)
        if (EN(10) && IN(pb + 5)) {
            const pg8::bf16_t* Wo = (const pg8::bf16_t*)(ws + WS_WOUT) + (size_t)L * 1024 * 1024;
            if (need_ctx) {
                { pg8::Gemm g{(const pg8::bf16_t*)(ws + WS_MERGED), Wo, ML, 1024, 1024}; pg8::StaticOrder S; S.init(ML, 1024, G, bx);
                  pg8::EpiPlain E{(pg8::bf16_t*)(ws + WS_YOUT), 1024, 4, 1.0f};
                  pg8::gemm_phase<pg8::EpiPlain, pg8::StaticOrder, true, true>(lds, g, S, E); }
                { const int t_ = OT(), lane_ = t_ & 63;
                  for (int row = vcu * 8 + (t_ >> 6); row < MC; row += G * 8) {
                      const unsigned char* pp = ws + WS_PART + ((size_t)row * 1024 + lane_ * 16) * 2;
                      float f[16];
#pragma unroll
                      for (int r = 0; r < 3; ++r) {
                          const uint4 w0 = *(const uint4*)(pp + (size_t)r * MC * 2048), w1 = *(const uint4*)(pp + (size_t)r * MC * 2048 + 16);
                          const unsigned ww[8] = {w0.x, w0.y, w0.z, w0.w, w1.x, w1.y, w1.z, w1.w};
#pragma unroll
                          for (int k = 0; k < 8; ++k) { const float lo_ = __uint_as_float(ww[k] << 16), hi_ = __uint_as_float(ww[k] & 0xffff0000u);
                              if (r == 0) { f[2 * k] = lo_; f[2 * k + 1] = hi_; } else { f[2 * k] += lo_; f[2 * k + 1] += hi_; } }
                      }
                      uint4 o0, o1;
                      o0.x = pg8::cvt_pk_bf16(f[0], f[1]); o0.y = pg8::cvt_pk_bf16(f[2], f[3]); o0.z = pg8::cvt_pk_bf16(f[4], f[5]); o0.w = pg8::cvt_pk_bf16(f[6], f[7]);
                      o1.x = pg8::cvt_pk_bf16(f[8], f[9]); o1.y = pg8::cvt_pk_bf16(f[10], f[11]); o1.z = pg8::cvt_pk_bf16(f[12], f[13]); o1.w = pg8::cvt_pk_bf16(f[14], f[15]);
                      unsigned char* op = ws + WS_MERGED + ((size_t)(ML + row) * 1024 + lane_ * 16) * 2;
                      *(uint4*)op = o0; *(uint4*)(op + 16) = o1;
                  } }
                BAR_ALWAYS();
                if (vcu < 32) { pg8::Gemm g{(const pg8::bf16_t*)(ws + WS_MERGED) + (size_t)ML * 1024, Wo, MC, 1024, 1024}; pg8::StaticOrder S; S.init(MC, 1024, 32, vcu);
                  pg8::EpiPlain E{(pg8::bf16_t*)(ws + WS_YOUT) + (size_t)ML * 1024, 1024, 4, 1.0f};
                  pg8::gemm_phase<pg8::EpiPlain, pg8::StaticOrder, true, true>(lds, g, S, E);
                  panel_signal((unsigned*)(ws + WS_CTL) + CW_PFLAG + ((L * 2 + 0) * 8 + (((vcu % 8) * 4 + vcu / 8) & 7)) * 64); }
                else thin_phase<1>(args, L, vcu - 32, G - 32, 0, ML, OT(), lds);
                panel_wait((const unsigned*)(ws + WS_CTL) + CW_PFLAG + (L * 2 + 0) * 8 * 64);
                thin_phase<1>(args, L, vcu, G, ML, MT, OT(), lds);
            } else {
                pg8::Gemm g{(const pg8::bf16_t*)(ws + WS_MERGED), Wo, ML, 1024, 1024}; pg8::StaticOrder S; S.init(ML, 1024, G, bx);
                pg8::EpiPlain E{(pg8::bf16_t*)(ws + WS_YOUT), 1024, 4, 1.0f};
                pg8::gemm_phase<pg8::EpiPlain, pg8::StaticOrder, true, true>(lds, g, S, E);
            }
        } SEAM(pb + 5);
        if (EN(11) && IN(pb + 6)) { if (!need_ctx) thin_phase<1>(args, L, vcu, G, 0, ML, OT(), lds); } if (!need_ctx) SEAM(pb + 6);
        if (L & 1) {
            const int mi = L >> 1;
            const unsigned* cnt = (const unsigned*)(ws + WS_CTL) + CW_MOE + mi * 8 * 64;
            if (EN(12) && IN(pb + 7)) REP(12) { gather_phase(args, L, vcu, G, OT()); } SEAM(pb + 7);
            if (EN(13) && IN(pb + 8)) REP(13) {
                constexpr int EB = F8UP_M ? 1 : 2;
                pg8::Gemm g{(const pg8::bf16_t*)(ws + WS_ASORT), (const pg8::bf16_t*)(ws + WS_WM13 + (size_t)mi * 8 * 2 * FFE * 1024 * EB), MSORT, 8 * 2 * FFE, 512 * EB};
                pg8::MoeOrder S; S.init(cnt, 28, G, bx);
                pg8::EpiSwiGLUx<F8UP_M, F8DN_M> E{ws + WS_HID, FFE, 28};
                pg8::gemm_phase<pg8::EpiSwiGLUx<F8UP_M, F8DN_M>, pg8::MoeOrder, true, true, F8UP_M>(lds, g, S, E);
            } SEAM(pb + 8);
            if (EN(14) && IN(pb + 9)) REP(14) {
                constexpr int EB = F8DN_M ? 1 : 2;
                pg8::Gemm g{(const pg8::bf16_t*)(ws + WS_HID), (const pg8::bf16_t*)(ws + WS_WM2 + (size_t)mi * 8 * 1024 * FFE * EB), MSORT, 8 * 1024, FFE / 2 * EB};
                pg8::MoeOrder S; S.init(cnt, 4, G, bx);
                pg8::EpiPlain E{(pg8::bf16_t*)(ws + WS_OSORT), 1024, 4, F8DN_M ? 1.0f / 2048.0f : 1.0f};
                pg8::gemm_phase<pg8::EpiPlain, pg8::MoeOrder, true, true, F8DN_M>(lds, g, S, E);
            } SEAM(pb + 9);
        } else {
            const int fi = L >> 1;
            if (EN(15) && IN(pb + 8)) REP(15) {
                constexpr int EB = F8UP_D ? 1 : 2;
                pg8::Gemm g{XN, (const pg8::bf16_t*)(ws + WS_WF13 + (size_t)fi * 2 * FFD * 1024 * EB), Mact, 2 * FFD, 512 * EB}; pg8::StaticOrder S; S.init(Mact, 2 * FFD, G, bx);
                pg8::EpiSwiGLUx<F8UP_D, F8DN_D> E{ws + WS_HID, FFD, 22};
                pg8::gemm_phase<pg8::EpiSwiGLUx<F8UP_D, F8DN_D>, pg8::StaticOrder, true, true, F8UP_D>(lds, g, S, E);
            } SEAM(pb + 8);
            if (EN(16) && IN(pb + 9)) {
                constexpr int EB = F8DN_D ? 1 : 2; constexpr float sc = F8DN_D ? 1.0f / 2048.0f : 1.0f;
                const pg8::bf16_t* W2 = (const pg8::bf16_t*)(ws + WS_WF2 + (size_t)fi * 1024 * FFD * EB);
                { pg8::Gemm g{(const pg8::bf16_t*)(ws + WS_HID), W2, ML, 1024, FFD / 2 * EB}; pg8::StaticOrder S; S.init(ML, 1024, G, bx);
                  pg8::EpiPlain E{(pg8::bf16_t*)(ws + WS_YOUT), 1024, 4, sc};
                  pg8::gemm_phase<pg8::EpiPlain, pg8::StaticOrder, true, true, F8DN_D>(lds, g, S, E); }
                BAR_ALWAYS();
                if (vcu < 32) { pg8::Gemm g{(const pg8::bf16_t*)(ws + WS_HID + (size_t)ML * FFD * EB), W2, MC, 1024, FFD / 2 * EB}; pg8::StaticOrder S; S.init(MC, 1024, 32, vcu);
                  pg8::EpiPlain E{(pg8::bf16_t*)(ws + WS_YOUT) + (size_t)ML * 1024, 1024, 4, sc};
                  pg8::gemm_phase<pg8::EpiPlain, pg8::StaticOrder, true, true, F8DN_D>(lds, g, S, E);
                  panel_signal((unsigned*)(ws + WS_CTL) + CW_PFLAG + ((L * 2 + 1) * 8 + (((vcu % 8) * 4 + vcu / 8) & 7)) * 64); }
                else thin_phase<2>(args, L, vcu - 32, G - 32, 0, ML, OT(), lds);
                panel_wait((const unsigned*)(ws + WS_CTL) + CW_PFLAG + (L * 2 + 1) * 8 * 64);
                thin_phase<2>(args, L, vcu, G, ML, MT, OT(), lds);
            } SEAM(pb + 9);
        }
        if (EN(17) && IN(pb + 10)) { if (L & 1) thin_phase<2>(args, L, vcu, G, 0, Mact, OT(), lds); } if (L & 1) SEAM(pb + 10);
    }
#undef IN
#undef SEAM
}


extern "C" void kernel_launch(void* const* d_in, const int* in_sizes, int n_in, void* d_out, int out_size, void* d_ws, size_t ws_size, hipStream_t stream) {
    static int grid = 0;
    if (grid == 0) {
        if (n_in != 20 || out_size != ML * D || ws_size < WS_END) { fprintf(stderr, "kernel_launch: unexpected shapes (n_in %d out %d ws %zu need %zu)\n", n_in, out_size, ws_size, (size_t)WS_END); grid = -1; return; }
        int dev = 0, cus = 0;
        if (hipGetDevice(&dev) != hipSuccess || hipDeviceGetAttribute(&cus, hipDeviceAttributeMultiprocessorCount, dev) != hipSuccess) { grid = -1; return; }
        if (hipFuncSetAttribute((const void*)mk_fwd, hipFuncAttributeMaxDynamicSharedMemorySize, LDS_BYTES) != hipSuccess) { fprintf(stderr, "kernel_launch: hipFuncSetAttribute failed\n"); grid = -1; return; }
        int per_cu = 0;
        (void)hipOccupancyMaxActiveBlocksPerMultiprocessor(&per_cu, (const void*)mk_fwd, NTHREADS, LDS_BYTES);
        (void)hipGetLastError();
        grid = cus;
    }
    if (grid < 0) return;
    (void)hipMemsetAsync((char*)d_ws + WS_CTL, 0, CTL_ZERO_BYTES, stream);
    Args a{};
    for (int i = 0; i < 20; ++i) a.in[i] = (const float*)d_in[i];
    a.out = (float*)d_out; a.ws = (unsigned char*)d_ws; a.li = 0; a.pad = 0;
#if MK_PER_PHASE
    for (int ph = 0; ph < MK_NPH_RUN; ++ph) { a.ph_lo = ph; a.ph_hi = ph + 1; hipLaunchKernelGGL(mk_fwd, dim3(grid), dim3(NTHREADS), LDS_BYTES, stream, a); }
#else
    a.ph_lo = 0; a.ph_hi = MK_NPH_RUN;
    hipLaunchKernelGGL(mk_fwd, dim3(grid), dim3(NTHREADS), LDS_BYTES, stream, a);
#endif
}
```
